# Optimizing an MI355X kernel written in HIP

```python
import math
import jax, jax.numpy as jnp
from jax import lax
import numpy as np

D_MODEL = 1024
BATCH = 8
SEQ = 2048
DEPTH = 2
DEC_BATCH = 32
DEC_SEQ = 32
PAST_LEN = 1024

CHUNK = 64
LEFT_CHUNKS = 8
BAND = (LEFT_CHUNKS + 1) * CHUNK
Q_BLOCK = 128
HEAD_DIM = 64
A_HEADS = D_MODEL // (2 * HEAD_DIM)
B_HEADS = D_MODEL // HEAD_DIM
D_FF = 4 * D_MODEL
REL_CLIP = 128
ROPE_THETA = 10000.0
EPS = 1e-6
NEG_INF = -1e30
N_A = DEPTH // 2
N_B = DEPTH - N_A

kernel_name = "yoco_diffattn_chunkband_stream_step"


def rmsnorm(x, g):
    xf = x.astype(jnp.float32)
    y = xf * lax.rsqrt(jnp.mean(xf * xf, axis=-1, keepdims=True) + EPS)
    return (y * g.astype(jnp.float32)).astype(x.dtype)


def rope(x, pos):
    half = HEAD_DIM // 2
    inv = 1.0 / (ROPE_THETA ** (jnp.arange(half, dtype=jnp.float32) / half))
    ang = pos.astype(jnp.float32)[:, None] * inv[None, :]
    cos = jnp.cos(ang)[:, None, None, :]
    sin = jnp.sin(ang)[:, None, None, :]
    xf = x.astype(jnp.float32)
    x1, x2 = xf[..., :half], xf[..., half:]
    return jnp.concatenate([x1 * cos - x2 * sin, x2 * cos + x1 * sin], axis=-1).astype(x.dtype)


def lambda_init(layer):
    return 0.8 - 0.6 * math.exp(-0.3 * layer)


def diff_lambda(lp, lam0):
    lp = lp.astype(jnp.float32)
    return jnp.exp(jnp.sum(lp[0] * lp[1])) - jnp.exp(jnp.sum(lp[2] * lp[3])) + lam0


def diff_weights(q, k, lam, mask):
    s = jnp.einsum("bqhcd,bkhcd->bhcqk", q, k).astype(jnp.float32) * (HEAD_DIM ** -0.5)
    if mask is not None:
        s = jnp.where(mask, s, NEG_INF)
    p = jax.nn.softmax(s, axis=-1)
    return p[:, :, 0] - lam * p[:, :, 1]


def diff_attn_prompt(q, k, v, lam):
    nb, ns = q.shape[0], q.shape[1]
    nblk = ns // Q_BLOCK
    qb = q.reshape(nb, nblk, Q_BLOCK, A_HEADS, 2, HEAD_DIM).transpose(1, 0, 2, 3, 4, 5)
    k_chunk = jnp.arange(ns) // CHUNK

    def one(args):
        qi, bi = args
        q_chunk = (bi * Q_BLOCK + jnp.arange(Q_BLOCK)) // CHUNK
        mask = q_chunk[:, None] >= k_chunk[None, :]
        p = diff_weights(qi, k, lam, mask)
        return jnp.einsum("bhqk,bkhe->bqhe", p.astype(v.dtype), v)

    o = lax.map(one, (qb, jnp.arange(nblk)))
    return o.transpose(1, 0, 2, 3, 4).reshape(nb, ns, A_HEADS, 2 * HEAD_DIM)


def diff_attn_full(q, k, v, lam):
    p = diff_weights(q, k, lam, None)
    return jnp.einsum("bhqk,bkhe->bqhe", p.astype(v.dtype), v)


def rel_bias(table, rel):
    idx = jnp.clip(rel, -REL_CLIP, REL_CLIP) + REL_CLIP
    return table.astype(jnp.float32)[:, idx]


def band_attn_prompt(q, k, v, table):
    nb, ns = q.shape[0], q.shape[1]
    nc = ns // CHUNK
    pad = LEFT_CHUNKS * CHUNK
    kp = jnp.pad(k, ((0, 0), (pad, 0), (0, 0), (0, 0)))
    vp = jnp.pad(v, ((0, 0), (pad, 0), (0, 0), (0, 0)))
    qc = q.reshape(nb, nc, CHUNK, B_HEADS, HEAD_DIM).transpose(1, 0, 2, 3, 4)
    rel = pad + jnp.arange(CHUNK)[:, None] - jnp.arange(BAND)[None, :]
    bias = rel_bias(table, rel)[None]

    def one(args):
        qi, ci = args
        kb = lax.dynamic_slice_in_dim(kp, ci * CHUNK, BAND, axis=1)
        vb = lax.dynamic_slice_in_dim(vp, ci * CHUNK, BAND, axis=1)
        valid = jnp.arange(BAND) >= (LEFT_CHUNKS - ci) * CHUNK
        s = jnp.einsum("bqhd,bkhd->bhqk", qi, kb).astype(jnp.float32) * (HEAD_DIM ** -0.5) + bias
        p = jax.nn.softmax(jnp.where(valid, s, NEG_INF), axis=-1)
        return jnp.einsum("bhqk,bkhd->bqhd", p.astype(vb.dtype), vb)

    o = lax.map(one, (qc, jnp.arange(nc)))
    return o.transpose(1, 0, 2, 3, 4).reshape(nb, ns, B_HEADS * HEAD_DIM)


def band_attn_sample(q, k_new, v_new, cache_k, cache_v, table, past):
    nb, nt = q.shape[0], q.shape[1]
    lb = cache_k.shape[1]
    k_all = jnp.concatenate([cache_k, k_new], axis=1)
    v_all = jnp.concatenate([cache_v, v_new], axis=1)
    qpos = jnp.arange(past, past + nt)
    kpos = jnp.arange(past - lb, past + nt)
    bias = rel_bias(table, qpos[:, None] - kpos[None, :])[None]
    s = jnp.einsum("bqhd,bkhd->bhqk", q, k_all).astype(jnp.float32) * (HEAD_DIM ** -0.5) + bias
    p = jax.nn.softmax(s, axis=-1)
    return jnp.einsum("bhqk,bkhd->bqhd", p.astype(v_all.dtype), v_all).reshape(nb, nt, B_HEADS * HEAD_DIM)


def sq_relu_mlp(h, w1, w2):
    return jnp.square(jax.nn.relu(h @ w1)) @ w2


def _trunk(x, pos, cache_a_k, cache_a_v, cache_b_k, cache_b_v,
           g_attn, w_a_qkv, a_lambda, a_subln, w_a_o, g_kv, w_kv, w_b_q, b_rel, w_b_o,
           g_mlp, w_ff1, w_ff2, g_final):
    prompt = cache_a_k is None
    nb, ns = x.shape[0], x.shape[1]
    h = x
    new_ak, new_av = [], []
    k_sh = v_sh = None
    for l in range(DEPTH):
        if l < N_A:
            hn = rmsnorm(h, g_attn[l])
            q, k, v = jnp.split(hn @ w_a_qkv[l], 3, axis=-1)
            q = rope(q.reshape(nb, ns, A_HEADS, 2, HEAD_DIM), pos)
            k = rope(k.reshape(nb, ns, A_HEADS, 2, HEAD_DIM), pos)
            v = v.reshape(nb, ns, A_HEADS, 2 * HEAD_DIM)
            new_ak.append(k.reshape(nb, ns, A_HEADS, 2 * HEAD_DIM))
            new_av.append(v)
            lam0 = lambda_init(l)
            lam = diff_lambda(a_lambda[l], lam0)
            if prompt:
                o = diff_attn_prompt(q, k, v, lam)
            else:
                past = cache_a_k.shape[2]
                k_all = jnp.concatenate(
                    [cache_a_k[l].reshape(nb, past, A_HEADS, 2, HEAD_DIM), k], axis=1)
                v_all = jnp.concatenate([cache_a_v[l], v], axis=1)
                o = diff_attn_full(q, k_all, v_all, lam)
            o = rmsnorm(o, a_subln[l]) * (1.0 - lam0)
            h = h + o.reshape(nb, ns, D_MODEL) @ w_a_o[l]
        else:
            j = l - N_A
            if j == 0:
                kv = rmsnorm(h, g_kv) @ w_kv
                k_sh, v_sh = jnp.split(kv, 2, axis=-1)
                k_sh = k_sh.reshape(nb, ns, B_HEADS, HEAD_DIM)
                v_sh = v_sh.reshape(nb, ns, B_HEADS, HEAD_DIM)
            q = (rmsnorm(h, g_attn[l]) @ w_b_q[j]).reshape(nb, ns, B_HEADS, HEAD_DIM)
            if prompt:
                o = band_attn_prompt(q, k_sh, v_sh, b_rel[j])
            else:
                o = band_attn_sample(q, k_sh, v_sh, cache_b_k, cache_b_v, b_rel[j], cache_a_k.shape[2])
            h = h + o @ w_b_o[j]
        h = h + sq_relu_mlp(rmsnorm(h, g_mlp[l]), w_ff1[l], w_ff2[l])
    y = rmsnorm(h, g_final)
    if prompt:
        keep = min(LEFT_CHUNKS * CHUNK, ns)
        k_sh, v_sh = k_sh[:, ns - keep:], v_sh[:, ns - keep:]
    return y, jnp.stack(new_ak), jnp.stack(new_av), k_sh, v_sh


def setup_inputs(seed: int = 0) -> dict:
    key = jax.random.key(seed)
    ks = jax.random.split(key, 20)
    f32 = jnp.float32
    lb = min(LEFT_CHUNKS * CHUNK, PAST_LEN)

    def nrm(k, shape, scale):
        return jax.random.normal(k, shape, f32) * scale

    return {
        "x_prompt": nrm(ks[0], (BATCH, SEQ, D_MODEL), 1.0),
        "x_sample": nrm(ks[1], (DEC_BATCH, DEC_SEQ, D_MODEL), 1.0),
        "cache_a_k": nrm(ks[2], (N_A, DEC_BATCH, PAST_LEN, A_HEADS, 2 * HEAD_DIM), 1.0),
        "cache_a_v": nrm(ks[3], (N_A, DEC_BATCH, PAST_LEN, A_HEADS, 2 * HEAD_DIM), 1.0),
        "cache_b_k": nrm(ks[4], (DEC_BATCH, lb, B_HEADS, HEAD_DIM), 1.0),
        "cache_b_v": nrm(ks[5], (DEC_BATCH, lb, B_HEADS, HEAD_DIM), 1.0),
        "g_attn": 1.0 + nrm(ks[6], (DEPTH, D_MODEL), 0.02),
        "w_a_qkv": nrm(ks[7], (N_A, D_MODEL, 3 * D_MODEL), D_MODEL ** -0.5),
        "a_lambda": nrm(ks[8], (N_A, 4, HEAD_DIM), 0.1),
        "a_subln": 1.0 + nrm(ks[9], (N_A, 2 * HEAD_DIM), 0.02),
        "w_a_o": nrm(ks[10], (N_A, D_MODEL, D_MODEL), D_MODEL ** -0.5),
        "g_kv": 1.0 + nrm(ks[11], (D_MODEL,), 0.02),
        "w_kv": nrm(ks[12], (D_MODEL, 2 * D_MODEL), D_MODEL ** -0.5),
        "w_b_q": nrm(ks[13], (N_B, D_MODEL, D_MODEL), D_MODEL ** -0.5),
        "b_rel": nrm(ks[14], (N_B, B_HEADS, 2 * REL_CLIP + 1), 0.5),
        "w_b_o": nrm(ks[15], (N_B, D_MODEL, D_MODEL), D_MODEL ** -0.5),
        "g_mlp": 1.0 + nrm(ks[16], (DEPTH, D_MODEL), 0.02),
        "w_ff1": nrm(ks[17], (DEPTH, D_MODEL, D_FF), D_MODEL ** -0.5),
        "w_ff2": nrm(ks[18], (DEPTH, D_FF, D_MODEL), 0.5 * D_FF ** -0.5),
        "g_final": 1.0 + nrm(ks[19], (D_MODEL,), 0.02),
    }


def reference(x_prompt, x_sample, cache_a_k, cache_a_v, cache_b_k, cache_b_v,
              g_attn, w_a_qkv, a_lambda, a_subln, w_a_o, g_kv, w_kv, w_b_q, b_rel, w_b_o,
              g_mlp, w_ff1, w_ff2, g_final):
    seq = x_prompt.shape[1]
    past = cache_a_k.shape[2]
    nt = x_sample.shape[1]
    y_prompt, ak_p, av_p, bk_p, bv_p = _trunk(
        x_prompt, jnp.arange(seq), None, None, None, None,
        g_attn, w_a_qkv, a_lambda, a_subln, w_a_o, g_kv, w_kv, w_b_q, b_rel, w_b_o,
        g_mlp, w_ff1, w_ff2, g_final)
    y_sample, ak_s, av_s, bk_s, bv_s = _trunk(
        x_sample, jnp.arange(past, past + nt), cache_a_k, cache_a_v, cache_b_k, cache_b_v,
        g_attn, w_a_qkv, a_lambda, a_subln, w_a_o, g_kv, w_kv, w_b_q, b_rel, w_b_o,
        g_mlp, w_ff1, w_ff2, g_final)
    return (y_prompt, y_sample, ak_p, av_p, bk_p, bv_p, ak_s, av_s, bk_s, bv_s)
```

```cpp
#include <hip/hip_runtime.h>
#include <cstdio>
#include <cstdint>
#include <cmath>
#define MK_N_LAUNCHES 12
namespace pg8 {
#define PG8_LAS __attribute__((address_space(3)))
typedef unsigned short bf16_t;
typedef short bf16x8 __attribute__((ext_vector_type(8)));
typedef float f32x4 __attribute__((ext_vector_type(4)));
typedef unsigned u32x4 __attribute__((ext_vector_type(4)));
constexpr int BM = 256, BK = 64, HALF = 128, HTB = HALF * BK * 2  , STAGE_BYTES = 8 * HTB, NXCD = 8, WGM = 8;

__host__ __device__ __forceinline__ int lds_byte(int r, int c) { const int st = (r >> 4) * 2 + (c >> 5), rr = r & 15, cc = c & 31, ob = rr * 64 + cc * 2; return st * 1024 + (ob ^ (((ob >> 9) & 1) << 5)); }
__host__ __device__ __forceinline__ void stage_rc(int b, int& R, int& C) { const int st = b / 1024, sb = b % 1024, swz = sb ^ (((sb >> 9) & 1) << 5); R = (st >> 1) * 16 + swz / 64; C = (st & 1) * 32 + (swz % 64) / 2; }
__host__ __device__ __forceinline__ int perm32(int rho) { const int n = rho >> 4, i = rho & 15; return 8 * (i >> 2) + 4 * n + (i & 3); }

struct Unit { int pm, pn; };
struct Gemm { const bf16_t* A; const bf16_t* Bt; int M, N, K; };

struct StaticOrder {
    int nM, nN, nwg, G, c;
    __host__ __device__ void init(int M, int N, int G_, int c_) { nM = M / BM; nN = N / BM; nwg = nM * nN; G = G_; c = c_; }
    __host__ __device__ bool next(int i, Unit& u) const {
        const long L = (long)i * G + c; if (L >= nwg) return false;
        int wgid = (int)L; { const int q = nwg / NXCD, r = nwg % NXCD, xcd = wgid % NXCD, off = wgid / NXCD; wgid = (xcd < r ? xcd * (q + 1) : r * (q + 1) + (xcd - r) * q) + off; }
        const int nig = WGM * nN, gid = wgid / nig, fm = gid * WGM, gsz = (nM - fm) < WGM ? (nM - fm) : WGM;
        u.pm = fm + ((wgid % nig) % gsz); u.pn = (wgid % nig) / gsz; return true;
    }
    __device__ __forceinline__ void a_ready(const Unit&) const {}
    __device__ __forceinline__ void done(const Unit&) const {}
};
__device__ __forceinline__ unsigned cvt_pk_bf16(float lo, float hi) { unsigned r; asm volatile("v_cvt_pk_bf16_f32 %0, %1, %2" : "=v"(r) : "v"(lo), "v"(hi)); return r; }
typedef float f32x2 __attribute__((ext_vector_type(2)));

constexpr size_t PO_AKP = 17825792, PO_AVP = 34603008, PO_BKP = 51380224, PO_BVP = 55574528, PO_AKS = 59768832, PO_AVS = 60817408, PO_BKS = 61865984, PO_BVS = 62914560;
constexpr size_t PW_KV = (size_t)36 * 1048576 / 2;
constexpr int P_MP = 16384;
constexpr float P_EPS = 1e-6f;
constexpr float P_C2 = 0.125f * 1.4426950408889634f;
typedef unsigned u32x2 __attribute__((ext_vector_type(2)));

__device__ __forceinline__ void row_rstd(const float* SS, int row0, int fq, float (&rs)[2][4]) {
#pragma unroll
    for (int ai = 0; ai < 2; ++ai)
#pragma unroll
        for (int m = 0; m < 4; ++m) {
            const f32x4 v = *(const f32x4*)(SS + (size_t)(row0 + ai * HALF + m * 16) * 16 + 4 * fq);
            float s = (v[0] + v[1]) + (v[2] + v[3]);
            s += __shfl_xor(s, 16); s += __shfl_xor(s, 32);
            rs[ai][m] = 1.0f / sqrtf(s * (1.0f / 1024.0f) + P_EPS);
        }
}

struct EpiQKV {
    static constexpr bool PERM = false, AFTER_DRAIN = false;
    const float* SS; const float* cs;
    bf16_t *Qb, *Kb, *Vb; float* out;
    __device__ __forceinline__ void operator()(const f32x4 (&acc)[2][2][4][2], const Unit& u, int wr, int wc, int fr, int fq) const {
        const int row0 = u.pm * BM + wr * 64 + fr;
        float rs[2][4]; row_rstd(SS, row0, fq, rs);
        const int sec = u.pn >> 2, ct = (u.pn & 3) * BM;
        const bool smp = (u.pm * BM) >= P_MP;
#pragma unroll
        for (int ai = 0; ai < 2; ++ai)
#pragma unroll
            for (int m = 0; m < 4; ++m) {
                const int row = row0 + ai * HALF + m * 16; const float r = rs[ai][m];
                const int pos = smp ? (1024 + ((row - P_MP) & 31)) : (row & 2047);
                const size_t orow = smp ? (size_t)(row - P_MP) * 1024 : (size_t)row * 1024;
                if (sec < 2) {
                    const int dl = 16 * (wc & 1) + 4 * fq;
                    const f32x4 c4 = *(const f32x4*)(cs + (size_t)pos * 64 + dl), s4 = *(const f32x4*)(cs + (size_t)pos * 64 + 32 + dl);
#pragma unroll
                    for (int bj = 0; bj < 2; ++bj) {
                        const int col = ct + 128 * bj + 64 * (wc >> 1) + dl;
                        const f32x4 x1 = acc[ai][bj][m][0] * r, x2 = acc[ai][bj][m][1] * r;
                        f32x4 y1 = x1 * c4 - x2 * s4, y2 = x2 * c4 + x1 * s4;
                        if (sec == 0) {
                            y1 = y1 * P_C2; y2 = y2 * P_C2;
                            u32x2 w1, w2; w1.x = cvt_pk_bf16(y1[0], y1[1]); w1.y = cvt_pk_bf16(y1[2], y1[3]); w2.x = cvt_pk_bf16(y2[0], y2[1]); w2.y = cvt_pk_bf16(y2[2], y2[3]);
                            *(u32x2*)(Qb + (size_t)row * 1024 + col) = w1; *(u32x2*)(Qb + (size_t)row * 1024 + col + 32) = w2;
                        } else {
                            float* ok = out + (smp ? PO_AKS : PO_AKP) + orow + col;
                            *(f32x4*)ok = y1; *(f32x4*)(ok + 32) = y2;
                            u32x2 w1, w2; w1.x = cvt_pk_bf16(y1[0], y1[1]); w1.y = cvt_pk_bf16(y1[2], y1[3]); w2.x = cvt_pk_bf16(y2[0], y2[1]); w2.y = cvt_pk_bf16(y2[2], y2[3]);
                            *(u32x2*)(Kb + (size_t)row * 1024 + col) = w1; *(u32x2*)(Kb + (size_t)row * 1024 + col + 32) = w2;
                        }
                    }
                } else {
#pragma unroll
                    for (int bj = 0; bj < 2; ++bj)
#pragma unroll
                        for (int n = 0; n < 2; ++n) {
                            const int col = ct + 128 * bj + 32 * wc + 16 * n + 4 * fq;
                            const f32x4 v = acc[ai][bj][m][n] * r;
                            *(f32x4*)(out + (smp ? PO_AVS : PO_AVP) + orow + col) = v;
                            u32x2 w; w.x = cvt_pk_bf16(v[0], v[1]); w.y = cvt_pk_bf16(v[2], v[3]);
                            *(u32x2*)(Vb + (size_t)row * 1024 + col) = w;
                        }
                }
            }
    }
};

struct EpiKVQ {
    static constexpr bool PERM = false, AFTER_DRAIN = false;
    const float* SS; bf16_t *Qb, *Kb; float* out;
    __device__ __forceinline__ void operator()(const f32x4 (&acc)[2][2][4][2], const Unit& u, int wr, int wc, int fr, int fq) const {
        const int row0 = u.pm * BM + wr * 64 + fr;
        float rs[2][4]; row_rstd(SS, row0, fq, rs);
        const int sec = u.pn >> 2, ct = (u.pn & 3) * BM;
        const bool smp = (u.pm * BM) >= P_MP;
        const bool keep = smp || ((u.pm & 7) >= 6);
#pragma unroll
        for (int ai = 0; ai < 2; ++ai)
#pragma unroll
            for (int m = 0; m < 4; ++m) {
                const int row = row0 + ai * HALF + m * 16; const float r = rs[ai][m];
                const size_t orow = smp ? (size_t)(row - P_MP) * 1024 : ((size_t)(row >> 11) * 512 + (size_t)((row & 2047) - 1536)) * 1024;
#pragma unroll
                for (int bj = 0; bj < 2; ++bj)
#pragma unroll
                    for (int n = 0; n < 2; ++n) {
                        const int col = ct + 128 * bj + 32 * wc + 16 * n + 4 * fq;
                        f32x4 v = acc[ai][bj][m][n] * r;
                        if (sec == 2) {
                            v = v * P_C2; u32x2 w; w.x = cvt_pk_bf16(v[0], v[1]); w.y = cvt_pk_bf16(v[2], v[3]);
                            *(u32x2*)(Qb + (size_t)row * 1024 + col) = w;
                        } else {
                            if (keep) *(f32x4*)(out + (sec == 0 ? (smp ? PO_BKS : PO_BKP) : (smp ? PO_BVS : PO_BVP)) + orow + col) = v;
                            u32x2 w; w.x = cvt_pk_bf16(v[0], v[1]); w.y = cvt_pk_bf16(v[2], v[3]);
                            *(u32x2*)(Kb + (sec == 0 ? (size_t)0 : PW_KV) + (size_t)row * 1024 + col) = w;
                        }
                    }
            }
    }
};

struct EpiRes {
    static constexpr bool PERM = false, AFTER_DRAIN = false;
    const float* xp; const float* xs;
    float* H; bf16_t* Hb; float* SS; bool first;
    __device__ __forceinline__ void operator()(const f32x4 (&acc)[2][2][4][2], const Unit& u, int wr, int wc, int fr, int fq) const {
        const int row0 = u.pm * BM + wr * 64 + fr;
        const bool smp = (u.pm * BM) >= P_MP;
#pragma unroll
        for (int ai = 0; ai < 2; ++ai)
#pragma unroll
            for (int m = 0; m < 4; ++m) {
                const int row = row0 + ai * HALF + m * 16;
                const float* src = first ? (smp ? xs + (size_t)(row - P_MP) * 1024 : xp + (size_t)row * 1024) : H + (size_t)row * 1024;
                float ssq = 0.f;
#pragma unroll
                for (int bj = 0; bj < 2; ++bj)
#pragma unroll
                    for (int n = 0; n < 2; ++n) {
                        const int col = u.pn * BM + 128 * bj + 32 * wc + 16 * n + 4 * fq;
                        const f32x4 h = *(const f32x4*)(src + col) + acc[ai][bj][m][n];
                        *(f32x4*)(H + (size_t)row * 1024 + col) = h;
                        u32x2 w; w.x = cvt_pk_bf16(h[0], h[1]); w.y = cvt_pk_bf16(h[2], h[3]);
                        *(u32x2*)(Hb + (size_t)row * 1024 + col) = w;
                        ssq += (h[0] * h[0] + h[1] * h[1]) + (h[2] * h[2] + h[3] * h[3]);
                    }
                ssq += __shfl_xor(ssq, 16); ssq += __shfl_xor(ssq, 32);
                if (fq == 0) SS[(size_t)row * 16 + u.pn * 4 + wc] = ssq;
            }
    }
};

struct EpiFF1 {
    static constexpr bool PERM = true, AFTER_DRAIN = false;
    const float* SS; bf16_t* U; int ldc;
    __device__ __forceinline__ void operator()(const f32x4 (&acc)[2][2][4][2], const Unit& u, int wr, int wc, int fr, int fq) const {
        const int row0 = u.pm * BM + wr * 64 + fr;
        float rs[2][4]; row_rstd(SS, row0, fq, rs);
        const int col0 = u.pn * BM + wc * 32 + 8 * fq;
#pragma unroll
        for (int ai = 0; ai < 2; ++ai)
#pragma unroll
            for (int m = 0; m < 4; ++m) {
                const float r = rs[ai][m]; bf16_t* rowp = U + (size_t)(row0 + ai * HALF + m * 16) * ldc + col0;
#pragma unroll
                for (int bj = 0; bj < 2; ++bj) {
                    f32x4 v0 = acc[ai][bj][m][0] * r, v1 = acc[ai][bj][m][1] * r;
#pragma unroll
                    for (int i = 0; i < 4; ++i) { const float a = fmaxf(v0[i], 0.f), b = fmaxf(v1[i], 0.f); v0[i] = a * a; v1[i] = b * b; }
                    u32x4 w; w.x = cvt_pk_bf16(v0[0], v0[1]); w.y = cvt_pk_bf16(v0[2], v0[3]); w.z = cvt_pk_bf16(v1[0], v1[1]); w.w = cvt_pk_bf16(v1[2], v1[3]);
                    *(u32x4*)(rowp + bj * HALF) = w;
                }
            }
    }
};
template <class Epi, class Sched, bool ALIGN_EPI = false, bool SP2 = false>
__device__ __forceinline__ void gemm_phase(PG8_LAS unsigned char* lds, const Gemm g, const Sched& S, const Epi& E) {
    const int tid = threadIdx.x, wid = __builtin_amdgcn_readfirstlane(tid >> 6), lane = tid & 63, wr = wid >> 2, wc = wid & 3, fr = lane & 15, fq = lane >> 4;
    const int K = g.K, nt = K / BK;
    unsigned voffA[2], voffB[2];
#pragma unroll
    for (int i = 0; i < 2; ++i) { int R, C; stage_rc(tid * 16 + i * 8192, R, C); const int Rb = Epi::PERM ? ((R & ~31) + perm32(R & 31)) : R;
        voffA[i] = (unsigned)(R * K + C) * 2u; voffB[i] = (unsigned)(Rb * K + C) * 2u; }
    const size_t kstep = (size_t)(BK * 2);
    const size_t hstep = (size_t)HALF * K * 2;
    const size_t tstep = 2 * hstep;
    const unsigned ldsw = (unsigned)wid * 1024u;
    const int aoff = lds_byte(wr * 64 + fr, fq * 8), boff = lds_byte(wc * 32 + fr, fq * 8);
#define PG8_SA(b, h) (((b) * 2 + (h)) * HTB)
#define PG8_SB(b, h) ((4 + (b) * 2 + (h)) * HTB)
#define PG8_STAGE(bufoff, gbase, voff) do { _Pragma("unroll") for (int _i = 0; _i < 2; ++_i) \
        __builtin_amdgcn_global_load_lds((const unsigned*)((const char*)(gbase) + (voff)[_i]), (PG8_LAS unsigned*)(lds + (bufoff) + ldsw + _i * 8192), 16, 0, 0); } while (0)
#define PG8_LDA(dst, b, h) do { _Pragma("unroll") for (int m = 0; m < 4; ++m) _Pragma("unroll") for (int k = 0; k < 2; ++k) dst[m][k] = *(const PG8_LAS bf16x8*)(lds + PG8_SA(b, h) + aoff + m * 2048 + k * 1024); } while (0)
#define PG8_LDB(dst, b, h) do { _Pragma("unroll") for (int n = 0; n < 2; ++n) _Pragma("unroll") for (int k = 0; k < 2; ++k) dst[n][k] = *(const PG8_LAS bf16x8*)(lds + PG8_SB(b, h) + boff + n * 2048 + k * 1024); } while (0)
#define PG8_MMA(ai, bj, At, Bt) do { __builtin_amdgcn_s_setprio(1); _Pragma("unroll") for (int m = 0; m < 4; ++m) _Pragma("unroll") for (int n = 0; n < 2; ++n) _Pragma("unroll") for (int k = 0; k < 2; ++k) \
        acc[ai][bj][m][n] = __builtin_amdgcn_mfma_f32_16x16x32_bf16(Bt[n][k], At[m][k], acc[ai][bj][m][n], 0, 0, 0); __builtin_amdgcn_s_setprio(0); } while (0)
#define PG8_WAIT_V(n) asm volatile("s_waitcnt vmcnt(" #n ")" ::: "memory")
#define PG8_WAIT_L(n) asm volatile("s_waitcnt lgkmcnt(" #n ")" ::: "memory")
#define PG8_BAR __builtin_amdgcn_s_barrier()
#define PG8_SCHED __builtin_amdgcn_sched_barrier(0)
    Unit cur, nxt; int ui = 0;
    if (!S.next(0, cur)) return;
    f32x4 acc[2][2][4][2];
#pragma unroll
    for (int a = 0; a < 2; ++a)
#pragma unroll
        for (int b = 0; b < 2; ++b)
#pragma unroll
            for (int m = 0; m < 4; ++m)
#pragma unroll
                for (int n = 0; n < 2; ++n) acc[a][b][m][n] = (f32x4){0.f, 0.f, 0.f, 0.f};
    bf16x8 At[4][2], B0[2][2], B1[2][2];
    const char* cA = (const char*)g.A + (size_t)cur.pm * tstep; const char* cB = (const char*)g.Bt + (size_t)cur.pn * tstep;
    S.a_ready(cur);
    if constexpr (SP2) {
        PG8_STAGE(PG8_SB(0, 0), cB, voffB); PG8_STAGE(PG8_SB(0, 1), cB + hstep, voffB); PG8_STAGE(PG8_SA(0, 0), cA, voffA); PG8_STAGE(PG8_SA(0, 1), cA + hstep, voffA);
        if (wr == 1) PG8_BAR;
        PG8_WAIT_V(2); PG8_BAR;
        PG8_STAGE(PG8_SB(1, 0), cB + kstep, voffB); PG8_STAGE(PG8_SA(1, 0), cA + kstep, voffA); PG8_STAGE(PG8_SB(1, 1), cB + hstep + kstep, voffB);
        PG8_WAIT_V(6); PG8_BAR;
    } else {
        PG8_STAGE(PG8_SB(0, 0), cB, voffB); PG8_STAGE(PG8_SA(0, 0), cA, voffA); PG8_STAGE(PG8_SB(0, 1), cB + hstep, voffB); PG8_STAGE(PG8_SA(0, 1), cA + hstep, voffA);
        if (wr == 1) PG8_BAR;
        PG8_WAIT_V(4); PG8_BAR;
        PG8_STAGE(PG8_SB(1, 0), cB + kstep, voffB); PG8_STAGE(PG8_SA(1, 0), cA + kstep, voffA); PG8_STAGE(PG8_SB(1, 1), cB + hstep + kstep, voffB);
        PG8_WAIT_V(6); PG8_BAR;
    }
    for (;;) {
        const bool has_next = S.next(ui + 1, nxt);
        const char* nA = has_next ? (const char*)g.A + (size_t)nxt.pm * tstep : cA; const char* nB = has_next ? (const char*)g.Bt + (size_t)nxt.pn * tstep : cB;
        for (int t = 0; t < nt; t += 2) {
            const bool last = (t == nt - 2);
            const char* a1 = cA + (size_t)(t + 1) * kstep;
            const char* a2 = last ? nA : cA + (size_t)(t + 2) * kstep; const char* b2 = last ? nB : cB + (size_t)(t + 2) * kstep;
            const char* a3 = a2 + kstep; const char* b3 = b2 + kstep;
            if (last && has_next) S.a_ready(nxt);
            if constexpr (SP2) {
            PG8_LDB(B0, 0, 0); PG8_LDB(B1, 0, 1); PG8_SCHED; PG8_LDA(At, 0, 0); PG8_STAGE(PG8_SA(1, 1), a1 + hstep, voffA);
            PG8_WAIT_V(8); PG8_WAIT_L(0); PG8_BAR; PG8_MMA(0, 0, At, B0); PG8_MMA(0, 1, At, B1); PG8_BAR; PG8_SCHED;
            PG8_LDA(At, 0, 1); PG8_STAGE(PG8_SB(0, 0), b2, voffB); PG8_STAGE(PG8_SB(0, 1), b2 + hstep, voffB); PG8_STAGE(PG8_SA(0, 0), a2, voffA);
            PG8_WAIT_V(8); PG8_WAIT_L(0); PG8_BAR; PG8_MMA(1, 0, At, B0); PG8_MMA(1, 1, At, B1); PG8_BAR; PG8_SCHED;
            PG8_LDB(B0, 1, 0); PG8_LDB(B1, 1, 1); PG8_SCHED; PG8_LDA(At, 1, 0); PG8_STAGE(PG8_SA(0, 1), a2 + hstep, voffA);
            PG8_WAIT_V(8); PG8_WAIT_L(0); PG8_BAR; PG8_MMA(0, 0, At, B0); PG8_MMA(0, 1, At, B1); PG8_BAR; PG8_SCHED;
            PG8_LDA(At, 1, 1); PG8_STAGE(PG8_SB(1, 0), b3, voffB); PG8_STAGE(PG8_SB(1, 1), b3 + hstep, voffB); PG8_STAGE(PG8_SA(1, 0), a3, voffA);
            PG8_WAIT_V(8); PG8_WAIT_L(0); PG8_BAR; PG8_MMA(1, 0, At, B0); PG8_MMA(1, 1, At, B1); PG8_BAR; PG8_SCHED;
            } else {
            PG8_LDB(B0, 0, 0); PG8_SCHED; PG8_LDA(At, 0, 0); PG8_STAGE(PG8_SA(1, 1), a1 + hstep, voffA);
            PG8_WAIT_L(8); PG8_BAR; PG8_WAIT_L(0); PG8_MMA(0, 0, At, B0); PG8_BAR; PG8_SCHED;
            PG8_LDB(B1, 0, 1); PG8_STAGE(PG8_SB(0, 0), b2, voffB);
            PG8_BAR; PG8_WAIT_L(0); PG8_MMA(0, 1, At, B1); PG8_BAR;
            PG8_LDA(At, 0, 1); PG8_STAGE(PG8_SA(0, 0), a2, voffA);
            PG8_BAR; PG8_WAIT_L(0); PG8_MMA(1, 0, At, B0); PG8_BAR; PG8_SCHED;
            PG8_STAGE(PG8_SB(0, 1), b2 + hstep, voffB);
            PG8_WAIT_V(6); PG8_BAR; PG8_MMA(1, 1, At, B1); PG8_BAR;
            PG8_LDB(B0, 1, 0); PG8_SCHED; PG8_LDA(At, 1, 0); PG8_STAGE(PG8_SA(0, 1), a2 + hstep, voffA);
            PG8_WAIT_L(8); PG8_BAR; PG8_WAIT_L(0); PG8_MMA(0, 0, At, B0); PG8_BAR; PG8_SCHED;
            PG8_LDB(B1, 1, 1); PG8_STAGE(PG8_SB(1, 0), b3, voffB);
            PG8_BAR; PG8_WAIT_L(0); PG8_MMA(0, 1, At, B1); PG8_BAR;
            PG8_LDA(At, 1, 1); PG8_STAGE(PG8_SA(1, 0), a3, voffA);
            PG8_BAR; PG8_WAIT_L(0); PG8_MMA(1, 0, At, B0); PG8_BAR; PG8_SCHED;
            PG8_STAGE(PG8_SB(1, 1), b3 + hstep, voffB);
            PG8_WAIT_V(6); PG8_BAR; PG8_MMA(1, 1, At, B1); PG8_BAR;
            }
        }
        if constexpr (ALIGN_EPI) { if (wr == 0) PG8_BAR; }
        if constexpr (!Epi::AFTER_DRAIN) { E(acc, cur, wr, wc, fr, fq); S.done(cur); }
        if (!has_next) break;
#pragma unroll
        for (int a = 0; a < 2; ++a)
#pragma unroll
            for (int b = 0; b < 2; ++b)
#pragma unroll
                for (int m = 0; m < 4; ++m)
#pragma unroll
                    for (int n = 0; n < 2; ++n) acc[a][b][m][n] = (f32x4){0.f, 0.f, 0.f, 0.f};
        cur = nxt; cA = nA; cB = nB; ++ui;
        if constexpr (ALIGN_EPI) { if (wr == 1) PG8_BAR; }
    }
    PG8_WAIT_V(0);
    if constexpr (!ALIGN_EPI) { if (wr == 0) PG8_BAR; }
    PG8_BAR;
    if constexpr (Epi::AFTER_DRAIN) { E.fused(acc, cur, wr, wc, fr, fq, lds, wid, lane); S.done(cur); }
#undef PG8_SA
#undef PG8_SB
#undef PG8_STAGE
#undef PG8_LDA
#undef PG8_LDB
#undef PG8_MMA
#undef PG8_WAIT_V
#undef PG8_WAIT_L
#undef PG8_BAR
#undef PG8_SCHED
}
}
#define GAS __attribute__((address_space(1)))
#define LAS __attribute__((address_space(3)))
typedef unsigned short bf16;
typedef unsigned v4u __attribute__((ext_vector_type(4)));
typedef float f32x4 __attribute__((ext_vector_type(4)));
typedef short bf16x8 __attribute__((ext_vector_type(8)));
typedef GAS unsigned gu32;
typedef GAS unsigned long long gu64;
#define RLX_AGENT __ATOMIC_RELAXED, __HIP_MEMORY_SCOPE_AGENT
#define LDS_WAIT() asm volatile("s_waitcnt lgkmcnt(0)" ::: "memory")
#define VM_WAIT() asm volatile("s_waitcnt vmcnt(0)" ::: "memory")
__device__ __forceinline__ unsigned long long rt() { return __builtin_amdgcn_s_memrealtime(); }
__device__ __forceinline__ unsigned f2bf(float f) { unsigned u = __builtin_bit_cast(unsigned, f); return (u + 0x7fffu + ((u >> 16) & 1u)) >> 16; }
__device__ __forceinline__ unsigned pk2(float lo, float hi) { return f2bf(lo) | (f2bf(hi) << 16); }

#define XB_TMO      128
#define XB_XCNT(j)  (256  + 64 * (j))
#define XB_XSUB(j)  (1280 + 64 * (j))
#define XB_XGEN(j)  (2304 + 64 * (j))
#define XB_TOP      3328
#define XB_TOPGEN   3392
#define XCD_BAR_WORDS 3456
#define XB_SPIN_CAP (1u << 18)

__device__ __forceinline__ unsigned xb_ld(unsigned* p)              { return __hip_atomic_load(p, __ATOMIC_RELAXED, __HIP_MEMORY_SCOPE_AGENT); }
__device__ __forceinline__ unsigned xb_add(unsigned* p, unsigned v) { return __hip_atomic_fetch_add(p, v, __ATOMIC_RELAXED, __HIP_MEMORY_SCOPE_AGENT); }
__device__ __forceinline__ unsigned xb_xcc_id() { return (unsigned)__builtin_amdgcn_s_getreg((3 << 11) | 20) & 0xFu; }
#define XB_SPIN(cond, bar) do { unsigned _sp = 0; while (cond) { __builtin_amdgcn_s_sleep(1); \
    if ((++_sp & 255u) == 0u) { if (xb_ld(&(bar)[XB_TMO])) break; if (_sp > XB_SPIN_CAP) { atomicAdd(&(bar)[XB_TMO], 1u); break; } } } } while (0)

struct XcdBarrier {
    unsigned* bar; unsigned x;
    volatile LAS unsigned* st;
};

__device__ __forceinline__ XcdBarrier xcd_barrier_post(unsigned* bar, volatile LAS unsigned* st) {
    XcdBarrier b; b.bar = bar; b.x = xb_xcc_id(); b.st = st;
    if (threadIdx.x == 0) (void)xb_add(&bar[XB_XCNT(b.x)], 1u);
    return b;
}
__device__ __forceinline__ void xcd_barrier_complete(unsigned* bar, unsigned x, unsigned& nloc, unsigned& nx) {
    const unsigned G = gridDim.x * gridDim.y * gridDim.z;
    unsigned sum, cnt, mine, sp = 0u;
    for (;;) {
        sum = 0u; cnt = 0u; mine = 0u;
#pragma unroll
        for (unsigned j = 0; j < 16; ++j) { const unsigned c = xb_ld(&bar[XB_XCNT(j)]); sum += c; cnt += (c > 0u) ? 1u : 0u; mine = (j == x) ? c : mine; }
        if (sum == G) break;
        __builtin_amdgcn_s_sleep(1);
        if ((++sp & 255u) == 0u) { if (xb_ld(&bar[XB_TMO])) break; if (sp > XB_SPIN_CAP) { atomicAdd(&bar[XB_TMO], 1u); break; } }
    }
    nloc = mine > 0u ? mine : 1u; nx = cnt > 0u ? cnt : 1u;
}

__device__ __forceinline__ void xcd_barrier(const XcdBarrier& b) {
    asm volatile("s_waitcnt vmcnt(0)" ::: "memory");
    __syncthreads();
    if (threadIdx.x == 0) {
        unsigned* bar = b.bar;
        __builtin_amdgcn_s_waitcnt(0);
        unsigned nloc = b.st[0], nx = b.st[1];
        if (nloc == 0u) { xcd_barrier_complete(bar, b.x, nloc, nx); b.st[0] = nloc; b.st[1] = nx; }
        const unsigned old = xb_add(&bar[XB_XSUB(b.x)], 1u);
        const unsigned gen = old / nloc;
        if (old + 1u == (gen + 1u) * nloc) {
            __builtin_amdgcn_fence(__ATOMIC_RELEASE, "agent");
            asm volatile("s_waitcnt vmcnt(0)" ::: "memory");
            const unsigned og = xb_add(&bar[XB_TOP], 1u);
            const unsigned tg = og / nx;
            if (og + 1u == (tg + 1u) * nx) xb_add(&bar[XB_TOPGEN], 1u);
            else XB_SPIN(xb_ld(&bar[XB_TOPGEN]) == tg, bar);
            __builtin_amdgcn_fence(__ATOMIC_ACQUIRE, "agent");
            xb_add(&bar[XB_XGEN(b.x)], 1u);
            asm volatile("s_waitcnt vmcnt(0)" ::: "memory");
        } else {
            XB_SPIN(xb_ld(&bar[XB_XGEN(b.x)]) == gen, bar);
            __builtin_amdgcn_fence(__ATOMIC_ACQUIRE, "agent");
            asm volatile("s_waitcnt vmcnt(0)" ::: "memory");
        }
    }
    __syncthreads();
}

namespace at {
#define AT_LAS __attribute__((address_space(3)))
typedef short bf16x8 __attribute__((ext_vector_type(8)));
typedef short s16x4 __attribute__((ext_vector_type(4)));
typedef float f32x16 __attribute__((ext_vector_type(16)));
typedef float f32x4 __attribute__((ext_vector_type(4)));
typedef unsigned u32x4 __attribute__((ext_vector_type(4)));
typedef unsigned u32x2 __attribute__((ext_vector_type(2)));
typedef unsigned short bf16_t;
constexpr int MP = 16384, PITCH = 1024, SEQ = 2048;
constexpr int KCS = 1040;
constexpr int KT_BYTES = 8 * KCS;
constexpr float THR = 8.0f;
constexpr int WSF_OFF = 160768;
constexpr int QIMG_OFF = 128 * 1024;
__device__ __forceinline__ int crow(int r, int hi) { return (r & 3) + 8 * (r >> 2) + 4 * hi; }
__device__ __forceinline__ unsigned cvtpk(float lo, float hi) { typedef float f2 __attribute__((ext_vector_type(2))); typedef __bf16 b2 __attribute__((ext_vector_type(2))); f2 v = {lo, hi}; b2 b = __builtin_convertvector(v, b2); return __builtin_bit_cast(unsigned, b); }
__device__ __forceinline__ s16x4 vtr(const AT_LAS unsigned char* p) { typedef short v4i16_t __attribute__((ext_vector_type(4))); return __builtin_bit_cast(s16x4, __builtin_amdgcn_ds_read_tr16_b64_v4i16((AT_LAS v4i16_t*)p)); }
#define AT_SYNC() __syncthreads()

template <bool QLDS>
__device__ __forceinline__ void qk_tile(f32x16& p0, f32x16& p1, const AT_LAS unsigned char* kt, const bf16x8 (&qr_)[4], const AT_LAS unsigned char* qimg, int r32, int hi) {
    p0 = f32x16{}; p1 = f32x16{};
#pragma unroll
    for (int d0 = 0; d0 < 4; ++d0) {
        bf16x8 qr[4]; if (QLDS) qr[d0] = *(const AT_LAS bf16x8*)(qimg + (2 * d0 + hi) * 512 + r32 * 16); else qr[d0] = qr_[d0];
        const bf16x8 a0 = *(const AT_LAS bf16x8*)(kt + (2 * d0 + hi) * KCS + r32 * 16);
        const bf16x8 a1 = *(const AT_LAS bf16x8*)(kt + (2 * d0 + hi) * KCS + r32 * 16 + 512);
        p0 = __builtin_amdgcn_mfma_f32_32x32x16_bf16(a0, qr[d0], p0, 0, 0, 0);
        p1 = __builtin_amdgcn_mfma_f32_32x32x16_bf16(a1, qr[d0], p1, 0, 0, 0);
    }
}
template <int ND0>
__device__ __forceinline__ void softmax_tile(f32x16& p0, f32x16& p1, float& m, float& l, f32x16 (&o)[ND0], AT_LAS float* wsf, int r32, int hi) {
    float rm = fmaxf(p0[0], p1[0]);
#pragma unroll
    for (int r = 1; r < 16; ++r) rm = fmaxf(rm, fmaxf(p0[r], p1[r]));
    rm = fmaxf(rm, __shfl_xor(rm, 32));
    if (__any(rm > m + THR)) {
        const float mn = fmaxf(m, rm), f = __builtin_amdgcn_exp2f(m - mn);
        l *= f; m = mn;
        if (hi == 0) wsf[r32] = f;
        asm volatile("s_waitcnt lgkmcnt(0)" ::: "memory");
#pragma unroll
        for (int r = 0; r < 16; ++r) { const float fr_ = wsf[crow(r, hi)];
#pragma unroll
            for (int d0 = 0; d0 < ND0; ++d0) o[d0][r] *= fr_; }
        asm volatile("s_waitcnt lgkmcnt(0)" ::: "memory");
    }
    float s = 0.f;
#pragma unroll
    for (int r = 0; r < 16; ++r) { p0[r] = __builtin_amdgcn_exp2f(p0[r] - m); p1[r] = __builtin_amdgcn_exp2f(p1[r] - m); s += p0[r] + p1[r]; }
    l += s;
}
template <int ND0>
__device__ __forceinline__ void pv_tile(f32x16 (&o)[ND0], const AT_LAS unsigned char* vt, const f32x16& p0, const f32x16& p1, int lane, int hi) {
    bf16x8 pa[4];
#pragma unroll
    for (int ks = 0; ks < 4; ++ks) {
        u32x4 w;
        if (ks < 2) { const int b = 8 * ks; w.x = cvtpk(p0[b], p0[b + 1]); w.y = cvtpk(p0[b + 2], p0[b + 3]); w.z = cvtpk(p0[b + 4], p0[b + 5]); w.w = cvtpk(p0[b + 6], p0[b + 7]); }
        else { const int b = 8 * (ks - 2); w.x = cvtpk(p1[b], p1[b + 1]); w.y = cvtpk(p1[b + 2], p1[b + 3]); w.z = cvtpk(p1[b + 4], p1[b + 5]); w.w = cvtpk(p1[b + 6], p1[b + 7]); }
        pa[ks] = __builtin_bit_cast(bf16x8, w);
    }
    const AT_LAS unsigned char* vb = vt + ((lane >> 4) & 1) * 32 + (lane & 3) * 8 + (4 * hi + ((lane & 15) >> 2)) * 64;
#pragma unroll
    for (int d0 = 0; d0 < ND0; ++d0)
#pragma unroll
        for (int ks = 0; ks < 4; ++ks) {
            const s16x4 lo = vtr(vb + d0 * 4096 + ks * 1024), hh = vtr(vb + d0 * 4096 + ks * 1024 + 512);
            const bf16x8 bfr = {lo[0], lo[1], lo[2], lo[3], hh[0], hh[1], hh[2], hh[3]};
            o[d0] = __builtin_amdgcn_mfma_f32_32x32x16_bf16(pa[ks], bfr, o[d0], 0, 0, 0);
        }
}
__device__ __forceinline__ u32x4 ld16(const void* p) { return *(const u32x4*)p; }
__device__ __forceinline__ u32x2 f4_to_bf4(u32x4 v) { u32x2 w; w.x = cvtpk(__uint_as_float(v.x), __uint_as_float(v.y)); w.y = cvtpk(__uint_as_float(v.z), __uint_as_float(v.w)); return w; }

struct Ctx {
    const bf16_t *Q, *K, *V; bf16_t* O;
    const float *cache_k, *cache_v;
    const float *lam_p, *subln;
    const float* rel;
};

template <int NK, int DV>
__device__ __forceinline__ void ld_bf(u32x4 (&st)[NK + DV / 64], const bf16_t* kbase, const bf16_t* vbase, int nrows, int tid) {
    const int row = tid >> 3, ch = tid & 7; const unsigned koff = (unsigned)row * PITCH + ch * 8;
#pragma unroll
    for (int c = 0; c < NK; ++c) st[c] = (row < nrows) ? ld16(kbase + koff + c * 64) : (u32x4){0u, 0u, 0u, 0u};
    if (DV == 64) { st[NK] = (row < nrows) ? ld16(vbase + koff) : (u32x4){0u, 0u, 0u, 0u}; }
    else {
        const int vrow = tid >> 4; const unsigned voff = (unsigned)vrow * PITCH + (tid & 15) * 8;
#pragma unroll
        for (int i = 0; i < 2; ++i) st[NK + i] = (vrow + 32 * i < nrows) ? ld16(vbase + voff + (size_t)i * 32 * PITCH) : (u32x4){0u, 0u, 0u, 0u};
    }
}
template <int NK, int DV>
__device__ __forceinline__ void wr_bf(const u32x4 (&st)[NK + DV / 64], AT_LAS unsigned char* sb, int tid) {
    const int row = tid >> 3, ch = tid & 7;
#pragma unroll
    for (int c = 0; c < NK; ++c) *(AT_LAS u32x4*)(sb + c * KT_BYTES + ch * KCS + row * 16) = st[c];
    AT_LAS unsigned char* vb = sb + NK * KT_BYTES;
    if (DV == 64) { const int col = ch * 8; *(AT_LAS u32x4*)(vb + ((col >> 5) * 4 + (row >> 4)) * 1024 + (row & 15) * 64 + (col & 31) * 2) = st[NK]; }
    else {
        const int vrow = tid >> 4, col = (tid & 15) * 8;
#pragma unroll
        for (int i = 0; i < 2; ++i) *(AT_LAS u32x4*)(vb + ((col >> 5) * 4 + ((vrow + 32 * i) >> 4)) * 1024 + (vrow & 15) * 64 + (col & 31) * 2) = st[NK + i];
    }
}
template <int NK, int DV>
__device__ __forceinline__ void ld_f32(u32x4 (&st)[2 * NK + DV / 32], const float* kbase, const float* vbase, int tid) {
    { const unsigned off = (unsigned)(tid >> 4) * 1024 + (tid & 15) * 4;
#pragma unroll
      for (int c = 0; c < NK; ++c)
#pragma unroll
          for (int i = 0; i < 2; ++i) st[c * 2 + i] = ld16(kbase + off + c * 64 + (size_t)i * 32 * 1024); }
    if (DV == 64) { const unsigned off = (unsigned)(tid >> 4) * 1024 + (tid & 15) * 4;
#pragma unroll
        for (int i = 0; i < 2; ++i) st[2 * NK + i] = ld16(vbase + off + (size_t)i * 32 * 1024); }
    else { const unsigned off = (unsigned)(tid >> 5) * 1024 + (tid & 31) * 4;
#pragma unroll
        for (int i = 0; i < 4; ++i) st[2 * NK + i] = ld16(vbase + off + (size_t)i * 16 * 1024); }
}
template <int NK, int DV>
__device__ __forceinline__ void wr_f32(const u32x4 (&st)[2 * NK + DV / 32], AT_LAS unsigned char* sb, int tid) {
    { const int row = tid >> 4, c4 = tid & 15;
#pragma unroll
      for (int c = 0; c < NK; ++c)
#pragma unroll
          for (int i = 0; i < 2; ++i) *(AT_LAS u32x2*)(sb + c * KT_BYTES + (c4 >> 1) * KCS + (row + 32 * i) * 16 + (c4 & 1) * 8) = f4_to_bf4(st[c * 2 + i]); }
    AT_LAS unsigned char* vb = sb + NK * KT_BYTES;
    if (DV == 64) { const int row = tid >> 4, col = (tid & 15) * 4;
#pragma unroll
        for (int i = 0; i < 2; ++i) *(AT_LAS u32x2*)(vb + ((col >> 5) * 4 + ((row + 32 * i) >> 4)) * 1024 + (row & 15) * 64 + (col & 31) * 2) = f4_to_bf4(st[2 * NK + i]); }
    else { const int row = tid >> 5, col = (tid & 31) * 4;
#pragma unroll
        for (int i = 0; i < 4; ++i) *(AT_LAS u32x2*)(vb + ((col >> 5) * 4 + ((row + 16 * i) >> 4)) * 1024 + (row & 15) * 64 + (col & 31) * 2) = f4_to_bf4(st[2 * NK + i]); }
}

constexpr int A_STAGE = 2 * KT_BYTES + 16384;
constexpr int A_TP = 132;
template <bool SAMPLE>
__device__ __forceinline__ void attnA_unit(AT_LAS unsigned char* lds, int b, int h, int ub, const Ctx& C) {
    const int tid = threadIdx.x, lane = tid & 63, r32 = lane & 31, hi = lane >> 5;
    const int w = __builtin_amdgcn_readfirstlane(tid >> 6), comp = w >> 2, qi = w & 3;
    AT_LAS float* wsf = (AT_LAS float*)(lds + WSF_OFF) + w * 64;
    const int NT = SAMPLE ? 16 : (2 * ub + 2);
    const bool active = SAMPLE ? (qi == 0) : true;
    const int cw = 2 * ub + (qi >> 1);
    const int qrow0 = SAMPLE ? (MP + b * 32) : (b * SEQ + ub * 128 + qi * 32);
    float lam;
    { const float a = C.lam_p[lane] * C.lam_p[64 + lane], c = C.lam_p[128 + lane] * C.lam_p[192 + lane];
      float sa = a, sc = c;
#pragma unroll
      for (int o_ = 1; o_ < 64; o_ <<= 1) { sa += __shfl_xor(sa, o_); sc += __shfl_xor(sc, o_); }
      lam = __expf(sa) - __expf(sc) + 0.2f; }
    bf16x8 qr[4];
    AT_LAS unsigned char* qimg = lds + QIMG_OFF + w * 4096;
#pragma unroll
    for (int d0 = 0; d0 < 4; ++d0) { qr[d0] = *(const bf16x8*)(C.Q + (size_t)(qrow0 + r32) * PITCH + h * 128 + comp * 64 + d0 * 16 + hi * 8);
        if (SAMPLE) *(AT_LAS bf16x8*)(qimg + (2 * d0 + hi) * 512 + r32 * 16) = qr[d0]; }
    f32x16 o[4]; o[0] = f32x16{}; o[1] = f32x16{}; o[2] = f32x16{}; o[3] = f32x16{};
    float m = -1e30f, l = 0.f;
    const bf16_t* kb0 = C.K + (size_t)(SAMPLE ? (MP + b * 32) : b * SEQ) * PITCH + h * 128;
    const bf16_t* vb0 = C.V + (size_t)(SAMPLE ? (MP + b * 32) : b * SEQ) * PITCH + h * 128;
    const float* kc0 = C.cache_k + (size_t)b * 1024 * 1024 + h * 128;
    const float* vc0 = C.cache_v + (size_t)b * 1024 * 1024 + h * 128;
    if (SAMPLE) { u32x4 sn[4]; ld_bf<2, 128>(sn, kb0, vb0, 32, tid); wr_bf<2, 128>(sn, lds + 2 * A_STAGE, tid); }
    u32x4 st[SAMPLE ? 8 : 4];
    if constexpr (SAMPLE) ld_f32<2, 128>(st, kc0, vc0, tid); else ld_bf<2, 128>(st, kb0, vb0, 64, tid);
    for (int t = 0; t < NT; ++t) {
        AT_LAS unsigned char* sb = lds + (t & 1) * A_STAGE;
        if constexpr (SAMPLE) wr_f32<2, 128>(st, sb, tid); else wr_bf<2, 128>(st, sb, tid);
        AT_SYNC();
        if (t + 1 < NT) { if constexpr (SAMPLE) ld_f32<2, 128>(st, kc0 + (size_t)(t + 1) * 64 * 1024, vc0 + (size_t)(t + 1) * 64 * 1024, tid); else ld_bf<2, 128>(st, kb0 + (size_t)(t + 1) * 64 * PITCH, vb0 + (size_t)(t + 1) * 64 * PITCH, 64, tid); }
        if (active && (SAMPLE || t <= cw)) {
            const int nsub = (SAMPLE && t == 0) ? 2 : 1;
#pragma unroll 1
            for (int sub = 0; sub < nsub; ++sub) {
                const AT_LAS unsigned char* sc = sub ? (lds + 2 * A_STAGE) : sb;
                f32x16 p0, p1;
                qk_tile<SAMPLE>(p0, p1, sc + comp * KT_BYTES, qr, qimg, r32, hi);
                if (SAMPLE && sub) {
#pragma unroll
                    for (int r = 0; r < 16; ++r) p1[r] = -INFINITY;
                }
                softmax_tile<4>(p0, p1, m, l, o, wsf, r32, hi);
                pv_tile<4>(o, sc + 2 * KT_BYTES, p0, p1, lane, hi);
            }
        }
    }
    AT_SYNC();
    { const float lt = l + __shfl_xor(l, 32); float inv = 1.0f / lt; if (comp == 1) inv *= lam;
      if (hi == 0) wsf[r32] = inv; asm volatile("s_waitcnt lgkmcnt(0)" ::: "memory"); }
    AT_LAS float* T2 = (AT_LAS float*)lds + qi * (32 * A_TP);
    if (active && comp == 1) {
#pragma unroll
        for (int r = 0; r < 16; ++r) { const int q = crow(r, hi); const float f = wsf[q];
#pragma unroll
            for (int d0 = 0; d0 < 4; ++d0) T2[q * A_TP + d0 * 32 + r32] = o[d0][r] * f; }
    }
    AT_SYNC();
    if (active && comp == 0) {
#pragma unroll
        for (int r = 0; r < 16; ++r) { const int q = crow(r, hi); const float f = wsf[q];
#pragma unroll
            for (int d0 = 0; d0 < 4; ++d0) { const int ix = q * A_TP + d0 * 32 + r32; T2[ix] = o[d0][r] * f - T2[ix]; } }
        asm volatile("s_waitcnt lgkmcnt(0)" ::: "memory");
        const int row = lane & 31, half = lane >> 5;
        f32x4 x[16]; float ss = 0.f;
#pragma unroll
        for (int i = 0; i < 16; ++i) { x[i] = *(const AT_LAS f32x4*)(T2 + row * A_TP + half * 64 + 4 * i); ss += (x[i][0] * x[i][0] + x[i][1] * x[i][1]) + (x[i][2] * x[i][2] + x[i][3] * x[i][3]); }
        ss += __shfl_xor(ss, 32);
        const float rinv = 0.8f / sqrtf(ss * (1.0f / 128.0f) + 1e-6f);
        bf16_t* op = C.O + (size_t)(qrow0 + row) * PITCH + h * 128 + half * 64;
#pragma unroll
        for (int i = 0; i < 16; i += 2) {
            const f32x4 g0 = *(const f32x4*)(C.subln + half * 64 + 4 * i), g1 = *(const f32x4*)(C.subln + half * 64 + 4 * i + 4);
            const f32x4 y0 = x[i] * g0 * rinv, y1 = x[i + 1] * g1 * rinv;
            u32x4 wv; wv.x = cvtpk(y0[0], y0[1]); wv.y = cvtpk(y0[2], y0[3]); wv.z = cvtpk(y1[0], y1[1]); wv.w = cvtpk(y1[2], y1[3]);
            *(u32x4*)(op + 4 * i) = wv;
        }
    }
    AT_SYNC();
}

constexpr int B_STAGE = KT_BYTES + 8192;
constexpr int B_TAB = 3 * B_STAGE;
constexpr int B_OST = 53248;
template <bool SAMPLE>
__device__ __forceinline__ void attnB_unit(AT_LAS unsigned char* lds, int b, int h, int qb, const Ctx& C) {
    const int tid = threadIdx.x, lane = tid & 63, r32 = lane & 31, hi = lane >> 5;
    const int w = __builtin_amdgcn_readfirstlane(tid >> 6);
    AT_LAS float* wsf = (AT_LAS float*)(lds + WSF_OFF) + w * 64;
    AT_LAS float* tab = (AT_LAS float*)(lds + B_TAB);
    const int kt0 = SAMPLE ? 0 : ((4 * qb - 8) > 0 ? (4 * qb - 8) : 0), kt1 = SAMPLE ? 7 : (4 * qb + 3);
    const bool active = SAMPLE ? (w == 0) : true;
    const int cw = 4 * qb + (w >> 1);
    const int qrow0 = SAMPLE ? (MP + b * 32) : (b * SEQ + qb * 256 + w * 32);
    const int qpos = SAMPLE ? (1024 + r32) : (qb * 256 + w * 32 + r32);
    if (tid < 257) tab[tid] = C.rel[h * 257 + tid] * 1.4426950408889634f;
    bf16x8 qr[4];
#pragma unroll
    for (int d0 = 0; d0 < 4; ++d0) qr[d0] = *(const bf16x8*)(C.Q + (size_t)(qrow0 + r32) * PITCH + h * 64 + d0 * 16 + hi * 8);
    f32x16 o[2]; o[0] = f32x16{}; o[1] = f32x16{};
    float m = -1e30f, l = 0.f;
    const bf16_t* kb0 = C.K + (size_t)(SAMPLE ? (MP + b * 32) : b * SEQ) * PITCH + h * 64;
    const bf16_t* vb0 = C.V + (size_t)(SAMPLE ? (MP + b * 32) : b * SEQ) * PITCH + h * 64;
    const float* kc0 = C.cache_k + (size_t)b * 512 * 1024 + h * 64;
    const float* vc0 = C.cache_v + (size_t)b * 512 * 1024 + h * 64;
    if (SAMPLE) { u32x4 sn[2]; ld_bf<1, 64>(sn, kb0, vb0, 32, tid); wr_bf<1, 64>(sn, lds + 2 * B_STAGE, tid); }
    u32x4 st[SAMPLE ? 4 : 2];
    if constexpr (SAMPLE) ld_f32<1, 64>(st, kc0, vc0, tid); else ld_bf<1, 64>(st, kb0 + (size_t)kt0 * 64 * PITCH, vb0 + (size_t)kt0 * 64 * PITCH, 64, tid);
    for (int kt = kt0; kt <= kt1; ++kt) {
        AT_LAS unsigned char* sb = lds + ((kt - kt0) & 1) * B_STAGE;
        if constexpr (SAMPLE) wr_f32<1, 64>(st, sb, tid); else wr_bf<1, 64>(st, sb, tid);
        AT_SYNC();
        if (kt + 1 <= kt1) { if constexpr (SAMPLE) ld_f32<1, 64>(st, kc0 + (size_t)(kt + 1) * 64 * 1024, vc0 + (size_t)(kt + 1) * 64 * 1024, tid); else ld_bf<1, 64>(st, kb0 + (size_t)(kt + 1) * 64 * PITCH, vb0 + (size_t)(kt + 1) * 64 * PITCH, 64, tid); }
        const bool mine = active && (SAMPLE || (kt <= cw && kt >= cw - 8));
        if (mine) {
            const int nsub = (SAMPLE && kt == 0) ? 2 : 1;
#pragma unroll 1
            for (int sub = 0; sub < nsub; ++sub) {
                const AT_LAS unsigned char* sc = sub ? (lds + 2 * B_STAGE) : sb;
                f32x16 p0, p1;
                qk_tile<false>(p0, p1, sc, qr, nullptr, r32, hi);
                const int kpos0 = SAMPLE ? (sub ? 1024 : 512 + kt * 64) : (kt * 64);
                const int relmin = SAMPLE ? (1024 - (kpos0 + 63)) : (cw * 64 + (w & 1) * 32 - (kpos0 + 63));
                if (relmin >= 128) {
                    const float cb = tab[256];
#pragma unroll
                    for (int r = 0; r < 16; ++r) { p0[r] += cb; p1[r] += cb; }
                } else {
#pragma unroll
                    for (int r = 0; r < 16; ++r) {
                        const int rel = qpos - (kpos0 + crow(r, hi));
                        const int i0 = rel < -128 ? -128 : (rel > 128 ? 128 : rel), i1 = (rel - 32) < -128 ? -128 : ((rel - 32) > 128 ? 128 : (rel - 32));
                        p0[r] += tab[i0 + 128]; p1[r] += tab[i1 + 128];
                    }
                }
                if (SAMPLE && sub) {
#pragma unroll
                    for (int r = 0; r < 16; ++r) p1[r] = -INFINITY;
                }
                softmax_tile<2>(p0, p1, m, l, o, wsf, r32, hi);
                pv_tile<2>(o, sc + KT_BYTES, p0, p1, lane, hi);
            }
        }
    }
    if (active) {
        const float lt = l + __shfl_xor(l, 32), inv = 1.0f / lt;
        if (hi == 0) wsf[r32] = inv; asm volatile("s_waitcnt lgkmcnt(0)" ::: "memory");
        AT_LAS bf16_t* stg = (AT_LAS bf16_t*)(lds + B_OST) + w * 2048;
#pragma unroll
        for (int r = 0; r < 16; ++r) { const int q = crow(r, hi); const float f = wsf[q];
#pragma unroll
            for (int d0 = 0; d0 < 2; ++d0) { const unsigned pk = cvtpk(o[d0][r] * f, 0.f); stg[q * 64 + d0 * 32 + r32] = (bf16_t)(pk & 0xffffu); } }
        asm volatile("s_waitcnt lgkmcnt(0)" ::: "memory");
        bf16_t* op = C.O + (size_t)qrow0 * PITCH + h * 64;
#pragma unroll
        for (int i = 0; i < 4; ++i) { const int row = i * 8 + (lane >> 3), ch = lane & 7; const u32x4 v = *(const AT_LAS u32x4*)(stg + row * 64 + ch * 8); *(u32x4*)(op + (size_t)row * PITCH + ch * 8) = v; }
    }
    AT_SYNC();
}
}

constexpr int NWAVES = 8;
#ifndef MK_N_LAUNCHES
#define MK_N_LAUNCHES 1
#endif
constexpr int N_PHASES = 12;
constexpr int DMODEL = 1024, SEQ = 2048, NBATCH = 8, MP = NBATCH * SEQ, MS = 1024, M = MP + MS, FF = 4096;
constexpr size_t O_Y = 0, O_AKP = 17825792, O_AVP = 34603008, O_BKP = 51380224, O_BVP = 55574528, O_AKS = 59768832, O_AVS = 60817408, O_BKS = 61865984, O_BVS = 62914560, O_END = 63963136;
constexpr size_t MiB = 1u << 20;
constexpr size_t WS_CTL = 0, CTL_ZERO_BYTES = 1 * MiB;
constexpr size_t WS_WQKV = 2 * MiB, WS_WAO = 8 * MiB, WS_WKVQ = 10 * MiB, WS_WBO = 16 * MiB, WS_W1 = 18 * MiB  , WS_W2 = 34 * MiB  ;
constexpr size_t WS_CS = 50 * MiB;
constexpr size_t WS_SS = 51 * MiB;
constexpr size_t WS_HB = 54 * MiB, WS_Q = 90 * MiB, WS_K = 126 * MiB, WS_V = 162 * MiB, WS_O = 198 * MiB;
constexpr size_t WS_U = 234 * MiB;
constexpr size_t WS_END = 372 * MiB;
constexpr int CW_TMO = 0, CW_CODE = 1, CW_BAR = 4096;
constexpr int RING_OFF = 0, RING_BYTES = 131072, LDS_BYTES = 163840, LDSCTL_OFF = LDS_BYTES - 1024, MISC_OFF = LDSCTL_OFF + 320;

struct Args { const float* in[20]; float* out; unsigned char* ws; int ph_lo, ph_hi, li, pad; };

struct Frame {
    LAS unsigned char* lds; volatile LAS unsigned* MISC; gu32* ctl;
    int tid, lane, wave, vcu, G;
};

__device__ __forceinline__ float wave_sum(float v) {
#pragma unroll
    for (int o = 1; o < 64; o <<= 1) v += __shfl_xor(v, o);
    return v;
}
__device__ __forceinline__ int pi64(int d) { return d < 32 ? 32 * (d >> 4) + (d & 15) : 32 * ((d - 32) >> 4) + 16 + ((d - 32) & 15); }
template <bool PERMQK>
__device__ __forceinline__ void p0_transpose_item(const float* W, const float* g, int K, int N, bf16* WT, int row_off, LAS float* scr, int item, int lane) {
    const int nblk = N / 32, kb = item / nblk, nb = item % nblk, k0 = 64 * kb, n0 = 32 * nb;
#pragma unroll 8
    for (int i = 0; i < 32; ++i) { const int kk = 2 * i + (lane >> 5); const float gv = g ? g[k0 + kk] : 1.0f; scr[kk * 33 + (lane & 31)] = W[(size_t)(k0 + kk) * N + n0 + (lane & 31)] * gv; }
    LDS_WAIT(); asm volatile("" ::: "memory");
    const int c = lane & 7;
#pragma unroll
    for (int j = 0; j < 4; ++j) { const int n = (lane >> 3) + 8 * j; const LAS float* s = scr + (8 * c) * 33 + n;
        v4u o; o.x = pk2(s[0 * 33], s[1 * 33]); o.y = pk2(s[2 * 33], s[3 * 33]); o.z = pk2(s[4 * 33], s[5 * 33]); o.w = pk2(s[6 * 33], s[7 * 33]);
        int nn = n0 + n; if (PERMQK && nn < 2048) nn = (nn & ~63) + pi64(nn & 63);
        *(GAS v4u*)(WT + (size_t)(row_off + nn) * K + k0 + 8 * c) = o; }
    LDS_WAIT(); asm volatile("" ::: "memory");
}
__device__ __forceinline__ void p0_prologue(Frame& F, const Args& A) {
    unsigned char* ws = A.ws;
    LAS float* scr = (LAS float*)(F.lds + RING_OFF + F.wave * 16384);
    const int gw = F.vcu * NWAVES + F.wave, NGW = F.G * NWAVES;
    constexpr int I_QKV = 16 * 96, I_SQ = 16 * 32, I_KV = 16 * 64, I_F1 = 16 * 128, I_F2 = 64 * 32;
    constexpr int NITEMS = I_QKV + I_SQ + I_KV + I_SQ + I_SQ + 2 * I_F1 + 2 * I_F2;
    const float* g_attn = A.in[6]; const float* g_mlp = A.in[16];
    for (int it = gw; it < NITEMS; it += NGW) {
        int r = it;
        if (r < I_QKV) { p0_transpose_item<true>(A.in[7], g_attn, 1024, 3072, (bf16*)(ws + WS_WQKV), 0, scr, r, F.lane); continue; } r -= I_QKV;
        if (r < I_SQ) { p0_transpose_item<false>(A.in[10], nullptr, 1024, 1024, (bf16*)(ws + WS_WAO), 0, scr, r, F.lane); continue; } r -= I_SQ;
        if (r < I_KV) { p0_transpose_item<false>(A.in[12], A.in[11], 1024, 2048, (bf16*)(ws + WS_WKVQ), 0, scr, r, F.lane); continue; } r -= I_KV;
        if (r < I_SQ) { p0_transpose_item<false>(A.in[13], g_attn + 1024, 1024, 1024, (bf16*)(ws + WS_WKVQ), 2048, scr, r, F.lane); continue; } r -= I_SQ;
        if (r < I_SQ) { p0_transpose_item<false>(A.in[15], nullptr, 1024, 1024, (bf16*)(ws + WS_WBO), 0, scr, r, F.lane); continue; } r -= I_SQ;
        if (r < I_F1) { p0_transpose_item<false>(A.in[17], g_mlp, 1024, 4096, (bf16*)(ws + WS_W1), 0, scr, r, F.lane); continue; } r -= I_F1;
        if (r < I_F1) { p0_transpose_item<false>(A.in[17] + (size_t)1024 * 4096, g_mlp + 1024, 1024, 4096, (bf16*)(ws + WS_W1 + 8 * MiB), 0, scr, r, F.lane); continue; } r -= I_F1;
        if (r < I_F2) { p0_transpose_item<false>(A.in[18], nullptr, 4096, 1024, (bf16*)(ws + WS_W2), 0, scr, r, F.lane); continue; } r -= I_F2;
        p0_transpose_item<false>(A.in[18] + (size_t)4096 * 1024, nullptr, 4096, 1024, (bf16*)(ws + WS_W2 + 8 * MiB), 0, scr, r, F.lane);
    }
    bf16* HB = (bf16*)(ws + WS_HB); float* SS = (float*)(ws + WS_SS);
    for (int m = gw; m < M; m += NGW) {
        const float* xrow = (m < MP) ? A.in[0] + (size_t)m * 1024 : A.in[1] + (size_t)(m - MP) * 1024;
        const GAS f32x4* xr = (const GAS f32x4*)xrow + F.lane;
        f32x4 v[4]; float s = 0.f;
#pragma unroll
        for (int j = 0; j < 4; ++j) { v[j] = xr[64 * j]; s += (v[j].x * v[j].x + v[j].y * v[j].y) + (v[j].z * v[j].z + v[j].w * v[j].w); }
        s = wave_sum(s);
        GAS unsigned long long* o8 = (GAS unsigned long long*)(HB + (size_t)m * 1024) + F.lane;
#pragma unroll
        for (int j = 0; j < 4; ++j) o8[64 * j] = (unsigned long long)pk2(v[j].x, v[j].y) | ((unsigned long long)pk2(v[j].z, v[j].w) << 32);
        if (F.lane < 16) SS[(size_t)m * 16 + F.lane] = (F.lane == 0) ? s : 0.f;
    }
    float* cs = (float*)(ws + WS_CS);
    for (int e = (F.vcu * NWAVES + F.wave) * 64 + F.lane; e < 2048 * 32; e += F.G * NWAVES * 64) {
        const int pos = e >> 5, i = e & 31;
        const float inv = 1.0f / powf(10000.0f, (float)i * (1.0f / 32.0f));
        const float ang = (float)pos * inv;
        float sv, cv; sincosf(ang, &sv, &cv);
        cs[(size_t)pos * 64 + i] = cv; cs[(size_t)pos * 64 + 32 + i] = sv;
    }
}
__device__ __forceinline__ void final_norm(Frame& F, const Args& A) {
    const int gw = F.vcu * NWAVES + F.wave, NGW = F.G * NWAVES;
    const float* SS = (const float*)(A.ws + WS_SS); const float* gf = A.in[19];
    f32x4 g[4];
#pragma unroll
    for (int j = 0; j < 4; ++j) g[j] = *((const f32x4*)gf + F.lane + 64 * j);
    for (int m = gw; m < M; m += NGW) {
        float s = (F.lane < 16) ? SS[(size_t)m * 16 + F.lane] : 0.f;
        s = wave_sum(s);
        const float r = 1.0f / sqrtf(s * (1.0f / 1024.0f) + 1e-6f);
        GAS f32x4* yr = (GAS f32x4*)(A.out + (size_t)m * 1024) + F.lane;
#pragma unroll
        for (int j = 0; j < 4; ++j) { f32x4 v = yr[64 * j]; v = v * g[j] * r; yr[64 * j] = v; }
    }
}

__global__ void __launch_bounds__(NWAVES * 64, 2) skel_fwd(Args args) {
    extern __shared__ __attribute__((aligned(16))) unsigned char lds[];
    Frame F;
    F.lds = (LAS unsigned char*)lds;
    F.MISC = (volatile LAS unsigned*)(F.lds + MISC_OFF);
    F.tid = threadIdx.x; F.lane = F.tid & 63; F.wave = __builtin_amdgcn_readfirstlane(F.tid >> 6);
    F.G = gridDim.x; { const int bx = blockIdx.x; F.vcu = (F.G % 8 == 0) ? (bx % 8) * (F.G / 8) + bx / 8 : bx; }
    unsigned char* ws = args.ws;
    F.ctl = (gu32*)(ws + WS_CTL);
    for (int u = F.tid; u < (LDS_BYTES - LDSCTL_OFF) / 4; u += NWAVES * 64) ((LAS unsigned*)(F.lds + LDSCTL_OFF))[u] = 0u;
    __syncthreads();
    const bool one_launch = (MK_N_LAUNCHES == 1);
    XcdBarrier bar; bar.bar = (unsigned*)(F.ctl + CW_BAR); bar.x = 0; bar.st = nullptr;
    if (one_launch) bar = xcd_barrier_post((unsigned*)(F.ctl + CW_BAR), F.MISC + 8);
#define GRID_BAR() do { if (one_launch) xcd_barrier(bar); } while (0)
    const int lo = args.ph_lo, hi = args.ph_hi;
#ifndef PHASE_MASK
#define PHASE_MASK 0xFFFF
#endif
#define IN(k) ((((PHASE_MASK) >> (k)) & 1) && lo <= (k) && (k) < hi)
#define BOTH(k) (IN(k) && IN((k) + 1))
    pg8::bf16_t* const HB = (pg8::bf16_t*)(ws + WS_HB); pg8::bf16_t* const QB = (pg8::bf16_t*)(ws + WS_Q); pg8::bf16_t* const KB = (pg8::bf16_t*)(ws + WS_K);
    pg8::bf16_t* const VB = (pg8::bf16_t*)(ws + WS_V); pg8::bf16_t* const OB = (pg8::bf16_t*)(ws + WS_O); pg8::bf16_t* const UB = (pg8::bf16_t*)(ws + WS_U);
    float* const SS = (float*)(ws + WS_SS); float* const H = args.out + O_Y;

    if (IN(0)) { p0_prologue(F, args); if (BOTH(0)) GRID_BAR(); }
    if (IN(1)) {
        pg8::Gemm g{HB, (const pg8::bf16_t*)(ws + WS_WQKV), M, 3072, 1024}; pg8::StaticOrder S; S.init(M, 3072, F.G, (int)blockIdx.x);
        pg8::EpiQKV E{SS, (const float*)(ws + WS_CS), QB, KB, VB, args.out};
        pg8::gemm_phase<pg8::EpiQKV, pg8::StaticOrder, true, true>(F.lds + RING_OFF, g, S, E);
        if (BOTH(1)) GRID_BAR();
    }
    if (IN(2)) {
        at::Ctx C{QB, KB, VB, OB, args.in[2], args.in[3], args.in[8], args.in[9], nullptr};
        for (int vv = F.vcu; vv < 256; vv += F.G) {
            const int bh = vv >> 2, s = vv & 3;
#pragma unroll 1
            for (int i = 0; i < 5; ++i) {
                const int j = (vv & 1) ? ((i + 1) % 5) : i;
                if (j == 0) at::attnA_unit<true>(F.lds, vv >> 3, vv & 7, 0, C);
                else { const int k_ = j - 1, ub = 8 * (k_ >> 1) + ((k_ & 1) ? 7 - s : s); at::attnA_unit<false>(F.lds, bh >> 3, bh & 7, ub, C); }
            }
        }
        if (BOTH(2)) GRID_BAR();
    }
    if (IN(3)) {
        pg8::Gemm g{OB, (const pg8::bf16_t*)(ws + WS_WAO), M, 1024, 1024}; pg8::StaticOrder S; S.init(M, 1024, F.G, (int)blockIdx.x);
        pg8::EpiRes E{args.in[0], args.in[1], H, HB, SS, true};
        pg8::gemm_phase<pg8::EpiRes, pg8::StaticOrder, true, true>(F.lds + RING_OFF, g, S, E);
        if (BOTH(3)) GRID_BAR();
    }
    if (IN(4)) {
        pg8::Gemm g{HB, (const pg8::bf16_t*)(ws + WS_W1), M, FF, 1024}; pg8::StaticOrder S; S.init(M, FF, F.G, (int)blockIdx.x);
        pg8::EpiFF1 E{SS, UB, FF};
        pg8::gemm_phase<pg8::EpiFF1, pg8::StaticOrder, true, true>(F.lds + RING_OFF, g, S, E);
        if (BOTH(4)) GRID_BAR();
    }
    if (IN(5)) {
        pg8::Gemm g{UB, (const pg8::bf16_t*)(ws + WS_W2), M, 1024, FF}; pg8::StaticOrder S; S.init(M, 1024, F.G, (int)blockIdx.x);
        pg8::EpiRes E{args.in[0], args.in[1], H, HB, SS, false};
        pg8::gemm_phase<pg8::EpiRes, pg8::StaticOrder, true, true>(F.lds + RING_OFF, g, S, E);
        if (BOTH(5)) GRID_BAR();
    }
    if (IN(6)) {
        pg8::Gemm g{HB, (const pg8::bf16_t*)(ws + WS_WKVQ), M, 3072, 1024}; pg8::StaticOrder S; S.init(M, 3072, F.G, (int)blockIdx.x);
        pg8::EpiKVQ E{SS, QB, KB, args.out};
        pg8::gemm_phase<pg8::EpiKVQ, pg8::StaticOrder, true, true>(F.lds + RING_OFF, g, S, E);
        if (BOTH(6)) GRID_BAR();
    }
    if (IN(7)) {
        at::Ctx C{QB, KB, VB, OB, args.in[4], args.in[5], nullptr, nullptr, args.in[14]};
        for (int vv = F.vcu; vv < 256; vv += F.G) {
            const int bh = vv >> 1, par = vv & 1;
#pragma unroll 1
            for (int i = 0; i < 4; ++i) { const int qb = 4 * (i >> 1) + ((i & 1) ? 3 - par : par); at::attnB_unit<false>(F.lds, bh >> 4, bh & 15, qb, C); }
#pragma unroll 1
            for (int i = 0; i < 2; ++i) at::attnB_unit<true>(F.lds, vv >> 3, 2 * (vv & 7) + i, 0, C);
        }
        if (BOTH(7)) GRID_BAR();
    }
    if (IN(8)) {
        pg8::Gemm g{OB, (const pg8::bf16_t*)(ws + WS_WBO), M, 1024, 1024}; pg8::StaticOrder S; S.init(M, 1024, F.G, (int)blockIdx.x);
        pg8::EpiRes E{args.in[0], args.in[1], H, HB, SS, false};
        pg8::gemm_phase<pg8::EpiRes, pg8::StaticOrder, true, true>(F.lds + RING_OFF, g, S, E);
        if (BOTH(8)) GRID_BAR();
    }
    if (IN(9)) {
        pg8::Gemm g{HB, (const pg8::bf16_t*)(ws + WS_W1 + 8 * MiB), M, FF, 1024}; pg8::StaticOrder S; S.init(M, FF, F.G, (int)blockIdx.x);
        pg8::EpiFF1 E{SS, UB, FF};
        pg8::gemm_phase<pg8::EpiFF1, pg8::StaticOrder, true, true>(F.lds + RING_OFF, g, S, E);
        if (BOTH(9)) GRID_BAR();
    }
    if (IN(10)) {
        pg8::Gemm g{UB, (const pg8::bf16_t*)(ws + WS_W2 + 8 * MiB), M, 1024, FF}; pg8::StaticOrder S; S.init(M, 1024, F.G, (int)blockIdx.x);
        pg8::EpiRes E{args.in[0], args.in[1], H, HB, SS, false};
        pg8::gemm_phase<pg8::EpiRes, pg8::StaticOrder, true, true>(F.lds + RING_OFF, g, S, E);
        if (BOTH(10)) GRID_BAR();
    }
    if (IN(11)) final_norm(F, args);
#undef IN
#undef BOTH
}

extern "C" void kernel_launch(void* const* d_in, const int* in_sizes, int n_in, void* d_out, int out_size, void* d_ws, size_t ws_size, hipStream_t stream) {
    static int grid = 0;
    if (grid == 0) {
        if (n_in != 20 || out_size != (int)O_END || ws_size < WS_END) { fprintf(stderr, "kernel_launch: unexpected problem (n_in %d out %d ws %zu)\n", n_in, out_size, ws_size); grid = -1; return; }
        int dev = 0, cus = 0, per_cu = 0;
        if (hipGetDevice(&dev) != hipSuccess || hipDeviceGetAttribute(&cus, hipDeviceAttributeMultiprocessorCount, dev) != hipSuccess) { grid = -1; return; }
        if (hipFuncSetAttribute((const void*)skel_fwd, hipFuncAttributeMaxDynamicSharedMemorySize, LDS_BYTES) != hipSuccess) { fprintf(stderr, "kernel_launch: hipFuncSetAttribute failed\n"); grid = -1; return; }
        if (hipOccupancyMaxActiveBlocksPerMultiprocessor(&per_cu, (const void*)skel_fwd, NWAVES * 64, LDS_BYTES) != hipSuccess || per_cu < 1) { fprintf(stderr, "kernel_launch: occupancy query reports %d\n", per_cu); per_cu = 1; }
        (void)hipGetLastError();
        grid = cus;
        if (grid > 256) grid = 256;
    }
    if (grid < 0) return;
    (void)hipMemsetAsync((char*)d_ws + WS_CTL, 0, CTL_ZERO_BYTES, stream);
    Args a{};
    for (int i = 0; i < 20; ++i) a.in[i] = (const float*)d_in[i];
    a.out = (float*)d_out; a.ws = (unsigned char*)d_ws;
    if (MK_N_LAUNCHES == 1) {
        a.ph_lo = 0; a.ph_hi = N_PHASES; a.li = 0;
        hipLaunchKernelGGL(skel_fwd, dim3(grid), dim3(NWAVES * 64), LDS_BYTES, stream, a);
    } else {
        for (int li = 0; li < N_PHASES; ++li) { a.ph_lo = li; a.ph_hi = li + 1; a.li = li; hipLaunchKernelGGL(skel_fwd, dim3(grid), dim3(NWAVES * 64), LDS_BYTES, stream, a); }
    }
}
```

```cpp
#include <hip/hip_runtime.h>
#include <cstdio>
#include <cstdint>
#include <cmath>
#define MK_N_LAUNCHES 1
namespace pg8 {
#define PG8_LAS __attribute__((address_space(3)))
typedef unsigned short bf16_t;
typedef short bf16x8 __attribute__((ext_vector_type(8)));
typedef float f32x4 __attribute__((ext_vector_type(4)));
typedef unsigned u32x4 __attribute__((ext_vector_type(4)));
constexpr int BM = 256, BK = 64, HALF = 128, HTB = HALF * BK * 2  , STAGE_BYTES = 8 * HTB, NXCD = 8, WGM = 8;

__host__ __device__ __forceinline__ int lds_byte(int r, int c) { const int st = (r >> 4) * 2 + (c >> 5), rr = r & 15, cc = c & 31, ob = rr * 64 + cc * 2; return st * 1024 + (ob ^ (((ob >> 9) & 1) << 5)); }
__host__ __device__ __forceinline__ void stage_rc(int b, int& R, int& C) { const int st = b / 1024, sb = b % 1024, swz = sb ^ (((sb >> 9) & 1) << 5); R = (st >> 1) * 16 + swz / 64; C = (st & 1) * 32 + (swz % 64) / 2; }
__host__ __device__ __forceinline__ int perm32(int rho) { const int n = rho >> 4, i = rho & 15; return 8 * (i >> 2) + 4 * n + (i & 3); }

struct Unit { int pm, pn; };
struct Gemm { const bf16_t* A; const bf16_t* Bt; int M, N, K; };

struct StaticOrder {
    int nM, nN, nwg, G, c;
    __host__ __device__ void init(int M, int N, int G_, int c_) { nM = M / BM; nN = N / BM; nwg = nM * nN; G = G_; c = c_; }
    __host__ __device__ bool next(int i, Unit& u) const {
        const long L = (long)i * G + c; if (L >= nwg) return false;
        int wgid = (int)L; { const int q = nwg / NXCD, r = nwg % NXCD, xcd = wgid % NXCD, off = wgid / NXCD; wgid = (xcd < r ? xcd * (q + 1) : r * (q + 1) + (xcd - r) * q) + off; }
        const int nig = WGM * nN, gid = wgid / nig, fm = gid * WGM, gsz = (nM - fm) < WGM ? (nM - fm) : WGM;
        u.pm = fm + ((wgid % nig) % gsz); u.pn = (wgid % nig) / gsz; return true;
    }
    __device__ __forceinline__ void a_ready(const Unit&) const {}
    __device__ __forceinline__ void done(const Unit&) const {}
};
__device__ __forceinline__ unsigned cvt_pk_bf16(float lo, float hi) { unsigned r; asm volatile("v_cvt_pk_bf16_f32 %0, %1, %2" : "=v"(r) : "v"(lo), "v"(hi)); return r; }
typedef float f32x2 __attribute__((ext_vector_type(2)));

constexpr size_t PO_AKP = 17825792, PO_AVP = 34603008, PO_BKP = 51380224, PO_BVP = 55574528, PO_AKS = 59768832, PO_AVS = 60817408, PO_BKS = 61865984, PO_BVS = 62914560;
constexpr size_t PW_KV = (size_t)36 * 1048576 / 2;
constexpr int P_MP = 16384;
constexpr float P_EPS = 1e-6f;
constexpr float P_C2 = 0.125f * 1.4426950408889634f;
typedef unsigned u32x2 __attribute__((ext_vector_type(2)));

__device__ __forceinline__ void row_rstd(const float* SS, int row0, int fq, float (&rs)[2][4]) {
#pragma unroll
    for (int ai = 0; ai < 2; ++ai)
#pragma unroll
        for (int m = 0; m < 4; ++m) {
            const f32x4 v = *(const f32x4*)(SS + (size_t)(row0 + ai * HALF + m * 16) * 16 + 4 * fq);
            float s = (v[0] + v[1]) + (v[2] + v[3]);
            s += __shfl_xor(s, 16); s += __shfl_xor(s, 32);
            rs[ai][m] = 1.0f / sqrtf(s * (1.0f / 1024.0f) + P_EPS);
        }
}

struct EpiQKV {
    static constexpr bool PERM = false, AFTER_DRAIN = false;
    const float* SS; const float* cs;
    bf16_t *Qb, *Kb, *Vb; float* out;
    __device__ __forceinline__ void operator()(const f32x4 (&acc)[2][2][4][2], const Unit& u, int wr, int wc, int fr, int fq) const {
        const int row0 = u.pm * BM + wr * 64 + fr;
        float rs[2][4]; row_rstd(SS, row0, fq, rs);
        const int sec = u.pn >> 2, ct = (u.pn & 3) * BM;
        const bool smp = (u.pm * BM) >= P_MP;
#pragma unroll
        for (int ai = 0; ai < 2; ++ai)
#pragma unroll
            for (int m = 0; m < 4; ++m) {
                const int row = row0 + ai * HALF + m * 16; const float r = rs[ai][m];
                const int pos = smp ? (1024 + ((row - P_MP) & 31)) : (row & 2047);
                const size_t orow = smp ? (size_t)(row - P_MP) * 1024 : (size_t)row * 1024;
                if (sec < 2) {
                    const int dl = 16 * (wc & 1) + 4 * fq;
                    const f32x4 c4 = *(const f32x4*)(cs + (size_t)pos * 64 + dl), s4 = *(const f32x4*)(cs + (size_t)pos * 64 + 32 + dl);
#pragma unroll
                    for (int bj = 0; bj < 2; ++bj) {
                        const int col = ct + 128 * bj + 64 * (wc >> 1) + dl;
                        const f32x4 x1 = acc[ai][bj][m][0] * r, x2 = acc[ai][bj][m][1] * r;
                        f32x4 y1 = x1 * c4 - x2 * s4, y2 = x2 * c4 + x1 * s4;
                        if (sec == 0) {
                            y1 = y1 * P_C2; y2 = y2 * P_C2;
                            u32x2 w1, w2; w1.x = cvt_pk_bf16(y1[0], y1[1]); w1.y = cvt_pk_bf16(y1[2], y1[3]); w2.x = cvt_pk_bf16(y2[0], y2[1]); w2.y = cvt_pk_bf16(y2[2], y2[3]);
                            *(u32x2*)(Qb + (size_t)row * 1024 + col) = w1; *(u32x2*)(Qb + (size_t)row * 1024 + col + 32) = w2;
                        } else {
                            float* ok = out + (smp ? PO_AKS : PO_AKP) + orow + col;
                            *(f32x4*)ok = y1; *(f32x4*)(ok + 32) = y2;
                            u32x2 w1, w2; w1.x = cvt_pk_bf16(y1[0], y1[1]); w1.y = cvt_pk_bf16(y1[2], y1[3]); w2.x = cvt_pk_bf16(y2[0], y2[1]); w2.y = cvt_pk_bf16(y2[2], y2[3]);
                            *(u32x2*)(Kb + (size_t)row * 1024 + col) = w1; *(u32x2*)(Kb + (size_t)row * 1024 + col + 32) = w2;
                        }
                    }
                } else {
#pragma unroll
                    for (int bj = 0; bj < 2; ++bj)
#pragma unroll
                        for (int n = 0; n < 2; ++n) {
                            const int col = ct + 128 * bj + 32 * wc + 16 * n + 4 * fq;
                            const f32x4 v = acc[ai][bj][m][n] * r;
                            *(f32x4*)(out + (smp ? PO_AVS : PO_AVP) + orow + col) = v;
                            u32x2 w; w.x = cvt_pk_bf16(v[0], v[1]); w.y = cvt_pk_bf16(v[2], v[3]);
                            *(u32x2*)(Vb + (size_t)row * 1024 + col) = w;
                        }
                }
            }
    }
};

struct EpiKVQ {
    static constexpr bool PERM = false, AFTER_DRAIN = false;
    const float* SS; bf16_t *Qb, *Kb; float* out;
    __device__ __forceinline__ void operator()(const f32x4 (&acc)[2][2][4][2], const Unit& u, int wr, int wc, int fr, int fq) const {
        const int row0 = u.pm * BM + wr * 64 + fr;
        float rs[2][4]; row_rstd(SS, row0, fq, rs);
        const int sec = u.pn >> 2, ct = (u.pn & 3) * BM;
        const bool smp = (u.pm * BM) >= P_MP;
        const bool keep = smp || ((u.pm & 7) >= 6);
#pragma unroll
        for (int ai = 0; ai < 2; ++ai)
#pragma unroll
            for (int m = 0; m < 4; ++m) {
                const int row = row0 + ai * HALF + m * 16; const float r = rs[ai][m];
                const size_t orow = smp ? (size_t)(row - P_MP) * 1024 : ((size_t)(row >> 11) * 512 + (size_t)((row & 2047) - 1536)) * 1024;
#pragma unroll
                for (int bj = 0; bj < 2; ++bj)
#pragma unroll
                    for (int n = 0; n < 2; ++n) {
                        const int col = ct + 128 * bj + 32 * wc + 16 * n + 4 * fq;
                        f32x4 v = acc[ai][bj][m][n] * r;
                        if (sec == 2) {
                            v = v * P_C2; u32x2 w; w.x = cvt_pk_bf16(v[0], v[1]); w.y = cvt_pk_bf16(v[2], v[3]);
                            *(u32x2*)(Qb + (size_t)row * 1024 + col) = w;
                        } else {
                            if (keep) *(f32x4*)(out + (sec == 0 ? (smp ? PO_BKS : PO_BKP) : (smp ? PO_BVS : PO_BVP)) + orow + col) = v;
                            u32x2 w; w.x = cvt_pk_bf16(v[0], v[1]); w.y = cvt_pk_bf16(v[2], v[3]);
                            *(u32x2*)(Kb + (sec == 0 ? (size_t)0 : PW_KV) + (size_t)row * 1024 + col) = w;
                        }
                    }
            }
    }
};

struct EpiRes {
    static constexpr bool PERM = false, AFTER_DRAIN = false;
    const float* xp; const float* xs;
    float* H; bf16_t* Hb; float* SS; bool first;
    __device__ __forceinline__ void operator()(const f32x4 (&acc)[2][2][4][2], const Unit& u, int wr, int wc, int fr, int fq) const {
        const int row0 = u.pm * BM + wr * 64 + fr;
        const bool smp = (u.pm * BM) >= P_MP;
#pragma unroll
        for (int ai = 0; ai < 2; ++ai)
#pragma unroll
            for (int m = 0; m < 4; ++m) {
                const int row = row0 + ai * HALF + m * 16;
                const float* src = first ? (smp ? xs + (size_t)(row - P_MP) * 1024 : xp + (size_t)row * 1024) : H + (size_t)row * 1024;
                float ssq = 0.f;
#pragma unroll
                for (int bj = 0; bj < 2; ++bj)
#pragma unroll
                    for (int n = 0; n < 2; ++n) {
                        const int col = u.pn * BM + 128 * bj + 32 * wc + 16 * n + 4 * fq;
                        const f32x4 h = *(const f32x4*)(src + col) + acc[ai][bj][m][n];
                        *(f32x4*)(H + (size_t)row * 1024 + col) = h;
                        u32x2 w; w.x = cvt_pk_bf16(h[0], h[1]); w.y = cvt_pk_bf16(h[2], h[3]);
                        *(u32x2*)(Hb + (size_t)row * 1024 + col) = w;
                        ssq += (h[0] * h[0] + h[1] * h[1]) + (h[2] * h[2] + h[3] * h[3]);
                    }
                ssq += __shfl_xor(ssq, 16); ssq += __shfl_xor(ssq, 32);
                if (fq == 0) SS[(size_t)row * 16 + u.pn * 4 + wc] = ssq;
            }
    }
};

struct EpiFF1 {
    static constexpr bool PERM = true, AFTER_DRAIN = false;
    const float* SS; bf16_t* U; int ldc;
    __device__ __forceinline__ void operator()(const f32x4 (&acc)[2][2][4][2], const Unit& u, int wr, int wc, int fr, int fq) const {
        const int row0 = u.pm * BM + wr * 64 + fr;
        float rs[2][4]; row_rstd(SS, row0, fq, rs);
        const int col0 = u.pn * BM + wc * 32 + 8 * fq;
#pragma unroll
        for (int ai = 0; ai < 2; ++ai)
#pragma unroll
            for (int m = 0; m < 4; ++m) {
                const float r = rs[ai][m]; bf16_t* rowp = U + (size_t)(row0 + ai * HALF + m * 16) * ldc + col0;
#pragma unroll
                for (int bj = 0; bj < 2; ++bj) {
                    f32x4 v0 = acc[ai][bj][m][0] * r, v1 = acc[ai][bj][m][1] * r;
#pragma unroll
                    for (int i = 0; i < 4; ++i) { const float a = fmaxf(v0[i], 0.f), b = fmaxf(v1[i], 0.f); v0[i] = a * a; v1[i] = b * b; }
                    u32x4 w; w.x = cvt_pk_bf16(v0[0], v0[1]); w.y = cvt_pk_bf16(v0[2], v0[3]); w.z = cvt_pk_bf16(v1[0], v1[1]); w.w = cvt_pk_bf16(v1[2], v1[3]);
                    *(u32x4*)(rowp + bj * HALF) = w;
                }
            }
    }
};
template <class Epi, class Sched, bool ALIGN_EPI = false, bool SP2 = false>
__device__ __forceinline__ void gemm_phase(PG8_LAS unsigned char* lds, const Gemm g, const Sched& S, const Epi& E) {
    const int tid = threadIdx.x, wid = __builtin_amdgcn_readfirstlane(tid >> 6), lane = tid & 63, wr = wid >> 2, wc = wid & 3, fr = lane & 15, fq = lane >> 4;
    const int K = g.K, nt = K / BK;
    unsigned voffA[2], voffB[2];
#pragma unroll
    for (int i = 0; i < 2; ++i) { int R, C; stage_rc(tid * 16 + i * 8192, R, C); const int Rb = Epi::PERM ? ((R & ~31) + perm32(R & 31)) : R;
        voffA[i] = (unsigned)(R * K + C) * 2u; voffB[i] = (unsigned)(Rb * K + C) * 2u; }
    const size_t kstep = (size_t)(BK * 2);
    const size_t hstep = (size_t)HALF * K * 2;
    const size_t tstep = 2 * hstep;
    const unsigned ldsw = (unsigned)wid * 1024u;
    const int aoff = lds_byte(wr * 64 + fr, fq * 8), boff = lds_byte(wc * 32 + fr, fq * 8);
#define PG8_SA(b, h) (((b) * 2 + (h)) * HTB)
#define PG8_SB(b, h) ((4 + (b) * 2 + (h)) * HTB)
#define PG8_STAGE(bufoff, gbase, voff) do { _Pragma("unroll") for (int _i = 0; _i < 2; ++_i) \
        __builtin_amdgcn_global_load_lds((const unsigned*)((const char*)(gbase) + (voff)[_i]), (PG8_LAS unsigned*)(lds + (bufoff) + ldsw + _i * 8192), 16, 0, 0); } while (0)
#define PG8_LDA(dst, b, h) do { _Pragma("unroll") for (int m = 0; m < 4; ++m) _Pragma("unroll") for (int k = 0; k < 2; ++k) dst[m][k] = *(const PG8_LAS bf16x8*)(lds + PG8_SA(b, h) + aoff + m * 2048 + k * 1024); } while (0)
#define PG8_LDB(dst, b, h) do { _Pragma("unroll") for (int n = 0; n < 2; ++n) _Pragma("unroll") for (int k = 0; k < 2; ++k) dst[n][k] = *(const PG8_LAS bf16x8*)(lds + PG8_SB(b, h) + boff + n * 2048 + k * 1024); } while (0)
#define PG8_MMA(ai, bj, At, Bt) do { __builtin_amdgcn_s_setprio(1); _Pragma("unroll") for (int m = 0; m < 4; ++m) _Pragma("unroll") for (int n = 0; n < 2; ++n) _Pragma("unroll") for (int k = 0; k < 2; ++k) \
        acc[ai][bj][m][n] = __builtin_amdgcn_mfma_f32_16x16x32_bf16(Bt[n][k], At[m][k], acc[ai][bj][m][n], 0, 0, 0); __builtin_amdgcn_s_setprio(0); } while (0)
#define PG8_WAIT_V(n) asm volatile("s_waitcnt vmcnt(" #n ")" ::: "memory")
#define PG8_WAIT_L(n) asm volatile("s_waitcnt lgkmcnt(" #n ")" ::: "memory")
#define PG8_BAR __builtin_amdgcn_s_barrier()
#define PG8_SCHED __builtin_amdgcn_sched_barrier(0)
    Unit cur, nxt; int ui = 0;
    if (!S.next(0, cur)) return;
    f32x4 acc[2][2][4][2];
#pragma unroll
    for (int a = 0; a < 2; ++a)
#pragma unroll
        for (int b = 0; b < 2; ++b)
#pragma unroll
            for (int m = 0; m < 4; ++m)
#pragma unroll
                for (int n = 0; n < 2; ++n) acc[a][b][m][n] = (f32x4){0.f, 0.f, 0.f, 0.f};
    bf16x8 At[4][2], B0[2][2], B1[2][2];
    const char* cA = (const char*)g.A + (size_t)cur.pm * tstep; const char* cB = (const char*)g.Bt + (size_t)cur.pn * tstep;
    S.a_ready(cur);
    if constexpr (SP2) {
        PG8_STAGE(PG8_SB(0, 0), cB, voffB); PG8_STAGE(PG8_SB(0, 1), cB + hstep, voffB); PG8_STAGE(PG8_SA(0, 0), cA, voffA); PG8_STAGE(PG8_SA(0, 1), cA + hstep, voffA);
        if (wr == 1) PG8_BAR;
        PG8_WAIT_V(2); PG8_BAR;
        PG8_STAGE(PG8_SB(1, 0), cB + kstep, voffB); PG8_STAGE(PG8_SA(1, 0), cA + kstep, voffA); PG8_STAGE(PG8_SB(1, 1), cB + hstep + kstep, voffB);
        PG8_WAIT_V(6); PG8_BAR;
    } else {
        PG8_STAGE(PG8_SB(0, 0), cB, voffB); PG8_STAGE(PG8_SA(0, 0), cA, voffA); PG8_STAGE(PG8_SB(0, 1), cB + hstep, voffB); PG8_STAGE(PG8_SA(0, 1), cA + hstep, voffA);
        if (wr == 1) PG8_BAR;
        PG8_WAIT_V(4); PG8_BAR;
        PG8_STAGE(PG8_SB(1, 0), cB + kstep, voffB); PG8_STAGE(PG8_SA(1, 0), cA + kstep, voffA); PG8_STAGE(PG8_SB(1, 1), cB + hstep + kstep, voffB);
        PG8_WAIT_V(6); PG8_BAR;
    }
    for (;;) {
        const bool has_next = S.next(ui + 1, nxt);
        const char* nA = has_next ? (const char*)g.A + (size_t)nxt.pm * tstep : cA; const char* nB = has_next ? (const char*)g.Bt + (size_t)nxt.pn * tstep : cB;
        for (int t = 0; t < nt; t += 2) {
            const bool last = (t == nt - 2);
            const char* a1 = cA + (size_t)(t + 1) * kstep;
            const char* a2 = last ? nA : cA + (size_t)(t + 2) * kstep; const char* b2 = last ? nB : cB + (size_t)(t + 2) * kstep;
            const char* a3 = a2 + kstep; const char* b3 = b2 + kstep;
            if (last && has_next) S.a_ready(nxt);
            if constexpr (SP2) {
            PG8_LDB(B0, 0, 0); PG8_LDB(B1, 0, 1); PG8_SCHED; PG8_LDA(At, 0, 0); PG8_STAGE(PG8_SA(1, 1), a1 + hstep, voffA);
            PG8_WAIT_V(8); PG8_WAIT_L(0); PG8_BAR; PG8_MMA(0, 0, At, B0); PG8_MMA(0, 1, At, B1); PG8_BAR; PG8_SCHED;
            PG8_LDA(At, 0, 1); PG8_STAGE(PG8_SB(0, 0), b2, voffB); PG8_STAGE(PG8_SB(0, 1), b2 + hstep, voffB); PG8_STAGE(PG8_SA(0, 0), a2, voffA);
            PG8_WAIT_V(8); PG8_WAIT_L(0); PG8_BAR; PG8_MMA(1, 0, At, B0); PG8_MMA(1, 1, At, B1); PG8_BAR; PG8_SCHED;
            PG8_LDB(B0, 1, 0); PG8_LDB(B1, 1, 1); PG8_SCHED; PG8_LDA(At, 1, 0); PG8_STAGE(PG8_SA(0, 1), a2 + hstep, voffA);
            PG8_WAIT_V(8); PG8_WAIT_L(0); PG8_BAR; PG8_MMA(0, 0, At, B0); PG8_MMA(0, 1, At, B1); PG8_BAR; PG8_SCHED;
            PG8_LDA(At, 1, 1); PG8_STAGE(PG8_SB(1, 0), b3, voffB); PG8_STAGE(PG8_SB(1, 1), b3 + hstep, voffB); PG8_STAGE(PG8_SA(1, 0), a3, voffA);
            PG8_WAIT_V(8); PG8_WAIT_L(0); PG8_BAR; PG8_MMA(1, 0, At, B0); PG8_MMA(1, 1, At, B1); PG8_BAR; PG8_SCHED;
            } else {
            PG8_LDB(B0, 0, 0); PG8_SCHED; PG8_LDA(At, 0, 0); PG8_STAGE(PG8_SA(1, 1), a1 + hstep, voffA);
            PG8_WAIT_L(8); PG8_BAR; PG8_WAIT_L(0); PG8_MMA(0, 0, At, B0); PG8_BAR; PG8_SCHED;
            PG8_LDB(B1, 0, 1); PG8_STAGE(PG8_SB(0, 0), b2, voffB);
            PG8_BAR; PG8_WAIT_L(0); PG8_MMA(0, 1, At, B1); PG8_BAR;
            PG8_LDA(At, 0, 1); PG8_STAGE(PG8_SA(0, 0), a2, voffA);
            PG8_BAR; PG8_WAIT_L(0); PG8_MMA(1, 0, At, B0); PG8_BAR; PG8_SCHED;
            PG8_STAGE(PG8_SB(0, 1), b2 + hstep, voffB);
            PG8_WAIT_V(6); PG8_BAR; PG8_MMA(1, 1, At, B1); PG8_BAR;
            PG8_LDB(B0, 1, 0); PG8_SCHED; PG8_LDA(At, 1, 0); PG8_STAGE(PG8_SA(0, 1), a2 + hstep, voffA);
            PG8_WAIT_L(8); PG8_BAR; PG8_WAIT_L(0); PG8_MMA(0, 0, At, B0); PG8_BAR; PG8_SCHED;
            PG8_LDB(B1, 1, 1); PG8_STAGE(PG8_SB(1, 0), b3, voffB);
            PG8_BAR; PG8_WAIT_L(0); PG8_MMA(0, 1, At, B1); PG8_BAR;
            PG8_LDA(At, 1, 1); PG8_STAGE(PG8_SA(1, 0), a3, voffA);
            PG8_BAR; PG8_WAIT_L(0); PG8_MMA(1, 0, At, B0); PG8_BAR; PG8_SCHED;
            PG8_STAGE(PG8_SB(1, 1), b3 + hstep, voffB);
            PG8_WAIT_V(6); PG8_BAR; PG8_MMA(1, 1, At, B1); PG8_BAR;
            }
        }
        if constexpr (ALIGN_EPI) { if (wr == 0) PG8_BAR; }
        if constexpr (!Epi::AFTER_DRAIN) { E(acc, cur, wr, wc, fr, fq); S.done(cur); }
        if (!has_next) break;
#pragma unroll
        for (int a = 0; a < 2; ++a)
#pragma unroll
            for (int b = 0; b < 2; ++b)
#pragma unroll
                for (int m = 0; m < 4; ++m)
#pragma unroll
                    for (int n = 0; n < 2; ++n) acc[a][b][m][n] = (f32x4){0.f, 0.f, 0.f, 0.f};
        cur = nxt; cA = nA; cB = nB; ++ui;
        if constexpr (ALIGN_EPI) { if (wr == 1) PG8_BAR; }
    }
    PG8_WAIT_V(0);
    if constexpr (!ALIGN_EPI) { if (wr == 0) PG8_BAR; }
    PG8_BAR;
    if constexpr (Epi::AFTER_DRAIN) { E.fused(acc, cur, wr, wc, fr, fq, lds, wid, lane); S.done(cur); }
#undef PG8_SA
#undef PG8_SB
#undef PG8_STAGE
#undef PG8_LDA
#undef PG8_LDB
#undef PG8_MMA
#undef PG8_WAIT_V
#undef PG8_WAIT_L
#undef PG8_BAR
#undef PG8_SCHED
}
}
#define GAS __attribute__((address_space(1)))
#define LAS __attribute__((address_space(3)))
typedef unsigned short bf16;
typedef unsigned v4u __attribute__((ext_vector_type(4)));
typedef float f32x4 __attribute__((ext_vector_type(4)));
typedef short bf16x8 __attribute__((ext_vector_type(8)));
typedef GAS unsigned gu32;
typedef GAS unsigned long long gu64;
#define RLX_AGENT __ATOMIC_RELAXED, __HIP_MEMORY_SCOPE_AGENT
#define LDS_WAIT() asm volatile("s_waitcnt lgkmcnt(0)" ::: "memory")
#define VM_WAIT() asm volatile("s_waitcnt vmcnt(0)" ::: "memory")
__device__ __forceinline__ unsigned long long rt() { return __builtin_amdgcn_s_memrealtime(); }
__device__ __forceinline__ unsigned f2bf(float f) { unsigned u = __builtin_bit_cast(unsigned, f); return (u + 0x7fffu + ((u >> 16) & 1u)) >> 16; }
__device__ __forceinline__ unsigned pk2(float lo, float hi) { return f2bf(lo) | (f2bf(hi) << 16); }

#define XB_TMO      128
#define XB_XCNT(j)  (256  + 64 * (j))
#define XB_XSUB(j)  (1280 + 64 * (j))
#define XB_XGEN(j)  (2304 + 64 * (j))
#define XB_TOP      3328
#define XB_TOPGEN   3392
#define XCD_BAR_WORDS 3456
#define XB_SPIN_CAP (1u << 18)

__device__ __forceinline__ unsigned xb_ld(unsigned* p)              { return __hip_atomic_load(p, __ATOMIC_RELAXED, __HIP_MEMORY_SCOPE_AGENT); }
__device__ __forceinline__ unsigned xb_add(unsigned* p, unsigned v) { return __hip_atomic_fetch_add(p, v, __ATOMIC_RELAXED, __HIP_MEMORY_SCOPE_AGENT); }
__device__ __forceinline__ unsigned xb_xcc_id() { return (unsigned)__builtin_amdgcn_s_getreg((3 << 11) | 20) & 0xFu; }
#define XB_SPIN(cond, bar) do { unsigned _sp = 0; while (cond) { __builtin_amdgcn_s_sleep(1); \
    if ((++_sp & 255u) == 0u) { if (xb_ld(&(bar)[XB_TMO])) break; if (_sp > XB_SPIN_CAP) { atomicAdd(&(bar)[XB_TMO], 1u); break; } } } } while (0)

struct XcdBarrier {
    unsigned* bar; unsigned x;
    volatile LAS unsigned* st;
};

__device__ __forceinline__ XcdBarrier xcd_barrier_post(unsigned* bar, volatile LAS unsigned* st) {
    XcdBarrier b; b.bar = bar; b.x = xb_xcc_id(); b.st = st;
    if (threadIdx.x == 0) (void)xb_add(&bar[XB_XCNT(b.x)], 1u);
    return b;
}
__device__ __forceinline__ void xcd_barrier_complete(unsigned* bar, unsigned x, unsigned& nloc, unsigned& nx) {
    const unsigned G = gridDim.x * gridDim.y * gridDim.z;
    unsigned sum, cnt, mine, sp = 0u;
    for (;;) {
        sum = 0u; cnt = 0u; mine = 0u;
#pragma unroll
        for (unsigned j = 0; j < 16; ++j) { const unsigned c = xb_ld(&bar[XB_XCNT(j)]); sum += c; cnt += (c > 0u) ? 1u : 0u; mine = (j == x) ? c : mine; }
        if (sum == G) break;
        __builtin_amdgcn_s_sleep(1);
        if ((++sp & 255u) == 0u) { if (xb_ld(&bar[XB_TMO])) break; if (sp > XB_SPIN_CAP) { atomicAdd(&bar[XB_TMO], 1u); break; } }
    }
    nloc = mine > 0u ? mine : 1u; nx = cnt > 0u ? cnt : 1u;
}

__device__ __forceinline__ void xcd_barrier(const XcdBarrier& b) {
    asm volatile("s_waitcnt vmcnt(0)" ::: "memory");
    __syncthreads();
    if (threadIdx.x == 0) {
        unsigned* bar = b.bar;
        __builtin_amdgcn_s_waitcnt(0);
        unsigned nloc = b.st[0], nx = b.st[1];
        if (nloc == 0u) { xcd_barrier_complete(bar, b.x, nloc, nx); b.st[0] = nloc; b.st[1] = nx; }
        const unsigned old = xb_add(&bar[XB_XSUB(b.x)], 1u);
        const unsigned gen = old / nloc;
        if (old + 1u == (gen + 1u) * nloc) {
            __builtin_amdgcn_fence(__ATOMIC_RELEASE, "agent");
            asm volatile("s_waitcnt vmcnt(0)" ::: "memory");
            const unsigned og = xb_add(&bar[XB_TOP], 1u);
            const unsigned tg = og / nx;
            if (og + 1u == (tg + 1u) * nx) xb_add(&bar[XB_TOPGEN], 1u);
            else XB_SPIN(xb_ld(&bar[XB_TOPGEN]) == tg, bar);
            __builtin_amdgcn_fence(__ATOMIC_ACQUIRE, "agent");
            xb_add(&bar[XB_XGEN(b.x)], 1u);
            asm volatile("s_waitcnt vmcnt(0)" ::: "memory");
        } else {
            XB_SPIN(xb_ld(&bar[XB_XGEN(b.x)]) == gen, bar);
            __builtin_amdgcn_fence(__ATOMIC_ACQUIRE, "agent");
            asm volatile("s_waitcnt vmcnt(0)" ::: "memory");
        }
    }
    __syncthreads();
}

namespace at {
#define AT_LAS __attribute__((address_space(3)))
typedef short bf16x8 __attribute__((ext_vector_type(8)));
typedef short s16x4 __attribute__((ext_vector_type(4)));
typedef float f32x16 __attribute__((ext_vector_type(16)));
typedef float f32x4 __attribute__((ext_vector_type(4)));
typedef unsigned u32x4 __attribute__((ext_vector_type(4)));
typedef unsigned u32x2 __attribute__((ext_vector_type(2)));
typedef unsigned short bf16_t;
constexpr int MP = 16384, PITCH = 1024, SEQ = 2048;
constexpr int KCS = 1040;
constexpr int KT_BYTES = 8 * KCS;
constexpr float THR = 8.0f;
constexpr int WSF_OFF = 132096;
constexpr int QIMG_OFF = 99328;
__device__ __forceinline__ int crow(int r, int hi) { return (r & 3) + 8 * (r >> 2) + 4 * hi; }
__device__ __forceinline__ unsigned cvtpk(float lo, float hi) { typedef float f2 __attribute__((ext_vector_type(2))); typedef __bf16 b2 __attribute__((ext_vector_type(2))); f2 v = {lo, hi}; b2 b = __builtin_convertvector(v, b2); return __builtin_bit_cast(unsigned, b); }
__device__ __forceinline__ s16x4 vtr(const AT_LAS unsigned char* p) { typedef short v4i16_t __attribute__((ext_vector_type(4))); return __builtin_bit_cast(s16x4, __builtin_amdgcn_ds_read_tr16_b64_v4i16((AT_LAS v4i16_t*)p)); }
#define AT_SYNC() __syncthreads()

template <bool QLDS>
__device__ __forceinline__ void qk_tile(f32x16& p0, f32x16& p1, const AT_LAS unsigned char* kt, const bf16x8 (&qr_)[4], const AT_LAS unsigned char* qimg, int r32, int hi) {
    p0 = f32x16{}; p1 = f32x16{};
#pragma unroll
    for (int d0 = 0; d0 < 4; ++d0) {
        bf16x8 qr[4]; if (QLDS) qr[d0] = *(const AT_LAS bf16x8*)(qimg + (2 * d0 + hi) * 512 + r32 * 16); else qr[d0] = qr_[d0];
        const bf16x8 a0 = *(const AT_LAS bf16x8*)(kt + (2 * d0 + hi) * KCS + r32 * 16);
        const bf16x8 a1 = *(const AT_LAS bf16x8*)(kt + (2 * d0 + hi) * KCS + r32 * 16 + 512);
        p0 = __builtin_amdgcn_mfma_f32_32x32x16_bf16(a0, qr[d0], p0, 0, 0, 0);
        p1 = __builtin_amdgcn_mfma_f32_32x32x16_bf16(a1, qr[d0], p1, 0, 0, 0);
    }
}
template <int ND0>
__device__ __forceinline__ void softmax_tile(f32x16& p0, f32x16& p1, float& m, float& l, f32x16 (&o)[ND0], AT_LAS float* wsf, int r32, int hi) {
    float rm = fmaxf(p0[0], p1[0]);
#pragma unroll
    for (int r = 1; r < 16; ++r) rm = fmaxf(rm, fmaxf(p0[r], p1[r]));
    rm = fmaxf(rm, __shfl_xor(rm, 32));
    if (__any(rm > m + THR)) {
        const float mn = fmaxf(m, rm), f = __builtin_amdgcn_exp2f(m - mn);
        l *= f; m = mn;
        if (hi == 0) wsf[r32] = f;
        asm volatile("s_waitcnt lgkmcnt(0)" ::: "memory");
#pragma unroll
        for (int r = 0; r < 16; ++r) { const float fr_ = wsf[crow(r, hi)];
#pragma unroll
            for (int d0 = 0; d0 < ND0; ++d0) o[d0][r] *= fr_; }
        asm volatile("s_waitcnt lgkmcnt(0)" ::: "memory");
    }
    float s = 0.f;
#pragma unroll
    for (int r = 0; r < 16; ++r) { p0[r] = __builtin_amdgcn_exp2f(p0[r] - m); p1[r] = __builtin_amdgcn_exp2f(p1[r] - m); s += p0[r] + p1[r]; }
    l += s;
}
template <int ND0>
__device__ __forceinline__ void pv_tile(f32x16 (&o)[ND0], const AT_LAS unsigned char* vt, const f32x16& p0, const f32x16& p1, int lane, int hi) {
    bf16x8 pa[4];
#pragma unroll
    for (int ks = 0; ks < 4; ++ks) {
        u32x4 w;
        if (ks < 2) { const int b = 8 * ks; w.x = cvtpk(p0[b], p0[b + 1]); w.y = cvtpk(p0[b + 2], p0[b + 3]); w.z = cvtpk(p0[b + 4], p0[b + 5]); w.w = cvtpk(p0[b + 6], p0[b + 7]); }
        else { const int b = 8 * (ks - 2); w.x = cvtpk(p1[b], p1[b + 1]); w.y = cvtpk(p1[b + 2], p1[b + 3]); w.z = cvtpk(p1[b + 4], p1[b + 5]); w.w = cvtpk(p1[b + 6], p1[b + 7]); }
        pa[ks] = __builtin_bit_cast(bf16x8, w);
    }
    const AT_LAS unsigned char* vb = vt + ((lane >> 4) & 1) * 32 + (lane & 3) * 8 + (4 * hi + ((lane & 15) >> 2)) * 64;
#pragma unroll
    for (int d0 = 0; d0 < ND0; ++d0)
#pragma unroll
        for (int ks = 0; ks < 4; ++ks) {
            const s16x4 lo = vtr(vb + d0 * 4096 + ks * 1024), hh = vtr(vb + d0 * 4096 + ks * 1024 + 512);
            const bf16x8 bfr = {lo[0], lo[1], lo[2], lo[3], hh[0], hh[1], hh[2], hh[3]};
            o[d0] = __builtin_amdgcn_mfma_f32_32x32x16_bf16(pa[ks], bfr, o[d0], 0, 0, 0);
        }
}
__device__ __forceinline__ u32x4 ld16(const void* p) { return *(const u32x4*)p; }
__device__ __forceinline__ u32x2 f4_to_bf4(u32x4 v) { u32x2 w; w.x = cvtpk(__uint_as_float(v.x), __uint_as_float(v.y)); w.y = cvtpk(__uint_as_float(v.z), __uint_as_float(v.w)); return w; }

struct Ctx {
    const bf16_t *Q, *K, *V; bf16_t* O;
    const float *cache_k, *cache_v;
    const float *lam_p, *subln;
    const float* rel;
};

template <int NK, int DV>
__device__ __forceinline__ void ld_bf(u32x4 (&st)[NK + DV / 64], const bf16_t* kbase, const bf16_t* vbase, int nrows, int tid) {
    const int row = tid >> 3, ch = tid & 7; const unsigned koff = (unsigned)row * PITCH + ch * 8;
#pragma unroll
    for (int c = 0; c < NK; ++c) st[c] = (row < nrows) ? ld16(kbase + koff + c * 64) : (u32x4){0u, 0u, 0u, 0u};
    if (DV == 64) { st[NK] = (row < nrows) ? ld16(vbase + koff) : (u32x4){0u, 0u, 0u, 0u}; }
    else {
        const int vrow = tid >> 4; const unsigned voff = (unsigned)vrow * PITCH + (tid & 15) * 8;
#pragma unroll
        for (int i = 0; i < 2; ++i) st[NK + i] = (vrow + 32 * i < nrows) ? ld16(vbase + voff + (size_t)i * 32 * PITCH) : (u32x4){0u, 0u, 0u, 0u};
    }
}
template <int NK, int DV>
__device__ __forceinline__ void wr_bf(const u32x4 (&st)[NK + DV / 64], AT_LAS unsigned char* sb, int tid) {
    const int row = tid >> 3, ch = tid & 7;
#pragma unroll
    for (int c = 0; c < NK; ++c) *(AT_LAS u32x4*)(sb + c * KT_BYTES + ch * KCS + row * 16) = st[c];
    AT_LAS unsigned char* vb = sb + NK * KT_BYTES;
    if (DV == 64) { const int col = ch * 8; *(AT_LAS u32x4*)(vb + ((col >> 5) * 4 + (row >> 4)) * 1024 + (row & 15) * 64 + (col & 31) * 2) = st[NK]; }
    else {
        const int vrow = tid >> 4, col = (tid & 15) * 8;
#pragma unroll
        for (int i = 0; i < 2; ++i) *(AT_LAS u32x4*)(vb + ((col >> 5) * 4 + ((vrow + 32 * i) >> 4)) * 1024 + (vrow & 15) * 64 + (col & 31) * 2) = st[NK + i];
    }
}
template <int NK, int DV>
__device__ __forceinline__ void ld_f32(u32x4 (&st)[2 * NK + DV / 32], const float* kbase, const float* vbase, int tid) {
    { const unsigned off = (unsigned)(tid >> 4) * 1024 + (tid & 15) * 4;
#pragma unroll
      for (int c = 0; c < NK; ++c)
#pragma unroll
          for (int i = 0; i < 2; ++i) st[c * 2 + i] = ld16(kbase + off + c * 64 + (size_t)i * 32 * 1024); }
    if (DV == 64) { const unsigned off = (unsigned)(tid >> 4) * 1024 + (tid & 15) * 4;
#pragma unroll
        for (int i = 0; i < 2; ++i) st[2 * NK + i] = ld16(vbase + off + (size_t)i * 32 * 1024); }
    else { const unsigned off = (unsigned)(tid >> 5) * 1024 + (tid & 31) * 4;
#pragma unroll
        for (int i = 0; i < 4; ++i) st[2 * NK + i] = ld16(vbase + off + (size_t)i * 16 * 1024); }
}
template <int NK, int DV>
__device__ __forceinline__ void wr_f32(const u32x4 (&st)[2 * NK + DV / 32], AT_LAS unsigned char* sb, int tid) {
    { const int row = tid >> 4, c4 = tid & 15;
#pragma unroll
      for (int c = 0; c < NK; ++c)
#pragma unroll
          for (int i = 0; i < 2; ++i) *(AT_LAS u32x2*)(sb + c * KT_BYTES + (c4 >> 1) * KCS + (row + 32 * i) * 16 + (c4 & 1) * 8) = f4_to_bf4(st[c * 2 + i]); }
    AT_LAS unsigned char* vb = sb + NK * KT_BYTES;
    if (DV == 64) { const int row = tid >> 4, col = (tid & 15) * 4;
#pragma unroll
        for (int i = 0; i < 2; ++i) *(AT_LAS u32x2*)(vb + ((col >> 5) * 4 + ((row + 32 * i) >> 4)) * 1024 + (row & 15) * 64 + (col & 31) * 2) = f4_to_bf4(st[2 * NK + i]); }
    else { const int row = tid >> 5, col = (tid & 31) * 4;
#pragma unroll
        for (int i = 0; i < 4; ++i) *(AT_LAS u32x2*)(vb + ((col >> 5) * 4 + ((row + 16 * i) >> 4)) * 1024 + (row & 15) * 64 + (col & 31) * 2) = f4_to_bf4(st[2 * NK + i]); }
}

constexpr int A_STAGE = 2 * KT_BYTES + 16384;
constexpr int A_TP = 132;
template <bool SAMPLE>
__device__ __forceinline__ void attnA_unit(AT_LAS unsigned char* lds, int b, int h, int ub, const Ctx& C) {
    const int tid = threadIdx.x, lane = tid & 63, r32 = lane & 31, hi = lane >> 5;
    const int w = __builtin_amdgcn_readfirstlane(tid >> 6), comp = w >> 2, qi = w & 3;
    AT_LAS float* wsf = (AT_LAS float*)(lds + WSF_OFF) + w * 64;
    const int NT = SAMPLE ? 16 : (2 * ub + 2);
    const bool active = SAMPLE ? (qi == 0) : true;
    const int cw = 2 * ub + (qi >> 1);
    const int qrow0 = SAMPLE ? (MP + b * 32) : (b * SEQ + ub * 128 + qi * 32);
    float lam;
    { const float a = C.lam_p[lane] * C.lam_p[64 + lane], c = C.lam_p[128 + lane] * C.lam_p[192 + lane];
      float sa = a, sc = c;
#pragma unroll
      for (int o_ = 1; o_ < 64; o_ <<= 1) { sa += __shfl_xor(sa, o_); sc += __shfl_xor(sc, o_); }
      lam = __expf(sa) - __expf(sc) + 0.2f; }
    bf16x8 qr[4];
    AT_LAS unsigned char* qimg = lds + QIMG_OFF + w * 4096;
#pragma unroll
    for (int d0 = 0; d0 < 4; ++d0) { qr[d0] = *(const bf16x8*)(C.Q + (size_t)(qrow0 + r32) * PITCH + h * 128 + comp * 64 + d0 * 16 + hi * 8);
        *(AT_LAS bf16x8*)(qimg + (2 * d0 + hi) * 512 + r32 * 16) = qr[d0]; }
    f32x16 o[4]; o[0] = f32x16{}; o[1] = f32x16{}; o[2] = f32x16{}; o[3] = f32x16{};
    float m = -1e30f, l = 0.f;
    const bf16_t* kb0 = C.K + (size_t)(SAMPLE ? (MP + b * 32) : b * SEQ) * PITCH + h * 128;
    const bf16_t* vb0 = C.V + (size_t)(SAMPLE ? (MP + b * 32) : b * SEQ) * PITCH + h * 128;
    const float* kc0 = C.cache_k + (size_t)b * 1024 * 1024 + h * 128;
    const float* vc0 = C.cache_v + (size_t)b * 1024 * 1024 + h * 128;
    if (SAMPLE) { u32x4 sn[4]; ld_bf<2, 128>(sn, kb0, vb0, 32, tid); wr_bf<2, 128>(sn, lds + 2 * A_STAGE, tid); }
    u32x4 st[SAMPLE ? 8 : 4];
    if constexpr (SAMPLE) ld_f32<2, 128>(st, kc0, vc0, tid); else ld_bf<2, 128>(st, kb0, vb0, 64, tid);
    for (int t = 0; t < NT; ++t) {
        AT_LAS unsigned char* sb = lds + (t & 1) * A_STAGE;
        if constexpr (SAMPLE) wr_f32<2, 128>(st, sb, tid); else wr_bf<2, 128>(st, sb, tid);
        AT_SYNC();
        if (t + 1 < NT) { if constexpr (SAMPLE) ld_f32<2, 128>(st, kc0 + (size_t)(t + 1) * 64 * 1024, vc0 + (size_t)(t + 1) * 64 * 1024, tid); else ld_bf<2, 128>(st, kb0 + (size_t)(t + 1) * 64 * PITCH, vb0 + (size_t)(t + 1) * 64 * PITCH, 64, tid); }
        if (active && (SAMPLE || t <= cw)) {
            const int nsub = (SAMPLE && t == 0) ? 2 : 1;
#pragma unroll 1
            for (int sub = 0; sub < nsub; ++sub) {
                const AT_LAS unsigned char* sc = sub ? (lds + 2 * A_STAGE) : sb;
                f32x16 p0, p1;
                qk_tile<true>(p0, p1, sc + comp * KT_BYTES, qr, qimg, r32, hi);
                if (SAMPLE && sub) {
#pragma unroll
                    for (int r = 0; r < 16; ++r) p1[r] = -INFINITY;
                }
                softmax_tile<4>(p0, p1, m, l, o, wsf, r32, hi);
                pv_tile<4>(o, sc + 2 * KT_BYTES, p0, p1, lane, hi);
            }
        }
    }
    AT_SYNC();
    { const float lt = l + __shfl_xor(l, 32); float inv = 1.0f / lt; if (comp == 1) inv *= lam;
      if (hi == 0) wsf[r32] = inv; asm volatile("s_waitcnt lgkmcnt(0)" ::: "memory"); }
    AT_LAS float* T2 = (AT_LAS float*)lds + qi * (32 * A_TP);
    if (active && comp == 1) {
#pragma unroll
        for (int r = 0; r < 16; ++r) { const int q = crow(r, hi); const float f = wsf[q];
#pragma unroll
            for (int d0 = 0; d0 < 4; ++d0) T2[q * A_TP + d0 * 32 + r32] = o[d0][r] * f; }
    }
    AT_SYNC();
    if (active && comp == 0) {
#pragma unroll
        for (int r = 0; r < 16; ++r) { const int q = crow(r, hi); const float f = wsf[q];
#pragma unroll
            for (int d0 = 0; d0 < 4; ++d0) { const int ix = q * A_TP + d0 * 32 + r32; T2[ix] = o[d0][r] * f - T2[ix]; } }
        asm volatile("s_waitcnt lgkmcnt(0)" ::: "memory");
        const int row = lane & 31, half = lane >> 5;
        f32x4 x[16]; float ss = 0.f;
#pragma unroll
        for (int i = 0; i < 16; ++i) { x[i] = *(const AT_LAS f32x4*)(T2 + row * A_TP + half * 64 + 4 * i); ss += (x[i][0] * x[i][0] + x[i][1] * x[i][1]) + (x[i][2] * x[i][2] + x[i][3] * x[i][3]); }
        ss += __shfl_xor(ss, 32);
        const float rinv = 0.8f / sqrtf(ss * (1.0f / 128.0f) + 1e-6f);
        bf16_t* op = C.O + (size_t)(qrow0 + row) * PITCH + h * 128 + half * 64;
#pragma unroll
        for (int i = 0; i < 16; i += 2) {
            const f32x4 g0 = *(const f32x4*)(C.subln + half * 64 + 4 * i), g1 = *(const f32x4*)(C.subln + half * 64 + 4 * i + 4);
            const f32x4 y0 = x[i] * g0 * rinv, y1 = x[i + 1] * g1 * rinv;
            u32x4 wv; wv.x = cvtpk(y0[0], y0[1]); wv.y = cvtpk(y0[2], y0[3]); wv.z = cvtpk(y1[0], y1[1]); wv.w = cvtpk(y1[2], y1[3]);
            *(u32x4*)(op + 4 * i) = wv;
        }
    }
    AT_SYNC();
}

constexpr int B_STAGE = KT_BYTES + 8192;
constexpr int B_TAB = 3 * B_STAGE;
constexpr int B_OST = 53248;
template <bool SAMPLE>
__device__ __forceinline__ void attnB_unit(AT_LAS unsigned char* lds, int b, int h, int qb, const Ctx& C) {
    const int tid = threadIdx.x, lane = tid & 63, r32 = lane & 31, hi = lane >> 5;
    const int w = __builtin_amdgcn_readfirstlane(tid >> 6);
    AT_LAS float* wsf = (AT_LAS float*)(lds + WSF_OFF) + w * 64;
    AT_LAS float* tab = (AT_LAS float*)(lds + B_TAB);
    const int kt0 = SAMPLE ? 0 : ((4 * qb - 8) > 0 ? (4 * qb - 8) : 0), kt1 = SAMPLE ? 7 : (4 * qb + 3);
    const bool active = SAMPLE ? (w == 0) : true;
    const int cw = 4 * qb + (w >> 1);
    const int qrow0 = SAMPLE ? (MP + b * 32) : (b * SEQ + qb * 256 + w * 32);
    const int qpos = SAMPLE ? (1024 + r32) : (qb * 256 + w * 32 + r32);
    if (tid < 257) tab[tid] = C.rel[h * 257 + tid] * 1.4426950408889634f;
    bf16x8 qr[4];
#pragma unroll
    for (int d0 = 0; d0 < 4; ++d0) qr[d0] = *(const bf16x8*)(C.Q + (size_t)(qrow0 + r32) * PITCH + h * 64 + d0 * 16 + hi * 8);
    f32x16 o[2]; o[0] = f32x16{}; o[1] = f32x16{};
    float m = -1e30f, l = 0.f;
    const bf16_t* kb0 = C.K + (size_t)(SAMPLE ? (MP + b * 32) : b * SEQ) * PITCH + h * 64;
    const bf16_t* vb0 = C.V + (size_t)(SAMPLE ? (MP + b * 32) : b * SEQ) * PITCH + h * 64;
    const float* kc0 = C.cache_k + (size_t)b * 512 * 1024 + h * 64;
    const float* vc0 = C.cache_v + (size_t)b * 512 * 1024 + h * 64;
    if (SAMPLE) { u32x4 sn[2]; ld_bf<1, 64>(sn, kb0, vb0, 32, tid); wr_bf<1, 64>(sn, lds + 2 * B_STAGE, tid); }
    u32x4 st[SAMPLE ? 4 : 2];
    if constexpr (SAMPLE) ld_f32<1, 64>(st, kc0, vc0, tid); else ld_bf<1, 64>(st, kb0 + (size_t)kt0 * 64 * PITCH, vb0 + (size_t)kt0 * 64 * PITCH, 64, tid);
    for (int kt = kt0; kt <= kt1; ++kt) {
        AT_LAS unsigned char* sb = lds + ((kt - kt0) & 1) * B_STAGE;
        if constexpr (SAMPLE) wr_f32<1, 64>(st, sb, tid); else wr_bf<1, 64>(st, sb, tid);
        AT_SYNC();
        if (kt + 1 <= kt1) { if constexpr (SAMPLE) ld_f32<1, 64>(st, kc0 + (size_t)(kt + 1) * 64 * 1024, vc0 + (size_t)(kt + 1) * 64 * 1024, tid); else ld_bf<1, 64>(st, kb0 + (size_t)(kt + 1) * 64 * PITCH, vb0 + (size_t)(kt + 1) * 64 * PITCH, 64, tid); }
        const bool mine = active && (SAMPLE || (kt <= cw && kt >= cw - 8));
        if (mine) {
            const int nsub = (SAMPLE && kt == 0) ? 2 : 1;
#pragma unroll 1
            for (int sub = 0; sub < nsub; ++sub) {
                const AT_LAS unsigned char* sc = sub ? (lds + 2 * B_STAGE) : sb;
                f32x16 p0, p1;
                qk_tile<false>(p0, p1, sc, qr, nullptr, r32, hi);
                const int kpos0 = SAMPLE ? (sub ? 1024 : 512 + kt * 64) : (kt * 64);
                const int relmin = SAMPLE ? (1024 - (kpos0 + 63)) : (cw * 64 + (w & 1) * 32 - (kpos0 + 63));
                if (relmin >= 128) {
                    const float cb = tab[256];
#pragma unroll
                    for (int r = 0; r < 16; ++r) { p0[r] += cb; p1[r] += cb; }
                } else {
#pragma unroll
                    for (int r = 0; r < 16; ++r) {
                        const int rel = qpos - (kpos0 + crow(r, hi));
                        const int i0 = rel < -128 ? -128 : (rel > 128 ? 128 : rel), i1 = (rel - 32) < -128 ? -128 : ((rel - 32) > 128 ? 128 : (rel - 32));
                        p0[r] += tab[i0 + 128]; p1[r] += tab[i1 + 128];
                    }
                }
                if (SAMPLE && sub) {
#pragma unroll
                    for (int r = 0; r < 16; ++r) p1[r] = -INFINITY;
                }
                softmax_tile<2>(p0, p1, m, l, o, wsf, r32, hi);
                pv_tile<2>(o, sc + KT_BYTES, p0, p1, lane, hi);
            }
        }
    }
    if (active) {
        const float lt = l + __shfl_xor(l, 32), inv = 1.0f / lt;
        if (hi == 0) wsf[r32] = inv; asm volatile("s_waitcnt lgkmcnt(0)" ::: "memory");
        AT_LAS bf16_t* stg = (AT_LAS bf16_t*)(lds + B_OST) + w * 2048;
#pragma unroll
        for (int r = 0; r < 16; ++r) { const int q = crow(r, hi); const float f = wsf[q];
#pragma unroll
            for (int d0 = 0; d0 < 2; ++d0) { const unsigned pk = cvtpk(o[d0][r] * f, 0.f); stg[q * 64 + d0 * 32 + r32] = (bf16_t)(pk & 0xffffu); } }
        asm volatile("s_waitcnt lgkmcnt(0)" ::: "memory");
        bf16_t* op = C.O + (size_t)qrow0 * PITCH + h * 64;
#pragma unroll
        for (int i = 0; i < 4; ++i) { const int row = i * 8 + (lane >> 3), ch = lane & 7; const u32x4 v = *(const AT_LAS u32x4*)(stg + row * 64 + ch * 8); *(u32x4*)(op + (size_t)row * PITCH + ch * 8) = v; }
    }
    AT_SYNC();
}
}

constexpr int NWAVES = 8;
#ifndef MK_N_LAUNCHES
#define MK_N_LAUNCHES 1
#endif
constexpr int N_PHASES = 12;
constexpr int DMODEL = 1024, SEQ = 2048, NBATCH = 8, MP = NBATCH * SEQ, MS = 1024, M = MP + MS, FF = 4096;
constexpr size_t O_Y = 0, O_AKP = 17825792, O_AVP = 34603008, O_BKP = 51380224, O_BVP = 55574528, O_AKS = 59768832, O_AVS = 60817408, O_BKS = 61865984, O_BVS = 62914560, O_END = 63963136;
constexpr size_t MiB = 1u << 20;
constexpr size_t WS_CTL = 0, CTL_ZERO_BYTES = 1 * MiB;
constexpr size_t WS_WQKV = 2 * MiB, WS_WAO = 8 * MiB, WS_WKVQ = 10 * MiB, WS_WBO = 16 * MiB, WS_W1 = 18 * MiB  , WS_W2 = 34 * MiB  ;
constexpr size_t WS_CS = 50 * MiB;
constexpr size_t WS_SS = 51 * MiB;
constexpr size_t WS_HB = 54 * MiB, WS_Q = 90 * MiB, WS_K = 126 * MiB, WS_V = 162 * MiB, WS_O = 198 * MiB;
constexpr size_t WS_U = 234 * MiB;
constexpr size_t WS_END = 372 * MiB;
constexpr int CW_TMO = 0, CW_CODE = 1, CW_BAR = 4096;
constexpr int RING_OFF = 0, RING_BYTES = 131072, LDS_BYTES = 163840, LDSCTL_OFF = LDS_BYTES - 1024, MISC_OFF = LDSCTL_OFF + 320;

struct Args { const float* in[20]; float* out; unsigned char* ws; int ph_lo, ph_hi, li, pad; };

struct Frame {
    LAS unsigned char* lds; volatile LAS unsigned* MISC; gu32* ctl;
    int tid, lane, wave, vcu, G;
};

__device__ __forceinline__ float wave_sum(float v) {
#pragma unroll
    for (int o = 1; o < 64; o <<= 1) v += __shfl_xor(v, o);
    return v;
}
__device__ __forceinline__ int pi64(int d) { return d < 32 ? 32 * (d >> 4) + (d & 15) : 32 * ((d - 32) >> 4) + 16 + ((d - 32) & 15); }
template <bool PERMQK>
__device__ __forceinline__ void p0_transpose_item(const float* W, const float* g, int K, int N, bf16* WT, int row_off, LAS float* scr, int item, int lane) {
    const int nblk = N / 32, kb = item / nblk, nb = item % nblk, k0 = 64 * kb, n0 = 32 * nb;
#pragma unroll 8
    for (int i = 0; i < 32; ++i) { const int kk = 2 * i + (lane >> 5); const float gv = g ? g[k0 + kk] : 1.0f; scr[kk * 33 + (lane & 31)] = W[(size_t)(k0 + kk) * N + n0 + (lane & 31)] * gv; }
    LDS_WAIT(); asm volatile("" ::: "memory");
    const int c = lane & 7;
#pragma unroll
    for (int j = 0; j < 4; ++j) { const int n = (lane >> 3) + 8 * j; const LAS float* s = scr + (8 * c) * 33 + n;
        v4u o; o.x = pk2(s[0 * 33], s[1 * 33]); o.y = pk2(s[2 * 33], s[3 * 33]); o.z = pk2(s[4 * 33], s[5 * 33]); o.w = pk2(s[6 * 33], s[7 * 33]);
        int nn = n0 + n; if (PERMQK && nn < 2048) nn = (nn & ~63) + pi64(nn & 63);
        *(GAS v4u*)(WT + (size_t)(row_off + nn) * K + k0 + 8 * c) = o; }
    LDS_WAIT(); asm volatile("" ::: "memory");
}
__device__ __forceinline__ void p0_prologue(Frame& F, const Args& A) {
    unsigned char* ws = A.ws;
    LAS float* scr = (LAS float*)(F.lds + RING_OFF + F.wave * 16384);
    const int gw = F.vcu * NWAVES + F.wave, NGW = F.G * NWAVES;
    constexpr int I_QKV = 16 * 96, I_SQ = 16 * 32, I_KV = 16 * 64, I_F1 = 16 * 128, I_F2 = 64 * 32;
    constexpr int NITEMS = I_QKV + I_SQ + I_KV + I_SQ + I_SQ + 2 * I_F1 + 2 * I_F2;
    const float* g_attn = A.in[6]; const float* g_mlp = A.in[16];
    for (int it = gw; it < NITEMS; it += NGW) {
        int r = it;
        if (r < I_QKV) { p0_transpose_item<true>(A.in[7], g_attn, 1024, 3072, (bf16*)(ws + WS_WQKV), 0, scr, r, F.lane); continue; } r -= I_QKV;
        if (r < I_SQ) { p0_transpose_item<false>(A.in[10], nullptr, 1024, 1024, (bf16*)(ws + WS_WAO), 0, scr, r, F.lane); continue; } r -= I_SQ;
        if (r < I_KV) { p0_transpose_item<false>(A.in[12], A.in[11], 1024, 2048, (bf16*)(ws + WS_WKVQ), 0, scr, r, F.lane); continue; } r -= I_KV;
        if (r < I_SQ) { p0_transpose_item<false>(A.in[13], g_attn + 1024, 1024, 1024, (bf16*)(ws + WS_WKVQ), 2048, scr, r, F.lane); continue; } r -= I_SQ;
        if (r < I_SQ) { p0_transpose_item<false>(A.in[15], nullptr, 1024, 1024, (bf16*)(ws + WS_WBO), 0, scr, r, F.lane); continue; } r -= I_SQ;
        if (r < I_F1) { p0_transpose_item<false>(A.in[17], g_mlp, 1024, 4096, (bf16*)(ws + WS_W1), 0, scr, r, F.lane); continue; } r -= I_F1;
        if (r < I_F1) { p0_transpose_item<false>(A.in[17] + (size_t)1024 * 4096, g_mlp + 1024, 1024, 4096, (bf16*)(ws + WS_W1 + 8 * MiB), 0, scr, r, F.lane); continue; } r -= I_F1;
        if (r < I_F2) { p0_transpose_item<false>(A.in[18], nullptr, 4096, 1024, (bf16*)(ws + WS_W2), 0, scr, r, F.lane); continue; } r -= I_F2;
        p0_transpose_item<false>(A.in[18] + (size_t)4096 * 1024, nullptr, 4096, 1024, (bf16*)(ws + WS_W2 + 8 * MiB), 0, scr, r, F.lane);
    }
    bf16* HB = (bf16*)(ws + WS_HB); float* SS = (float*)(ws + WS_SS);
    for (int m = gw; m < M; m += NGW) {
        const float* xrow = (m < MP) ? A.in[0] + (size_t)m * 1024 : A.in[1] + (size_t)(m - MP) * 1024;
        const GAS f32x4* xr = (const GAS f32x4*)xrow + F.lane;
        f32x4 v[4]; float s = 0.f;
#pragma unroll
        for (int j = 0; j < 4; ++j) { v[j] = xr[64 * j]; s += (v[j].x * v[j].x + v[j].y * v[j].y) + (v[j].z * v[j].z + v[j].w * v[j].w); }
        s = wave_sum(s);
        GAS unsigned long long* o8 = (GAS unsigned long long*)(HB + (size_t)m * 1024) + F.lane;
#pragma unroll
        for (int j = 0; j < 4; ++j) o8[64 * j] = (unsigned long long)pk2(v[j].x, v[j].y) | ((unsigned long long)pk2(v[j].z, v[j].w) << 32);
        if (F.lane < 16) SS[(size_t)m * 16 + F.lane] = (F.lane == 0) ? s : 0.f;
    }
    float* cs = (float*)(ws + WS_CS);
    for (int e = (F.vcu * NWAVES + F.wave) * 64 + F.lane; e < 2048 * 32; e += F.G * NWAVES * 64) {
        const int pos = e >> 5, i = e & 31;
        const float inv = 1.0f / powf(10000.0f, (float)i * (1.0f / 32.0f));
        const float ang = (float)pos * inv;
        float sv, cv; sincosf(ang, &sv, &cv);
        cs[(size_t)pos * 64 + i] = cv; cs[(size_t)pos * 64 + 32 + i] = sv;
    }
}
__device__ __forceinline__ void final_norm(Frame& F, const Args& A) {
    const int gw = F.vcu * NWAVES + F.wave, NGW = F.G * NWAVES;
    const float* SS = (const float*)(A.ws + WS_SS); const float* gf = A.in[19];
    f32x4 g[4];
#pragma unroll
    for (int j = 0; j < 4; ++j) g[j] = *((const f32x4*)gf + F.lane + 64 * j);
    for (int m = gw; m < M; m += NGW) {
        float s = (F.lane < 16) ? SS[(size_t)m * 16 + F.lane] : 0.f;
        s = wave_sum(s);
        const float r = 1.0f / sqrtf(s * (1.0f / 1024.0f) + 1e-6f);
        GAS f32x4* yr = (GAS f32x4*)(A.out + (size_t)m * 1024) + F.lane;
#pragma unroll
        for (int j = 0; j < 4; ++j) { f32x4 v = yr[64 * j]; v = v * g[j] * r; yr[64 * j] = v; }
    }
}

__global__ void __launch_bounds__(NWAVES * 64, 2) skel_fwd(Args args) {
    extern __shared__ __attribute__((aligned(16))) unsigned char lds[];
    Frame F;
    F.lds = (LAS unsigned char*)lds;
    F.MISC = (volatile LAS unsigned*)(F.lds + MISC_OFF);
    F.tid = threadIdx.x; F.lane = F.tid & 63; F.wave = __builtin_amdgcn_readfirstlane(F.tid >> 6);
    F.G = gridDim.x; { const int bx = blockIdx.x; F.vcu = (F.G % 8 == 0) ? (bx % 8) * (F.G / 8) + bx / 8 : bx; }
    unsigned char* ws = args.ws;
    F.ctl = (gu32*)(ws + WS_CTL);
    for (int u = F.tid; u < (LDS_BYTES - LDSCTL_OFF) / 4; u += NWAVES * 64) ((LAS unsigned*)(F.lds + LDSCTL_OFF))[u] = 0u;
    __syncthreads();
    const bool one_launch = (MK_N_LAUNCHES == 1);
    XcdBarrier bar; bar.bar = (unsigned*)(F.ctl + CW_BAR); bar.x = 0; bar.st = nullptr;
    if (one_launch) bar = xcd_barrier_post((unsigned*)(F.ctl + CW_BAR), F.MISC + 8);
#define GRID_BAR() do { if (one_launch) xcd_barrier(bar); } while (0)
    const int lo = args.ph_lo, hi = args.ph_hi;
#ifndef PHASE_MASK
#define PHASE_MASK 0xFFFF
#endif
#define IN(k) ((((PHASE_MASK) >> (k)) & 1) && lo <= (k) && (k) < hi)
#define BOTH(k) (IN(k) && IN((k) + 1))
    pg8::bf16_t* const HB = (pg8::bf16_t*)(ws + WS_HB); pg8::bf16_t* const QB = (pg8::bf16_t*)(ws + WS_Q); pg8::bf16_t* const KB = (pg8::bf16_t*)(ws + WS_K);
    pg8::bf16_t* const VB = (pg8::bf16_t*)(ws + WS_V); pg8::bf16_t* const OB = (pg8::bf16_t*)(ws + WS_O); pg8::bf16_t* const UB = (pg8::bf16_t*)(ws + WS_U);
    float* const SS = (float*)(ws + WS_SS); float* const H = args.out + O_Y;

    if (IN(0)) { p0_prologue(F, args); if (BOTH(0)) GRID_BAR(); }
    if (IN(1)) {
        pg8::Gemm g{HB, (const pg8::bf16_t*)(ws + WS_WQKV), M, 3072, 1024}; pg8::StaticOrder S; S.init(M, 3072, F.G, (int)blockIdx.x);
        pg8::EpiQKV E{SS, (const float*)(ws + WS_CS), QB, KB, VB, args.out};
        pg8::gemm_phase<pg8::EpiQKV, pg8::StaticOrder, true, true>(F.lds + RING_OFF, g, S, E);
        if (BOTH(1)) GRID_BAR();
    }
    if (IN(2)) {
        at::Ctx C{QB, KB, VB, OB, args.in[2], args.in[3], args.in[8], args.in[9], nullptr};
        for (int vv = F.vcu; vv < 256; vv += F.G) {
            const int bh = vv >> 2, s = vv & 3;
#pragma unroll 1
            for (int i = 0; i < 5; ++i) {
                const int j = (vv & 1) ? ((i + 1) % 5) : i;
                if (j == 0) at::attnA_unit<true>(F.lds, vv >> 3, vv & 7, 0, C);
                else { const int k_ = j - 1, ub = 8 * (k_ >> 1) + ((k_ & 1) ? 7 - s : s); at::attnA_unit<false>(F.lds, bh >> 3, bh & 7, ub, C); }
            }
        }
        if (BOTH(2)) GRID_BAR();
    }
    if (IN(3)) {
        pg8::Gemm g{OB, (const pg8::bf16_t*)(ws + WS_WAO), M, 1024, 1024}; pg8::StaticOrder S; S.init(M, 1024, F.G, (int)blockIdx.x);
        pg8::EpiRes E{args.in[0], args.in[1], H, HB, SS, true};
        pg8::gemm_phase<pg8::EpiRes, pg8::StaticOrder, true, true>(F.lds + RING_OFF, g, S, E);
        if (BOTH(3)) GRID_BAR();
    }
    if (IN(4)) {
        pg8::Gemm g{HB, (const pg8::bf16_t*)(ws + WS_W1), M, FF, 1024}; pg8::StaticOrder S; S.init(M, FF, F.G, (int)blockIdx.x);
        pg8::EpiFF1 E{SS, UB, FF};
        pg8::gemm_phase<pg8::EpiFF1, pg8::StaticOrder, true, true>(F.lds + RING_OFF, g, S, E);
        if (BOTH(4)) GRID_BAR();
    }
    if (IN(5)) {
        pg8::Gemm g{UB, (const pg8::bf16_t*)(ws + WS_W2), M, 1024, FF}; pg8::StaticOrder S; S.init(M, 1024, F.G, (int)blockIdx.x);
        pg8::EpiRes E{args.in[0], args.in[1], H, HB, SS, false};
        pg8::gemm_phase<pg8::EpiRes, pg8::StaticOrder, true, true>(F.lds + RING_OFF, g, S, E);
        if (BOTH(5)) GRID_BAR();
    }
    if (IN(6)) {
        pg8::Gemm g{HB, (const pg8::bf16_t*)(ws + WS_WKVQ), M, 3072, 1024}; pg8::StaticOrder S; S.init(M, 3072, F.G, (int)blockIdx.x);
        pg8::EpiKVQ E{SS, QB, KB, args.out};
        pg8::gemm_phase<pg8::EpiKVQ, pg8::StaticOrder, true, true>(F.lds + RING_OFF, g, S, E);
        if (BOTH(6)) GRID_BAR();
    }
    if (IN(7)) {
        at::Ctx C{QB, KB, VB, OB, args.in[4], args.in[5], nullptr, nullptr, args.in[14]};
        for (int vv = F.vcu; vv < 256; vv += F.G) {
            const int bh = vv >> 1, par = vv & 1;
#pragma unroll 1
            for (int i = 0; i < 4; ++i) { const int qb = 4 * (i >> 1) + ((i & 1) ? 3 - par : par); at::attnB_unit<false>(F.lds, bh >> 4, bh & 15, qb, C); }
#pragma unroll 1
            for (int i = 0; i < 2; ++i) at::attnB_unit<true>(F.lds, vv >> 3, 2 * (vv & 7) + i, 0, C);
        }
        if (BOTH(7)) GRID_BAR();
    }
    if (IN(8)) {
        pg8::Gemm g{OB, (const pg8::bf16_t*)(ws + WS_WBO), M, 1024, 1024}; pg8::StaticOrder S; S.init(M, 1024, F.G, (int)blockIdx.x);
        pg8::EpiRes E{args.in[0], args.in[1], H, HB, SS, false};
        pg8::gemm_phase<pg8::EpiRes, pg8::StaticOrder, true, true>(F.lds + RING_OFF, g, S, E);
        if (BOTH(8)) GRID_BAR();
    }
    if (IN(9)) {
        pg8::Gemm g{HB, (const pg8::bf16_t*)(ws + WS_W1 + 8 * MiB), M, FF, 1024}; pg8::StaticOrder S; S.init(M, FF, F.G, (int)blockIdx.x);
        pg8::EpiFF1 E{SS, UB, FF};
        pg8::gemm_phase<pg8::EpiFF1, pg8::StaticOrder, true, true>(F.lds + RING_OFF, g, S, E);
        if (BOTH(9)) GRID_BAR();
    }
    if (IN(10)) {
        pg8::Gemm g{UB, (const pg8::bf16_t*)(ws + WS_W2 + 8 * MiB), M, 1024, FF}; pg8::StaticOrder S; S.init(M, 1024, F.G, (int)blockIdx.x);
        pg8::EpiRes E{args.in[0], args.in[1], H, HB, SS, false};
        pg8::gemm_phase<pg8::EpiRes, pg8::StaticOrder, true, true>(F.lds + RING_OFF, g, S, E);
        if (BOTH(10)) GRID_BAR();
    }
    if (IN(11)) final_norm(F, args);
#undef IN
#undef BOTH
}

extern "C" void kernel_launch(void* const* d_in, const int* in_sizes, int n_in, void* d_out, int out_size, void* d_ws, size_t ws_size, hipStream_t stream) {
    static int grid = 0;
    if (grid == 0) {
        if (n_in != 20 || out_size != (int)O_END || ws_size < WS_END) { fprintf(stderr, "kernel_launch: unexpected problem (n_in %d out %d ws %zu)\n", n_in, out_size, ws_size); grid = -1; return; }
        int dev = 0, cus = 0, per_cu = 0;
        if (hipGetDevice(&dev) != hipSuccess || hipDeviceGetAttribute(&cus, hipDeviceAttributeMultiprocessorCount, dev) != hipSuccess) { grid = -1; return; }
        if (hipFuncSetAttribute((const void*)skel_fwd, hipFuncAttributeMaxDynamicSharedMemorySize, LDS_BYTES) != hipSuccess) { fprintf(stderr, "kernel_launch: hipFuncSetAttribute failed\n"); grid = -1; return; }
        if (hipOccupancyMaxActiveBlocksPerMultiprocessor(&per_cu, (const void*)skel_fwd, NWAVES * 64, LDS_BYTES) != hipSuccess || per_cu < 1) { fprintf(stderr, "kernel_launch: occupancy query reports %d\n", per_cu); per_cu = 1; }
        (void)hipGetLastError();
        grid = cus;
        if (grid > 256) grid = 256;
    }
    if (grid < 0) return;
    (void)hipMemsetAsync((char*)d_ws + WS_CTL, 0, CTL_ZERO_BYTES, stream);
    Args a{};
    for (int i = 0; i < 20; ++i) a.in[i] = (const float*)d_in[i];
    a.out = (float*)d_out; a.ws = (unsigned char*)d_ws;
    if (MK_N_LAUNCHES == 1) {
        a.ph_lo = 0; a.ph_hi = N_PHASES; a.li = 0;
        hipLaunchKernelGGL(skel_fwd, dim3(grid), dim3(NWAVES * 64), LDS_BYTES, stream, a);
    } else {
        for (int li = 0; li < N_PHASES; ++li) { a.ph_lo = li; a.ph_hi = li + 1; a.li = li; hipLaunchKernelGGL(skel_fwd, dim3(grid), dim3(NWAVES * 64), LDS_BYTES, stream, a); }
    }
}
```

```cpp
#include <hip/hip_runtime.h>
#include <cstdio>
#include <cstdint>
#include <cmath>
namespace pg8 {
__device__ __forceinline__ int opaque_tid() { int t = threadIdx.x; asm volatile("" : "+v"(t)); return t; }
#define PG8_LAS __attribute__((address_space(3)))
typedef unsigned short bf16_t;
typedef short bf16x8 __attribute__((ext_vector_type(8)));
typedef float f32x4 __attribute__((ext_vector_type(4)));
typedef unsigned u32x4 __attribute__((ext_vector_type(4)));
constexpr int BM = 256, BK = 64, HALF = 128, HTB = HALF * BK * 2  , STAGE_BYTES = 8 * HTB, NXCD = 8, WGM = 8;

__host__ __device__ __forceinline__ int lds_byte(int r, int c) { const int st = (r >> 4) * 2 + (c >> 5), rr = r & 15, cc = c & 31, ob = rr * 64 + cc * 2; return st * 1024 + (ob ^ (((ob >> 9) & 1) << 5)); }
__host__ __device__ __forceinline__ void stage_rc(int b, int& R, int& C) { const int st = b / 1024, sb = b % 1024, swz = sb ^ (((sb >> 9) & 1) << 5); R = (st >> 1) * 16 + swz / 64; C = (st & 1) * 32 + (swz % 64) / 2; }
__host__ __device__ __forceinline__ int perm32(int rho) { const int n = rho >> 4, i = rho & 15; return 8 * (i >> 2) + 4 * n + (i & 3); }

struct Unit { int pm, pn; };
struct Gemm { const bf16_t* A; const bf16_t* Bt; int M, N, K; };

struct StaticOrder {
    int nM, nN, nwg, G, c;
    __host__ __device__ void init(int M, int N, int G_, int c_) { nM = M / BM; nN = N / BM; nwg = nM * nN; G = G_; c = c_; }
    __host__ __device__ bool next(int i, Unit& u) const {
        const long L = (long)i * G + c; if (L >= nwg) return false;
        int wgid = (int)L; { const int q = nwg / NXCD, r = nwg % NXCD, xcd = wgid % NXCD, off = wgid / NXCD; wgid = (xcd < r ? xcd * (q + 1) : r * (q + 1) + (xcd - r) * q) + off; }
        const int nig = WGM * nN, gid = wgid / nig, fm = gid * WGM, gsz = (nM - fm) < WGM ? (nM - fm) : WGM;
        u.pm = fm + ((wgid % nig) % gsz); u.pn = (wgid % nig) / gsz; return true;
    }
    __device__ __forceinline__ void a_ready(const Unit&) const {}
    __device__ __forceinline__ void done(const Unit&) const {}
};
__device__ __forceinline__ unsigned cvt_pk_bf16(float lo, float hi) { unsigned r; asm volatile("v_cvt_pk_bf16_f32 %0, %1, %2" : "=v"(r) : "v"(lo), "v"(hi)); return r; }
typedef float f32x2 __attribute__((ext_vector_type(2)));

constexpr size_t PO_AKP = 17825792, PO_AVP = 34603008, PO_BKP = 51380224, PO_BVP = 55574528, PO_AKS = 59768832, PO_AVS = 60817408, PO_BKS = 61865984, PO_BVS = 62914560;
constexpr size_t PW_KV = (size_t)36 * 1048576 / 2;
constexpr int P_MP = 16384;
constexpr float P_EPS = 1e-6f;
constexpr float P_C2 = 0.125f * 1.4426950408889634f;
typedef unsigned u32x2 __attribute__((ext_vector_type(2)));
struct GeoBig  { static constexpr int NAI = 2, NBJ = 2, NM = 4, NN = 2, RS_WR = 64, CS_WC = 32, WCN = 4; };
struct GeoS128 { static constexpr int NAI = 1, NBJ = 1, NM = 4, NN = 2, RS_WR = 64, CS_WC = 32, WCN = 4; };
struct GeoS64  { static constexpr int NAI = 1, NBJ = 1, NM = 1, NN = 2, RS_WR = 16, CS_WC = 32, WCN = 2; };
struct Tile { int row0, col0; };

template <class G>
__device__ __forceinline__ void row_rstd(const float* SS, int row0, int fq, float (&rs)[2][4]) {
#pragma unroll
    for (int ai = 0; ai < G::NAI; ++ai)
#pragma unroll
        for (int m = 0; m < G::NM; ++m) {
            const f32x4 v = *(const f32x4*)(SS + (size_t)(row0 + ai * HALF + m * 16) * 16 + 4 * fq);
            float s = (v[0] + v[1]) + (v[2] + v[3]);
            s += __shfl_xor(s, 16); s += __shfl_xor(s, 32);
            rs[ai][m] = 1.0f / sqrtf(s * (1.0f / 1024.0f) + P_EPS);
        }
}

struct EpiQKV {
    static constexpr bool PERM = false, AFTER_DRAIN = false;
    const float* SS; const float* cs;
    bf16_t *Qb, *Kb, *Vb; float* out;
    __device__ __forceinline__ void operator()(const f32x4 (&acc)[2][2][4][2], const Unit& u, int wr, int wc, int fr, int fq) const { run<GeoBig>(acc, Tile{u.pm * BM, u.pn * BM}, wr, wc, fr, fq, nullptr); }
    template <class G> __device__ __forceinline__ void run(const f32x4 (&acc)[2][2][4][2], const Tile T, int wr, int wc, int fr, int fq, PG8_LAS float* scr) const {
        const int row0 = T.row0 + wr * G::RS_WR + fr;
        float rs[2][4]; row_rstd<G>(SS, row0, fq, rs);
        const int sec = T.col0 >> 10, ct = T.col0 & 1023;
        const bool smp = T.row0 >= P_MP;
#pragma unroll
        for (int ai = 0; ai < G::NAI; ++ai)
#pragma unroll
            for (int m = 0; m < G::NM; ++m) {
                const int row = row0 + ai * HALF + m * 16; const float r = rs[ai][m];
                const int pos = smp ? (1024 + ((row - P_MP) & 31)) : (row & 2047);
                const size_t orow = smp ? (size_t)(row - P_MP) * 1024 : (size_t)row * 1024;
                if (sec < 2) {
                    const int dl = 16 * (wc & 1) + 4 * fq;
                    const f32x4 c4 = *(const f32x4*)(cs + (size_t)pos * 64 + dl), s4 = *(const f32x4*)(cs + (size_t)pos * 64 + 32 + dl);
#pragma unroll
                    for (int bj = 0; bj < G::NBJ; ++bj) {
                        const int col = ct + 128 * bj + 64 * (wc >> 1) + dl;
                        const f32x4 x1 = acc[ai][bj][m][0] * r, x2 = acc[ai][bj][m][1] * r;
                        f32x4 y1 = x1 * c4 - x2 * s4, y2 = x2 * c4 + x1 * s4;
                        if (sec == 0) {
                            y1 = y1 * P_C2; y2 = y2 * P_C2;
                            u32x2 w1, w2; w1.x = cvt_pk_bf16(y1[0], y1[1]); w1.y = cvt_pk_bf16(y1[2], y1[3]); w2.x = cvt_pk_bf16(y2[0], y2[1]); w2.y = cvt_pk_bf16(y2[2], y2[3]);
                            *(u32x2*)(Qb + (size_t)row * 1024 + col) = w1; *(u32x2*)(Qb + (size_t)row * 1024 + col + 32) = w2;
                        } else {
                            float* ok = out + (smp ? PO_AKS : PO_AKP) + orow + col;
                            *(f32x4*)ok = y1; *(f32x4*)(ok + 32) = y2;
                            u32x2 w1, w2; w1.x = cvt_pk_bf16(y1[0], y1[1]); w1.y = cvt_pk_bf16(y1[2], y1[3]); w2.x = cvt_pk_bf16(y2[0], y2[1]); w2.y = cvt_pk_bf16(y2[2], y2[3]);
                            *(u32x2*)(Kb + (size_t)row * 1024 + col) = w1; *(u32x2*)(Kb + (size_t)row * 1024 + col + 32) = w2;
                        }
                    }
                } else {
#pragma unroll
                    for (int bj = 0; bj < G::NBJ; ++bj)
#pragma unroll
                        for (int n = 0; n < G::NN; ++n) {
                            const int col = ct + 128 * bj + G::CS_WC * wc + 16 * n + 4 * fq;
                            const f32x4 v = acc[ai][bj][m][n] * r;
                            *(f32x4*)(out + (smp ? PO_AVS : PO_AVP) + orow + col) = v;
                            u32x2 w; w.x = cvt_pk_bf16(v[0], v[1]); w.y = cvt_pk_bf16(v[2], v[3]);
                            *(u32x2*)(Vb + (size_t)row * 1024 + col) = w;
                        }
                }
            }
    }
};

struct EpiKVQ {
    static constexpr bool PERM = false, AFTER_DRAIN = false;
    const float* SS; bf16_t *Qb, *Kb; float* out;
    __device__ __forceinline__ void operator()(const f32x4 (&acc)[2][2][4][2], const Unit& u, int wr, int wc, int fr, int fq) const { run<GeoBig>(acc, Tile{u.pm * BM, u.pn * BM}, wr, wc, fr, fq, nullptr); }
    template <class G> __device__ __forceinline__ void run(const f32x4 (&acc)[2][2][4][2], const Tile T, int wr, int wc, int fr, int fq, PG8_LAS float* scr) const {
        const int row0 = T.row0 + wr * G::RS_WR + fr;
        float rs[2][4]; row_rstd<G>(SS, row0, fq, rs);
        const int sec = T.col0 >> 10, ct = T.col0 & 1023;
        const bool smp = T.row0 >= P_MP;
        const bool keep = smp || (((T.row0 >> 8) & 7) >= 6);
#pragma unroll
        for (int ai = 0; ai < G::NAI; ++ai)
#pragma unroll
            for (int m = 0; m < G::NM; ++m) {
                const int row = row0 + ai * HALF + m * 16; const float r = rs[ai][m];
                const size_t orow = smp ? (size_t)(row - P_MP) * 1024 : ((size_t)(row >> 11) * 512 + (size_t)((row & 2047) - 1536)) * 1024;
#pragma unroll
                for (int bj = 0; bj < G::NBJ; ++bj)
#pragma unroll
                    for (int n = 0; n < G::NN; ++n) {
                        const int col = ct + 128 * bj + G::CS_WC * wc + 16 * n + 4 * fq;
                        f32x4 v = acc[ai][bj][m][n] * r;
                        if (sec == 2) {
                            v = v * P_C2; u32x2 w; w.x = cvt_pk_bf16(v[0], v[1]); w.y = cvt_pk_bf16(v[2], v[3]);
                            *(u32x2*)(Qb + (size_t)row * 1024 + col) = w;
                        } else {
                            if (keep) *(f32x4*)(out + (sec == 0 ? (smp ? PO_BKS : PO_BKP) : (smp ? PO_BVS : PO_BVP)) + orow + col) = v;
                            u32x2 w; w.x = cvt_pk_bf16(v[0], v[1]); w.y = cvt_pk_bf16(v[2], v[3]);
                            *(u32x2*)(Kb + (sec == 0 ? (size_t)0 : PW_KV) + (size_t)row * 1024 + col) = w;
                        }
                    }
            }
    }
};

struct EpiRes {
    static constexpr bool PERM = true, AFTER_DRAIN = false;
    bf16_t* Hb; float* SS;
    __device__ __forceinline__ void operator()(const f32x4 (&acc)[2][2][4][2], const Unit& u, int wr, int wc, int fr, int fq) const { run<GeoBig>(acc, Tile{u.pm * BM, u.pn * BM}, wr, wc, fr, fq, nullptr); }
    template <class G> __device__ __forceinline__ void run(const f32x4 (&acc)[2][2][4][2], const Tile T, int wr, int wc, int fr, int fq, PG8_LAS float* scr) const {
        const int row0 = T.row0 + wr * G::RS_WR + fr, col0 = T.col0 + wc * 32 + 8 * fq;
#pragma unroll
        for (int ai = 0; ai < G::NAI; ++ai)
#pragma unroll
            for (int m = 0; m < G::NM; ++m) {
                const int row = row0 + ai * HALF + m * 16;
                float ssq = 0.f;
#pragma unroll
                for (int bj = 0; bj < G::NBJ; ++bj) {
                    bf16_t* p = Hb + (size_t)row * 1024 + col0 + bj * HALF;
                    const u32x4 o = *(const u32x4*)p;
                    f32x4 h0 = acc[ai][bj][m][0], h1 = acc[ai][bj][m][1];
                    h0[0] += __uint_as_float(o.x << 16); h0[1] += __uint_as_float(o.x & 0xffff0000u); h0[2] += __uint_as_float(o.y << 16); h0[3] += __uint_as_float(o.y & 0xffff0000u);
                    h1[0] += __uint_as_float(o.z << 16); h1[1] += __uint_as_float(o.z & 0xffff0000u); h1[2] += __uint_as_float(o.w << 16); h1[3] += __uint_as_float(o.w & 0xffff0000u);
                    u32x4 w; w.x = cvt_pk_bf16(h0[0], h0[1]); w.y = cvt_pk_bf16(h0[2], h0[3]); w.z = cvt_pk_bf16(h1[0], h1[1]); w.w = cvt_pk_bf16(h1[2], h1[3]);
                    *(u32x4*)p = w;
                    ssq += ((h0[0] * h0[0] + h0[1] * h0[1]) + (h0[2] * h0[2] + h0[3] * h0[3])) + ((h1[0] * h1[0] + h1[1] * h1[1]) + (h1[2] * h1[2] + h1[3] * h1[3]));
                }
                ssq += __shfl_xor(ssq, 16); ssq += __shfl_xor(ssq, 32);
                if (G::WCN == 4) { if (fq == 0) SS[(size_t)row * 16 + (T.col0 >> 8) * 4 + wc] = ssq; }
                else { if (fq == 0) scr[(wr * G::RS_WR + m * 16 + fr) * 2 + wc] = ssq; }
            }
        if (G::WCN != 4) {
            __syncthreads();
            const int t_ = threadIdx.x;
            if (t_ < 64) SS[(size_t)(T.row0 + t_) * 16 + (T.col0 >> 6)] = scr[t_ * 2] + scr[t_ * 2 + 1];
            __syncthreads();
        }
    }
};

struct EpiFF1 {
    static constexpr bool PERM = true, AFTER_DRAIN = false;
    const float* SS; bf16_t* U; int ldc;
    __device__ __forceinline__ void operator()(const f32x4 (&acc)[2][2][4][2], const Unit& u, int wr, int wc, int fr, int fq) const { run<GeoBig>(acc, Tile{u.pm * BM, u.pn * BM}, wr, wc, fr, fq, nullptr); }
    template <class G> __device__ __forceinline__ void run(const f32x4 (&acc)[2][2][4][2], const Tile T, int wr, int wc, int fr, int fq, PG8_LAS float* scr) const {
        const int row0 = T.row0 + wr * G::RS_WR + fr;
        float rs[2][4]; row_rstd<G>(SS, row0, fq, rs);
        const int col0 = T.col0 + wc * 32 + 8 * fq;
#pragma unroll
        for (int ai = 0; ai < G::NAI; ++ai)
#pragma unroll
            for (int m = 0; m < G::NM; ++m) {
                const float r = rs[ai][m]; bf16_t* rowp = U + (size_t)(row0 + ai * HALF + m * 16) * ldc + col0;
#pragma unroll
                for (int bj = 0; bj < G::NBJ; ++bj) {
                    f32x4 v0 = acc[ai][bj][m][0] * r, v1 = acc[ai][bj][m][1] * r;
#pragma unroll
                    for (int i = 0; i < 4; ++i) { const float a = fmaxf(v0[i], 0.f), b = fmaxf(v1[i], 0.f); v0[i] = a * a; v1[i] = b * b; }
                    u32x4 w; w.x = cvt_pk_bf16(v0[0], v0[1]); w.y = cvt_pk_bf16(v0[2], v0[3]); w.z = cvt_pk_bf16(v1[0], v1[1]); w.w = cvt_pk_bf16(v1[2], v1[3]);
                    *(u32x4*)(rowp + bj * HALF) = w;
                }
            }
    }
};
template <class Epi, class Sched, bool ALIGN_EPI = false, bool SP2 = false>
__device__ __forceinline__ void gemm_phase(PG8_LAS unsigned char* lds, const Gemm g, const Sched& S, const Epi& E) {
    const int tid = opaque_tid(), wid = __builtin_amdgcn_readfirstlane(tid >> 6), lane = tid & 63, wr = wid >> 2, wc = wid & 3, fr = lane & 15, fq = lane >> 4;
    const int K = g.K, nt = K / BK;
    unsigned voffA[2], voffB[2];
#pragma unroll
    for (int i = 0; i < 2; ++i) { int R, C; stage_rc(tid * 16 + i * 8192, R, C); const int Rb = Epi::PERM ? ((R & ~31) + perm32(R & 31)) : R;
        voffA[i] = (unsigned)(R * K + C) * 2u; voffB[i] = (unsigned)(Rb * K + C) * 2u; }
    const size_t kstep = (size_t)(BK * 2);
    const size_t hstep = (size_t)HALF * K * 2;
    const size_t tstep = 2 * hstep;
    const unsigned ldsw = (unsigned)wid * 1024u;
    const int aoff = lds_byte(wr * 64 + fr, fq * 8), boff = lds_byte(wc * 32 + fr, fq * 8);
#define PG8_SA(b, h) (((b) * 2 + (h)) * HTB)
#define PG8_SB(b, h) ((4 + (b) * 2 + (h)) * HTB)
#define PG8_STAGE(bufoff, gbase, voff) do { _Pragma("unroll") for (int _i = 0; _i < 2; ++_i) \
        __builtin_amdgcn_global_load_lds((const unsigned*)((const char*)(gbase) + (voff)[_i]), (PG8_LAS unsigned*)(lds + (bufoff) + ldsw + _i * 8192), 16, 0, 0); } while (0)
#define PG8_LDA(dst, b, h) do { _Pragma("unroll") for (int m = 0; m < 4; ++m) _Pragma("unroll") for (int k = 0; k < 2; ++k) dst[m][k] = *(const PG8_LAS bf16x8*)(lds + PG8_SA(b, h) + aoff + m * 2048 + k * 1024); } while (0)
#define PG8_LDB(dst, b, h) do { _Pragma("unroll") for (int n = 0; n < 2; ++n) _Pragma("unroll") for (int k = 0; k < 2; ++k) dst[n][k] = *(const PG8_LAS bf16x8*)(lds + PG8_SB(b, h) + boff + n * 2048 + k * 1024); } while (0)
#define PG8_MMA(ai, bj, At, Bt) do { __builtin_amdgcn_s_setprio(1); _Pragma("unroll") for (int m = 0; m < 4; ++m) _Pragma("unroll") for (int n = 0; n < 2; ++n) _Pragma("unroll") for (int k = 0; k < 2; ++k) \
        acc[ai][bj][m][n] = __builtin_amdgcn_mfma_f32_16x16x32_bf16(Bt[n][k], At[m][k], acc[ai][bj][m][n], 0, 0, 0); __builtin_amdgcn_s_setprio(0); } while (0)
#define PG8_WAIT_V(n) asm volatile("s_waitcnt vmcnt(" #n ")" ::: "memory")
#define PG8_WAIT_L(n) asm volatile("s_waitcnt lgkmcnt(" #n ")" ::: "memory")
#define PG8_BAR __builtin_amdgcn_s_barrier()
#define PG8_SCHED __builtin_amdgcn_sched_barrier(0)
    Unit cur, nxt; int ui = 0;
    if (!S.next(0, cur)) return;
    f32x4 acc[2][2][4][2];
#pragma unroll
    for (int a = 0; a < 2; ++a)
#pragma unroll
        for (int b = 0; b < 2; ++b)
#pragma unroll
            for (int m = 0; m < 4; ++m)
#pragma unroll
                for (int n = 0; n < 2; ++n) acc[a][b][m][n] = (f32x4){0.f, 0.f, 0.f, 0.f};
    bf16x8 At[4][2], B0[2][2], B1[2][2];
    const char* cA = (const char*)g.A + (size_t)cur.pm * tstep; const char* cB = (const char*)g.Bt + (size_t)cur.pn * tstep;
    S.a_ready(cur);
    if constexpr (SP2) {
        PG8_STAGE(PG8_SB(0, 0), cB, voffB); PG8_STAGE(PG8_SB(0, 1), cB + hstep, voffB); PG8_STAGE(PG8_SA(0, 0), cA, voffA); PG8_STAGE(PG8_SA(0, 1), cA + hstep, voffA);
        if (wr == 1) PG8_BAR;
        PG8_WAIT_V(2); PG8_BAR;
        PG8_STAGE(PG8_SB(1, 0), cB + kstep, voffB); PG8_STAGE(PG8_SA(1, 0), cA + kstep, voffA); PG8_STAGE(PG8_SB(1, 1), cB + hstep + kstep, voffB);
        PG8_WAIT_V(6); PG8_BAR;
    } else {
        PG8_STAGE(PG8_SB(0, 0), cB, voffB); PG8_STAGE(PG8_SA(0, 0), cA, voffA); PG8_STAGE(PG8_SB(0, 1), cB + hstep, voffB); PG8_STAGE(PG8_SA(0, 1), cA + hstep, voffA);
        if (wr == 1) PG8_BAR;
        PG8_WAIT_V(4); PG8_BAR;
        PG8_STAGE(PG8_SB(1, 0), cB + kstep, voffB); PG8_STAGE(PG8_SA(1, 0), cA + kstep, voffA); PG8_STAGE(PG8_SB(1, 1), cB + hstep + kstep, voffB);
        PG8_WAIT_V(6); PG8_BAR;
    }
    for (;;) {
        const bool has_next = S.next(ui + 1, nxt);
        const char* nA = has_next ? (const char*)g.A + (size_t)nxt.pm * tstep : cA; const char* nB = has_next ? (const char*)g.Bt + (size_t)nxt.pn * tstep : cB;
        for (int t = 0; t < nt; t += 2) {
            const bool last = (t == nt - 2);
            const char* a1 = cA + (size_t)(t + 1) * kstep;
            const char* a2 = last ? nA : cA + (size_t)(t + 2) * kstep; const char* b2 = last ? nB : cB + (size_t)(t + 2) * kstep;
            const char* a3 = a2 + kstep; const char* b3 = b2 + kstep;
            if (last && has_next) S.a_ready(nxt);
            if constexpr (SP2) {
            PG8_LDB(B0, 0, 0); PG8_LDB(B1, 0, 1); PG8_SCHED; PG8_LDA(At, 0, 0); PG8_STAGE(PG8_SA(1, 1), a1 + hstep, voffA);
            PG8_WAIT_V(8); PG8_WAIT_L(0); PG8_BAR; PG8_MMA(0, 0, At, B0); PG8_MMA(0, 1, At, B1); PG8_BAR; PG8_SCHED;
            PG8_LDA(At, 0, 1); PG8_STAGE(PG8_SB(0, 0), b2, voffB); PG8_STAGE(PG8_SB(0, 1), b2 + hstep, voffB); PG8_STAGE(PG8_SA(0, 0), a2, voffA);
            PG8_WAIT_V(8); PG8_WAIT_L(0); PG8_BAR; PG8_MMA(1, 0, At, B0); PG8_MMA(1, 1, At, B1); PG8_BAR; PG8_SCHED;
            PG8_LDB(B0, 1, 0); PG8_LDB(B1, 1, 1); PG8_SCHED; PG8_LDA(At, 1, 0); PG8_STAGE(PG8_SA(0, 1), a2 + hstep, voffA);
            PG8_WAIT_V(8); PG8_WAIT_L(0); PG8_BAR; PG8_MMA(0, 0, At, B0); PG8_MMA(0, 1, At, B1); PG8_BAR; PG8_SCHED;
            PG8_LDA(At, 1, 1); PG8_STAGE(PG8_SB(1, 0), b3, voffB); PG8_STAGE(PG8_SB(1, 1), b3 + hstep, voffB); PG8_STAGE(PG8_SA(1, 0), a3, voffA);
            PG8_WAIT_V(8); PG8_WAIT_L(0); PG8_BAR; PG8_MMA(1, 0, At, B0); PG8_MMA(1, 1, At, B1); PG8_BAR; PG8_SCHED;
            } else {
            PG8_LDB(B0, 0, 0); PG8_SCHED; PG8_LDA(At, 0, 0); PG8_STAGE(PG8_SA(1, 1), a1 + hstep, voffA);
            PG8_WAIT_L(8); PG8_BAR; PG8_WAIT_L(0); PG8_MMA(0, 0, At, B0); PG8_BAR; PG8_SCHED;
            PG8_LDB(B1, 0, 1); PG8_STAGE(PG8_SB(0, 0), b2, voffB);
            PG8_BAR; PG8_WAIT_L(0); PG8_MMA(0, 1, At, B1); PG8_BAR;
            PG8_LDA(At, 0, 1); PG8_STAGE(PG8_SA(0, 0), a2, voffA);
            PG8_BAR; PG8_WAIT_L(0); PG8_MMA(1, 0, At, B0); PG8_BAR; PG8_SCHED;
            PG8_STAGE(PG8_SB(0, 1), b2 + hstep, voffB);
            PG8_WAIT_V(6); PG8_BAR; PG8_MMA(1, 1, At, B1); PG8_BAR;
            PG8_LDB(B0, 1, 0); PG8_SCHED; PG8_LDA(At, 1, 0); PG8_STAGE(PG8_SA(0, 1), a2 + hstep, voffA);
            PG8_WAIT_L(8); PG8_BAR; PG8_WAIT_L(0); PG8_MMA(0, 0, At, B0); PG8_BAR; PG8_SCHED;
            PG8_LDB(B1, 1, 1); PG8_STAGE(PG8_SB(1, 0), b3, voffB);
            PG8_BAR; PG8_WAIT_L(0); PG8_MMA(0, 1, At, B1); PG8_BAR;
            PG8_LDA(At, 1, 1); PG8_STAGE(PG8_SA(1, 0), a3, voffA);
            PG8_BAR; PG8_WAIT_L(0); PG8_MMA(1, 0, At, B0); PG8_BAR; PG8_SCHED;
            PG8_STAGE(PG8_SB(1, 1), b3 + hstep, voffB);
            PG8_WAIT_V(6); PG8_BAR; PG8_MMA(1, 1, At, B1); PG8_BAR;
            }
        }
        if constexpr (ALIGN_EPI) { if (wr == 0) PG8_BAR; }
        if constexpr (!Epi::AFTER_DRAIN) { E(acc, cur, wr, wc, fr, fq); S.done(cur); }
        if (!has_next) break;
#pragma unroll
        for (int a = 0; a < 2; ++a)
#pragma unroll
            for (int b = 0; b < 2; ++b)
#pragma unroll
                for (int m = 0; m < 4; ++m)
#pragma unroll
                    for (int n = 0; n < 2; ++n) acc[a][b][m][n] = (f32x4){0.f, 0.f, 0.f, 0.f};
        cur = nxt; cA = nA; cB = nB; ++ui;
        if constexpr (ALIGN_EPI) { if (wr == 1) PG8_BAR; }
    }
    PG8_WAIT_V(0);
    if constexpr (!ALIGN_EPI) { if (wr == 0) PG8_BAR; }
    PG8_BAR;
    if constexpr (Epi::AFTER_DRAIN) { E.fused(acc, cur, wr, wc, fr, fq, lds, wid, lane); S.done(cur); }
#undef PG8_SA
#undef PG8_SB
#undef PG8_STAGE
#undef PG8_LDA
#undef PG8_LDB
#undef PG8_MMA
#undef PG8_WAIT_V
#undef PG8_WAIT_L
#undef PG8_BAR
#undef PG8_SCHED
}

template <class G, class Epi>
__device__ __forceinline__ void gemm_small(PG8_LAS unsigned char* lds, const bf16_t* A, const bf16_t* Bt, int K, int row_base, int ntm, int ntn, int vcu, int nwg, const Epi& E) {
    constexpr int TM = (8 / G::WCN) * G::RS_WR * (G::NM * 16 / G::RS_WR), TN = G::WCN * G::CS_WC, SBK = 128, NCA = TM * 16 / 512, NCB = TN * 16 / 512, STG = (TM + TN) * 256;
    const int tid = opaque_tid(), wid = __builtin_amdgcn_readfirstlane(tid >> 6), lane = tid & 63, wr = wid / G::WCN, wc = wid % G::WCN, fr = lane & 15, fq = lane >> 4;
    const int nk = K / SBK;
    for (int tile = vcu; tile < ntm * ntn; tile += nwg) {
        const int tm = tile % ntm, tn = tile / ntm;
        const bf16_t* Ab = A + (size_t)(row_base + tm * TM) * K; const bf16_t* Bb = Bt + (size_t)(tn * TN) * K;
        f32x4 acc[2][2][4][2];
#pragma unroll
        for (int m = 0; m < G::NM; ++m)
#pragma unroll
            for (int n = 0; n < G::NN; ++n) acc[0][0][m][n] = (f32x4){0.f, 0.f, 0.f, 0.f};
        u32x4 ra0[NCA], rb0[NCB], ra1[NCA], rb1[NCB];
        unsigned goffA[NCA], goffB[NCB], loffA[NCA], loffB[NCB];
#pragma unroll
        for (int i = 0; i < NCA; ++i) { const int idx = tid + 512 * i, R = idx >> 4, c = idx & 15; goffA[i] = (unsigned)R * K + c * 8; loffA[i] = R * 256 + ((c ^ (R & 15)) * 16); }
#pragma unroll
        for (int i = 0; i < NCB; ++i) { const int idx = tid + 512 * i, R = idx >> 4, c = idx & 15; const int Rb = Epi::PERM ? ((R & ~31) + perm32(R & 31)) : R; goffB[i] = (unsigned)Rb * K + c * 8; loffB[i] = TM * 256 + R * 256 + ((c ^ (R & 15)) * 16); }
#define SM_LOAD(RA, RB, kt_) do { _Pragma("unroll") for (int i = 0; i < NCA; ++i) RA[i] = *(const u32x4*)(Ab + goffA[i] + (size_t)(kt_) * SBK); \
                                  _Pragma("unroll") for (int i = 0; i < NCB; ++i) RB[i] = *(const u32x4*)(Bb + goffB[i] + (size_t)(kt_) * SBK); } while (0)
#define SM_STEP(RA, RB, kt_) do { PG8_LAS unsigned char* sb = lds + ((kt_) & 1) * STG; \
            _Pragma("unroll") for (int i = 0; i < NCA; ++i) *(PG8_LAS u32x4*)(sb + loffA[i]) = RA[i]; \
            _Pragma("unroll") for (int i = 0; i < NCB; ++i) *(PG8_LAS u32x4*)(sb + loffB[i]) = RB[i]; \
            __syncthreads(); \
            if ((kt_) + 2 < nk) SM_LOAD(RA, RB, (kt_) + 2); \
            _Pragma("unroll") for (int kh = 0; kh < 4; ++kh) { bf16x8 af[G::NM], bfr[G::NN]; \
                _Pragma("unroll") for (int m = 0; m < G::NM; ++m) { const int R = wr * G::RS_WR + m * 16 + fr; af[m] = *(const PG8_LAS bf16x8*)(sb + R * 256 + (((kh * 4 + fq) ^ (R & 15)) * 16)); } \
                _Pragma("unroll") for (int n = 0; n < G::NN; ++n) { const int R = wc * G::CS_WC + n * 16 + fr; bfr[n] = *(const PG8_LAS bf16x8*)(sb + TM * 256 + R * 256 + (((kh * 4 + fq) ^ (R & 15)) * 16)); } \
                _Pragma("unroll") for (int m = 0; m < G::NM; ++m) _Pragma("unroll") for (int n = 0; n < G::NN; ++n) acc[0][0][m][n] = __builtin_amdgcn_mfma_f32_16x16x32_bf16(bfr[n], af[m], acc[0][0][m][n], 0, 0, 0); } } while (0)
        SM_LOAD(ra0, rb0, 0); SM_LOAD(ra1, rb1, 1);
        for (int kt = 0; kt < nk; kt += 2) { SM_STEP(ra0, rb0, kt); SM_STEP(ra1, rb1, kt + 1); }
#undef SM_LOAD
#undef SM_STEP
        __syncthreads();
        E.template run<G>(acc, Tile{row_base + tm * TM, tn * TN}, wr, wc, fr, fq, (PG8_LAS float*)(lds + 2 * STG));
    }
}
}
#define GAS __attribute__((address_space(1)))
#define LAS __attribute__((address_space(3)))
typedef unsigned short bf16;
typedef unsigned v4u __attribute__((ext_vector_type(4)));
typedef float f32x4 __attribute__((ext_vector_type(4)));
typedef short bf16x8 __attribute__((ext_vector_type(8)));
typedef GAS unsigned gu32;
typedef GAS unsigned long long gu64;
#define RLX_AGENT __ATOMIC_RELAXED, __HIP_MEMORY_SCOPE_AGENT
#define LDS_WAIT() asm volatile("s_waitcnt lgkmcnt(0)" ::: "memory")
#define VM_WAIT() asm volatile("s_waitcnt vmcnt(0)" ::: "memory")
__device__ __forceinline__ unsigned long long rt() { return __builtin_amdgcn_s_memrealtime(); }
__device__ __forceinline__ unsigned f2bf(float f) { unsigned u = __builtin_bit_cast(unsigned, f); return (u + 0x7fffu + ((u >> 16) & 1u)) >> 16; }
__device__ __forceinline__ unsigned pk2(float lo, float hi) { return f2bf(lo) | (f2bf(hi) << 16); }

#define XB_TMO      128
#define XB_XCNT(j)  (256  + 64 * (j))
#define XB_XSUB(j)  (1280 + 64 * (j))
#define XB_XGEN(j)  (2304 + 64 * (j))
#define XB_TOP      3328
#define XB_TOPGEN   3392
#define XCD_BAR_WORDS 3456
#define XB_SPIN_CAP (1u << 18)

__device__ __forceinline__ unsigned xb_ld(unsigned* p)              { return __hip_atomic_load(p, __ATOMIC_RELAXED, __HIP_MEMORY_SCOPE_AGENT); }
__device__ __forceinline__ unsigned xb_add(unsigned* p, unsigned v) { return __hip_atomic_fetch_add(p, v, __ATOMIC_RELAXED, __HIP_MEMORY_SCOPE_AGENT); }
__device__ __forceinline__ unsigned xb_xcc_id() { return (unsigned)__builtin_amdgcn_s_getreg((3 << 11) | 20) & 0xFu; }
#define XB_SPIN(cond, bar) do { unsigned _sp = 0; while (cond) { __builtin_amdgcn_s_sleep(1); \
    if ((++_sp & 255u) == 0u) { if (xb_ld(&(bar)[XB_TMO])) break; if (_sp > XB_SPIN_CAP) { atomicAdd(&(bar)[XB_TMO], 1u); break; } } } } while (0)

struct XcdBarrier {
    unsigned* bar; unsigned x;
    volatile LAS unsigned* st;
};

__device__ __forceinline__ XcdBarrier xcd_barrier_post(unsigned* bar, volatile LAS unsigned* st) {
    XcdBarrier b; b.bar = bar; b.x = xb_xcc_id(); b.st = st;
    if (threadIdx.x == 0) (void)xb_add(&bar[XB_XCNT(b.x)], 1u);
    return b;
}
__device__ __forceinline__ void xcd_barrier_complete(unsigned* bar, unsigned x, unsigned& nloc, unsigned& nx) {
    const unsigned G = gridDim.x * gridDim.y * gridDim.z;
    unsigned sum, cnt, mine, sp = 0u;
    for (;;) {
        sum = 0u; cnt = 0u; mine = 0u;
#pragma unroll
        for (unsigned j = 0; j < 16; ++j) { const unsigned c = xb_ld(&bar[XB_XCNT(j)]); sum += c; cnt += (c > 0u) ? 1u : 0u; mine = (j == x) ? c : mine; }
        if (sum == G) break;
        __builtin_amdgcn_s_sleep(1);
        if ((++sp & 255u) == 0u) { if (xb_ld(&bar[XB_TMO])) break; if (sp > XB_SPIN_CAP) { atomicAdd(&bar[XB_TMO], 1u); break; } }
    }
    nloc = mine > 0u ? mine : 1u; nx = cnt > 0u ? cnt : 1u;
}

__device__ __forceinline__ void xcd_barrier(const XcdBarrier& b) {
    asm volatile("s_waitcnt vmcnt(0)" ::: "memory");
    __syncthreads();
    if (threadIdx.x == 0) {
        unsigned* bar = b.bar;
        __builtin_amdgcn_s_waitcnt(0);
        unsigned nloc = b.st[0], nx = b.st[1];
        if (nloc == 0u) { xcd_barrier_complete(bar, b.x, nloc, nx); b.st[0] = nloc; b.st[1] = nx; }
        const unsigned old = xb_add(&bar[XB_XSUB(b.x)], 1u);
        const unsigned gen = old / nloc;
        if (old + 1u == (gen + 1u) * nloc) {
            __builtin_amdgcn_fence(__ATOMIC_RELEASE, "agent");
            asm volatile("s_waitcnt vmcnt(0)" ::: "memory");
            const unsigned og = xb_add(&bar[XB_TOP], 1u);
            const unsigned tg = og / nx;
            if (og + 1u == (tg + 1u) * nx) xb_add(&bar[XB_TOPGEN], 1u);
            else XB_SPIN(xb_ld(&bar[XB_TOPGEN]) == tg, bar);
            __builtin_amdgcn_fence(__ATOMIC_ACQUIRE, "agent");
            xb_add(&bar[XB_XGEN(b.x)], 1u);
            asm volatile("s_waitcnt vmcnt(0)" ::: "memory");
        } else {
            XB_SPIN(xb_ld(&bar[XB_XGEN(b.x)]) == gen, bar);
            __builtin_amdgcn_fence(__ATOMIC_ACQUIRE, "agent");
            asm volatile("s_waitcnt vmcnt(0)" ::: "memory");
        }
    }
    __syncthreads();
}

namespace at {
#define AT_LAS __attribute__((address_space(3)))
typedef short bf16x8 __attribute__((ext_vector_type(8)));
typedef short s16x4 __attribute__((ext_vector_type(4)));
typedef float f32x16 __attribute__((ext_vector_type(16)));
typedef float f32x4 __attribute__((ext_vector_type(4)));
typedef unsigned u32x4 __attribute__((ext_vector_type(4)));
typedef unsigned u32x2 __attribute__((ext_vector_type(2)));
typedef unsigned short bf16_t;
constexpr int MP = 16384, PITCH = 1024, SEQ = 2048;
constexpr int KCS = 1040;
constexpr int KT_BYTES = 8 * KCS;
constexpr float THR = 8.0f;
constexpr int WSF_OFF = 132096;
constexpr int QIMG_OFF = 99328;
__device__ __forceinline__ int crow(int r, int hi) { return (r & 3) + 8 * (r >> 2) + 4 * hi; }
__device__ __forceinline__ unsigned cvtpk(float lo, float hi) { typedef float f2 __attribute__((ext_vector_type(2))); typedef __bf16 b2 __attribute__((ext_vector_type(2))); f2 v = {lo, hi}; b2 b = __builtin_convertvector(v, b2); return __builtin_bit_cast(unsigned, b); }
__device__ __forceinline__ s16x4 vtr(const AT_LAS unsigned char* p) { typedef short v4i16_t __attribute__((ext_vector_type(4))); return __builtin_bit_cast(s16x4, __builtin_amdgcn_ds_read_tr16_b64_v4i16((AT_LAS v4i16_t*)p)); }
#define AT_SYNC() __syncthreads()

template <bool QLDS>
__device__ __forceinline__ void qk_tile(f32x16& p0, f32x16& p1, const AT_LAS unsigned char* kt, const bf16x8 (&qr_)[4], const AT_LAS unsigned char* qimg, int r32, int hi) {
    p0 = f32x16{}; p1 = f32x16{};
#pragma unroll
    for (int d0 = 0; d0 < 4; ++d0) {
        bf16x8 qr[4]; if (QLDS) qr[d0] = *(const AT_LAS bf16x8*)(qimg + (2 * d0 + hi) * 512 + r32 * 16); else qr[d0] = qr_[d0];
        const bf16x8 a0 = *(const AT_LAS bf16x8*)(kt + (2 * d0 + hi) * KCS + r32 * 16);
        const bf16x8 a1 = *(const AT_LAS bf16x8*)(kt + (2 * d0 + hi) * KCS + r32 * 16 + 512);
        p0 = __builtin_amdgcn_mfma_f32_32x32x16_bf16(a0, qr[d0], p0, 0, 0, 0);
        p1 = __builtin_amdgcn_mfma_f32_32x32x16_bf16(a1, qr[d0], p1, 0, 0, 0);
    }
}
template <int ND0>
__device__ __forceinline__ void softmax_tile(f32x16& p0, f32x16& p1, float& m, float& l, f32x16 (&o)[ND0], AT_LAS float* wsf, int r32, int hi) {
    float rm = fmaxf(p0[0], p1[0]);
#pragma unroll
    for (int r = 1; r < 16; ++r) rm = fmaxf(rm, fmaxf(p0[r], p1[r]));
    rm = fmaxf(rm, __shfl_xor(rm, 32));
    if (__any(rm > m + THR)) {
        const float mn = fmaxf(m, rm), f = __builtin_amdgcn_exp2f(m - mn);
        l *= f; m = mn;
        if (hi == 0) wsf[r32] = f;
        asm volatile("s_waitcnt lgkmcnt(0)" ::: "memory");
#pragma unroll
        for (int r = 0; r < 16; ++r) { const float fr_ = wsf[crow(r, hi)];
#pragma unroll
            for (int d0 = 0; d0 < ND0; ++d0) o[d0][r] *= fr_; }
        asm volatile("s_waitcnt lgkmcnt(0)" ::: "memory");
    }
    float s = 0.f;
#pragma unroll
    for (int r = 0; r < 16; ++r) { p0[r] = __builtin_amdgcn_exp2f(p0[r] - m); p1[r] = __builtin_amdgcn_exp2f(p1[r] - m); s += p0[r] + p1[r]; }
    l += s;
}
template <int ND0>
__device__ __forceinline__ void pv_tile(f32x16 (&o)[ND0], const AT_LAS unsigned char* vt, const f32x16& p0, const f32x16& p1, int lane, int hi) {
    bf16x8 pa[4];
#pragma unroll
    for (int ks = 0; ks < 4; ++ks) {
        u32x4 w;
        if (ks < 2) { const int b = 8 * ks; w.x = cvtpk(p0[b], p0[b + 1]); w.y = cvtpk(p0[b + 2], p0[b + 3]); w.z = cvtpk(p0[b + 4], p0[b + 5]); w.w = cvtpk(p0[b + 6], p0[b + 7]); }
        else { const int b = 8 * (ks - 2); w.x = cvtpk(p1[b], p1[b + 1]); w.y = cvtpk(p1[b + 2], p1[b + 3]); w.z = cvtpk(p1[b + 4], p1[b + 5]); w.w = cvtpk(p1[b + 6], p1[b + 7]); }
        pa[ks] = __builtin_bit_cast(bf16x8, w);
    }
    const AT_LAS unsigned char* vb = vt + ((lane >> 4) & 1) * 32 + (lane & 3) * 8 + (4 * hi + ((lane & 15) >> 2)) * 64;
#pragma unroll
    for (int d0 = 0; d0 < ND0; ++d0)
#pragma unroll
        for (int ks = 0; ks < 4; ++ks) {
            const s16x4 lo = vtr(vb + d0 * 4096 + ks * 1024), hh = vtr(vb + d0 * 4096 + ks * 1024 + 512);
            const bf16x8 bfr = {lo[0], lo[1], lo[2], lo[3], hh[0], hh[1], hh[2], hh[3]};
            o[d0] = __builtin_amdgcn_mfma_f32_32x32x16_bf16(pa[ks], bfr, o[d0], 0, 0, 0);
        }
}
__device__ __forceinline__ u32x4 ld16(const void* p) { return *(const u32x4*)p; }
__device__ __forceinline__ u32x2 f4_to_bf4(u32x4 v) { u32x2 w; w.x = cvtpk(__uint_as_float(v.x), __uint_as_float(v.y)); w.y = cvtpk(__uint_as_float(v.z), __uint_as_float(v.w)); return w; }

struct Ctx {
    const bf16_t *Q, *K, *V; bf16_t* O;
    const float *cache_k, *cache_v;
    const float *lam_p, *subln;
    const float* rel;
};

template <int NK, int DV>
__device__ __forceinline__ void ld_bf(u32x4 (&st)[NK + DV / 64], const bf16_t* kbase, const bf16_t* vbase, int nrows, int tid) {
    const int row = tid >> 3, ch = tid & 7; const unsigned koff = (unsigned)row * PITCH + ch * 8;
#pragma unroll
    for (int c = 0; c < NK; ++c) st[c] = (row < nrows) ? ld16(kbase + koff + c * 64) : (u32x4){0u, 0u, 0u, 0u};
    if (DV == 64) { st[NK] = (row < nrows) ? ld16(vbase + koff) : (u32x4){0u, 0u, 0u, 0u}; }
    else {
        const int vrow = tid >> 4; const unsigned voff = (unsigned)vrow * PITCH + (tid & 15) * 8;
#pragma unroll
        for (int i = 0; i < 2; ++i) st[NK + i] = (vrow + 32 * i < nrows) ? ld16(vbase + voff + (size_t)i * 32 * PITCH) : (u32x4){0u, 0u, 0u, 0u};
    }
}
template <int NK, int DV>
__device__ __forceinline__ void wr_bf(const u32x4 (&st)[NK + DV / 64], AT_LAS unsigned char* sb, int tid) {
    const int row = tid >> 3, ch = tid & 7;
#pragma unroll
    for (int c = 0; c < NK; ++c) *(AT_LAS u32x4*)(sb + c * KT_BYTES + ch * KCS + row * 16) = st[c];
    AT_LAS unsigned char* vb = sb + NK * KT_BYTES;
    if (DV == 64) { const int col = ch * 8; *(AT_LAS u32x4*)(vb + ((col >> 5) * 4 + (row >> 4)) * 1024 + (row & 15) * 64 + (col & 31) * 2) = st[NK]; }
    else {
        const int vrow = tid >> 4, col = (tid & 15) * 8;
#pragma unroll
        for (int i = 0; i < 2; ++i) *(AT_LAS u32x4*)(vb + ((col >> 5) * 4 + ((vrow + 32 * i) >> 4)) * 1024 + (vrow & 15) * 64 + (col & 31) * 2) = st[NK + i];
    }
}
template <int NK, int DV>
__device__ __forceinline__ void ld_f32(u32x4 (&st)[2 * NK + DV / 32], const float* kbase, const float* vbase, int tid) {
    { const unsigned off = (unsigned)(tid >> 4) * 1024 + (tid & 15) * 4;
#pragma unroll
      for (int c = 0; c < NK; ++c)
#pragma unroll
          for (int i = 0; i < 2; ++i) st[c * 2 + i] = ld16(kbase + off + c * 64 + (size_t)i * 32 * 1024); }
    if (DV == 64) { const unsigned off = (unsigned)(tid >> 4) * 1024 + (tid & 15) * 4;
#pragma unroll
        for (int i = 0; i < 2; ++i) st[2 * NK + i] = ld16(vbase + off + (size_t)i * 32 * 1024); }
    else { const unsigned off = (unsigned)(tid >> 5) * 1024 + (tid & 31) * 4;
#pragma unroll
        for (int i = 0; i < 4; ++i) st[2 * NK + i] = ld16(vbase + off + (size_t)i * 16 * 1024); }
}
template <int NK, int DV>
__device__ __forceinline__ void wr_f32(const u32x4 (&st)[2 * NK + DV / 32], AT_LAS unsigned char* sb, int tid) {
    { const int row = tid >> 4, c4 = tid & 15;
#pragma unroll
      for (int c = 0; c < NK; ++c)
#pragma unroll
          for (int i = 0; i < 2; ++i) *(AT_LAS u32x2*)(sb + c * KT_BYTES + (c4 >> 1) * KCS + (row + 32 * i) * 16 + (c4 & 1) * 8) = f4_to_bf4(st[c * 2 + i]); }
    AT_LAS unsigned char* vb = sb + NK * KT_BYTES;
    if (DV == 64) { const int row = tid >> 4, col = (tid & 15) * 4;
#pragma unroll
        for (int i = 0; i < 2; ++i) *(AT_LAS u32x2*)(vb + ((col >> 5) * 4 + ((row + 32 * i) >> 4)) * 1024 + (row & 15) * 64 + (col & 31) * 2) = f4_to_bf4(st[2 * NK + i]); }
    else { const int row = tid >> 5, col = (tid & 31) * 4;
#pragma unroll
        for (int i = 0; i < 4; ++i) *(AT_LAS u32x2*)(vb + ((col >> 5) * 4 + ((row + 16 * i) >> 4)) * 1024 + (row & 15) * 64 + (col & 31) * 2) = f4_to_bf4(st[2 * NK + i]); }
}

constexpr int A_STAGE = 2 * KT_BYTES + 16384;
constexpr int A_TP = 132;
template <bool SAMPLE>
__device__ __forceinline__ void attnA_unit(AT_LAS unsigned char* lds, int b, int h, int ub, const Ctx& C) {
    const int tid = pg8::opaque_tid(), lane = tid & 63, r32 = lane & 31, hi = lane >> 5;
    const int w = __builtin_amdgcn_readfirstlane(tid >> 6), comp = w >> 2, qi = w & 3;
    AT_LAS float* wsf = (AT_LAS float*)(lds + WSF_OFF) + w * 64;
    const int NT = SAMPLE ? 16 : (2 * ub + 2);
    const bool active = SAMPLE ? (qi == 0) : true;
    const int cw = 2 * ub + (qi >> 1);
    const int qrow0 = SAMPLE ? (MP + b * 32) : (b * SEQ + ub * 128 + qi * 32);
    float lam;
    { const float a = C.lam_p[lane] * C.lam_p[64 + lane], c = C.lam_p[128 + lane] * C.lam_p[192 + lane];
      float sa = a, sc = c;
#pragma unroll
      for (int o_ = 1; o_ < 64; o_ <<= 1) { sa += __shfl_xor(sa, o_); sc += __shfl_xor(sc, o_); }
      lam = __expf(sa) - __expf(sc) + 0.2f; }
    bf16x8 qr[4];
    AT_LAS unsigned char* qimg = lds + QIMG_OFF + w * 4096;
#pragma unroll
    for (int d0 = 0; d0 < 4; ++d0) { qr[d0] = *(const bf16x8*)(C.Q + (size_t)(qrow0 + r32) * PITCH + h * 128 + comp * 64 + d0 * 16 + hi * 8);
        *(AT_LAS bf16x8*)(qimg + (2 * d0 + hi) * 512 + r32 * 16) = qr[d0]; }
    f32x16 o[4]; o[0] = f32x16{}; o[1] = f32x16{}; o[2] = f32x16{}; o[3] = f32x16{};
    float m = -1e30f, l = 0.f;
    const bf16_t* kb0 = C.K + (size_t)(SAMPLE ? (MP + b * 32) : b * SEQ) * PITCH + h * 128;
    const bf16_t* vb0 = C.V + (size_t)(SAMPLE ? (MP + b * 32) : b * SEQ) * PITCH + h * 128;
    const float* kc0 = C.cache_k + (size_t)b * 1024 * 1024 + h * 128;
    const float* vc0 = C.cache_v + (size_t)b * 1024 * 1024 + h * 128;
    if (SAMPLE) { u32x4 sn[4]; ld_bf<2, 128>(sn, kb0, vb0, 32, tid); wr_bf<2, 128>(sn, lds + 2 * A_STAGE, tid); }
    u32x4 st[SAMPLE ? 8 : 4];
    if constexpr (SAMPLE) ld_f32<2, 128>(st, kc0, vc0, tid); else ld_bf<2, 128>(st, kb0, vb0, 64, tid);
    for (int t = 0; t < NT; ++t) {
        AT_LAS unsigned char* sb = lds + (t & 1) * A_STAGE;
        if constexpr (SAMPLE) wr_f32<2, 128>(st, sb, tid); else wr_bf<2, 128>(st, sb, tid);
        AT_SYNC();
        if (t + 1 < NT) { if constexpr (SAMPLE) ld_f32<2, 128>(st, kc0 + (size_t)(t + 1) * 64 * 1024, vc0 + (size_t)(t + 1) * 64 * 1024, tid); else ld_bf<2, 128>(st, kb0 + (size_t)(t + 1) * 64 * PITCH, vb0 + (size_t)(t + 1) * 64 * PITCH, 64, tid); }
        if (active && (SAMPLE || t <= cw)) {
            const int nsub = (SAMPLE && t == 0) ? 2 : 1;
#pragma unroll 1
            for (int sub = 0; sub < nsub; ++sub) {
                const AT_LAS unsigned char* sc = sub ? (lds + 2 * A_STAGE) : sb;
                f32x16 p0, p1;
                qk_tile<true>(p0, p1, sc + comp * KT_BYTES, qr, qimg, r32, hi);
                if (SAMPLE && sub) {
#pragma unroll
                    for (int r = 0; r < 16; ++r) p1[r] = -INFINITY;
                }
                softmax_tile<4>(p0, p1, m, l, o, wsf, r32, hi);
                pv_tile<4>(o, sc + 2 * KT_BYTES, p0, p1, lane, hi);
            }
        }
    }
    AT_SYNC();
    { const float lt = l + __shfl_xor(l, 32); float inv = 1.0f / lt; if (comp == 1) inv *= lam;
      if (hi == 0) wsf[r32] = inv; asm volatile("s_waitcnt lgkmcnt(0)" ::: "memory"); }
    AT_LAS float* T2 = (AT_LAS float*)lds + qi * (32 * A_TP);
    if (active && comp == 1) {
#pragma unroll
        for (int r = 0; r < 16; ++r) { const int q = crow(r, hi); const float f = wsf[q];
#pragma unroll
            for (int d0 = 0; d0 < 4; ++d0) T2[q * A_TP + d0 * 32 + r32] = o[d0][r] * f; }
    }
    AT_SYNC();
    if (active && comp == 0) {
#pragma unroll
        for (int r = 0; r < 16; ++r) { const int q = crow(r, hi); const float f = wsf[q];
#pragma unroll
            for (int d0 = 0; d0 < 4; ++d0) { const int ix = q * A_TP + d0 * 32 + r32; T2[ix] = o[d0][r] * f - T2[ix]; } }
        asm volatile("s_waitcnt lgkmcnt(0)" ::: "memory");
        const int row = lane & 31, half = lane >> 5;
        f32x4 x[16]; float ss = 0.f;
#pragma unroll
        for (int i = 0; i < 16; ++i) { x[i] = *(const AT_LAS f32x4*)(T2 + row * A_TP + half * 64 + 4 * i); ss += (x[i][0] * x[i][0] + x[i][1] * x[i][1]) + (x[i][2] * x[i][2] + x[i][3] * x[i][3]); }
        ss += __shfl_xor(ss, 32);
        const float rinv = 0.8f / sqrtf(ss * (1.0f / 128.0f) + 1e-6f);
        bf16_t* op = C.O + (size_t)(qrow0 + row) * PITCH + h * 128 + half * 64;
#pragma unroll
        for (int i = 0; i < 16; i += 2) {
            const f32x4 g0 = *(const f32x4*)(C.subln + half * 64 + 4 * i), g1 = *(const f32x4*)(C.subln + half * 64 + 4 * i + 4);
            const f32x4 y0 = x[i] * g0 * rinv, y1 = x[i + 1] * g1 * rinv;
            u32x4 wv; wv.x = cvtpk(y0[0], y0[1]); wv.y = cvtpk(y0[2], y0[3]); wv.z = cvtpk(y1[0], y1[1]); wv.w = cvtpk(y1[2], y1[3]);
            *(u32x4*)(op + 4 * i) = wv;
        }
    }
    AT_SYNC();
}

constexpr int B_STAGE = KT_BYTES + 8192;
constexpr int B_TAB = 3 * B_STAGE;
constexpr int B_OST = 53248;
template <bool SAMPLE>
__device__ __forceinline__ void attnB_unit(AT_LAS unsigned char* lds, int b, int h, int qb, const Ctx& C) {
    const int tid = pg8::opaque_tid(), lane = tid & 63, r32 = lane & 31, hi = lane >> 5;
    const int w = __builtin_amdgcn_readfirstlane(tid >> 6);
    AT_LAS float* wsf = (AT_LAS float*)(lds + WSF_OFF) + w * 64;
    AT_LAS float* tab = (AT_LAS float*)(lds + B_TAB);
    const int kt0 = SAMPLE ? 0 : ((4 * qb - 8) > 0 ? (4 * qb - 8) : 0), kt1 = SAMPLE ? 7 : (4 * qb + 3);
    const bool active = SAMPLE ? (w == 0) : true;
    const int cw = 4 * qb + (w >> 1);
    const int qrow0 = SAMPLE ? (MP + b * 32) : (b * SEQ + qb * 256 + w * 32);
    const int qpos = SAMPLE ? (1024 + r32) : (qb * 256 + w * 32 + r32);
    if (tid < 257) tab[tid] = C.rel[h * 257 + tid] * 1.4426950408889634f;
    bf16x8 qr[4];
#pragma unroll
    for (int d0 = 0; d0 < 4; ++d0) qr[d0] = *(const bf16x8*)(C.Q + (size_t)(qrow0 + r32) * PITCH + h * 64 + d0 * 16 + hi * 8);
    f32x16 o[2]; o[0] = f32x16{}; o[1] = f32x16{};
    float m = -1e30f, l = 0.f;
    const bf16_t* kb0 = C.K + (size_t)(SAMPLE ? (MP + b * 32) : b * SEQ) * PITCH + h * 64;
    const bf16_t* vb0 = C.V + (size_t)(SAMPLE ? (MP + b * 32) : b * SEQ) * PITCH + h * 64;
    const float* kc0 = C.cache_k + (size_t)b * 512 * 1024 + h * 64;
    const float* vc0 = C.cache_v + (size_t)b * 512 * 1024 + h * 64;
    if (SAMPLE) { u32x4 sn[2]; ld_bf<1, 64>(sn, kb0, vb0, 32, tid); wr_bf<1, 64>(sn, lds + 2 * B_STAGE, tid); }
    u32x4 st[SAMPLE ? 4 : 2];
    if constexpr (SAMPLE) ld_f32<1, 64>(st, kc0, vc0, tid); else ld_bf<1, 64>(st, kb0 + (size_t)kt0 * 64 * PITCH, vb0 + (size_t)kt0 * 64 * PITCH, 64, tid);
    for (int kt = kt0; kt <= kt1; ++kt) {
        AT_LAS unsigned char* sb = lds + ((kt - kt0) & 1) * B_STAGE;
        if constexpr (SAMPLE) wr_f32<1, 64>(st, sb, tid); else wr_bf<1, 64>(st, sb, tid);
        AT_SYNC();
        if (kt + 1 <= kt1) { if constexpr (SAMPLE) ld_f32<1, 64>(st, kc0 + (size_t)(kt + 1) * 64 * 1024, vc0 + (size_t)(kt + 1) * 64 * 1024, tid); else ld_bf<1, 64>(st, kb0 + (size_t)(kt + 1) * 64 * PITCH, vb0 + (size_t)(kt + 1) * 64 * PITCH, 64, tid); }
        const bool mine = active && (SAMPLE || (kt <= cw && kt >= cw - 8));
        if (mine) {
            const int nsub = (SAMPLE && kt == 0) ? 2 : 1;
#pragma unroll 1
            for (int sub = 0; sub < nsub; ++sub) {
                const AT_LAS unsigned char* sc = sub ? (lds + 2 * B_STAGE) : sb;
                f32x16 p0, p1;
                qk_tile<false>(p0, p1, sc, qr, nullptr, r32, hi);
                const int kpos0 = SAMPLE ? (sub ? 1024 : 512 + kt * 64) : (kt * 64);
                const int relmin = SAMPLE ? (1024 - (kpos0 + 63)) : (cw * 64 + (w & 1) * 32 - (kpos0 + 63));
                if (relmin >= 128) {
                    const float cb = tab[256];
#pragma unroll
                    for (int r = 0; r < 16; ++r) { p0[r] += cb; p1[r] += cb; }
                } else {
#pragma unroll
                    for (int r = 0; r < 16; ++r) {
                        const int rel = qpos - (kpos0 + crow(r, hi));
                        const int i0 = rel < -128 ? -128 : (rel > 128 ? 128 : rel), i1 = (rel - 32) < -128 ? -128 : ((rel - 32) > 128 ? 128 : (rel - 32));
                        p0[r] += tab[i0 + 128]; p1[r] += tab[i1 + 128];
                    }
                }
                if (SAMPLE && sub) {
#pragma unroll
                    for (int r = 0; r < 16; ++r) p1[r] = -INFINITY;
                }
                softmax_tile<2>(p0, p1, m, l, o, wsf, r32, hi);
                pv_tile<2>(o, sc + KT_BYTES, p0, p1, lane, hi);
            }
        }
    }
    if (active) {
        const float lt = l + __shfl_xor(l, 32), inv = 1.0f / lt;
        if (hi == 0) wsf[r32] = inv; asm volatile("s_waitcnt lgkmcnt(0)" ::: "memory");
        AT_LAS bf16_t* stg = (AT_LAS bf16_t*)(lds + B_OST) + w * 2048;
#pragma unroll
        for (int r = 0; r < 16; ++r) { const int q = crow(r, hi); const float f = wsf[q];
#pragma unroll
            for (int d0 = 0; d0 < 2; ++d0) { const unsigned pk = cvtpk(o[d0][r] * f, 0.f); stg[q * 64 + d0 * 32 + r32] = (bf16_t)(pk & 0xffffu); } }
        asm volatile("s_waitcnt lgkmcnt(0)" ::: "memory");
        bf16_t* op = C.O + (size_t)qrow0 * PITCH + h * 64;
#pragma unroll
        for (int i = 0; i < 4; ++i) { const int row = i * 8 + (lane >> 3), ch = lane & 7; const u32x4 v = *(const AT_LAS u32x4*)(stg + row * 64 + ch * 8); *(u32x4*)(op + (size_t)row * PITCH + ch * 8) = v; }
    }
    AT_SYNC();
}
}

constexpr int NWAVES = 8;
#ifndef MK_N_LAUNCHES
#define MK_N_LAUNCHES 1
#endif
constexpr int N_PHASES = 12;
constexpr int DMODEL = 1024, SEQ = 2048, NBATCH = 8, MP = NBATCH * SEQ, MS = 1024, M = MP + MS, FF = 4096;
constexpr size_t O_Y = 0, O_AKP = 17825792, O_AVP = 34603008, O_BKP = 51380224, O_BVP = 55574528, O_AKS = 59768832, O_AVS = 60817408, O_BKS = 61865984, O_BVS = 62914560, O_END = 63963136;
constexpr size_t MiB = 1u << 20;
constexpr size_t WS_CTL = 0, CTL_ZERO_BYTES = 1 * MiB;
constexpr size_t WS_WQKV = 2 * MiB, WS_WAO = 8 * MiB, WS_WKVQ = 10 * MiB, WS_WBO = 16 * MiB, WS_W1 = 18 * MiB  , WS_W2 = 34 * MiB  ;
constexpr size_t WS_CS = 50 * MiB;
constexpr size_t WS_SS = 51 * MiB;
constexpr size_t WS_HB = 54 * MiB, WS_Q = 90 * MiB, WS_K = 126 * MiB, WS_V = 162 * MiB, WS_O = 198 * MiB;
constexpr size_t WS_U = 234 * MiB;
constexpr size_t WS_END = 372 * MiB;
constexpr int CW_TMO = 0, CW_CODE = 1, CW_BAR = 4096;
constexpr int RING_OFF = 0, RING_BYTES = 131072, LDS_BYTES = 163840, LDSCTL_OFF = LDS_BYTES - 1024, MISC_OFF = LDSCTL_OFF + 320;

struct Args { const float* in[20]; float* out; unsigned char* ws; int ph_lo, ph_hi, li, pad; };

struct Frame {
    LAS unsigned char* lds; volatile LAS unsigned* MISC; gu32* ctl;
    int tid, lane, wave, vcu, G;
};

__device__ __forceinline__ float wave_sum(float v) {
#pragma unroll
    for (int o = 1; o < 64; o <<= 1) v += __shfl_xor(v, o);
    return v;
}
__device__ __forceinline__ int pi64(int d) { return d < 32 ? 32 * (d >> 4) + (d & 15) : 32 * ((d - 32) >> 4) + 16 + ((d - 32) & 15); }
template <bool PERMQK>
__device__ __forceinline__ void p0_transpose_item(const float* W, const float* g, int K, int N, bf16* WT, int row_off, LAS float* scr, int item, int lane) {
    const int nblk = N / 32, kb = item / nblk, nb = item % nblk, k0 = 64 * kb, n0 = 32 * nb;
#pragma unroll 8
    for (int i = 0; i < 32; ++i) { const int kk = 2 * i + (lane >> 5); const float gv = g ? g[k0 + kk] : 1.0f; scr[kk * 33 + (lane & 31)] = W[(size_t)(k0 + kk) * N + n0 + (lane & 31)] * gv; }
    LDS_WAIT(); asm volatile("" ::: "memory");
    const int c = lane & 7;
#pragma unroll
    for (int j = 0; j < 4; ++j) { const int n = (lane >> 3) + 8 * j; const LAS float* s = scr + (8 * c) * 33 + n;
        v4u o; o.x = pk2(s[0 * 33], s[1 * 33]); o.y = pk2(s[2 * 33], s[3 * 33]); o.z = pk2(s[4 * 33], s[5 * 33]); o.w = pk2(s[6 * 33], s[7 * 33]);
        int nn = n0 + n; if (PERMQK && nn < 2048) nn = (nn & ~63) + pi64(nn & 63);
        *(GAS v4u*)(WT + (size_t)(row_off + nn) * K + k0 + 8 * c) = o; }
    LDS_WAIT(); asm volatile("" ::: "memory");
}
__device__ __forceinline__ void p0_prologue(Frame& F, const Args& A) {
    unsigned char* ws = A.ws;
    LAS float* scr = (LAS float*)(F.lds + RING_OFF + F.wave * 16384);
    const int gw = F.vcu * NWAVES + F.wave, NGW = F.G * NWAVES;
    constexpr int I_QKV = 16 * 96, I_SQ = 16 * 32, I_KV = 16 * 64, I_F1 = 16 * 128, I_F2 = 64 * 32;
    constexpr int NITEMS = I_QKV + I_SQ + I_KV + I_SQ + I_SQ + 2 * I_F1 + 2 * I_F2;
    const float* g_attn = A.in[6]; const float* g_mlp = A.in[16];
    for (int it = gw; it < NITEMS; it += NGW) {
        int r = it;
        if (r < I_QKV) { p0_transpose_item<true>(A.in[7], g_attn, 1024, 3072, (bf16*)(ws + WS_WQKV), 0, scr, r, F.lane); continue; } r -= I_QKV;
        if (r < I_SQ) { p0_transpose_item<false>(A.in[10], nullptr, 1024, 1024, (bf16*)(ws + WS_WAO), 0, scr, r, F.lane); continue; } r -= I_SQ;
        if (r < I_KV) { p0_transpose_item<false>(A.in[12], A.in[11], 1024, 2048, (bf16*)(ws + WS_WKVQ), 0, scr, r, F.lane); continue; } r -= I_KV;
        if (r < I_SQ) { p0_transpose_item<false>(A.in[13], g_attn + 1024, 1024, 1024, (bf16*)(ws + WS_WKVQ), 2048, scr, r, F.lane); continue; } r -= I_SQ;
        if (r < I_SQ) { p0_transpose_item<false>(A.in[15], nullptr, 1024, 1024, (bf16*)(ws + WS_WBO), 0, scr, r, F.lane); continue; } r -= I_SQ;
        if (r < I_F1) { p0_transpose_item<false>(A.in[17], g_mlp, 1024, 4096, (bf16*)(ws + WS_W1), 0, scr, r, F.lane); continue; } r -= I_F1;
        if (r < I_F1) { p0_transpose_item<false>(A.in[17] + (size_t)1024 * 4096, g_mlp + 1024, 1024, 4096, (bf16*)(ws + WS_W1 + 8 * MiB), 0, scr, r, F.lane); continue; } r -= I_F1;
        if (r < I_F2) { p0_transpose_item<false>(A.in[18], nullptr, 4096, 1024, (bf16*)(ws + WS_W2), 0, scr, r, F.lane); continue; } r -= I_F2;
        p0_transpose_item<false>(A.in[18] + (size_t)4096 * 1024, nullptr, 4096, 1024, (bf16*)(ws + WS_W2 + 8 * MiB), 0, scr, r, F.lane);
    }
    bf16* HB = (bf16*)(ws + WS_HB); float* SS = (float*)(ws + WS_SS);
    for (int m = gw; m < M; m += NGW) {
        const float* xrow = (m < MP) ? A.in[0] + (size_t)m * 1024 : A.in[1] + (size_t)(m - MP) * 1024;
        const GAS f32x4* xr = (const GAS f32x4*)xrow + F.lane;
        f32x4 v[4]; float s = 0.f;
#pragma unroll
        for (int j = 0; j < 4; ++j) { v[j] = xr[64 * j]; s += (v[j].x * v[j].x + v[j].y * v[j].y) + (v[j].z * v[j].z + v[j].w * v[j].w); }
        s = wave_sum(s);
        GAS unsigned long long* o8 = (GAS unsigned long long*)(HB + (size_t)m * 1024) + F.lane;
#pragma unroll
        for (int j = 0; j < 4; ++j) o8[64 * j] = (unsigned long long)pk2(v[j].x, v[j].y) | ((unsigned long long)pk2(v[j].z, v[j].w) << 32);
        if (F.lane < 16) SS[(size_t)m * 16 + F.lane] = (F.lane == 0) ? s : 0.f;
    }
    float* cs = (float*)(ws + WS_CS);
    for (int e = (F.vcu * NWAVES + F.wave) * 64 + F.lane; e < 2048 * 32; e += F.G * NWAVES * 64) {
        const int pos = e >> 5, i = e & 31;
        const float inv = 1.0f / powf(10000.0f, (float)i * (1.0f / 32.0f));
        const float ang = (float)pos * inv;
        float sv, cv; sincosf(ang, &sv, &cv);
        cs[(size_t)pos * 64 + i] = cv; cs[(size_t)pos * 64 + 32 + i] = sv;
    }
}
__device__ __forceinline__ void final_norm(Frame& F, const Args& A) {
    const int gw = F.vcu * NWAVES + F.wave, NGW = F.G * NWAVES;
    const float* SS = (const float*)(A.ws + WS_SS); const float* gf = A.in[19]; const bf16* HB = (const bf16*)(A.ws + WS_HB);
    f32x4 g[4];
#pragma unroll
    for (int j = 0; j < 4; ++j) g[j] = *((const f32x4*)gf + 4 * F.lane + j);
    for (int m = gw; m < M; m += NGW) {
        float s = (F.lane < 16) ? SS[(size_t)m * 16 + F.lane] : 0.f;
        s = wave_sum(s);
        const float r = 1.0f / sqrtf(s * (1.0f / 1024.0f) + 1e-6f);
        const v4u h0 = *((const GAS v4u*)(HB + (size_t)m * 1024) + 2 * F.lane), h1 = *((const GAS v4u*)(HB + (size_t)m * 1024) + 2 * F.lane + 1);
        GAS f32x4* yr = (GAS f32x4*)(A.out + (size_t)m * 1024) + 4 * F.lane;
        const unsigned w[8] = {h0.x, h0.y, h0.z, h0.w, h1.x, h1.y, h1.z, h1.w};
#pragma unroll
        for (int j = 0; j < 4; ++j) { f32x4 v; v.x = __uint_as_float(w[2 * j] << 16); v.y = __uint_as_float(w[2 * j] & 0xffff0000u); v.z = __uint_as_float(w[2 * j + 1] << 16); v.w = __uint_as_float(w[2 * j + 1] & 0xffff0000u);
            yr[j] = v * g[j] * r; }
    }
}

#ifndef PHASE_MASK
#define PHASE_MASK 0xFFFF
#endif
#ifndef REPEAT_MASK
#define REPEAT_MASK 0
#endif
template <int PH>
__device__ __forceinline__ void run_phase(Frame& F, const Args& args) {
    unsigned char* const ws = args.ws;
    pg8::bf16_t* const HB = (pg8::bf16_t*)(ws + WS_HB); pg8::bf16_t* const QB = (pg8::bf16_t*)(ws + WS_Q); pg8::bf16_t* const KB = (pg8::bf16_t*)(ws + WS_K);
    pg8::bf16_t* const VB = (pg8::bf16_t*)(ws + WS_V); pg8::bf16_t* const OB = (pg8::bf16_t*)(ws + WS_O); pg8::bf16_t* const UB = (pg8::bf16_t*)(ws + WS_U);
    float* const SS = (float*)(ws + WS_SS); float* const H = args.out + O_Y;
    if constexpr (PH == 0) p0_prologue(F, args);
    if constexpr (PH == 1) {
        pg8::Gemm g{HB, (const pg8::bf16_t*)(ws + WS_WQKV), M, 3072, 1024}; pg8::StaticOrder S; S.init(MP, 3072, F.G, (int)blockIdx.x);
        pg8::EpiQKV E{SS, (const float*)(ws + WS_CS), QB, KB, VB, args.out};
        pg8::gemm_phase<pg8::EpiQKV, pg8::StaticOrder, true, true>(F.lds + RING_OFF, g, S, E);
        pg8::gemm_small<pg8::GeoS128, pg8::EpiQKV>(F.lds + RING_OFF, g.A, g.Bt, g.K, MP, 8, g.N / 128, F.vcu, F.G, E);
    }
    if constexpr (PH == 2) {
        at::Ctx C{QB, KB, VB, OB, args.in[2], args.in[3], args.in[8], args.in[9], nullptr};
        for (int vv = F.vcu; vv < 256; vv += F.G) {
            const int bh = vv >> 2, s = vv & 3;
#pragma unroll 1
            for (int i = 0; i < 5; ++i) {
                const int j = (vv & 1) ? ((i + 1) % 5) : i;
                if (j == 0) at::attnA_unit<true>(F.lds, vv >> 3, vv & 7, 0, C);
                else { const int k_ = j - 1, ub = 8 * (k_ >> 1) + ((k_ & 1) ? 7 - s : s); at::attnA_unit<false>(F.lds, bh >> 3, bh & 7, ub, C); }
            }
        }
    }
    if constexpr (PH == 3 || PH == 8) {
        pg8::Gemm g{OB, (const pg8::bf16_t*)(ws + (PH == 3 ? WS_WAO : WS_WBO)), M, 1024, 1024}; pg8::StaticOrder S; S.init(MP, 1024, F.G, (int)blockIdx.x);
        pg8::EpiRes E{HB, SS};
        pg8::gemm_phase<pg8::EpiRes, pg8::StaticOrder, true, true>(F.lds + RING_OFF, g, S, E);
        pg8::gemm_small<pg8::GeoS64, pg8::EpiRes>(F.lds + RING_OFF, g.A, g.Bt, g.K, MP, 16, g.N / 64, F.vcu, F.G, E);
    }
    if constexpr (PH == 4 || PH == 9) {
        pg8::Gemm g{HB, (const pg8::bf16_t*)(ws + WS_W1 + (PH == 9 ? 8 * MiB : 0)), M, FF, 1024}; pg8::StaticOrder S; S.init(MP, FF, F.G, (int)blockIdx.x);
        pg8::EpiFF1 E{SS, UB, FF};
        pg8::gemm_phase<pg8::EpiFF1, pg8::StaticOrder, true, true>(F.lds + RING_OFF, g, S, E);
        pg8::gemm_small<pg8::GeoS128, pg8::EpiFF1>(F.lds + RING_OFF, g.A, g.Bt, g.K, MP, 8, g.N / 128, F.vcu, F.G, E);
    }
    if constexpr (PH == 5 || PH == 10) {
        pg8::Gemm g{UB, (const pg8::bf16_t*)(ws + WS_W2 + (PH == 10 ? 8 * MiB : 0)), M, 1024, FF}; pg8::StaticOrder S; S.init(MP, 1024, F.G, (int)blockIdx.x);
        pg8::EpiRes E{HB, SS};
        pg8::gemm_phase<pg8::EpiRes, pg8::StaticOrder, true, true>(F.lds + RING_OFF, g, S, E);
        pg8::gemm_small<pg8::GeoS64, pg8::EpiRes>(F.lds + RING_OFF, g.A, g.Bt, g.K, MP, 16, g.N / 64, F.vcu, F.G, E);
    }
    if constexpr (PH == 6) {
        pg8::Gemm g{HB, (const pg8::bf16_t*)(ws + WS_WKVQ), M, 3072, 1024}; pg8::StaticOrder S; S.init(MP, 3072, F.G, (int)blockIdx.x);
        pg8::EpiKVQ E{SS, QB, KB, args.out};
        pg8::gemm_phase<pg8::EpiKVQ, pg8::StaticOrder, true, true>(F.lds + RING_OFF, g, S, E);
        pg8::gemm_small<pg8::GeoS128, pg8::EpiKVQ>(F.lds + RING_OFF, g.A, g.Bt, g.K, MP, 8, g.N / 128, F.vcu, F.G, E);
    }
    if constexpr (PH == 7) {
        at::Ctx C{QB, KB, VB, OB, args.in[4], args.in[5], nullptr, nullptr, args.in[14]};
        for (int vv = F.vcu; vv < 256; vv += F.G) {
            const int bh = vv >> 1, par = vv & 1;
#pragma unroll 1
            for (int i = 0; i < 4; ++i) { const int qb = 4 * (i >> 1) + ((i & 1) ? 3 - par : par); at::attnB_unit<false>(F.lds, bh >> 4, bh & 15, qb, C); }
#pragma unroll 1
            for (int i = 0; i < 2; ++i) at::attnB_unit<true>(F.lds, vv >> 3, 2 * (vv & 7) + i, 0, C);
        }
    }
    if constexpr (PH == 11) final_norm(F, args);
}
__global__ void __launch_bounds__(NWAVES * 64, 2) skel_fwd(Args args) {
    extern __shared__ __attribute__((aligned(16))) unsigned char lds[];
    Frame F;
    F.lds = (LAS unsigned char*)lds;
    F.MISC = (volatile LAS unsigned*)(F.lds + MISC_OFF);
    F.tid = threadIdx.x; F.lane = F.tid & 63; F.wave = __builtin_amdgcn_readfirstlane(F.tid >> 6);
    F.G = gridDim.x; { const int bx = blockIdx.x; F.vcu = (F.G % 8 == 0) ? (bx % 8) * (F.G / 8) + bx / 8 : bx; }
    F.ctl = (gu32*)(args.ws + WS_CTL);
    for (int u = F.tid; u < (LDS_BYTES - LDSCTL_OFF) / 4; u += NWAVES * 64) ((LAS unsigned*)(F.lds + LDSCTL_OFF))[u] = 0u;
    __syncthreads();
    XcdBarrier bar = xcd_barrier_post((unsigned*)(F.ctl + CW_BAR), F.MISC + 8);
#define DO_PHASE(k) do { if constexpr (((PHASE_MASK) >> (k)) & 1) { run_phase<k>(F, args); \
        if constexpr (((REPEAT_MASK) >> (k)) & 1) { xcd_barrier(bar); run_phase<k>(F, args); } \
        if constexpr ((k) != N_PHASES - 1) xcd_barrier(bar); } } while (0)
    DO_PHASE(0); DO_PHASE(1); DO_PHASE(2); DO_PHASE(3); DO_PHASE(4); DO_PHASE(5); DO_PHASE(6); DO_PHASE(7); DO_PHASE(8); DO_PHASE(9); DO_PHASE(10); DO_PHASE(11);
#undef DO_PHASE
}

extern "C" void kernel_launch(void* const* d_in, const int* in_sizes, int n_in, void* d_out, int out_size, void* d_ws, size_t ws_size, hipStream_t stream) {
    static int grid = 0;
    if (grid == 0) {
        if (n_in != 20 || out_size != (int)O_END || ws_size < WS_END) { fprintf(stderr, "kernel_launch: unexpected problem (n_in %d out %d ws %zu)\n", n_in, out_size, ws_size); grid = -1; return; }
        int dev = 0, cus = 0, per_cu = 0;
        if (hipGetDevice(&dev) != hipSuccess || hipDeviceGetAttribute(&cus, hipDeviceAttributeMultiprocessorCount, dev) != hipSuccess) { grid = -1; return; }
        if (hipFuncSetAttribute((const void*)skel_fwd, hipFuncAttributeMaxDynamicSharedMemorySize, LDS_BYTES) != hipSuccess) { fprintf(stderr, "kernel_launch: hipFuncSetAttribute failed\n"); grid = -1; return; }
        if (hipOccupancyMaxActiveBlocksPerMultiprocessor(&per_cu, (const void*)skel_fwd, NWAVES * 64, LDS_BYTES) != hipSuccess || per_cu < 1) { fprintf(stderr, "kernel_launch: occupancy query reports %d\n", per_cu); per_cu = 1; }
        (void)hipGetLastError();
        grid = cus;
        if (grid > 256) grid = 256;
    }
    if (grid < 0) return;
    (void)hipMemsetAsync((char*)d_ws + WS_CTL, 0, CTL_ZERO_BYTES, stream);
    Args a{};
    for (int i = 0; i < 20; ++i) a.in[i] = (const float*)d_in[i];
    a.out = (float*)d_out; a.ws = (unsigned char*)d_ws;
    hipLaunchKernelGGL(skel_fwd, dim3(grid), dim3(NWAVES * 64), LDS_BYTES, stream, a);
}
```

```cpp
#include <hip/hip_runtime.h>
#include <cstdio>
#include <cstdint>
#include <cmath>
namespace pg8 {
__device__ __forceinline__ int opaque_tid() { int t = threadIdx.x; asm volatile("" : "+v"(t)); return t; }
#define PG8_LAS __attribute__((address_space(3)))
typedef unsigned short bf16_t;
typedef short bf16x8 __attribute__((ext_vector_type(8)));
typedef float f32x4 __attribute__((ext_vector_type(4)));
typedef unsigned u32x4 __attribute__((ext_vector_type(4)));
constexpr int BM = 256, BK = 64, HALF = 128, HTB = HALF * BK * 2  , STAGE_BYTES = 8 * HTB, NXCD = 8, WGM = 8;

__host__ __device__ __forceinline__ int lds_byte(int r, int c) { const int st = (r >> 4) * 2 + (c >> 5), rr = r & 15, cc = c & 31, ob = rr * 64 + cc * 2; return st * 1024 + (ob ^ (((ob >> 9) & 1) << 5)); }
__host__ __device__ __forceinline__ void stage_rc(int b, int& R, int& C) { const int st = b / 1024, sb = b % 1024, swz = sb ^ (((sb >> 9) & 1) << 5); R = (st >> 1) * 16 + swz / 64; C = (st & 1) * 32 + (swz % 64) / 2; }
__host__ __device__ __forceinline__ int perm32(int rho) { const int n = rho >> 4, i = rho & 15; return 8 * (i >> 2) + 4 * n + (i & 3); }

struct Unit { int pm, pn; };
struct Gemm { const bf16_t* A; const bf16_t* Bt; int M, N, K; };

struct StaticOrder {
    int nM, nN, nwg, G, c;
    __host__ __device__ void init(int M, int N, int G_, int c_) { nM = M / BM; nN = N / BM; nwg = nM * nN; G = G_; c = c_; }
    __host__ __device__ bool next(int i, Unit& u) const {
        const long L = (long)i * G + c; if (L >= nwg) return false;
        int wgid = (int)L; { const int q = nwg / NXCD, r = nwg % NXCD, xcd = wgid % NXCD, off = wgid / NXCD; wgid = (xcd < r ? xcd * (q + 1) : r * (q + 1) + (xcd - r) * q) + off; }
        const int nig = WGM * nN, gid = wgid / nig, fm = gid * WGM, gsz = (nM - fm) < WGM ? (nM - fm) : WGM;
        u.pm = fm + ((wgid % nig) % gsz); u.pn = (wgid % nig) / gsz; return true;
    }
    __device__ __forceinline__ void a_ready(const Unit&) const {}
    __device__ __forceinline__ void done(const Unit&) const {}
};
__device__ __forceinline__ unsigned cvt_pk_bf16(float lo, float hi) { unsigned r; asm volatile("v_cvt_pk_bf16_f32 %0, %1, %2" : "=v"(r) : "v"(lo), "v"(hi)); return r; }
typedef float f32x2 __attribute__((ext_vector_type(2)));

constexpr size_t PO_AKP = 17825792, PO_AVP = 34603008, PO_BKP = 51380224, PO_BVP = 55574528, PO_AKS = 59768832, PO_AVS = 60817408, PO_BKS = 61865984, PO_BVS = 62914560;
constexpr size_t PW_KV = (size_t)36 * 1048576 / 2;
constexpr int P_MP = 16384;
constexpr float P_EPS = 1e-6f;
constexpr float P_C2 = 0.125f * 1.4426950408889634f;
typedef unsigned u32x2 __attribute__((ext_vector_type(2)));
struct GeoBig  { static constexpr int NAI = 2, NBJ = 2, NM = 4, NN = 2, RS_WR = 64, CS_WC = 32, WCN = 4; };
struct GeoS128 { static constexpr int NAI = 1, NBJ = 1, NM = 4, NN = 2, RS_WR = 64, CS_WC = 32, WCN = 4; };
struct GeoS64  { static constexpr int NAI = 1, NBJ = 1, NM = 1, NN = 2, RS_WR = 16, CS_WC = 32, WCN = 2; };
struct Tile { int row0, col0; };

template <class G>
__device__ __forceinline__ void row_rstd(const float* SS, int row0, int fq, float (&rs)[2][4]) {
#pragma unroll
    for (int ai = 0; ai < G::NAI; ++ai)
#pragma unroll
        for (int m = 0; m < G::NM; ++m) {
            const f32x4 v = *(const f32x4*)(SS + (size_t)(row0 + ai * HALF + m * 16) * 16 + 4 * fq);
            float s = (v[0] + v[1]) + (v[2] + v[3]);
            s += __shfl_xor(s, 16); s += __shfl_xor(s, 32);
            rs[ai][m] = 1.0f / sqrtf(s * (1.0f / 1024.0f) + P_EPS);
        }
}

struct EpiQKV {
    static constexpr bool PERM = false, AFTER_DRAIN = false;
    const float* SS; const float* cs;
    bf16_t *Qb, *Kb, *Vb; float* out;
    __device__ __forceinline__ void operator()(const f32x4 (&acc)[2][2][4][2], const Unit& u, int wr, int wc, int fr, int fq) const { run<GeoBig>(acc, Tile{u.pm * BM, u.pn * BM}, wr, wc, fr, fq, nullptr); }
    template <class G> __device__ __forceinline__ void run(const f32x4 (&acc)[2][2][4][2], const Tile T, int wr, int wc, int fr, int fq, PG8_LAS float* scr) const {
        const int row0 = T.row0 + wr * G::RS_WR + fr;
        float rs[2][4]; row_rstd<G>(SS, row0, fq, rs);
        const int sec = T.col0 >> 10, ct = T.col0 & 1023;
        const bool smp = T.row0 >= P_MP;
#pragma unroll
        for (int ai = 0; ai < G::NAI; ++ai)
#pragma unroll
            for (int m = 0; m < G::NM; ++m) {
                const int row = row0 + ai * HALF + m * 16; const float r = rs[ai][m];
                const int pos = smp ? (1024 + ((row - P_MP) & 31)) : (row & 2047);
                const size_t orow = smp ? (size_t)(row - P_MP) * 1024 : (size_t)row * 1024;
                if (sec < 2) {
                    const int dl = 16 * (wc & 1) + 4 * fq;
                    const f32x4 c4 = *(const f32x4*)(cs + (size_t)pos * 64 + dl), s4 = *(const f32x4*)(cs + (size_t)pos * 64 + 32 + dl);
#pragma unroll
                    for (int bj = 0; bj < G::NBJ; ++bj) {
                        const int col = ct + 128 * bj + 64 * (wc >> 1) + dl;
                        const f32x4 x1 = acc[ai][bj][m][0] * r, x2 = acc[ai][bj][m][1] * r;
                        f32x4 y1 = x1 * c4 - x2 * s4, y2 = x2 * c4 + x1 * s4;
                        if (sec == 0) {
                            y1 = y1 * P_C2; y2 = y2 * P_C2;
                            u32x2 w1, w2; w1.x = cvt_pk_bf16(y1[0], y1[1]); w1.y = cvt_pk_bf16(y1[2], y1[3]); w2.x = cvt_pk_bf16(y2[0], y2[1]); w2.y = cvt_pk_bf16(y2[2], y2[3]);
                            *(u32x2*)(Qb + (size_t)row * 1024 + col) = w1; *(u32x2*)(Qb + (size_t)row * 1024 + col + 32) = w2;
                        } else {
                            float* ok = out + (smp ? PO_AKS : PO_AKP) + orow + col;
                            *(f32x4*)ok = y1; *(f32x4*)(ok + 32) = y2;
                            u32x2 w1, w2; w1.x = cvt_pk_bf16(y1[0], y1[1]); w1.y = cvt_pk_bf16(y1[2], y1[3]); w2.x = cvt_pk_bf16(y2[0], y2[1]); w2.y = cvt_pk_bf16(y2[2], y2[3]);
                            *(u32x2*)(Kb + (size_t)row * 1024 + col) = w1; *(u32x2*)(Kb + (size_t)row * 1024 + col + 32) = w2;
                        }
                    }
                } else {
#pragma unroll
                    for (int bj = 0; bj < G::NBJ; ++bj)
#pragma unroll
                        for (int n = 0; n < G::NN; ++n) {
                            const int col = ct + 128 * bj + G::CS_WC * wc + 16 * n + 4 * fq;
                            const f32x4 v = acc[ai][bj][m][n] * r;
                            *(f32x4*)(out + (smp ? PO_AVS : PO_AVP) + orow + col) = v;
                            u32x2 w; w.x = cvt_pk_bf16(v[0], v[1]); w.y = cvt_pk_bf16(v[2], v[3]);
                            *(u32x2*)(Vb + (size_t)row * 1024 + col) = w;
                        }
                }
            }
    }
};

struct EpiKVQ {
    static constexpr bool PERM = false, AFTER_DRAIN = false;
    const float* SS; bf16_t *Qb, *Kb; float* out;
    __device__ __forceinline__ void operator()(const f32x4 (&acc)[2][2][4][2], const Unit& u, int wr, int wc, int fr, int fq) const { run<GeoBig>(acc, Tile{u.pm * BM, u.pn * BM}, wr, wc, fr, fq, nullptr); }
    template <class G> __device__ __forceinline__ void run(const f32x4 (&acc)[2][2][4][2], const Tile T, int wr, int wc, int fr, int fq, PG8_LAS float* scr) const {
        const int row0 = T.row0 + wr * G::RS_WR + fr;
        float rs[2][4]; row_rstd<G>(SS, row0, fq, rs);
        const int sec = T.col0 >> 10, ct = T.col0 & 1023;
        const bool smp = T.row0 >= P_MP;
        const bool keep = smp || (((T.row0 >> 8) & 7) >= 6);
#pragma unroll
        for (int ai = 0; ai < G::NAI; ++ai)
#pragma unroll
            for (int m = 0; m < G::NM; ++m) {
                const int row = row0 + ai * HALF + m * 16; const float r = rs[ai][m];
                const size_t orow = smp ? (size_t)(row - P_MP) * 1024 : ((size_t)(row >> 11) * 512 + (size_t)((row & 2047) - 1536)) * 1024;
#pragma unroll
                for (int bj = 0; bj < G::NBJ; ++bj)
#pragma unroll
                    for (int n = 0; n < G::NN; ++n) {
                        const int col = ct + 128 * bj + G::CS_WC * wc + 16 * n + 4 * fq;
                        f32x4 v = acc[ai][bj][m][n] * r;
                        if (sec == 2) {
                            v = v * P_C2; u32x2 w; w.x = cvt_pk_bf16(v[0], v[1]); w.y = cvt_pk_bf16(v[2], v[3]);
                            *(u32x2*)(Qb + (size_t)row * 1024 + col) = w;
                        } else {
                            if (keep) *(f32x4*)(out + (sec == 0 ? (smp ? PO_BKS : PO_BKP) : (smp ? PO_BVS : PO_BVP)) + orow + col) = v;
                            u32x2 w; w.x = cvt_pk_bf16(v[0], v[1]); w.y = cvt_pk_bf16(v[2], v[3]);
                            *(u32x2*)(Kb + (sec == 0 ? (size_t)0 : PW_KV) + (size_t)row * 1024 + col) = w;
                        }
                    }
            }
    }
};

struct EpiRes {
    static constexpr bool PERM = true, AFTER_DRAIN = false;
    bf16_t* Hb; float* SS; float sc;
    __device__ __forceinline__ void operator()(const f32x4 (&acc)[2][2][4][2], const Unit& u, int wr, int wc, int fr, int fq) const { run<GeoBig>(acc, Tile{u.pm * BM, u.pn * BM}, wr, wc, fr, fq, nullptr); }
    template <class G> __device__ __forceinline__ void run(const f32x4 (&acc)[2][2][4][2], const Tile T, int wr, int wc, int fr, int fq, PG8_LAS float* scr) const {
        const int row0 = T.row0 + wr * G::RS_WR + fr, col0 = T.col0 + wc * 32 + 8 * fq;
#pragma unroll
        for (int ai = 0; ai < G::NAI; ++ai)
#pragma unroll
            for (int m = 0; m < G::NM; ++m) {
                const int row = row0 + ai * HALF + m * 16;
                float ssq = 0.f;
#pragma unroll
                for (int bj = 0; bj < G::NBJ; ++bj) {
                    bf16_t* p = Hb + (size_t)row * 1024 + col0 + bj * HALF;
                    const u32x4 o = *(const u32x4*)p;
                    f32x4 h0 = acc[ai][bj][m][0] * sc, h1 = acc[ai][bj][m][1] * sc;
                    h0[0] += __uint_as_float(o.x << 16); h0[1] += __uint_as_float(o.x & 0xffff0000u); h0[2] += __uint_as_float(o.y << 16); h0[3] += __uint_as_float(o.y & 0xffff0000u);
                    h1[0] += __uint_as_float(o.z << 16); h1[1] += __uint_as_float(o.z & 0xffff0000u); h1[2] += __uint_as_float(o.w << 16); h1[3] += __uint_as_float(o.w & 0xffff0000u);
                    u32x4 w; w.x = cvt_pk_bf16(h0[0], h0[1]); w.y = cvt_pk_bf16(h0[2], h0[3]); w.z = cvt_pk_bf16(h1[0], h1[1]); w.w = cvt_pk_bf16(h1[2], h1[3]);
                    *(u32x4*)p = w;
                    ssq += ((h0[0] * h0[0] + h0[1] * h0[1]) + (h0[2] * h0[2] + h0[3] * h0[3])) + ((h1[0] * h1[0] + h1[1] * h1[1]) + (h1[2] * h1[2] + h1[3] * h1[3]));
                }
                ssq += __shfl_xor(ssq, 16); ssq += __shfl_xor(ssq, 32);
                if (G::WCN == 4) { if (fq == 0) SS[(size_t)row * 16 + (T.col0 >> 8) * 4 + wc] = ssq; }
                else { if (fq == 0) scr[(wr * G::RS_WR + m * 16 + fr) * 2 + wc] = ssq; }
            }
        if (G::WCN != 4) {
            __syncthreads();
            const int t_ = threadIdx.x;
            if (t_ < 64) SS[(size_t)(T.row0 + t_) * 16 + (T.col0 >> 6)] = scr[t_ * 2] + scr[t_ * 2 + 1];
            __syncthreads();
        }
    }
};

struct EpiFF1 {
    static constexpr bool PERM = true, AFTER_DRAIN = false;
    const float* SS; bf16_t* U; int ldc;
    __device__ __forceinline__ void operator()(const f32x4 (&acc)[2][2][4][2], const Unit& u, int wr, int wc, int fr, int fq) const { run<GeoBig>(acc, Tile{u.pm * BM, u.pn * BM}, wr, wc, fr, fq, nullptr); }
    template <class G> __device__ __forceinline__ void run(const f32x4 (&acc)[2][2][4][2], const Tile T, int wr, int wc, int fr, int fq, PG8_LAS float* scr) const {
        const int row0 = T.row0 + wr * G::RS_WR + fr;
        float rs[2][4]; row_rstd<G>(SS, row0, fq, rs);
        const int col0 = T.col0 + wc * 32 + 8 * fq;
#pragma unroll
        for (int ai = 0; ai < G::NAI; ++ai)
#pragma unroll
            for (int m = 0; m < G::NM; ++m) {
                const float r = rs[ai][m]; bf16_t* rowp = U + (size_t)(row0 + ai * HALF + m * 16) * ldc + col0;
#pragma unroll
                for (int bj = 0; bj < G::NBJ; ++bj) {
                    f32x4 v0 = acc[ai][bj][m][0] * r, v1 = acc[ai][bj][m][1] * r;
#pragma unroll
                    for (int i = 0; i < 4; ++i) { const float a = fmaxf(v0[i], 0.f), b = fmaxf(v1[i], 0.f); v0[i] = a * a; v1[i] = b * b; }
                    u32x4 w; w.x = cvt_pk_bf16(v0[0], v0[1]); w.y = cvt_pk_bf16(v0[2], v0[3]); w.z = cvt_pk_bf16(v1[0], v1[1]); w.w = cvt_pk_bf16(v1[2], v1[3]);
                    *(u32x4*)(rowp + bj * HALF) = w;
                }
            }
    }
};
template <class Epi, class Sched, bool ALIGN_EPI = false, bool SP2 = false>
__device__ __forceinline__ void gemm_phase(PG8_LAS unsigned char* lds, const Gemm g, const Sched& S, const Epi& E) {
    const int tid = opaque_tid(), wid = __builtin_amdgcn_readfirstlane(tid >> 6), lane = tid & 63, wr = wid >> 2, wc = wid & 3, fr = lane & 15, fq = lane >> 4;
    const int K = g.K, nt = K / BK;
    unsigned voffA[2], voffB[2];
#pragma unroll
    for (int i = 0; i < 2; ++i) { int R, C; stage_rc(tid * 16 + i * 8192, R, C); const int Rb = Epi::PERM ? ((R & ~31) + perm32(R & 31)) : R;
        voffA[i] = (unsigned)(R * K + C) * 2u; voffB[i] = (unsigned)(Rb * K + C) * 2u; }
    const size_t kstep = (size_t)(BK * 2);
    const size_t hstep = (size_t)HALF * K * 2;
    const size_t tstep = 2 * hstep;
    const unsigned ldsw = (unsigned)wid * 1024u;
    const int aoff = lds_byte(wr * 64 + fr, fq * 8), boff = lds_byte(wc * 32 + fr, fq * 8);
#define PG8_SA(b, h) (((b) * 2 + (h)) * HTB)
#define PG8_SB(b, h) ((4 + (b) * 2 + (h)) * HTB)
#define PG8_STAGE(bufoff, gbase, voff) do { _Pragma("unroll") for (int _i = 0; _i < 2; ++_i) \
        __builtin_amdgcn_global_load_lds((const unsigned*)((const char*)(gbase) + (voff)[_i]), (PG8_LAS unsigned*)(lds + (bufoff) + ldsw + _i * 8192), 16, 0, 0); } while (0)
#define PG8_LDA(dst, b, h) do { _Pragma("unroll") for (int m = 0; m < 4; ++m) _Pragma("unroll") for (int k = 0; k < 2; ++k) dst[m][k] = *(const PG8_LAS bf16x8*)(lds + PG8_SA(b, h) + aoff + m * 2048 + k * 1024); } while (0)
#define PG8_LDB(dst, b, h) do { _Pragma("unroll") for (int n = 0; n < 2; ++n) _Pragma("unroll") for (int k = 0; k < 2; ++k) dst[n][k] = *(const PG8_LAS bf16x8*)(lds + PG8_SB(b, h) + boff + n * 2048 + k * 1024); } while (0)
#define PG8_MMA(ai, bj, At, Bt) do { __builtin_amdgcn_s_setprio(1); _Pragma("unroll") for (int m = 0; m < 4; ++m) _Pragma("unroll") for (int n = 0; n < 2; ++n) _Pragma("unroll") for (int k = 0; k < 2; ++k) \
        acc[ai][bj][m][n] = __builtin_amdgcn_mfma_f32_16x16x32_bf16(Bt[n][k], At[m][k], acc[ai][bj][m][n], 0, 0, 0); __builtin_amdgcn_s_setprio(0); } while (0)
#define PG8_WAIT_V(n) asm volatile("s_waitcnt vmcnt(" #n ")" ::: "memory")
#define PG8_WAIT_L(n) asm volatile("s_waitcnt lgkmcnt(" #n ")" ::: "memory")
#define PG8_BAR __builtin_amdgcn_s_barrier()
#define PG8_SCHED __builtin_amdgcn_sched_barrier(0)
    Unit cur, nxt; int ui = 0;
    if (!S.next(0, cur)) return;
    f32x4 acc[2][2][4][2];
#pragma unroll
    for (int a = 0; a < 2; ++a)
#pragma unroll
        for (int b = 0; b < 2; ++b)
#pragma unroll
            for (int m = 0; m < 4; ++m)
#pragma unroll
                for (int n = 0; n < 2; ++n) acc[a][b][m][n] = (f32x4){0.f, 0.f, 0.f, 0.f};
    bf16x8 At[4][2], B0[2][2], B1[2][2];
    const char* cA = (const char*)g.A + (size_t)cur.pm * tstep; const char* cB = (const char*)g.Bt + (size_t)cur.pn * tstep;
    S.a_ready(cur);
    if constexpr (SP2) {
        PG8_STAGE(PG8_SB(0, 0), cB, voffB); PG8_STAGE(PG8_SB(0, 1), cB + hstep, voffB); PG8_STAGE(PG8_SA(0, 0), cA, voffA); PG8_STAGE(PG8_SA(0, 1), cA + hstep, voffA);
        if (wr == 1) PG8_BAR;
        PG8_WAIT_V(2); PG8_BAR;
        PG8_STAGE(PG8_SB(1, 0), cB + kstep, voffB); PG8_STAGE(PG8_SA(1, 0), cA + kstep, voffA); PG8_STAGE(PG8_SB(1, 1), cB + hstep + kstep, voffB);
        PG8_WAIT_V(6); PG8_BAR;
    } else {
        PG8_STAGE(PG8_SB(0, 0), cB, voffB); PG8_STAGE(PG8_SA(0, 0), cA, voffA); PG8_STAGE(PG8_SB(0, 1), cB + hstep, voffB); PG8_STAGE(PG8_SA(0, 1), cA + hstep, voffA);
        if (wr == 1) PG8_BAR;
        PG8_WAIT_V(4); PG8_BAR;
        PG8_STAGE(PG8_SB(1, 0), cB + kstep, voffB); PG8_STAGE(PG8_SA(1, 0), cA + kstep, voffA); PG8_STAGE(PG8_SB(1, 1), cB + hstep + kstep, voffB);
        PG8_WAIT_V(6); PG8_BAR;
    }
    for (;;) {
        const bool has_next = S.next(ui + 1, nxt);
        const char* nA = has_next ? (const char*)g.A + (size_t)nxt.pm * tstep : cA; const char* nB = has_next ? (const char*)g.Bt + (size_t)nxt.pn * tstep : cB;
        for (int t = 0; t < nt; t += 2) {
            const bool last = (t == nt - 2);
            const char* a1 = cA + (size_t)(t + 1) * kstep;
            const char* a2 = last ? nA : cA + (size_t)(t + 2) * kstep; const char* b2 = last ? nB : cB + (size_t)(t + 2) * kstep;
            const char* a3 = a2 + kstep; const char* b3 = b2 + kstep;
            if (last && has_next) S.a_ready(nxt);
            if constexpr (SP2) {
            PG8_LDB(B0, 0, 0); PG8_LDB(B1, 0, 1); PG8_SCHED; PG8_LDA(At, 0, 0); PG8_STAGE(PG8_SA(1, 1), a1 + hstep, voffA);
            PG8_WAIT_V(8); PG8_WAIT_L(0); PG8_BAR; PG8_MMA(0, 0, At, B0); PG8_MMA(0, 1, At, B1); PG8_BAR; PG8_SCHED;
            PG8_LDA(At, 0, 1); PG8_STAGE(PG8_SB(0, 0), b2, voffB); PG8_STAGE(PG8_SB(0, 1), b2 + hstep, voffB); PG8_STAGE(PG8_SA(0, 0), a2, voffA);
            PG8_WAIT_V(8); PG8_WAIT_L(0); PG8_BAR; PG8_MMA(1, 0, At, B0); PG8_MMA(1, 1, At, B1); PG8_BAR; PG8_SCHED;
            PG8_LDB(B0, 1, 0); PG8_LDB(B1, 1, 1); PG8_SCHED; PG8_LDA(At, 1, 0); PG8_STAGE(PG8_SA(0, 1), a2 + hstep, voffA);
            PG8_WAIT_V(8); PG8_WAIT_L(0); PG8_BAR; PG8_MMA(0, 0, At, B0); PG8_MMA(0, 1, At, B1); PG8_BAR; PG8_SCHED;
            PG8_LDA(At, 1, 1); PG8_STAGE(PG8_SB(1, 0), b3, voffB); PG8_STAGE(PG8_SB(1, 1), b3 + hstep, voffB); PG8_STAGE(PG8_SA(1, 0), a3, voffA);
            PG8_WAIT_V(8); PG8_WAIT_L(0); PG8_BAR; PG8_MMA(1, 0, At, B0); PG8_MMA(1, 1, At, B1); PG8_BAR; PG8_SCHED;
            } else {
            PG8_LDB(B0, 0, 0); PG8_SCHED; PG8_LDA(At, 0, 0); PG8_STAGE(PG8_SA(1, 1), a1 + hstep, voffA);
            PG8_WAIT_L(8); PG8_BAR; PG8_WAIT_L(0); PG8_MMA(0, 0, At, B0); PG8_BAR; PG8_SCHED;
            PG8_LDB(B1, 0, 1); PG8_STAGE(PG8_SB(0, 0), b2, voffB);
            PG8_BAR; PG8_WAIT_L(0); PG8_MMA(0, 1, At, B1); PG8_BAR;
            PG8_LDA(At, 0, 1); PG8_STAGE(PG8_SA(0, 0), a2, voffA);
            PG8_BAR; PG8_WAIT_L(0); PG8_MMA(1, 0, At, B0); PG8_BAR; PG8_SCHED;
            PG8_STAGE(PG8_SB(0, 1), b2 + hstep, voffB);
            PG8_WAIT_V(6); PG8_BAR; PG8_MMA(1, 1, At, B1); PG8_BAR;
            PG8_LDB(B0, 1, 0); PG8_SCHED; PG8_LDA(At, 1, 0); PG8_STAGE(PG8_SA(0, 1), a2 + hstep, voffA);
            PG8_WAIT_L(8); PG8_BAR; PG8_WAIT_L(0); PG8_MMA(0, 0, At, B0); PG8_BAR; PG8_SCHED;
            PG8_LDB(B1, 1, 1); PG8_STAGE(PG8_SB(1, 0), b3, voffB);
            PG8_BAR; PG8_WAIT_L(0); PG8_MMA(0, 1, At, B1); PG8_BAR;
            PG8_LDA(At, 1, 1); PG8_STAGE(PG8_SA(1, 0), a3, voffA);
            PG8_BAR; PG8_WAIT_L(0); PG8_MMA(1, 0, At, B0); PG8_BAR; PG8_SCHED;
            PG8_STAGE(PG8_SB(1, 1), b3 + hstep, voffB);
            PG8_WAIT_V(6); PG8_BAR; PG8_MMA(1, 1, At, B1); PG8_BAR;
            }
        }
        if constexpr (ALIGN_EPI) { if (wr == 0) PG8_BAR; }
        if constexpr (!Epi::AFTER_DRAIN) { E(acc, cur, wr, wc, fr, fq); S.done(cur); }
        if (!has_next) break;
#pragma unroll
        for (int a = 0; a < 2; ++a)
#pragma unroll
            for (int b = 0; b < 2; ++b)
#pragma unroll
                for (int m = 0; m < 4; ++m)
#pragma unroll
                    for (int n = 0; n < 2; ++n) acc[a][b][m][n] = (f32x4){0.f, 0.f, 0.f, 0.f};
        cur = nxt; cA = nA; cB = nB; ++ui;
        if constexpr (ALIGN_EPI) { if (wr == 1) PG8_BAR; }
    }
    PG8_WAIT_V(0);
    if constexpr (!ALIGN_EPI) { if (wr == 0) PG8_BAR; }
    PG8_BAR;
    if constexpr (Epi::AFTER_DRAIN) { E.fused(acc, cur, wr, wc, fr, fq, lds, wid, lane); S.done(cur); }
#undef PG8_SA
#undef PG8_SB
#undef PG8_STAGE
#undef PG8_LDA
#undef PG8_LDB
#undef PG8_MMA
#undef PG8_WAIT_V
#undef PG8_WAIT_L
#undef PG8_BAR
#undef PG8_SCHED
}

template <class G, class Epi>
__device__ __forceinline__ void gemm_small(PG8_LAS unsigned char* lds, const bf16_t* A, const bf16_t* Bt, int K, int row_base, int ntm, int ntn, int vcu, int nwg, const Epi& E) {
    constexpr int TM = (8 / G::WCN) * G::RS_WR * (G::NM * 16 / G::RS_WR), TN = G::WCN * G::CS_WC, SBK = 128, NCA = TM * 16 / 512, NCB = TN * 16 / 512, STG = (TM + TN) * 256;
    const int tid = opaque_tid(), wid = __builtin_amdgcn_readfirstlane(tid >> 6), lane = tid & 63, wr = wid / G::WCN, wc = wid % G::WCN, fr = lane & 15, fq = lane >> 4;
    const int nk = K / SBK;
    for (int tile = vcu; tile < ntm * ntn; tile += nwg) {
        const int tm = tile % ntm, tn = tile / ntm;
        const bf16_t* Ab = A + (size_t)(row_base + tm * TM) * K; const bf16_t* Bb = Bt + (size_t)(tn * TN) * K;
        f32x4 acc[2][2][4][2];
#pragma unroll
        for (int m = 0; m < G::NM; ++m)
#pragma unroll
            for (int n = 0; n < G::NN; ++n) acc[0][0][m][n] = (f32x4){0.f, 0.f, 0.f, 0.f};
        u32x4 ra0[NCA], rb0[NCB], ra1[NCA], rb1[NCB];
        unsigned goffA[NCA], goffB[NCB], loffA[NCA], loffB[NCB];
#pragma unroll
        for (int i = 0; i < NCA; ++i) { const int idx = tid + 512 * i, R = idx >> 4, c = idx & 15; goffA[i] = (unsigned)R * K + c * 8; loffA[i] = R * 256 + ((c ^ (R & 15)) * 16); }
#pragma unroll
        for (int i = 0; i < NCB; ++i) { const int idx = tid + 512 * i, R = idx >> 4, c = idx & 15; const int Rb = Epi::PERM ? ((R & ~31) + perm32(R & 31)) : R; goffB[i] = (unsigned)Rb * K + c * 8; loffB[i] = TM * 256 + R * 256 + ((c ^ (R & 15)) * 16); }
#define SM_LOAD(RA, RB, kt_) do { _Pragma("unroll") for (int i = 0; i < NCA; ++i) RA[i] = *(const u32x4*)(Ab + goffA[i] + (size_t)(kt_) * SBK); \
                                  _Pragma("unroll") for (int i = 0; i < NCB; ++i) RB[i] = *(const u32x4*)(Bb + goffB[i] + (size_t)(kt_) * SBK); } while (0)
#define SM_STEP(RA, RB, kt_) do { PG8_LAS unsigned char* sb = lds + ((kt_) & 1) * STG; \
            _Pragma("unroll") for (int i = 0; i < NCA; ++i) *(PG8_LAS u32x4*)(sb + loffA[i]) = RA[i]; \
            _Pragma("unroll") for (int i = 0; i < NCB; ++i) *(PG8_LAS u32x4*)(sb + loffB[i]) = RB[i]; \
            __syncthreads(); \
            if ((kt_) + 2 < nk) SM_LOAD(RA, RB, (kt_) + 2); \
            _Pragma("unroll") for (int kh = 0; kh < 4; ++kh) { bf16x8 af[G::NM], bfr[G::NN]; \
                _Pragma("unroll") for (int m = 0; m < G::NM; ++m) { const int R = wr * G::RS_WR + m * 16 + fr; af[m] = *(const PG8_LAS bf16x8*)(sb + R * 256 + (((kh * 4 + fq) ^ (R & 15)) * 16)); } \
                _Pragma("unroll") for (int n = 0; n < G::NN; ++n) { const int R = wc * G::CS_WC + n * 16 + fr; bfr[n] = *(const PG8_LAS bf16x8*)(sb + TM * 256 + R * 256 + (((kh * 4 + fq) ^ (R & 15)) * 16)); } \
                _Pragma("unroll") for (int m = 0; m < G::NM; ++m) _Pragma("unroll") for (int n = 0; n < G::NN; ++n) acc[0][0][m][n] = __builtin_amdgcn_mfma_f32_16x16x32_bf16(bfr[n], af[m], acc[0][0][m][n], 0, 0, 0); } } while (0)
        SM_LOAD(ra0, rb0, 0); SM_LOAD(ra1, rb1, 1);
        for (int kt = 0; kt < nk; kt += 2) { SM_STEP(ra0, rb0, kt); SM_STEP(ra1, rb1, kt + 1); }
#undef SM_LOAD
#undef SM_STEP
        __syncthreads();
        E.template run<G>(acc, Tile{row_base + tm * TM, tn * TN}, wr, wc, fr, fq, (PG8_LAS float*)(lds + 2 * STG));
    }
}
}
#define GAS __attribute__((address_space(1)))
#define LAS __attribute__((address_space(3)))
typedef unsigned short bf16;
typedef unsigned v4u __attribute__((ext_vector_type(4)));
typedef float f32x4 __attribute__((ext_vector_type(4)));
typedef short bf16x8 __attribute__((ext_vector_type(8)));
typedef GAS unsigned gu32;
typedef GAS unsigned long long gu64;
#define RLX_AGENT __ATOMIC_RELAXED, __HIP_MEMORY_SCOPE_AGENT
#define LDS_WAIT() asm volatile("s_waitcnt lgkmcnt(0)" ::: "memory")
#define VM_WAIT() asm volatile("s_waitcnt vmcnt(0)" ::: "memory")
__device__ __forceinline__ unsigned long long rt() { return __builtin_amdgcn_s_memrealtime(); }
__device__ __forceinline__ unsigned f2bf(float f) { unsigned u = __builtin_bit_cast(unsigned, f); return (u + 0x7fffu + ((u >> 16) & 1u)) >> 16; }
__device__ __forceinline__ unsigned pk2(float lo, float hi) { return f2bf(lo) | (f2bf(hi) << 16); }

#define XB_TMO      128
#define XB_XCNT(j)  (256  + 64 * (j))
#define XB_XSUB(j)  (1280 + 64 * (j))
#define XB_XGEN(j)  (2304 + 64 * (j))
#define XB_TOP      3328
#define XB_TOPGEN   3392
#define XCD_BAR_WORDS 3456
#define XB_SPIN_CAP (1u << 18)

__device__ __forceinline__ unsigned xb_ld(unsigned* p)              { return __hip_atomic_load(p, __ATOMIC_RELAXED, __HIP_MEMORY_SCOPE_AGENT); }
__device__ __forceinline__ unsigned xb_add(unsigned* p, unsigned v) { return __hip_atomic_fetch_add(p, v, __ATOMIC_RELAXED, __HIP_MEMORY_SCOPE_AGENT); }
__device__ __forceinline__ unsigned xb_xcc_id() { return (unsigned)__builtin_amdgcn_s_getreg((3 << 11) | 20) & 0xFu; }
#define XB_SPIN(cond, bar) do { unsigned _sp = 0; while (cond) { __builtin_amdgcn_s_sleep(1); \
    if ((++_sp & 255u) == 0u) { if (xb_ld(&(bar)[XB_TMO])) break; if (_sp > XB_SPIN_CAP) { atomicAdd(&(bar)[XB_TMO], 1u); break; } } } } while (0)

struct XcdBarrier {
    unsigned* bar; unsigned x;
    volatile LAS unsigned* st;
};

__device__ __forceinline__ XcdBarrier xcd_barrier_post(unsigned* bar, volatile LAS unsigned* st) {
    XcdBarrier b; b.bar = bar; b.x = xb_xcc_id(); b.st = st;
    if (threadIdx.x == 0) (void)xb_add(&bar[XB_XCNT(b.x)], 1u);
    return b;
}
__device__ __forceinline__ void xcd_barrier_complete(unsigned* bar, unsigned x, unsigned& nloc, unsigned& nx) {
    const unsigned G = gridDim.x * gridDim.y * gridDim.z;
    unsigned sum, cnt, mine, sp = 0u;
    for (;;) {
        sum = 0u; cnt = 0u; mine = 0u;
#pragma unroll
        for (unsigned j = 0; j < 16; ++j) { const unsigned c = xb_ld(&bar[XB_XCNT(j)]); sum += c; cnt += (c > 0u) ? 1u : 0u; mine = (j == x) ? c : mine; }
        if (sum == G) break;
        __builtin_amdgcn_s_sleep(1);
        if ((++sp & 255u) == 0u) { if (xb_ld(&bar[XB_TMO])) break; if (sp > XB_SPIN_CAP) { atomicAdd(&bar[XB_TMO], 1u); break; } }
    }
    nloc = mine > 0u ? mine : 1u; nx = cnt > 0u ? cnt : 1u;
}

__device__ __forceinline__ void xcd_barrier(const XcdBarrier& b) {
    asm volatile("s_waitcnt vmcnt(0)" ::: "memory");
    __syncthreads();
    if (threadIdx.x == 0) {
        unsigned* bar = b.bar;
        __builtin_amdgcn_s_waitcnt(0);
        unsigned nloc = b.st[0], nx = b.st[1];
        if (nloc == 0u) { xcd_barrier_complete(bar, b.x, nloc, nx); b.st[0] = nloc; b.st[1] = nx; }
        const unsigned old = xb_add(&bar[XB_XSUB(b.x)], 1u);
        const unsigned gen = old / nloc;
        if (old + 1u == (gen + 1u) * nloc) {
            __builtin_amdgcn_fence(__ATOMIC_RELEASE, "agent");
            asm volatile("s_waitcnt vmcnt(0)" ::: "memory");
            const unsigned og = xb_add(&bar[XB_TOP], 1u);
            const unsigned tg = og / nx;
            if (og + 1u == (tg + 1u) * nx) xb_add(&bar[XB_TOPGEN], 1u);
            else XB_SPIN(xb_ld(&bar[XB_TOPGEN]) == tg, bar);
            __builtin_amdgcn_fence(__ATOMIC_ACQUIRE, "agent");
            xb_add(&bar[XB_XGEN(b.x)], 1u);
            asm volatile("s_waitcnt vmcnt(0)" ::: "memory");
        } else {
            XB_SPIN(xb_ld(&bar[XB_XGEN(b.x)]) == gen, bar);
            __builtin_amdgcn_fence(__ATOMIC_ACQUIRE, "agent");
            asm volatile("s_waitcnt vmcnt(0)" ::: "memory");
        }
    }
    __syncthreads();
}

namespace at {
#define AT_LAS __attribute__((address_space(3)))
typedef short bf16x8 __attribute__((ext_vector_type(8)));
typedef short s16x4 __attribute__((ext_vector_type(4)));
typedef float f32x16 __attribute__((ext_vector_type(16)));
typedef float f32x4 __attribute__((ext_vector_type(4)));
typedef unsigned u32x4 __attribute__((ext_vector_type(4)));
typedef unsigned u32x2 __attribute__((ext_vector_type(2)));
typedef unsigned short bf16_t;
constexpr int MP = 16384, PITCH = 1024, SEQ = 2048;
constexpr int KCS = 1040;
constexpr int KT_BYTES = 8 * KCS;
constexpr float THR = 8.0f;
constexpr int WSF_OFF = 132096;
constexpr int QIMG_OFF = 99328;
__device__ __forceinline__ int crow(int r, int hi) { return (r & 3) + 8 * (r >> 2) + 4 * hi; }
__device__ __forceinline__ unsigned cvtpk(float lo, float hi) { typedef float f2 __attribute__((ext_vector_type(2))); typedef __bf16 b2 __attribute__((ext_vector_type(2))); f2 v = {lo, hi}; b2 b = __builtin_convertvector(v, b2); return __builtin_bit_cast(unsigned, b); }
__device__ __forceinline__ s16x4 vtr(const AT_LAS unsigned char* p) { typedef short v4i16_t __attribute__((ext_vector_type(4))); return __builtin_bit_cast(s16x4, __builtin_amdgcn_ds_read_tr16_b64_v4i16((AT_LAS v4i16_t*)p)); }
#define AT_SYNC() __syncthreads()

template <bool QLDS>
__device__ __forceinline__ void qk_tile(f32x16& p0, f32x16& p1, const AT_LAS unsigned char* kt, const bf16x8 (&qr_)[4], const AT_LAS unsigned char* qimg, int r32, int hi) {
    p0 = f32x16{}; p1 = f32x16{};
#pragma unroll
    for (int d0 = 0; d0 < 4; ++d0) {
        bf16x8 qr[4]; if (QLDS) qr[d0] = *(const AT_LAS bf16x8*)(qimg + (2 * d0 + hi) * 512 + r32 * 16); else qr[d0] = qr_[d0];
        const bf16x8 a0 = *(const AT_LAS bf16x8*)(kt + (2 * d0 + hi) * KCS + r32 * 16);
        const bf16x8 a1 = *(const AT_LAS bf16x8*)(kt + (2 * d0 + hi) * KCS + r32 * 16 + 512);
        p0 = __builtin_amdgcn_mfma_f32_32x32x16_bf16(a0, qr[d0], p0, 0, 0, 0);
        p1 = __builtin_amdgcn_mfma_f32_32x32x16_bf16(a1, qr[d0], p1, 0, 0, 0);
    }
}
template <int ND0>
__device__ __forceinline__ void softmax_tile(f32x16& p0, f32x16& p1, float& m, float& l, f32x16 (&o)[ND0], AT_LAS float* wsf, int r32, int hi) {
    float rm = fmaxf(p0[0], p1[0]);
#pragma unroll
    for (int r = 1; r < 16; ++r) rm = fmaxf(rm, fmaxf(p0[r], p1[r]));
    rm = fmaxf(rm, __shfl_xor(rm, 32));
    if (__any(rm > m + THR)) {
        const float mn = fmaxf(m, rm), f = __builtin_amdgcn_exp2f(m - mn);
        l *= f; m = mn;
        if (hi == 0) wsf[r32] = f;
        asm volatile("s_waitcnt lgkmcnt(0)" ::: "memory");
#pragma unroll
        for (int r = 0; r < 16; ++r) { const float fr_ = wsf[crow(r, hi)];
#pragma unroll
            for (int d0 = 0; d0 < ND0; ++d0) o[d0][r] *= fr_; }
        asm volatile("s_waitcnt lgkmcnt(0)" ::: "memory");
    }
    float s = 0.f;
#pragma unroll
    for (int r = 0; r < 16; ++r) { p0[r] = __builtin_amdgcn_exp2f(p0[r] - m); p1[r] = __builtin_amdgcn_exp2f(p1[r] - m); s += p0[r] + p1[r]; }
    l += s;
}
__device__ __forceinline__ void pack_p(bf16x8 (&pa)[4], const f32x16& p0, const f32x16& p1) {
#pragma unroll
    for (int ks = 0; ks < 4; ++ks) {
        u32x4 w;
        if (ks < 2) { const int b = 8 * ks; w.x = cvtpk(p0[b], p0[b + 1]); w.y = cvtpk(p0[b + 2], p0[b + 3]); w.z = cvtpk(p0[b + 4], p0[b + 5]); w.w = cvtpk(p0[b + 6], p0[b + 7]); }
        else { const int b = 8 * (ks - 2); w.x = cvtpk(p1[b], p1[b + 1]); w.y = cvtpk(p1[b + 2], p1[b + 3]); w.z = cvtpk(p1[b + 4], p1[b + 5]); w.w = cvtpk(p1[b + 6], p1[b + 7]); }
        pa[ks] = __builtin_bit_cast(bf16x8, w);
    }
}
template <int ND0>
__device__ __forceinline__ void pv_packed(f32x16 (&o)[ND0], const AT_LAS unsigned char* vt, const bf16x8 (&pa)[4], int lane, int hi) {
    const AT_LAS unsigned char* vb = vt + ((lane >> 4) & 1) * 32 + (lane & 3) * 8 + (4 * hi + ((lane & 15) >> 2)) * 64;
#pragma unroll
    for (int d0 = 0; d0 < ND0; ++d0)
#pragma unroll
        for (int ks = 0; ks < 4; ++ks) {
            const s16x4 lo = vtr(vb + d0 * 4096 + ks * 1024), hh = vtr(vb + d0 * 4096 + ks * 1024 + 512);
            const bf16x8 bfr = {lo[0], lo[1], lo[2], lo[3], hh[0], hh[1], hh[2], hh[3]};
            o[d0] = __builtin_amdgcn_mfma_f32_32x32x16_bf16(pa[ks], bfr, o[d0], 0, 0, 0);
        }
}
template <int ND0>
__device__ __forceinline__ void pv_tile(f32x16 (&o)[ND0], const AT_LAS unsigned char* vt, const f32x16& p0, const f32x16& p1, int lane, int hi) {
    bf16x8 pa[4]; pack_p(pa, p0, p1); pv_packed<ND0>(o, vt, pa, lane, hi);
}
__device__ __forceinline__ u32x4 ld16(const void* p) { return *(const u32x4*)p; }
__device__ __forceinline__ u32x2 f4_to_bf4(u32x4 v) { u32x2 w; w.x = cvtpk(__uint_as_float(v.x), __uint_as_float(v.y)); w.y = cvtpk(__uint_as_float(v.z), __uint_as_float(v.w)); return w; }

struct Ctx {
    const bf16_t *Q, *K, *V; bf16_t* O;
    const float *cache_k, *cache_v;
    const float *lam_p, *subln;
    const float* rel;
};

template <int NK, int DV>
__device__ __forceinline__ void ld_bf(u32x4 (&st)[NK + DV / 64], const bf16_t* kbase, const bf16_t* vbase, int nrows, int tid) {
    const int row = tid >> 3, ch = tid & 7; const unsigned koff = (unsigned)row * PITCH + ch * 8;
#pragma unroll
    for (int c = 0; c < NK; ++c) st[c] = (row < nrows) ? ld16(kbase + koff + c * 64) : (u32x4){0u, 0u, 0u, 0u};
    if (DV == 64) { st[NK] = (row < nrows) ? ld16(vbase + koff) : (u32x4){0u, 0u, 0u, 0u}; }
    else {
        const int vrow = tid >> 4; const unsigned voff = (unsigned)vrow * PITCH + (tid & 15) * 8;
#pragma unroll
        for (int i = 0; i < 2; ++i) st[NK + i] = (vrow + 32 * i < nrows) ? ld16(vbase + voff + (size_t)i * 32 * PITCH) : (u32x4){0u, 0u, 0u, 0u};
    }
}
template <int NK, int DV>
__device__ __forceinline__ void wr_bf(const u32x4 (&st)[NK + DV / 64], AT_LAS unsigned char* sb, int tid) {
    const int row = tid >> 3, ch = tid & 7;
#pragma unroll
    for (int c = 0; c < NK; ++c) *(AT_LAS u32x4*)(sb + c * KT_BYTES + ch * KCS + row * 16) = st[c];
    AT_LAS unsigned char* vb = sb + NK * KT_BYTES;
    if (DV == 64) { const int col = ch * 8; *(AT_LAS u32x4*)(vb + ((col >> 5) * 4 + (row >> 4)) * 1024 + (row & 15) * 64 + (col & 31) * 2) = st[NK]; }
    else {
        const int vrow = tid >> 4, col = (tid & 15) * 8;
#pragma unroll
        for (int i = 0; i < 2; ++i) *(AT_LAS u32x4*)(vb + ((col >> 5) * 4 + ((vrow + 32 * i) >> 4)) * 1024 + (vrow & 15) * 64 + (col & 31) * 2) = st[NK + i];
    }
}
__device__ __forceinline__ void glds16(const void* gsrc, unsigned lds_dst) { unsigned keep;
    asm volatile("s_mov_b32 %0, m0\n\ts_mov_b32 m0, %2\n\ts_nop 0\n\tglobal_load_lds_dwordx4 %1, off\n\ts_mov_b32 m0, %0" : "=&s"(keep) : "v"(gsrc), "s"(lds_dst) : "memory"); }
template <int NK, int DV>
__device__ __forceinline__ void dma_bf(const bf16_t* kbase, const bf16_t* vbase, AT_LAS unsigned char* sb, int w, int lane) {
    const unsigned s0 = (unsigned)__builtin_amdgcn_readfirstlane((int)(unsigned)(uintptr_t)sb);
#pragma unroll
    for (int c = 0; c < NK; ++c) glds16(kbase + (size_t)lane * PITCH + c * 64 + w * 8, (unsigned)__builtin_amdgcn_readfirstlane((int)(s0 + c * KT_BYTES + w * KCS)));
#pragma unroll
    for (int i = 0; i < DV / 64; ++i) { const int d0 = 2 * i + (w >> 2), rg = w & 3;
        glds16(vbase + (size_t)(16 * rg + (lane >> 2)) * PITCH + d0 * 32 + (lane & 3) * 8, (unsigned)__builtin_amdgcn_readfirstlane((int)(s0 + NK * KT_BYTES + (d0 * 4 + rg) * 1024))); }
}
__device__ __forceinline__ void dma_prompt(const bf16_t* kbase, const bf16_t* vbase, AT_LAS unsigned char* sb, int w, int lane) {
    const unsigned s0 = (unsigned)__builtin_amdgcn_readfirstlane((int)(unsigned)(uintptr_t)sb);
#pragma unroll
    for (int i = 0; i < 2; ++i) { const int j = 2 * w + i, R = 4 * j + (lane >> 4), c = (lane & 15) ^ (R & 15);
        glds16(kbase + (size_t)R * PITCH + c * 8, (unsigned)__builtin_amdgcn_readfirstlane((int)(s0 + j * 1024))); }
#pragma unroll
    for (int i = 0; i < 2; ++i) { const int d0 = 2 * i + (w >> 2), rg = w & 3;
        glds16(vbase + (size_t)(16 * rg + (lane >> 2)) * PITCH + d0 * 32 + (lane & 3) * 8, (unsigned)__builtin_amdgcn_readfirstlane((int)(s0 + 16384 + (d0 * 4 + rg) * 1024))); }
}
__device__ __forceinline__ void dma_promptB(const bf16_t* kbase, const bf16_t* vbase, AT_LAS unsigned char* sb, int w, int lane) {
    const unsigned s0 = (unsigned)__builtin_amdgcn_readfirstlane((int)(unsigned)(uintptr_t)sb);
    { const int R = 8 * w + (lane >> 3), c = (lane & 7) ^ ((R >> 1) & 7);
      glds16(kbase + (size_t)R * PITCH + c * 8, (unsigned)__builtin_amdgcn_readfirstlane((int)(s0 + w * 1024))); }
    { const int d0 = w >> 2, rg = w & 3;
      glds16(vbase + (size_t)(16 * rg + (lane >> 2)) * PITCH + d0 * 32 + (lane & 3) * 8, (unsigned)__builtin_amdgcn_readfirstlane((int)(s0 + 8192 + (d0 * 4 + rg) * 1024))); }
}
template <int NK, int DV>
__device__ __forceinline__ void ld_f32(u32x4 (&st)[2 * NK + DV / 32], const float* kbase, const float* vbase, int tid) {
    { const unsigned off = (unsigned)(tid >> 4) * 1024 + (tid & 15) * 4;
#pragma unroll
      for (int c = 0; c < NK; ++c)
#pragma unroll
          for (int i = 0; i < 2; ++i) st[c * 2 + i] = ld16(kbase + off + c * 64 + (size_t)i * 32 * 1024); }
    if (DV == 64) { const unsigned off = (unsigned)(tid >> 4) * 1024 + (tid & 15) * 4;
#pragma unroll
        for (int i = 0; i < 2; ++i) st[2 * NK + i] = ld16(vbase + off + (size_t)i * 32 * 1024); }
    else { const unsigned off = (unsigned)(tid >> 5) * 1024 + (tid & 31) * 4;
#pragma unroll
        for (int i = 0; i < 4; ++i) st[2 * NK + i] = ld16(vbase + off + (size_t)i * 16 * 1024); }
}
template <int NK, int DV>
__device__ __forceinline__ void wr_f32(const u32x4 (&st)[2 * NK + DV / 32], AT_LAS unsigned char* sb, int tid) {
    { const int row = tid >> 4, c4 = tid & 15;
#pragma unroll
      for (int c = 0; c < NK; ++c)
#pragma unroll
          for (int i = 0; i < 2; ++i) *(AT_LAS u32x2*)(sb + c * KT_BYTES + (c4 >> 1) * KCS + (row + 32 * i) * 16 + (c4 & 1) * 8) = f4_to_bf4(st[c * 2 + i]); }
    AT_LAS unsigned char* vb = sb + NK * KT_BYTES;
    if (DV == 64) { const int row = tid >> 4, col = (tid & 15) * 4;
#pragma unroll
        for (int i = 0; i < 2; ++i) *(AT_LAS u32x2*)(vb + ((col >> 5) * 4 + ((row + 32 * i) >> 4)) * 1024 + (row & 15) * 64 + (col & 31) * 2) = f4_to_bf4(st[2 * NK + i]); }
    else { const int row = tid >> 5, col = (tid & 31) * 4;
#pragma unroll
        for (int i = 0; i < 4; ++i) *(AT_LAS u32x2*)(vb + ((col >> 5) * 4 + ((row + 16 * i) >> 4)) * 1024 + (row & 15) * 64 + (col & 31) * 2) = f4_to_bf4(st[2 * NK + i]); }
}

constexpr int A_STAGE = 2 * KT_BYTES + 16384;
constexpr int A_TP = 132;
constexpr int S_TAB = WSF_OFF + 2048;
template <bool ISB>
__device__ __forceinline__ void attn_sample_unit(AT_LAS unsigned char* lds, int b, int cg, const Ctx& C) {
    constexpr int ND0 = ISB ? 2 : 4, NT = ISB ? 8 : 16, PAST = ISB ? 512 : 1024;
    const int tid = pg8::opaque_tid(), lane = tid & 63, r32 = lane & 31, hi = lane >> 5;
    const int w = __builtin_amdgcn_readfirstlane(tid >> 6), g = w >> 2;
    AT_LAS float* wsf = (AT_LAS float*)(lds + WSF_OFF) + w * 64;
    AT_LAS float* tab = (AT_LAS float*)(lds + S_TAB) + g * 264;
    const bool active = (w & 3) == 0;
    const int qrow0 = MP + b * 32, qpos = 1024 + r32;
    if (ISB) { for (int i = tid; i < 2 * 257; i += 512) { const int hh = i >= 257 ? 1 : 0, j = i - hh * 257; ((AT_LAS float*)(lds + S_TAB))[hh * 264 + j] = C.rel[(2 * cg + hh) * 257 + j] * 1.4426950408889634f; } }
    float lam = 0.f;
    if (!ISB) { const float a_ = C.lam_p[lane] * C.lam_p[64 + lane], c_ = C.lam_p[128 + lane] * C.lam_p[192 + lane];
      float sa = a_, sc = c_;
#pragma unroll
      for (int o_ = 1; o_ < 64; o_ <<= 1) { sa += __shfl_xor(sa, o_); sc += __shfl_xor(sc, o_); }
      lam = __expf(sa) - __expf(sc) + 0.2f; }
    bf16x8 qr[4];
    AT_LAS unsigned char* qimg = lds + QIMG_OFF + w * 4096;
#pragma unroll
    for (int d0 = 0; d0 < 4; ++d0) { qr[d0] = *(const bf16x8*)(C.Q + (size_t)(qrow0 + r32) * PITCH + cg * 128 + g * 64 + d0 * 16 + hi * 8);
        *(AT_LAS bf16x8*)(qimg + (2 * d0 + hi) * 512 + r32 * 16) = qr[d0]; }
    f32x16 o[ND0];
#pragma unroll
    for (int d0 = 0; d0 < ND0; ++d0) o[d0] = f32x16{};
    float m = -1e30f, l = 0.f;
    const bf16_t* kb0 = C.K + (size_t)qrow0 * PITCH + cg * 128;
    const bf16_t* vb0 = C.V + (size_t)qrow0 * PITCH + cg * 128;
    const float* kc0 = C.cache_k + (size_t)b * PAST * 1024 + cg * 128;
    const float* vc0 = C.cache_v + (size_t)b * PAST * 1024 + cg * 128;
    { u32x4 sn[4]; ld_bf<2, 128>(sn, kb0, vb0, 32, tid); wr_bf<2, 128>(sn, lds + 2 * A_STAGE, tid); }
    u32x4 st[8];
    ld_f32<2, 128>(st, kc0, vc0, tid);
    for (int t = 0; t < NT; ++t) {
        AT_LAS unsigned char* sb = lds + (t & 1) * A_STAGE;
        wr_f32<2, 128>(st, sb, tid);
        AT_SYNC();
        if (t + 1 < NT) ld_f32<2, 128>(st, kc0 + (size_t)(t + 1) * 64 * 1024, vc0 + (size_t)(t + 1) * 64 * 1024, tid);
        if (active) {
            const int nsub = (t == 0) ? 2 : 1;
#pragma unroll 1
            for (int sub = 0; sub < nsub; ++sub) {
                const AT_LAS unsigned char* sc = sub ? (lds + 2 * A_STAGE) : sb;
                f32x16 p0, p1;
                qk_tile<true>(p0, p1, sc + g * KT_BYTES, qr, qimg, r32, hi);
                if (ISB) {
                    const int kpos0 = sub ? 1024 : 512 + t * 64;
                    if (1024 - (kpos0 + 63) >= 128) { const float cb = tab[256];
#pragma unroll
                        for (int r = 0; r < 16; ++r) { p0[r] += cb; p1[r] += cb; } }
                    else {
#pragma unroll
                        for (int r = 0; r < 16; ++r) { const int rel = qpos - (kpos0 + crow(r, hi));
                            const int i0 = rel < -128 ? -128 : (rel > 128 ? 128 : rel), i1 = (rel - 32) < -128 ? -128 : ((rel - 32) > 128 ? 128 : (rel - 32));
                            p0[r] += tab[i0 + 128]; p1[r] += tab[i1 + 128]; } }
                }
                if (sub) {
#pragma unroll
                    for (int r = 0; r < 16; ++r) p1[r] = -INFINITY;
                }
                softmax_tile<ND0>(p0, p1, m, l, o, wsf, r32, hi);
                pv_tile<ND0>(o, sc + 2 * KT_BYTES + (ISB ? g * 8192 : 0), p0, p1, lane, hi);
            }
        }
    }
    AT_SYNC();
    const float lt = l + __shfl_xor(l, 32);
    if (!ISB) {
        { float inv = 1.0f / lt; if (g == 1) inv *= lam; if (hi == 0) wsf[r32] = inv; asm volatile("s_waitcnt lgkmcnt(0)" ::: "memory"); }
        AT_LAS float* T2 = (AT_LAS float*)lds;
        if (active && g == 1) {
#pragma unroll
            for (int r = 0; r < 16; ++r) { const int q = crow(r, hi); const float f = wsf[q];
#pragma unroll
                for (int d0 = 0; d0 < ND0; ++d0) T2[q * A_TP + d0 * 32 + r32] = o[d0][r] * f; }
        }
        AT_SYNC();
        if (active && g == 0) {
#pragma unroll
            for (int r = 0; r < 16; ++r) { const int q = crow(r, hi); const float f = wsf[q];
#pragma unroll
                for (int d0 = 0; d0 < ND0; ++d0) { const int ix = q * A_TP + d0 * 32 + r32; T2[ix] = o[d0][r] * f - T2[ix]; } }
            asm volatile("s_waitcnt lgkmcnt(0)" ::: "memory");
            const int row = lane & 31, half = lane >> 5;
            f32x4 x[16]; float ss = 0.f;
#pragma unroll
            for (int i = 0; i < 16; ++i) { x[i] = *(const AT_LAS f32x4*)(T2 + row * A_TP + half * 64 + 4 * i); ss += (x[i][0] * x[i][0] + x[i][1] * x[i][1]) + (x[i][2] * x[i][2] + x[i][3] * x[i][3]); }
            ss += __shfl_xor(ss, 32);
            const float rinv = 0.8f / sqrtf(ss * (1.0f / 128.0f) + 1e-6f);
            bf16_t* op = C.O + (size_t)(qrow0 + row) * PITCH + cg * 128 + half * 64;
#pragma unroll
            for (int i = 0; i < 16; i += 2) {
                const f32x4 g0 = *(const f32x4*)(C.subln + half * 64 + 4 * i), g1 = *(const f32x4*)(C.subln + half * 64 + 4 * i + 4);
                const f32x4 y0 = x[i] * g0 * rinv, y1 = x[i + 1] * g1 * rinv;
                u32x4 wv; wv.x = cvtpk(y0[0], y0[1]); wv.y = cvtpk(y0[2], y0[3]); wv.z = cvtpk(y1[0], y1[1]); wv.w = cvtpk(y1[2], y1[3]);
                *(u32x4*)(op + 4 * i) = wv;
            }
        }
    } else if (active) {
        { const float inv = 1.0f / lt; if (hi == 0) wsf[r32] = inv; asm volatile("s_waitcnt lgkmcnt(0)" ::: "memory"); }
        AT_LAS bf16_t* stg = (AT_LAS bf16_t*)lds + g * 2048;
#pragma unroll
        for (int r = 0; r < 16; ++r) { const int q = crow(r, hi); const float f = wsf[q];
#pragma unroll
            for (int d0 = 0; d0 < ND0; ++d0) { const unsigned pk = cvtpk(o[d0][r] * f, 0.f); stg[q * 64 + d0 * 32 + r32] = (bf16_t)(pk & 0xffffu); } }
        asm volatile("s_waitcnt lgkmcnt(0)" ::: "memory");
        bf16_t* op = C.O + (size_t)qrow0 * PITCH + cg * 128 + g * 64;
#pragma unroll
        for (int i = 0; i < 4; ++i) { const int row = i * 8 + (lane >> 3), ch = lane & 7; const u32x4 v = *(const AT_LAS u32x4*)(stg + row * 64 + ch * 8); *(u32x4*)(op + (size_t)row * PITCH + ch * 8) = v; }
    }
    AT_SYNC();
}

constexpr int P_STAGE = 16384 + 16384;
constexpr int P_WSF = 4 * P_STAGE;
constexpr int P_TAB = P_WSF + 2048;
template <bool ISB>
__device__ __forceinline__ void attn_prompt_unit(AT_LAS unsigned char* lds, int b, int cg, int ub, const Ctx& C) {
    constexpr int ND0 = ISB ? 2 : 4, NS = ISB ? 8 : 4, STG = ISB ? 16384 : P_STAGE, DIST = ISB ? 4 : 2, VOFF = ISB ? 8192 : 16384, KR2 = ISB ? 4096 : 8192;
    const int tid = pg8::opaque_tid(), lane = tid & 63, r32 = lane & 31, hi = lane >> 5;
#ifdef PROBE_PARITY
    const int w = __builtin_amdgcn_readfirstlane(tid >> 6), g = ISB ? (w & 1) : (w >> 2), qi = w & 3;
#else
    const int w = __builtin_amdgcn_readfirstlane(tid >> 6), g = w >> 2, qi = w & 3;
#endif
    AT_LAS float* wsf = (AT_LAS float*)(lds + P_WSF) + w * 64;
    AT_LAS float* tab = (AT_LAS float*)(lds + P_TAB);
    const int cw = ISB ? 4 * ub + (w >> 1) : 2 * ub + (qi >> 1);
    const int kt0 = ISB ? ((4 * ub - 8) > 0 ? (4 * ub - 8) : 0) : 0, NT = (ISB ? 4 * ub + 4 : 2 * ub + 2) - kt0;
    const int fv = ISB ? ((cw - 8) > 0 ? (cw - 8) : 0) : 0;
    const int qoff = ISB ? ub * 256 + w * 32 : ub * 128 + qi * 32, qrow0 = b * SEQ + qoff, qpos = qoff + r32;
    const int ccol = ISB ? cg * 64 : cg * 128;
    if (ISB) { if (tid < 257) tab[tid] = C.rel[cg * 257 + tid] * 1.4426950408889634f; }
    float lam = 0.f;
    if (!ISB) { const float a_ = C.lam_p[lane] * C.lam_p[64 + lane], c_ = C.lam_p[128 + lane] * C.lam_p[192 + lane];
      float sa = a_, sc = c_;
#pragma unroll
      for (int o_ = 1; o_ < 64; o_ <<= 1) { sa += __shfl_xor(sa, o_); sc += __shfl_xor(sc, o_); }
      lam = __expf(sa) - __expf(sc) + 0.2f; }
    bf16x8 qr[4];
#pragma unroll
    for (int d0 = 0; d0 < 4; ++d0) qr[d0] = *(const bf16x8*)(C.Q + (size_t)(qrow0 + r32) * PITCH + ccol + (ISB ? 0 : g * 64) + d0 * 16 + hi * 8);
    f32x16 o[ND0];
#pragma unroll
    for (int d0 = 0; d0 < ND0; ++d0) o[d0] = f32x16{};
    f32x16 negm = f32x16{};
    float m = 0.f, l = 0.f;
    bf16x8 pa[4];
#pragma unroll
    for (int ks = 0; ks < 4; ++ks) pa[ks] = bf16x8{};
    const bf16_t* kb0 = C.K + (size_t)(b * SEQ + kt0 * 64) * PITCH + ccol;
    const bf16_t* vb0 = C.V + (size_t)(b * SEQ + kt0 * 64) * PITCH + ccol;
#define P_DMA(tt) do { if (ISB) dma_promptB(kb0 + (size_t)(tt) * 64 * PITCH, vb0 + (size_t)(tt) * 64 * PITCH, lds + ((tt) & (NS - 1)) * STG, w, lane); \
                       else dma_prompt(kb0 + (size_t)(tt) * 64 * PITCH, vb0 + (size_t)(tt) * 64 * PITCH, lds + ((tt) & (NS - 1)) * STG, w, lane); } while (0)
#pragma unroll
    for (int tt = 0; tt < DIST; ++tt) if (tt < NT) P_DMA(tt);
    const int vlane = ((lane >> 4) & 1) * 32 + (lane & 3) * 8 + (4 * hi + ((lane & 15) >> 2)) * 64 + VOFF;
    const int klane = ISB ? (r32 * 128 + ((hi ^ ((r32 >> 1) & 7)) << 4)) : (r32 * 256 + (((g * 8 + hi) ^ (r32 & 15)) << 4));
#define P_VRD(buf, blk) do { _Pragma("unroll") for (int ks = 0; ks < 4; ++ks) { buf[2 * ks] = vtr(vp + (blk) * 4096 + ks * 1024); buf[2 * ks + 1] = vtr(vp + (blk) * 4096 + ks * 1024 + 512); } } while (0)
#define P_VMM(buf, blk) do { _Pragma("unroll") for (int ks = 0; ks < 4; ++ks) { const bf16x8 bfr = {buf[2 * ks][0], buf[2 * ks][1], buf[2 * ks][2], buf[2 * ks][3], buf[2 * ks + 1][0], buf[2 * ks + 1][1], buf[2 * ks + 1][2], buf[2 * ks + 1][3]}; \
        o[blk] = __builtin_amdgcn_mfma_f32_32x32x16_bf16(pa[ks], bfr, o[blk], 0, 0, 0); } } while (0)
#define P_SB() __builtin_amdgcn_sched_barrier(0)
#define P_KRD(scur) do { \
        _Pragma("unroll") for (int d0 = 0; d0 < 4; ++d0) { ka[2 * d0] = *(const AT_LAS bf16x8*)(lds + (scur) + (klane ^ (d0 << 5))); ka[2 * d0 + 1] = *(const AT_LAS bf16x8*)(lds + (scur) + (klane ^ (d0 << 5)) + KR2); } } while (0)
#define P_PV(sprev, KRD_STMT) do { const AT_LAS unsigned char* vp = lds + (sprev) + vlane; \
        P_VMM(va, 0); \
        if (ND0 == 4) { P_VRD(va, 2); P_SB(); P_VMM(vb, 1); P_VRD(vb, 3); P_SB(); P_VMM(va, 2); KRD_STMT; P_SB(); P_VMM(vb, 3); } else { KRD_STMT; P_SB(); P_VMM(vb, 1); } P_SB(); } while (0)
#define P_PRE(sprev) do { const AT_LAS unsigned char* vp = lds + (sprev) + vlane; P_VRD(va, 0); P_VRD(vb, 1); } while (0)
#define P_BAR() do { __builtin_amdgcn_sched_barrier(0); asm volatile("s_barrier" ::: "memory"); __builtin_amdgcn_sched_barrier(0); } while (0)
#define P_BAR_V0() do { __builtin_amdgcn_sched_barrier(0); asm volatile("s_waitcnt vmcnt(0)\n\ts_barrier" ::: "memory"); __builtin_amdgcn_sched_barrier(0); } while (0)
#define P_BAR_V2() do { __builtin_amdgcn_sched_barrier(0); asm volatile("s_waitcnt vmcnt(2)\n\ts_barrier" ::: "memory"); __builtin_amdgcn_sched_barrier(0); } while (0)
#define P_BAR_V4() do { __builtin_amdgcn_sched_barrier(0); asm volatile("s_waitcnt vmcnt(4)\n\ts_barrier" ::: "memory"); __builtin_amdgcn_sched_barrier(0); } while (0)
    asm volatile("s_waitcnt vmcnt(0) lgkmcnt(0)\n\ts_barrier" ::: "memory");
    if (g == 1) P_BAR();
    f32x16 p0, p1;
    s16x4 va[8], vb[8]; bf16x8 ka[8];
    P_PRE(0);
    for (int t = 0; t < NT; ++t) {
        if (t > 0) P_BAR();
        P_PV((t > 0 ? ((t - 1) & (NS - 1)) : 0) * STG, P_KRD((t & (NS - 1)) * STG));
        p0 = __builtin_amdgcn_mfma_f32_32x32x16_bf16(ka[0], qr[0], negm, 0, 0, 0); p1 = __builtin_amdgcn_mfma_f32_32x32x16_bf16(ka[1], qr[0], negm, 0, 0, 0);
#pragma unroll
        for (int d0 = 1; d0 < 4; ++d0) { p0 = __builtin_amdgcn_mfma_f32_32x32x16_bf16(ka[2 * d0], qr[d0], p0, 0, 0, 0); p1 = __builtin_amdgcn_mfma_f32_32x32x16_bf16(ka[2 * d0 + 1], qr[d0], p1, 0, 0, 0); }
        if (ISB) { const int nn = NT - 2 - t; if (nn >= 2) P_BAR_V4(); else if (nn == 1) P_BAR_V2(); else P_BAR_V0(); }
        else P_BAR_V0();
        if (t + DIST < NT) P_DMA(t + DIST);
        const int kt = kt0 + t;
        const bool vis = ISB ? (kt <= cw && kt >= cw - 8) : (kt <= cw);
        if (vis) {
            if (ISB) {
                const int relmin = cw * 64 + (w & 1) * 32 - (kt * 64 + 63);
                if (relmin >= 128) { const float cb = tab[256];
#pragma unroll
                    for (int r = 0; r < 16; ++r) { p0[r] += cb; p1[r] += cb; } }
                else {
#pragma unroll
                    for (int r = 0; r < 16; ++r) { const int rel = qpos - (kt * 64 + crow(r, hi));
                        const int i0 = rel < -128 ? -128 : (rel > 128 ? 128 : rel), i1 = (rel - 32) < -128 ? -128 : ((rel - 32) > 128 ? 128 : (rel - 32));
                        p0[r] += tab[i0 + 128]; p1[r] += tab[i1 + 128]; } }
            }
            float ra = __builtin_fmaxf(__builtin_fmaxf(p0[0], p0[1]), p1[0]), rb = __builtin_fmaxf(__builtin_fmaxf(p0[2], p0[3]), p1[1]);
            ra = __builtin_fmaxf(__builtin_fmaxf(ra, p1[2]), p1[3]);
#pragma unroll
            for (int r = 4; r < 16; r += 4) { ra = __builtin_fmaxf(__builtin_fmaxf(ra, p0[r]), p0[r + 1]); rb = __builtin_fmaxf(__builtin_fmaxf(rb, p0[r + 2]), p0[r + 3]);
                                              ra = __builtin_fmaxf(__builtin_fmaxf(ra, p1[r]), p1[r + 1]); rb = __builtin_fmaxf(__builtin_fmaxf(rb, p1[r + 2]), p1[r + 3]); }
            float rm = __builtin_fmaxf(ra, rb);
            { auto rr = __builtin_amdgcn_permlane32_swap(__float_as_uint(rm), __float_as_uint(rm), false, false); rm = __builtin_fmaxf(__uint_as_float(rr[0]), __uint_as_float(rr[1])); }
            const bool first = (kt == fv);
            if (first || __any(rm > THR)) {
                const float dl = first ? rm : __builtin_fmaxf(rm, 0.f);
                m += dl;
#pragma unroll
                for (int r = 0; r < 16; ++r) { p0[r] -= dl; p1[r] -= dl; }
#pragma unroll
                for (int r = 0; r < 16; ++r) negm[r] = -m;
                if (!first) {
                    const float f = __builtin_amdgcn_exp2f(-dl); l *= f;
                    if (hi == 0) wsf[r32] = f;
                    asm volatile("s_waitcnt lgkmcnt(0)" ::: "memory");
#pragma unroll
                    for (int r = 0; r < 16; ++r) { const float fr_ = wsf[crow(r, hi)];
#pragma unroll
                        for (int d0 = 0; d0 < ND0; ++d0) o[d0][r] *= fr_; }
                    asm volatile("s_waitcnt lgkmcnt(0)" ::: "memory");
                }
            }
            float s = 0.f;
#pragma unroll
            for (int r = 0; r < 16; ++r) { p0[r] = __builtin_amdgcn_exp2f(p0[r]); p1[r] = __builtin_amdgcn_exp2f(p1[r]); s += p0[r] + p1[r]; }
            l += s;
#ifdef PROBE_S2X
            { float xs = 0.f;
              for (int rep = 0; rep < PROBE_S2X; ++rep) {
#pragma unroll
              for (int r = 0; r < 16; ++r) { xs += __builtin_amdgcn_exp2f(p0[r] - 20.f - xs) + __builtin_amdgcn_exp2f(p1[r] - 21.f - xs); } }
              asm volatile("" :: "v"(xs)); }
#endif
            pack_p(pa, p0, p1);
        } else {
#pragma unroll
            for (int ks = 0; ks < 4; ++ks) pa[ks] = bf16x8{};
        }
        P_PRE((t & (NS - 1)) * STG);
    }
    P_BAR();
    P_PV(((NT - 1) & (NS - 1)) * STG, (void)0);
    asm volatile("s_waitcnt lgkmcnt(0)" ::: "memory");
    if (g == 0) P_BAR();
    P_BAR();
#undef P_KRD
#undef P_PRE
#undef P_BAR
#undef P_BAR_V0
#undef P_BAR_V2
#undef P_BAR_V4
#undef P_DMA
#undef P_VRD
#undef P_VMM
#undef P_SB
#undef P_PV
    const float lt = l + __shfl_xor(l, 32);
    if (!ISB) {
        { float inv = 1.0f / lt; if (g == 1) inv *= lam; if (hi == 0) wsf[r32] = inv; asm volatile("s_waitcnt lgkmcnt(0)" ::: "memory"); }
        AT_LAS float* T2 = (AT_LAS float*)lds + qi * (32 * A_TP);
        if (g == 1) {
#pragma unroll
            for (int r = 0; r < 16; ++r) { const int q = crow(r, hi); const float f = wsf[q];
#pragma unroll
                for (int d0 = 0; d0 < ND0; ++d0) T2[q * A_TP + d0 * 32 + r32] = o[d0][r] * f; }
        }
        AT_SYNC();
        if (g == 0) {
#pragma unroll
            for (int r = 0; r < 16; ++r) { const int q = crow(r, hi); const float f = wsf[q];
#pragma unroll
                for (int d0 = 0; d0 < ND0; ++d0) { const int ix = q * A_TP + d0 * 32 + r32; T2[ix] = o[d0][r] * f - T2[ix]; } }
            asm volatile("s_waitcnt lgkmcnt(0)" ::: "memory");
            const int row = lane & 31, half = lane >> 5;
            f32x4 x[16]; float ss = 0.f;
#pragma unroll
            for (int i = 0; i < 16; ++i) { x[i] = *(const AT_LAS f32x4*)(T2 + row * A_TP + half * 64 + 4 * i); ss += (x[i][0] * x[i][0] + x[i][1] * x[i][1]) + (x[i][2] * x[i][2] + x[i][3] * x[i][3]); }
            ss += __shfl_xor(ss, 32);
            const float rinv = 0.8f / sqrtf(ss * (1.0f / 128.0f) + 1e-6f);
            bf16_t* op = C.O + (size_t)(qrow0 + row) * PITCH + cg * 128 + half * 64;
#pragma unroll
            for (int i = 0; i < 16; i += 2) {
                const f32x4 g0 = *(const f32x4*)(C.subln + half * 64 + 4 * i), g1 = *(const f32x4*)(C.subln + half * 64 + 4 * i + 4);
                const f32x4 y0 = x[i] * g0 * rinv, y1 = x[i + 1] * g1 * rinv;
                u32x4 wv; wv.x = cvtpk(y0[0], y0[1]); wv.y = cvtpk(y0[2], y0[3]); wv.z = cvtpk(y1[0], y1[1]); wv.w = cvtpk(y1[2], y1[3]);
                *(u32x4*)(op + 4 * i) = wv;
            }
        }
    } else {
        { const float inv = 1.0f / lt; if (hi == 0) wsf[r32] = inv; asm volatile("s_waitcnt lgkmcnt(0)" ::: "memory"); }
        AT_LAS bf16_t* stg = (AT_LAS bf16_t*)lds + w * 2048;
#pragma unroll
        for (int r = 0; r < 16; ++r) { const int q = crow(r, hi); const float f = wsf[q];
#pragma unroll
            for (int d0 = 0; d0 < ND0; ++d0) { const unsigned pk = cvtpk(o[d0][r] * f, 0.f); stg[q * 64 + d0 * 32 + r32] = (bf16_t)(pk & 0xffffu); } }
        asm volatile("s_waitcnt lgkmcnt(0)" ::: "memory");
        bf16_t* op = C.O + (size_t)qrow0 * PITCH + ccol;
#pragma unroll
        for (int i = 0; i < 4; ++i) { const int row = i * 8 + (lane >> 3), ch = lane & 7; const u32x4 v = *(const AT_LAS u32x4*)(stg + row * 64 + ch * 8); *(u32x4*)(op + (size_t)row * PITCH + ch * 8) = v; }
    }
    AT_SYNC();
}
}

constexpr int NWAVES = 8;
#ifndef MK_N_LAUNCHES
#define MK_N_LAUNCHES 1
#endif
constexpr int N_PHASES = 12;
constexpr int DMODEL = 1024, SEQ = 2048, NBATCH = 8, MP = NBATCH * SEQ, MS = 1024, M = MP + MS, FF = 4096;
constexpr size_t O_Y = 0, O_AKP = 17825792, O_AVP = 34603008, O_BKP = 51380224, O_BVP = 55574528, O_AKS = 59768832, O_AVS = 60817408, O_BKS = 61865984, O_BVS = 62914560, O_END = 63963136;
constexpr size_t MiB = 1u << 20;
constexpr size_t WS_CTL = 0, CTL_ZERO_BYTES = 1 * MiB;
constexpr size_t WS_WQKV = 2 * MiB, WS_WAO = 8 * MiB, WS_WKVQ = 10 * MiB, WS_WBO = 16 * MiB, WS_W1 = 18 * MiB  , WS_W2 = 34 * MiB  ;
constexpr size_t WS_CS = 50 * MiB;
constexpr size_t WS_SS = 51 * MiB;
constexpr size_t WS_HB = 54 * MiB, WS_Q = 90 * MiB, WS_K = 126 * MiB, WS_V = 162 * MiB, WS_O = 198 * MiB;
constexpr size_t WS_U = 234 * MiB;
constexpr size_t WS_END = 372 * MiB;
constexpr int CW_TMO = 0, CW_CODE = 1, CW_BAR = 4096;
constexpr int RING_OFF = 0, RING_BYTES = 131072, LDS_BYTES = 163840, LDSCTL_OFF = LDS_BYTES - 1024, MISC_OFF = LDSCTL_OFF + 320;

struct Args { const float* in[20]; float* out; unsigned char* ws; int ph_lo, ph_hi, li, pad; };

struct Frame {
    LAS unsigned char* lds; volatile LAS unsigned* MISC; gu32* ctl;
    int tid, lane, wave, vcu, G;
};

__device__ __forceinline__ float wave_sum(float v) {
#pragma unroll
    for (int o = 1; o < 64; o <<= 1) v += __shfl_xor(v, o);
    return v;
}
__device__ __forceinline__ int pi64(int d) { return d < 32 ? 32 * (d >> 4) + (d & 15) : 32 * ((d - 32) >> 4) + 16 + ((d - 32) & 15); }
template <bool PERMQK>
__device__ __forceinline__ void p0_transpose_item(const float* W, const float* g, int K, int N, bf16* WT, int row_off, LAS float* scr, int item, int lane) {
    const int nblk = N / 32, kb = item / nblk, nb = item % nblk, k0 = 64 * kb, n0 = 32 * nb;
    float wv[32];
#pragma unroll
    for (int i = 0; i < 32; ++i) { const int kk = 2 * i + (lane >> 5); wv[i] = W[(size_t)(k0 + kk) * N + n0 + (lane & 31)]; }
#pragma unroll
    for (int i = 0; i < 32; ++i) { const int kk = 2 * i + (lane >> 5); const float gv = g ? g[k0 + kk] : 1.0f; scr[kk * 33 + (lane & 31)] = wv[i] * gv; }
    LDS_WAIT(); asm volatile("" ::: "memory");
    const int c = lane & 7;
#pragma unroll
    for (int j = 0; j < 4; ++j) { const int n = (lane >> 3) + 8 * j; const LAS float* s = scr + (8 * c) * 33 + n;
        v4u o; o.x = pk2(s[0 * 33], s[1 * 33]); o.y = pk2(s[2 * 33], s[3 * 33]); o.z = pk2(s[4 * 33], s[5 * 33]); o.w = pk2(s[6 * 33], s[7 * 33]);
        int nn = n0 + n; if (PERMQK && nn < 2048) nn = (nn & ~63) + pi64(nn & 63);
        *(GAS v4u*)(WT + (size_t)(row_off + nn) * K + k0 + 8 * c) = o; }
    LDS_WAIT(); asm volatile("" ::: "memory");
}
__device__ __forceinline__ void p0_prologue(Frame& F, const Args& A) {
    unsigned char* ws = A.ws;
    LAS float* scr = (LAS float*)(F.lds + RING_OFF + F.wave * 16384);
    const int gw = F.vcu * NWAVES + F.wave, NGW = F.G * NWAVES;
    constexpr int I_QKV = 16 * 96, I_SQ = 16 * 32, I_KV = 16 * 64, I_F1 = 16 * 128, I_F2 = 64 * 32;
    constexpr int NITEMS = I_QKV + I_SQ + I_KV + I_SQ + I_SQ + 2 * I_F1 + 2 * I_F2;
    const float* g_attn = A.in[6]; const float* g_mlp = A.in[16];
    for (int it = gw; it < NITEMS; it += NGW) {
        int r = it;
        if (r < I_QKV) { p0_transpose_item<true>(A.in[7], g_attn, 1024, 3072, (bf16*)(ws + WS_WQKV), 0, scr, r, F.lane); continue; } r -= I_QKV;
        if (r < I_SQ) { p0_transpose_item<false>(A.in[10], nullptr, 1024, 1024, (bf16*)(ws + WS_WAO), 0, scr, r, F.lane); continue; } r -= I_SQ;
        if (r < I_KV) { p0_transpose_item<false>(A.in[12], A.in[11], 1024, 2048, (bf16*)(ws + WS_WKVQ), 0, scr, r, F.lane); continue; } r -= I_KV;
        if (r < I_SQ) { p0_transpose_item<false>(A.in[13], g_attn + 1024, 1024, 1024, (bf16*)(ws + WS_WKVQ), 2048, scr, r, F.lane); continue; } r -= I_SQ;
        if (r < I_SQ) { p0_transpose_item<false>(A.in[15], nullptr, 1024, 1024, (bf16*)(ws + WS_WBO), 0, scr, r, F.lane); continue; } r -= I_SQ;
        if (r < I_F1) { p0_transpose_item<false>(A.in[17], g_mlp, 1024, 4096, (bf16*)(ws + WS_W1), 0, scr, r, F.lane); continue; } r -= I_F1;
        if (r < I_F1) { p0_transpose_item<false>(A.in[17] + (size_t)1024 * 4096, g_mlp + 1024, 1024, 4096, (bf16*)(ws + WS_W1 + 8 * MiB), 0, scr, r, F.lane); continue; } r -= I_F1;
        if (r < I_F2) { p0_transpose_item<false>(A.in[18], nullptr, 4096, 1024, (bf16*)(ws + WS_W2), 0, scr, r, F.lane); continue; } r -= I_F2;
        p0_transpose_item<false>(A.in[18] + (size_t)4096 * 1024, nullptr, 4096, 1024, (bf16*)(ws + WS_W2 + 8 * MiB), 0, scr, r, F.lane);
    }
    bf16* HB = (bf16*)(ws + WS_HB); float* SS = (float*)(ws + WS_SS);
    for (int m = gw; m < M; m += NGW) {
        const float* xrow = (m < MP) ? A.in[0] + (size_t)m * 1024 : A.in[1] + (size_t)(m - MP) * 1024;
        const GAS f32x4* xr = (const GAS f32x4*)xrow + F.lane;
        f32x4 v[4]; float s = 0.f;
#pragma unroll
        for (int j = 0; j < 4; ++j) { v[j] = xr[64 * j]; s += (v[j].x * v[j].x + v[j].y * v[j].y) + (v[j].z * v[j].z + v[j].w * v[j].w); }
        s = wave_sum(s);
        GAS unsigned long long* o8 = (GAS unsigned long long*)(HB + (size_t)m * 1024) + F.lane;
#pragma unroll
        for (int j = 0; j < 4; ++j) o8[64 * j] = (unsigned long long)pk2(v[j].x, v[j].y) | ((unsigned long long)pk2(v[j].z, v[j].w) << 32);
        if (F.lane < 16) SS[(size_t)m * 16 + F.lane] = (F.lane == 0) ? s : 0.f;
    }
    float* cs = (float*)(ws + WS_CS);
    for (int e = (F.vcu * NWAVES + F.wave) * 64 + F.lane; e < 2048 * 32; e += F.G * NWAVES * 64) {
        const int pos = e >> 5, i = e & 31;
        const float inv = 1.0f / powf(10000.0f, (float)i * (1.0f / 32.0f));
        const float ang = (float)pos * inv;
        float sv, cv; sincosf(ang, &sv, &cv);
        cs[(size_t)pos * 64 + i] = cv; cs[(size_t)pos * 64 + 32 + i] = sv;
    }
}
__device__ __forceinline__ void final_norm(Frame& F, const Args& A) {
    const int gw = F.vcu * NWAVES + F.wave, NGW = F.G * NWAVES;
    const float* SS = (const float*)(A.ws + WS_SS); const float* gf = A.in[19]; const bf16* HB = (const bf16*)(A.ws + WS_HB);
    f32x4 g[4];
#pragma unroll
    for (int j = 0; j < 4; ++j) g[j] = *((const f32x4*)gf + 4 * F.lane + j);
    for (int m = gw; m < M; m += NGW) {
        float s = (F.lane < 16) ? SS[(size_t)m * 16 + F.lane] : 0.f;
        s = wave_sum(s);
        const float r = 1.0f / sqrtf(s * (1.0f / 1024.0f) + 1e-6f);
        const v4u h0 = *((const GAS v4u*)(HB + (size_t)m * 1024) + 2 * F.lane), h1 = *((const GAS v4u*)(HB + (size_t)m * 1024) + 2 * F.lane + 1);
        GAS f32x4* yr = (GAS f32x4*)(A.out + (size_t)m * 1024) + 4 * F.lane;
        const unsigned w[8] = {h0.x, h0.y, h0.z, h0.w, h1.x, h1.y, h1.z, h1.w};
#pragma unroll
        for (int j = 0; j < 4; ++j) { f32x4 v; v.x = __uint_as_float(w[2 * j] << 16); v.y = __uint_as_float(w[2 * j] & 0xffff0000u); v.z = __uint_as_float(w[2 * j + 1] << 16); v.w = __uint_as_float(w[2 * j + 1] & 0xffff0000u);
            yr[j] = v * g[j] * r; }
    }
}

#ifndef PHASE_MASK
#define PHASE_MASK 0xFFFF
#endif
#ifndef REPEAT_MASK
#define REPEAT_MASK 0
#endif
template <int PH, bool DRY = false>
__device__ __forceinline__ void run_phase(Frame& F, const Args& args) {
    unsigned char* const ws = args.ws;
    pg8::bf16_t* const HB = (pg8::bf16_t*)(ws + WS_HB); pg8::bf16_t* const QB = (pg8::bf16_t*)(ws + WS_Q); pg8::bf16_t* const KB = (pg8::bf16_t*)(ws + WS_K);
    pg8::bf16_t* const VB = (pg8::bf16_t*)(ws + WS_V); pg8::bf16_t* const OB = (pg8::bf16_t*)(ws + WS_O); pg8::bf16_t* const UB = (pg8::bf16_t*)(ws + WS_U);
    float* const SS = (float*)(ws + WS_SS); float* const H = args.out + O_Y;
    if constexpr (PH == 0) p0_prologue(F, args);
    if constexpr (PH == 1) {
        pg8::Gemm g{HB, (const pg8::bf16_t*)(ws + WS_WQKV), M, 3072, 1024}; pg8::StaticOrder S; S.init(MP, 3072, F.G, (int)blockIdx.x);
        pg8::EpiQKV E{SS, (const float*)(ws + WS_CS), QB, KB, VB, args.out};
        pg8::gemm_phase<pg8::EpiQKV, pg8::StaticOrder, true, true>(F.lds + RING_OFF, g, S, E);
        pg8::gemm_small<pg8::GeoS128, pg8::EpiQKV>(F.lds + RING_OFF, g.A, g.Bt, g.K, MP, 8, g.N / 128, F.vcu, F.G, E);
    }
    if constexpr (PH == 2) {
        at::Ctx C{QB, KB, VB, OB, args.in[2], args.in[3], args.in[8], args.in[9], nullptr};
#ifndef AS_REPS
#define AS_REPS 1
#endif
#ifndef AP_REPS
#define AP_REPS 1
#endif
        for (int vv = F.vcu; vv < 256; vv += F.G) {
            const int x = vv >> 5, c = vv & 31, u = c & 15, par = x & 1;
#pragma unroll 1
            for (int i = 0; i < 5; ++i) {
                const int j = par ? ((i + 1) % 5) : i;
                if (j == 0) { for (int r_ = 0; r_ < AS_REPS; ++r_) at::attn_sample_unit<false>(F.lds, vv >> 3, vv & 7, C); }
                else { const int r = j - 1, bh = r * 16 + x * 2 + (c >> 4), ub = (r & 1) ? 15 - u : u; for (int r_ = 0; r_ < AP_REPS; ++r_) at::attn_prompt_unit<false>(F.lds, bh >> 3, bh & 7, ub, C); }
            }
        }
    }
    if constexpr (PH == 3 || PH == 8) {
        pg8::Gemm g{OB, (const pg8::bf16_t*)(ws + (PH == 3 ? WS_WAO : WS_WBO)), M, 1024, 1024}; pg8::StaticOrder S; S.init(MP, 1024, F.G, (int)blockIdx.x);
        pg8::EpiRes E{HB, SS, DRY ? 0.f : 1.f};
        pg8::gemm_phase<pg8::EpiRes, pg8::StaticOrder, true, true>(F.lds + RING_OFF, g, S, E);
        pg8::gemm_small<pg8::GeoS64, pg8::EpiRes>(F.lds + RING_OFF, g.A, g.Bt, g.K, MP, 16, g.N / 64, F.vcu, F.G, E);
    }
    if constexpr (PH == 4 || PH == 9) {
        pg8::Gemm g{HB, (const pg8::bf16_t*)(ws + WS_W1 + (PH == 9 ? 8 * MiB : 0)), M, FF, 1024}; pg8::StaticOrder S; S.init(MP, FF, F.G, (int)blockIdx.x);
        pg8::EpiFF1 E{SS, UB, FF};
        pg8::gemm_phase<pg8::EpiFF1, pg8::StaticOrder, true, true>(F.lds + RING_OFF, g, S, E);
#ifndef SMALL_REPS
#define SMALL_REPS 1
#endif
#ifndef BIG_REPS
#define BIG_REPS 0
#endif
        for (int sr_ = 0; sr_ < BIG_REPS; ++sr_) pg8::gemm_phase<pg8::EpiFF1, pg8::StaticOrder, true, true>(F.lds + RING_OFF, g, S, E);
        for (int sr_ = 0; sr_ < SMALL_REPS; ++sr_) pg8::gemm_small<pg8::GeoS128, pg8::EpiFF1>(F.lds + RING_OFF, g.A, g.Bt, g.K, MP, 8, g.N / 128, F.vcu, F.G, E);
    }
    if constexpr (PH == 5 || PH == 10) {
        pg8::Gemm g{UB, (const pg8::bf16_t*)(ws + WS_W2 + (PH == 10 ? 8 * MiB : 0)), M, 1024, FF}; pg8::StaticOrder S; S.init(MP, 1024, F.G, (int)blockIdx.x);
        pg8::EpiRes E{HB, SS, DRY ? 0.f : 1.f};
        pg8::gemm_phase<pg8::EpiRes, pg8::StaticOrder, true, true>(F.lds + RING_OFF, g, S, E);
        pg8::gemm_small<pg8::GeoS64, pg8::EpiRes>(F.lds + RING_OFF, g.A, g.Bt, g.K, MP, 16, g.N / 64, F.vcu, F.G, E);
    }
    if constexpr (PH == 6) {
        pg8::Gemm g{HB, (const pg8::bf16_t*)(ws + WS_WKVQ), M, 3072, 1024}; pg8::StaticOrder S; S.init(MP, 3072, F.G, (int)blockIdx.x);
        pg8::EpiKVQ E{SS, QB, KB, args.out};
        pg8::gemm_phase<pg8::EpiKVQ, pg8::StaticOrder, true, true>(F.lds + RING_OFF, g, S, E);
        pg8::gemm_small<pg8::GeoS128, pg8::EpiKVQ>(F.lds + RING_OFF, g.A, g.Bt, g.K, MP, 8, g.N / 128, F.vcu, F.G, E);
    }
    if constexpr (PH == 7) {
        at::Ctx C{QB, KB, VB, OB, args.in[4], args.in[5], nullptr, nullptr, args.in[14]};
#ifndef BS_REPS
#define BS_REPS 1
#endif
#ifndef BP_REPS
#define BP_REPS 1
#endif
        for (int vv = F.vcu; vv < 256; vv += F.G) {
            const int x = vv >> 5, c = vv & 31, u = c & 15;
#pragma unroll 1
            for (int i = 0; i < 4 * BP_REPS; ++i) { const int k_ = i & 3, bhh = vv >> 1, par = vv & 1, qb = 4 * (k_ >> 1) + ((k_ & 1) ? 3 - par : par); at::attn_prompt_unit<true>(F.lds, bhh >> 4, bhh & 15, qb, C); }
#pragma unroll 1
            for (int i = 0; i < BS_REPS; ++i) at::attn_sample_unit<true>(F.lds, vv >> 3, vv & 7, C);
        }
    }
    if constexpr (PH == 11) final_norm(F, args);
}
__global__ void __launch_bounds__(NWAVES * 64, 2) skel_fwd(Args args) {
    extern __shared__ __attribute__((aligned(16))) unsigned char lds[];
    Frame F;
    F.lds = (LAS unsigned char*)lds;
    F.MISC = (volatile LAS unsigned*)(F.lds + MISC_OFF);
    F.tid = threadIdx.x; F.lane = F.tid & 63; F.wave = __builtin_amdgcn_readfirstlane(F.tid >> 6);
    F.G = gridDim.x; { const int bx = blockIdx.x; F.vcu = (F.G % 8 == 0) ? (bx % 8) * (F.G / 8) + bx / 8 : bx; }
    F.ctl = (gu32*)(args.ws + WS_CTL);
    for (int u = F.tid; u < (LDS_BYTES - LDSCTL_OFF) / 4; u += NWAVES * 64) ((LAS unsigned*)(F.lds + LDSCTL_OFF))[u] = 0u;
    __syncthreads();
    XcdBarrier bar = xcd_barrier_post((unsigned*)(F.ctl + CW_BAR), F.MISC + 8);
#define DO_PHASE(k) do { if constexpr (((PHASE_MASK) >> (k)) & 1) { run_phase<k>(F, args); \
        if constexpr (((REPEAT_MASK) >> (k)) & 1) { xcd_barrier(bar); run_phase<k, true>(F, args); } \
        if constexpr ((k) != N_PHASES - 1) xcd_barrier(bar); } } while (0)
    DO_PHASE(0); DO_PHASE(1); DO_PHASE(2); DO_PHASE(3); DO_PHASE(4); DO_PHASE(5); DO_PHASE(6); DO_PHASE(7); DO_PHASE(8); DO_PHASE(9); DO_PHASE(10); DO_PHASE(11);
#undef DO_PHASE
}

extern "C" void kernel_launch(void* const* d_in, const int* in_sizes, int n_in, void* d_out, int out_size, void* d_ws, size_t ws_size, hipStream_t stream) {
    static int grid = 0;
    if (grid == 0) {
        if (n_in != 20 || out_size != (int)O_END || ws_size < WS_END) { fprintf(stderr, "kernel_launch: unexpected problem (n_in %d out %d ws %zu)\n", n_in, out_size, ws_size); grid = -1; return; }
        int dev = 0, cus = 0, per_cu = 0;
        if (hipGetDevice(&dev) != hipSuccess || hipDeviceGetAttribute(&cus, hipDeviceAttributeMultiprocessorCount, dev) != hipSuccess) { grid = -1; return; }
        if (hipFuncSetAttribute((const void*)skel_fwd, hipFuncAttributeMaxDynamicSharedMemorySize, LDS_BYTES) != hipSuccess) { fprintf(stderr, "kernel_launch: hipFuncSetAttribute failed\n"); grid = -1; return; }
        if (hipOccupancyMaxActiveBlocksPerMultiprocessor(&per_cu, (const void*)skel_fwd, NWAVES * 64, LDS_BYTES) != hipSuccess || per_cu < 1) { fprintf(stderr, "kernel_launch: occupancy query reports %d\n", per_cu); per_cu = 1; }
        (void)hipGetLastError();
        grid = cus;
        if (grid > 256) grid = 256;
    }
    if (grid < 0) return;
    (void)hipMemsetAsync((char*)d_ws + WS_CTL, 0, CTL_ZERO_BYTES, stream);
    Args a{};
    for (int i = 0; i < 20; ++i) a.in[i] = (const float*)d_in[i];
    a.out = (float*)d_out; a.ws = (unsigned char*)d_ws;
    hipLaunchKernelGGL(skel_fwd, dim3(grid), dim3(NWAVES * 64), LDS_BYTES, stream, a);
}
```

```cpp
#include <hip/hip_runtime.h>
#include <cstdio>
#include <cstdint>
#include <cmath>
namespace pg8 {
__device__ __forceinline__ int opaque_tid() { int t = threadIdx.x; asm volatile("" : "+v"(t)); return t; }
#define PG8_LAS __attribute__((address_space(3)))
typedef unsigned short bf16_t;
typedef short bf16x8 __attribute__((ext_vector_type(8)));
typedef float f32x4 __attribute__((ext_vector_type(4)));
typedef unsigned u32x4 __attribute__((ext_vector_type(4)));
constexpr int BM = 256, BK = 64, HALF = 128, HTB = HALF * BK * 2  , STAGE_BYTES = 8 * HTB, NXCD = 8, WGM = 8;

__host__ __device__ __forceinline__ int lds_byte(int r, int c) { const int st = (r >> 4) * 2 + (c >> 5), rr = r & 15, cc = c & 31, ob = rr * 64 + cc * 2; return st * 1024 + (ob ^ (((ob >> 9) & 1) << 5)); }
__host__ __device__ __forceinline__ void stage_rc(int b, int& R, int& C) { const int st = b / 1024, sb = b % 1024, swz = sb ^ (((sb >> 9) & 1) << 5); R = (st >> 1) * 16 + swz / 64; C = (st & 1) * 32 + (swz % 64) / 2; }
__host__ __device__ __forceinline__ int perm32(int rho) { const int n = rho >> 4, i = rho & 15; return 8 * (i >> 2) + 4 * n + (i & 3); }

struct Unit { int pm, pn; };
struct Gemm { const bf16_t* A; const bf16_t* Bt; int M, N, K; };

struct StaticOrder {
    int nM, nN, nwg, G, c;
    __host__ __device__ void init(int M, int N, int G_, int c_) { nM = M / BM; nN = N / BM; nwg = nM * nN; G = G_; c = c_; }
    __host__ __device__ bool next(int i, Unit& u) const {
        const long L = (long)i * G + c; if (L >= nwg) return false;
        int wgid = (int)L; { const int q = nwg / NXCD, r = nwg % NXCD, xcd = wgid % NXCD, off = wgid / NXCD; wgid = (xcd < r ? xcd * (q + 1) : r * (q + 1) + (xcd - r) * q) + off; }
        const int nig = WGM * nN, gid = wgid / nig, fm = gid * WGM, gsz = (nM - fm) < WGM ? (nM - fm) : WGM;
        u.pm = fm + ((wgid % nig) % gsz); u.pn = (wgid % nig) / gsz; return true;
    }
    __device__ __forceinline__ void a_ready(const Unit&) const {}
    __device__ __forceinline__ void done(const Unit&) const {}
};
__device__ __forceinline__ unsigned cvt_pk_bf16(float lo, float hi) { unsigned r; asm volatile("v_cvt_pk_bf16_f32 %0, %1, %2" : "=v"(r) : "v"(lo), "v"(hi)); return r; }
typedef float f32x2 __attribute__((ext_vector_type(2)));

constexpr size_t PO_AKP = 17825792, PO_AVP = 34603008, PO_BKP = 51380224, PO_BVP = 55574528, PO_AKS = 59768832, PO_AVS = 60817408, PO_BKS = 61865984, PO_BVS = 62914560;
constexpr size_t PW_KV = (size_t)36 * 1048576 / 2;
constexpr int P_MP = 16384;
constexpr float P_EPS = 1e-6f;
constexpr float P_C2 = 0.125f * 1.4426950408889634f;
typedef unsigned u32x2 __attribute__((ext_vector_type(2)));
struct GeoBig  { static constexpr int NAI = 2, NBJ = 2, NM = 4, NN = 2, RS_WR = 64, CS_WC = 32, WCN = 4; };
struct GeoS128 { static constexpr int NAI = 1, NBJ = 1, NM = 4, NN = 2, RS_WR = 64, CS_WC = 32, WCN = 4; };
struct GeoS64  { static constexpr int NAI = 1, NBJ = 1, NM = 1, NN = 2, RS_WR = 16, CS_WC = 32, WCN = 2; };
struct Tile { int row0, col0; };

template <class G>
__device__ __forceinline__ void row_rstd(const float* SS, int row0, int fq, float (&rs)[2][4]) {
#pragma unroll
    for (int ai = 0; ai < G::NAI; ++ai)
#pragma unroll
        for (int m = 0; m < G::NM; ++m) {
            const f32x4 v = *(const f32x4*)(SS + (size_t)(row0 + ai * HALF + m * 16) * 16 + 4 * fq);
            float s = (v[0] + v[1]) + (v[2] + v[3]);
            s += __shfl_xor(s, 16); s += __shfl_xor(s, 32);
            rs[ai][m] = 1.0f / sqrtf(s * (1.0f / 1024.0f) + P_EPS);
        }
}
struct RsTab { PG8_LAS const float* t; int row0, nrows; };
__device__ __forceinline__ void rs_fill(const float* SS, PG8_LAS float* t, int row0, int nrows) {
    const int r = threadIdx.x;
    if (r < nrows) {
        const f32x4* p = (const f32x4*)(SS + (size_t)(row0 + r) * 16);
        const f32x4 a = p[0], b = p[1], c = p[2], d = p[3];
        const float s = (((a[0] + a[1]) + (a[2] + a[3])) + ((b[0] + b[1]) + (b[2] + b[3]))) + (((c[0] + c[1]) + (c[2] + c[3])) + ((d[0] + d[1]) + (d[2] + d[3])));
        t[r] = 1.0f / sqrtf(s * (1.0f / 1024.0f) + P_EPS);
    }
}
template <class G>
__device__ __forceinline__ void row_rstd_tab(const RsTab& R, const float* SS, int tile_row0, int row0, int fq, float (&rs)[2][4]) {
    if (tile_row0 >= R.row0 && tile_row0 + (G::NAI == 2 ? 256 : 128) <= R.row0 + R.nrows) {
#pragma unroll
        for (int ai = 0; ai < G::NAI; ++ai)
#pragma unroll
            for (int m = 0; m < G::NM; ++m) rs[ai][m] = R.t[row0 - R.row0 + ai * HALF + m * 16];
    } else row_rstd<G>(SS, row0, fq, rs);
}

struct EpiQKV {
    static constexpr bool PERM = false, AFTER_DRAIN = false;
    const float* SS; const float* cs;
    bf16_t *Qb, *Kb, *Vb; float* out;
    RsTab rsA, rsB;
    __device__ __forceinline__ void operator()(const f32x4 (&acc)[2][2][4][2], const Unit& u, int wr, int wc, int fr, int fq) const { run<GeoBig>(acc, Tile{u.pm * BM, u.pn * BM}, wr, wc, fr, fq, nullptr); }
    template <class G> __device__ __forceinline__ void run(const f32x4 (&acc)[2][2][4][2], const Tile T, int wr, int wc, int fr, int fq, PG8_LAS float* scr) const {
        const int row0 = T.row0 + wr * G::RS_WR + fr;
        float rs[2][4]; row_rstd_tab<G>(G::NAI == 2 ? rsA : rsB, SS, T.row0, row0, fq, rs);
        const int sec = T.col0 >> 10, ct = T.col0 & 1023;
        const bool smp = T.row0 >= P_MP;
#pragma unroll
        for (int ai = 0; ai < G::NAI; ++ai)
#pragma unroll
            for (int m = 0; m < G::NM; ++m) {
                const int row = row0 + ai * HALF + m * 16; const float r = rs[ai][m];
                const int pos = smp ? (1024 + ((row - P_MP) & 31)) : (row & 2047);
                const size_t orow = smp ? (size_t)(row - P_MP) * 1024 : (size_t)row * 1024;
                if (sec < 2) {
                    const int dl = 16 * (wc & 1) + 4 * fq;
                    const f32x4 c4 = *(const f32x4*)(cs + (size_t)pos * 64 + dl), s4 = *(const f32x4*)(cs + (size_t)pos * 64 + 32 + dl);
#pragma unroll
                    for (int bj = 0; bj < G::NBJ; ++bj) {
                        const int col = ct + 128 * bj + 64 * (wc >> 1) + dl;
                        const f32x4 x1 = acc[ai][bj][m][0] * r, x2 = acc[ai][bj][m][1] * r;
                        f32x4 y1 = x1 * c4 - x2 * s4, y2 = x2 * c4 + x1 * s4;
                        if (sec == 0) {
                            y1 = y1 * P_C2; y2 = y2 * P_C2;
                            u32x2 w1, w2; w1.x = cvt_pk_bf16(y1[0], y1[1]); w1.y = cvt_pk_bf16(y1[2], y1[3]); w2.x = cvt_pk_bf16(y2[0], y2[1]); w2.y = cvt_pk_bf16(y2[2], y2[3]);
                            *(u32x2*)(Qb + (size_t)row * 1024 + col) = w1; *(u32x2*)(Qb + (size_t)row * 1024 + col + 32) = w2;
                        } else {
                            float* ok = out + (smp ? PO_AKS : PO_AKP) + orow + col;
                            *(f32x4*)ok = y1; *(f32x4*)(ok + 32) = y2;
                            u32x2 w1, w2; w1.x = cvt_pk_bf16(y1[0], y1[1]); w1.y = cvt_pk_bf16(y1[2], y1[3]); w2.x = cvt_pk_bf16(y2[0], y2[1]); w2.y = cvt_pk_bf16(y2[2], y2[3]);
                            *(u32x2*)(Kb + (size_t)row * 1024 + col) = w1; *(u32x2*)(Kb + (size_t)row * 1024 + col + 32) = w2;
                        }
                    }
                } else {
#pragma unroll
                    for (int bj = 0; bj < G::NBJ; ++bj)
#pragma unroll
                        for (int n = 0; n < G::NN; ++n) {
                            const int col = ct + 128 * bj + G::CS_WC * wc + 16 * n + 4 * fq;
                            const f32x4 v = acc[ai][bj][m][n] * r;
                            *(f32x4*)(out + (smp ? PO_AVS : PO_AVP) + orow + col) = v;
                            u32x2 w; w.x = cvt_pk_bf16(v[0], v[1]); w.y = cvt_pk_bf16(v[2], v[3]);
                            *(u32x2*)(Vb + (size_t)row * 1024 + col) = w;
                        }
                }
            }
    }
};

struct EpiKVQ {
    static constexpr bool PERM = true, AFTER_DRAIN = false;
    const float* SS; bf16_t *Qb, *Kb; float* out;
    RsTab rsA, rsB;
    __device__ __forceinline__ void operator()(const f32x4 (&acc)[2][2][4][2], const Unit& u, int wr, int wc, int fr, int fq) const { run<GeoBig>(acc, Tile{u.pm * BM, u.pn * BM}, wr, wc, fr, fq, nullptr); }
    template <class G> __device__ __forceinline__ void run(const f32x4 (&acc)[2][2][4][2], const Tile T, int wr, int wc, int fr, int fq, PG8_LAS float* scr) const {
        const int row0 = T.row0 + wr * G::RS_WR + fr;
        float rs[2][4]; row_rstd_tab<G>(G::NAI == 2 ? rsA : rsB, SS, T.row0, row0, fq, rs);
        const int sec = T.col0 >> 10, ct = T.col0 & 1023;
        const bool smp = T.row0 >= P_MP;
        const bool keep = smp || (((T.row0 >> 8) & 7) >= 6);
        const int col0 = ct + wc * 32 + 8 * fq;
#pragma unroll
        for (int ai = 0; ai < G::NAI; ++ai)
#pragma unroll
            for (int m = 0; m < G::NM; ++m) {
                const int row = row0 + ai * HALF + m * 16; const float r = rs[ai][m];
                const size_t orow = smp ? (size_t)(row - P_MP) * 1024 : ((size_t)(row >> 11) * 512 + (size_t)((row & 2047) - 1536)) * 1024;
#pragma unroll
                for (int bj = 0; bj < G::NBJ; ++bj) {
                    const int col = col0 + bj * HALF;
                    f32x4 v0 = acc[ai][bj][m][0] * r, v1 = acc[ai][bj][m][1] * r;
                    if (sec == 2) {
                        v0 = v0 * P_C2; v1 = v1 * P_C2;
                        u32x4 w; w.x = cvt_pk_bf16(v0[0], v0[1]); w.y = cvt_pk_bf16(v0[2], v0[3]); w.z = cvt_pk_bf16(v1[0], v1[1]); w.w = cvt_pk_bf16(v1[2], v1[3]);
                        *(u32x4*)(Qb + (size_t)row * 1024 + col) = w;
                    } else {
                        if (keep) { float* op = out + (sec == 0 ? (smp ? PO_BKS : PO_BKP) : (smp ? PO_BVS : PO_BVP)) + orow + col; *(f32x4*)op = v0; *(f32x4*)(op + 4) = v1; }
                        u32x4 w; w.x = cvt_pk_bf16(v0[0], v0[1]); w.y = cvt_pk_bf16(v0[2], v0[3]); w.z = cvt_pk_bf16(v1[0], v1[1]); w.w = cvt_pk_bf16(v1[2], v1[3]);
                        *(u32x4*)(Kb + (sec == 0 ? (size_t)0 : PW_KV) + (size_t)row * 1024 + col) = w;
                    }
                }
            }
    }
};

struct EpiRes {
    static constexpr bool PERM = true, AFTER_DRAIN = false;
    bf16_t* Hb; float* SS; float sc;
    __device__ __forceinline__ void operator()(const f32x4 (&acc)[2][2][4][2], const Unit& u, int wr, int wc, int fr, int fq) const { run<GeoBig>(acc, Tile{u.pm * BM, u.pn * BM}, wr, wc, fr, fq, nullptr); }
    template <class G> __device__ __forceinline__ void run(const f32x4 (&acc)[2][2][4][2], const Tile T, int wr, int wc, int fr, int fq, PG8_LAS float* scr) const {
        const int row0 = T.row0 + wr * G::RS_WR + fr, col0 = T.col0 + wc * 32 + 8 * fq;
#pragma unroll
        for (int ai = 0; ai < G::NAI; ++ai)
#pragma unroll
            for (int m = 0; m < G::NM; ++m) {
                const int row = row0 + ai * HALF + m * 16;
                float ssq = 0.f;
#pragma unroll
                for (int bj = 0; bj < G::NBJ; ++bj) {
                    bf16_t* p = Hb + (size_t)row * 1024 + col0 + bj * HALF;
                    const u32x4 o = *(const u32x4*)p;
                    f32x4 h0 = acc[ai][bj][m][0] * sc, h1 = acc[ai][bj][m][1] * sc;
                    h0[0] += __uint_as_float(o.x << 16); h0[1] += __uint_as_float(o.x & 0xffff0000u); h0[2] += __uint_as_float(o.y << 16); h0[3] += __uint_as_float(o.y & 0xffff0000u);
                    h1[0] += __uint_as_float(o.z << 16); h1[1] += __uint_as_float(o.z & 0xffff0000u); h1[2] += __uint_as_float(o.w << 16); h1[3] += __uint_as_float(o.w & 0xffff0000u);
                    u32x4 w; w.x = cvt_pk_bf16(h0[0], h0[1]); w.y = cvt_pk_bf16(h0[2], h0[3]); w.z = cvt_pk_bf16(h1[0], h1[1]); w.w = cvt_pk_bf16(h1[2], h1[3]);
                    *(u32x4*)p = w;
                    ssq += ((h0[0] * h0[0] + h0[1] * h0[1]) + (h0[2] * h0[2] + h0[3] * h0[3])) + ((h1[0] * h1[0] + h1[1] * h1[1]) + (h1[2] * h1[2] + h1[3] * h1[3]));
                }
                ssq += __shfl_xor(ssq, 16); ssq += __shfl_xor(ssq, 32);
                if (G::WCN == 4) { if (fq == 0) SS[(size_t)row * 16 + (T.col0 >> 8) * 4 + wc] = ssq; }
                else { if (fq == 0) scr[(wr * G::RS_WR + m * 16 + fr) * 2 + wc] = ssq; }
            }
        if (G::WCN != 4) {
            __syncthreads();
            const int t_ = threadIdx.x;
            if (t_ < 64) SS[(size_t)(T.row0 + t_) * 16 + (T.col0 >> 6)] = scr[t_ * 2] + scr[t_ * 2 + 1];
            __syncthreads();
        }
    }
};

struct EpiResFinal {
    static constexpr bool PERM = true, AFTER_DRAIN = true;
    const bf16_t* Hb; float* SS; float* out; const float* gf; unsigned* cnt; unsigned* tmo;
    __device__ __forceinline__ void fused(f32x4 (&acc)[2][2][4][2], const Unit& u, int wr, int wc, int fr, int fq, PG8_LAS unsigned char* lds, int wid, int lane) const { run<GeoBig>(acc, Tile{u.pm * BM, u.pn * BM}, wr, wc, fr, fq, (PG8_LAS float*)lds); }
    template <class G> __device__ __forceinline__ void run(f32x4 (&acc)[2][2][4][2], const Tile T, int wr, int wc, int fr, int fq, PG8_LAS float* scr) const {
        const int row0 = T.row0 + wr * G::RS_WR + fr, col0 = T.col0 + wc * 32 + 8 * fq;
        const int tid = threadIdx.x, lane = tid & 63, wid = __builtin_amdgcn_readfirstlane(tid >> 6);
#pragma unroll
        for (int ai = 0; ai < G::NAI; ++ai)
#pragma unroll
            for (int m = 0; m < G::NM; ++m) {
                const int row = row0 + ai * HALF + m * 16;
                float ssq = 0.f;
#pragma unroll
                for (int bj = 0; bj < G::NBJ; ++bj) {
                    const u32x4 o = *(const u32x4*)(Hb + (size_t)row * 1024 + col0 + bj * HALF);
                    f32x4 h0 = acc[ai][bj][m][0], h1 = acc[ai][bj][m][1];
                    h0[0] += __uint_as_float(o.x << 16); h0[1] += __uint_as_float(o.x & 0xffff0000u); h0[2] += __uint_as_float(o.y << 16); h0[3] += __uint_as_float(o.y & 0xffff0000u);
                    h1[0] += __uint_as_float(o.z << 16); h1[1] += __uint_as_float(o.z & 0xffff0000u); h1[2] += __uint_as_float(o.w << 16); h1[3] += __uint_as_float(o.w & 0xffff0000u);
                    acc[ai][bj][m][0] = h0; acc[ai][bj][m][1] = h1;
                    ssq += ((h0[0] * h0[0] + h0[1] * h0[1]) + (h0[2] * h0[2] + h0[3] * h0[3])) + ((h1[0] * h1[0] + h1[1] * h1[1]) + (h1[2] * h1[2] + h1[3] * h1[3]));
                }
                ssq += __shfl_xor(ssq, 16); ssq += __shfl_xor(ssq, 32);
                if (G::WCN == 4) { if (fq == 0) __hip_atomic_store(SS + (size_t)row * 16 + (T.col0 >> 8) * 4 + wc, ssq, __ATOMIC_RELAXED, __HIP_MEMORY_SCOPE_AGENT); }
                else { if (fq == 0) scr[(wr * G::RS_WR + m * 16 + fr) * 2 + wc] = ssq; }
            }
        unsigned* c; unsigned want;
        if (G::WCN == 4) {
            c = cnt + 64 * (T.row0 >> 8); want = 32u;
            asm volatile("s_waitcnt vmcnt(0)" ::: "memory");
            if (lane == 0) __hip_atomic_fetch_add(c, 1u, __ATOMIC_RELAXED, __HIP_MEMORY_SCOPE_AGENT);
        } else {
            c = cnt + 64 * (64 + ((T.row0 - P_MP) >> 6)); want = 16u;
            __syncthreads();
            if (tid < 64) __hip_atomic_store(SS + (size_t)(T.row0 + tid) * 16 + (T.col0 >> 6), scr[tid * 2] + scr[tid * 2 + 1], __ATOMIC_RELAXED, __HIP_MEMORY_SCOPE_AGENT);
            asm volatile("s_waitcnt vmcnt(0)" ::: "memory");
            if (tid == 0) __hip_atomic_fetch_add(c, 1u, __ATOMIC_RELAXED, __HIP_MEMORY_SCOPE_AGENT);
        }
        if (wid == 0) {
            const unsigned long long t0 = __builtin_amdgcn_s_memrealtime();
            for (;;) {
                if ((unsigned)__builtin_amdgcn_readfirstlane((int)__hip_atomic_load(c, __ATOMIC_RELAXED, __HIP_MEMORY_SCOPE_AGENT)) >= want) break;
                if (__builtin_amdgcn_s_memrealtime() - t0 > 2000000ull) { if (lane == 0) __hip_atomic_store(tmo, 1u, __ATOMIC_RELAXED, __HIP_MEMORY_SCOPE_AGENT); break; }
                __builtin_amdgcn_s_sleep(2);
            }
            __builtin_amdgcn_fence(__ATOMIC_ACQUIRE, "agent");
            asm volatile("s_waitcnt vmcnt(0)" ::: "memory");
        }
        __syncthreads();
        f32x4 gv[2][2];
#pragma unroll
        for (int bj = 0; bj < G::NBJ; ++bj) { gv[bj][0] = *(const f32x4*)(gf + col0 + bj * HALF); gv[bj][1] = *(const f32x4*)(gf + col0 + bj * HALF + 4); }
#pragma unroll
        for (int ai = 0; ai < G::NAI; ++ai)
#pragma unroll
            for (int m = 0; m < G::NM; ++m) {
                const int row = row0 + ai * HALF + m * 16;
                const f32x4 v = *(const f32x4*)(SS + (size_t)row * 16 + 4 * fq);
                float s = (v[0] + v[1]) + (v[2] + v[3]);
                s += __shfl_xor(s, 16); s += __shfl_xor(s, 32);
                const float r = 1.0f / sqrtf(s * (1.0f / 1024.0f) + P_EPS);
#pragma unroll
                for (int bj = 0; bj < G::NBJ; ++bj) { float* op = out + (size_t)row * 1024 + col0 + bj * HALF;
                    *(f32x4*)op = acc[ai][bj][m][0] * gv[bj][0] * r; *(f32x4*)(op + 4) = acc[ai][bj][m][1] * gv[bj][1] * r; }
            }
        if (G::WCN != 4) __syncthreads();
    }
};

struct EpiFF1 {
    static constexpr bool PERM = true, AFTER_DRAIN = false;
    const float* SS; bf16_t* U; int ldc;
    RsTab rsA, rsB;
    __device__ __forceinline__ void operator()(const f32x4 (&acc)[2][2][4][2], const Unit& u, int wr, int wc, int fr, int fq) const { run<GeoBig>(acc, Tile{u.pm * BM, u.pn * BM}, wr, wc, fr, fq, nullptr); }
    template <class G> __device__ __forceinline__ void run(const f32x4 (&acc)[2][2][4][2], const Tile T, int wr, int wc, int fr, int fq, PG8_LAS float* scr) const {
        const int row0 = T.row0 + wr * G::RS_WR + fr;
        float rs[2][4]; row_rstd_tab<G>(G::NAI == 2 ? rsA : rsB, SS, T.row0, row0, fq, rs);
        const int col0 = T.col0 + wc * 32 + 8 * fq;
#pragma unroll
        for (int ai = 0; ai < G::NAI; ++ai)
#pragma unroll
            for (int m = 0; m < G::NM; ++m) {
                const float r = rs[ai][m]; bf16_t* rowp = U + (size_t)(row0 + ai * HALF + m * 16) * ldc + col0;
#pragma unroll
                for (int bj = 0; bj < G::NBJ; ++bj) {
                    f32x4 v0 = acc[ai][bj][m][0] * r, v1 = acc[ai][bj][m][1] * r;
#pragma unroll
                    for (int i = 0; i < 4; ++i) { const float a = fmaxf(v0[i], 0.f), b = fmaxf(v1[i], 0.f); v0[i] = a * a; v1[i] = b * b; }
                    u32x4 w; w.x = cvt_pk_bf16(v0[0], v0[1]); w.y = cvt_pk_bf16(v0[2], v0[3]); w.z = cvt_pk_bf16(v1[0], v1[1]); w.w = cvt_pk_bf16(v1[2], v1[3]);
                    *(u32x4*)(rowp + bj * HALF) = w;
                }
            }
    }
};
template <class Epi, class Sched, bool ALIGN_EPI = false, bool SP2 = false>
__device__ __forceinline__ void gemm_phase(PG8_LAS unsigned char* lds, const Gemm g, const Sched& S, const Epi& E) {
    const int tid = opaque_tid(), wid = __builtin_amdgcn_readfirstlane(tid >> 6), lane = tid & 63, wr = wid >> 2, wc = wid & 3, fr = lane & 15, fq = lane >> 4;
    const int K = g.K, nt = K / BK;
    unsigned voffA[2], voffB[2];
#pragma unroll
    for (int i = 0; i < 2; ++i) { int R, C; stage_rc(tid * 16 + i * 8192, R, C); const int Rb = Epi::PERM ? ((R & ~31) + perm32(R & 31)) : R;
        voffA[i] = (unsigned)(R * K + C) * 2u; voffB[i] = (unsigned)(Rb * K + C) * 2u; }
    const size_t kstep = (size_t)(BK * 2);
    const size_t hstep = (size_t)HALF * K * 2;
    const size_t tstep = 2 * hstep;
    const unsigned ldsw = (unsigned)wid * 1024u;
    const int aoff = lds_byte(wr * 64 + fr, fq * 8), boff = lds_byte(wc * 32 + fr, fq * 8);
#define PG8_SA(b, h) (((b) * 2 + (h)) * HTB)
#define PG8_SB(b, h) ((4 + (b) * 2 + (h)) * HTB)
#define PG8_STAGE(bufoff, gbase, voff) do { _Pragma("unroll") for (int _i = 0; _i < 2; ++_i) \
        __builtin_amdgcn_global_load_lds((const unsigned*)((const char*)(gbase) + (voff)[_i]), (PG8_LAS unsigned*)(lds + (bufoff) + ldsw + _i * 8192), 16, 0, 0); } while (0)
#define PG8_LDA(dst, b, h) do { _Pragma("unroll") for (int m = 0; m < 4; ++m) _Pragma("unroll") for (int k = 0; k < 2; ++k) dst[m][k] = *(const PG8_LAS bf16x8*)(lds + PG8_SA(b, h) + aoff + m * 2048 + k * 1024); } while (0)
#define PG8_LDB(dst, b, h) do { _Pragma("unroll") for (int n = 0; n < 2; ++n) _Pragma("unroll") for (int k = 0; k < 2; ++k) dst[n][k] = *(const PG8_LAS bf16x8*)(lds + PG8_SB(b, h) + boff + n * 2048 + k * 1024); } while (0)
#define PG8_MMA(ai, bj, At, Bt) do { __builtin_amdgcn_s_setprio(1); _Pragma("unroll") for (int m = 0; m < 4; ++m) _Pragma("unroll") for (int n = 0; n < 2; ++n) _Pragma("unroll") for (int k = 0; k < 2; ++k) \
        acc[ai][bj][m][n] = __builtin_amdgcn_mfma_f32_16x16x32_bf16(Bt[n][k], At[m][k], acc[ai][bj][m][n], 0, 0, 0); __builtin_amdgcn_s_setprio(0); } while (0)
#define PG8_WAIT_V(n) asm volatile("s_waitcnt vmcnt(" #n ")" ::: "memory")
#define PG8_WAIT_L(n) asm volatile("s_waitcnt lgkmcnt(" #n ")" ::: "memory")
#define PG8_BAR __builtin_amdgcn_s_barrier()
#define PG8_SCHED __builtin_amdgcn_sched_barrier(0)
    Unit cur, nxt; int ui = 0;
    if (!S.next(0, cur)) return;
    f32x4 acc[2][2][4][2];
#pragma unroll
    for (int a = 0; a < 2; ++a)
#pragma unroll
        for (int b = 0; b < 2; ++b)
#pragma unroll
            for (int m = 0; m < 4; ++m)
#pragma unroll
                for (int n = 0; n < 2; ++n) acc[a][b][m][n] = (f32x4){0.f, 0.f, 0.f, 0.f};
    bf16x8 At[4][2], B0[2][2], B1[2][2];
    const char* cA = (const char*)g.A + (size_t)cur.pm * tstep; const char* cB = (const char*)g.Bt + (size_t)cur.pn * tstep;
    S.a_ready(cur);
    if constexpr (SP2) {
        PG8_STAGE(PG8_SB(0, 0), cB, voffB); PG8_STAGE(PG8_SB(0, 1), cB + hstep, voffB); PG8_STAGE(PG8_SA(0, 0), cA, voffA); PG8_STAGE(PG8_SA(0, 1), cA + hstep, voffA);
        if (wr == 1) PG8_BAR;
        PG8_WAIT_V(2); PG8_BAR;
        PG8_STAGE(PG8_SB(1, 0), cB + kstep, voffB); PG8_STAGE(PG8_SA(1, 0), cA + kstep, voffA); PG8_STAGE(PG8_SB(1, 1), cB + hstep + kstep, voffB);
        PG8_WAIT_V(6); PG8_BAR;
    } else {
        PG8_STAGE(PG8_SB(0, 0), cB, voffB); PG8_STAGE(PG8_SA(0, 0), cA, voffA); PG8_STAGE(PG8_SB(0, 1), cB + hstep, voffB); PG8_STAGE(PG8_SA(0, 1), cA + hstep, voffA);
        if (wr == 1) PG8_BAR;
        PG8_WAIT_V(4); PG8_BAR;
        PG8_STAGE(PG8_SB(1, 0), cB + kstep, voffB); PG8_STAGE(PG8_SA(1, 0), cA + kstep, voffA); PG8_STAGE(PG8_SB(1, 1), cB + hstep + kstep, voffB);
        PG8_WAIT_V(6); PG8_BAR;
    }
    for (;;) {
        const bool has_next = S.next(ui + 1, nxt);
        const char* nA = has_next ? (const char*)g.A + (size_t)nxt.pm * tstep : cA; const char* nB = has_next ? (const char*)g.Bt + (size_t)nxt.pn * tstep : cB;
        for (int t = 0; t < nt; t += 2) {
            const bool last = (t == nt - 2);
            const char* a1 = cA + (size_t)(t + 1) * kstep;
            const char* a2 = last ? nA : cA + (size_t)(t + 2) * kstep; const char* b2 = last ? nB : cB + (size_t)(t + 2) * kstep;
            const char* a3 = a2 + kstep; const char* b3 = b2 + kstep;
            if (last && has_next) S.a_ready(nxt);
            if constexpr (SP2) {
            PG8_LDB(B0, 0, 0); PG8_LDB(B1, 0, 1); PG8_SCHED; PG8_LDA(At, 0, 0); PG8_STAGE(PG8_SA(1, 1), a1 + hstep, voffA);
            PG8_WAIT_V(8); PG8_WAIT_L(0); PG8_BAR; PG8_MMA(0, 0, At, B0); PG8_MMA(0, 1, At, B1); PG8_BAR; PG8_SCHED;
            PG8_LDA(At, 0, 1); PG8_STAGE(PG8_SB(0, 0), b2, voffB); PG8_STAGE(PG8_SB(0, 1), b2 + hstep, voffB); PG8_STAGE(PG8_SA(0, 0), a2, voffA);
            PG8_WAIT_V(8); PG8_WAIT_L(0); PG8_BAR; PG8_MMA(1, 0, At, B0); PG8_MMA(1, 1, At, B1); PG8_BAR; PG8_SCHED;
            PG8_LDB(B0, 1, 0); PG8_LDB(B1, 1, 1); PG8_SCHED; PG8_LDA(At, 1, 0); PG8_STAGE(PG8_SA(0, 1), a2 + hstep, voffA);
            PG8_WAIT_V(8); PG8_WAIT_L(0); PG8_BAR; PG8_MMA(0, 0, At, B0); PG8_MMA(0, 1, At, B1); PG8_BAR; PG8_SCHED;
            PG8_LDA(At, 1, 1); PG8_STAGE(PG8_SB(1, 0), b3, voffB); PG8_STAGE(PG8_SB(1, 1), b3 + hstep, voffB); PG8_STAGE(PG8_SA(1, 0), a3, voffA);
            PG8_WAIT_V(8); PG8_WAIT_L(0); PG8_BAR; PG8_MMA(1, 0, At, B0); PG8_MMA(1, 1, At, B1); PG8_BAR; PG8_SCHED;
            } else {
            PG8_LDB(B0, 0, 0); PG8_SCHED; PG8_LDA(At, 0, 0); PG8_STAGE(PG8_SA(1, 1), a1 + hstep, voffA);
            PG8_WAIT_L(8); PG8_BAR; PG8_WAIT_L(0); PG8_MMA(0, 0, At, B0); PG8_BAR; PG8_SCHED;
            PG8_LDB(B1, 0, 1); PG8_STAGE(PG8_SB(0, 0), b2, voffB);
            PG8_BAR; PG8_WAIT_L(0); PG8_MMA(0, 1, At, B1); PG8_BAR;
            PG8_LDA(At, 0, 1); PG8_STAGE(PG8_SA(0, 0), a2, voffA);
            PG8_BAR; PG8_WAIT_L(0); PG8_MMA(1, 0, At, B0); PG8_BAR; PG8_SCHED;
            PG8_STAGE(PG8_SB(0, 1), b2 + hstep, voffB);
            PG8_WAIT_V(6); PG8_BAR; PG8_MMA(1, 1, At, B1); PG8_BAR;
            PG8_LDB(B0, 1, 0); PG8_SCHED; PG8_LDA(At, 1, 0); PG8_STAGE(PG8_SA(0, 1), a2 + hstep, voffA);
            PG8_WAIT_L(8); PG8_BAR; PG8_WAIT_L(0); PG8_MMA(0, 0, At, B0); PG8_BAR; PG8_SCHED;
            PG8_LDB(B1, 1, 1); PG8_STAGE(PG8_SB(1, 0), b3, voffB);
            PG8_BAR; PG8_WAIT_L(0); PG8_MMA(0, 1, At, B1); PG8_BAR;
            PG8_LDA(At, 1, 1); PG8_STAGE(PG8_SA(1, 0), a3, voffA);
            PG8_BAR; PG8_WAIT_L(0); PG8_MMA(1, 0, At, B0); PG8_BAR; PG8_SCHED;
            PG8_STAGE(PG8_SB(1, 1), b3 + hstep, voffB);
            PG8_WAIT_V(6); PG8_BAR; PG8_MMA(1, 1, At, B1); PG8_BAR;
            }
        }
        if constexpr (ALIGN_EPI) { if (wr == 0) PG8_BAR; }
        if constexpr (!Epi::AFTER_DRAIN) { E(acc, cur, wr, wc, fr, fq); S.done(cur); }
        if (!has_next) break;
#pragma unroll
        for (int a = 0; a < 2; ++a)
#pragma unroll
            for (int b = 0; b < 2; ++b)
#pragma unroll
                for (int m = 0; m < 4; ++m)
#pragma unroll
                    for (int n = 0; n < 2; ++n) acc[a][b][m][n] = (f32x4){0.f, 0.f, 0.f, 0.f};
        cur = nxt; cA = nA; cB = nB; ++ui;
        if constexpr (ALIGN_EPI) { if (wr == 1) PG8_BAR; }
    }
    PG8_WAIT_V(0);
    if constexpr (!ALIGN_EPI) { if (wr == 0) PG8_BAR; }
    PG8_BAR;
    if constexpr (Epi::AFTER_DRAIN) { E.fused(acc, cur, wr, wc, fr, fq, lds, wid, lane); S.done(cur); }
#undef PG8_SA
#undef PG8_SB
#undef PG8_STAGE
#undef PG8_LDA
#undef PG8_LDB
#undef PG8_MMA
#undef PG8_WAIT_V
#undef PG8_WAIT_L
#undef PG8_BAR
#undef PG8_SCHED
}

template <class G, class Epi>
__device__ __forceinline__ void gemm_small(PG8_LAS unsigned char* lds, const bf16_t* A, const bf16_t* Bt, int K, int row_base, int ntm, int ntn, int vcu, int nwg, const Epi& E) {
    constexpr int TM = (8 / G::WCN) * G::RS_WR * (G::NM * 16 / G::RS_WR), TN = G::WCN * G::CS_WC, SBK = 128, NCA = TM * 16 / 512, NCB = TN * 16 / 512, STG = (TM + TN) * 256;
    const int tid = opaque_tid(), wid = __builtin_amdgcn_readfirstlane(tid >> 6), lane = tid & 63, wr = wid / G::WCN, wc = wid % G::WCN, fr = lane & 15, fq = lane >> 4;
    const int nk = K / SBK;
    for (int tile = vcu; tile < ntm * ntn; tile += nwg) {
        const int tm = tile % ntm, tn = tile / ntm;
        const bf16_t* Ab = A + (size_t)(row_base + tm * TM) * K; const bf16_t* Bb = Bt + (size_t)(tn * TN) * K;
        f32x4 acc[2][2][4][2];
#pragma unroll
        for (int m = 0; m < G::NM; ++m)
#pragma unroll
            for (int n = 0; n < G::NN; ++n) acc[0][0][m][n] = (f32x4){0.f, 0.f, 0.f, 0.f};
        u32x4 ra0[NCA], rb0[NCB], ra1[NCA], rb1[NCB];
        unsigned goffA[NCA], goffB[NCB], loffA[NCA], loffB[NCB];
#pragma unroll
        for (int i = 0; i < NCA; ++i) { const int idx = tid + 512 * i, R = idx >> 4, c = idx & 15; goffA[i] = (unsigned)R * K + c * 8; loffA[i] = R * 256 + ((c ^ (R & 15)) * 16); }
#pragma unroll
        for (int i = 0; i < NCB; ++i) { const int idx = tid + 512 * i, R = idx >> 4, c = idx & 15; const int Rb = Epi::PERM ? ((R & ~31) + perm32(R & 31)) : R; goffB[i] = (unsigned)Rb * K + c * 8; loffB[i] = TM * 256 + R * 256 + ((c ^ (R & 15)) * 16); }
#define SM_LOAD(RA, RB, kt_) do { _Pragma("unroll") for (int i = 0; i < NCA; ++i) RA[i] = *(const u32x4*)(Ab + goffA[i] + (size_t)(kt_) * SBK); \
                                  _Pragma("unroll") for (int i = 0; i < NCB; ++i) RB[i] = *(const u32x4*)(Bb + goffB[i] + (size_t)(kt_) * SBK); } while (0)
#define SM_STEP(RA, RB, kt_) do { PG8_LAS unsigned char* sb = lds + ((kt_) & 1) * STG; \
            _Pragma("unroll") for (int i = 0; i < NCA; ++i) *(PG8_LAS u32x4*)(sb + loffA[i]) = RA[i]; \
            _Pragma("unroll") for (int i = 0; i < NCB; ++i) *(PG8_LAS u32x4*)(sb + loffB[i]) = RB[i]; \
            __syncthreads(); \
            if ((kt_) + 2 < nk) SM_LOAD(RA, RB, (kt_) + 2); \
            _Pragma("unroll") for (int kh = 0; kh < 4; ++kh) { bf16x8 af[G::NM], bfr[G::NN]; \
                _Pragma("unroll") for (int m = 0; m < G::NM; ++m) { const int R = wr * G::RS_WR + m * 16 + fr; af[m] = *(const PG8_LAS bf16x8*)(sb + R * 256 + (((kh * 4 + fq) ^ (R & 15)) * 16)); } \
                _Pragma("unroll") for (int n = 0; n < G::NN; ++n) { const int R = wc * G::CS_WC + n * 16 + fr; bfr[n] = *(const PG8_LAS bf16x8*)(sb + TM * 256 + R * 256 + (((kh * 4 + fq) ^ (R & 15)) * 16)); } \
                _Pragma("unroll") for (int m = 0; m < G::NM; ++m) _Pragma("unroll") for (int n = 0; n < G::NN; ++n) acc[0][0][m][n] = __builtin_amdgcn_mfma_f32_16x16x32_bf16(bfr[n], af[m], acc[0][0][m][n], 0, 0, 0); } } while (0)
        SM_LOAD(ra0, rb0, 0); SM_LOAD(ra1, rb1, 1);
        for (int kt = 0; kt < nk; kt += 2) { SM_STEP(ra0, rb0, kt); SM_STEP(ra1, rb1, kt + 1); }
#undef SM_LOAD
#undef SM_STEP
        __syncthreads();
        E.template run<G>(acc, Tile{row_base + tm * TM, tn * TN}, wr, wc, fr, fq, (PG8_LAS float*)(lds + 2 * STG));
    }
}
}
#define GAS __attribute__((address_space(1)))
#define LAS __attribute__((address_space(3)))
typedef unsigned short bf16;
typedef unsigned v4u __attribute__((ext_vector_type(4)));
typedef float f32x4 __attribute__((ext_vector_type(4)));
typedef short bf16x8 __attribute__((ext_vector_type(8)));
typedef GAS unsigned gu32;
typedef GAS unsigned long long gu64;
#define RLX_AGENT __ATOMIC_RELAXED, __HIP_MEMORY_SCOPE_AGENT
#define LDS_WAIT() asm volatile("s_waitcnt lgkmcnt(0)" ::: "memory")
#define VM_WAIT() asm volatile("s_waitcnt vmcnt(0)" ::: "memory")
__device__ __forceinline__ unsigned long long rt() { return __builtin_amdgcn_s_memrealtime(); }
__device__ __forceinline__ unsigned f2bf(float f) { unsigned u = __builtin_bit_cast(unsigned, f); return (u + 0x7fffu + ((u >> 16) & 1u)) >> 16; }
__device__ __forceinline__ unsigned pk2(float lo, float hi) { return f2bf(lo) | (f2bf(hi) << 16); }

#define XB_TMO      128
#define XB_XCNT(j)  (256  + 64 * (j))
#define XB_XSUB(j)  (1280 + 64 * (j))
#define XB_XGEN(j)  (2304 + 64 * (j))
#define XB_TOP      3328
#define XB_TOPGEN   3392
#define XCD_BAR_WORDS 3456
#define XB_SPIN_CAP (1u << 18)

__device__ __forceinline__ unsigned xb_ld(unsigned* p)              { return __hip_atomic_load(p, __ATOMIC_RELAXED, __HIP_MEMORY_SCOPE_AGENT); }
__device__ __forceinline__ unsigned xb_add(unsigned* p, unsigned v) { return __hip_atomic_fetch_add(p, v, __ATOMIC_RELAXED, __HIP_MEMORY_SCOPE_AGENT); }
__device__ __forceinline__ unsigned xb_xcc_id() { return (unsigned)__builtin_amdgcn_s_getreg((3 << 11) | 20) & 0xFu; }
#define XB_SPIN(cond, bar) do { unsigned _sp = 0; while (cond) { __builtin_amdgcn_s_sleep(1); \
    if ((++_sp & 255u) == 0u) { if (xb_ld(&(bar)[XB_TMO])) break; if (_sp > XB_SPIN_CAP) { atomicAdd(&(bar)[XB_TMO], 1u); break; } } } } while (0)

struct XcdBarrier {
    unsigned* bar; unsigned x;
    volatile LAS unsigned* st;
};

__device__ __forceinline__ XcdBarrier xcd_barrier_post(unsigned* bar, volatile LAS unsigned* st) {
    XcdBarrier b; b.bar = bar; b.x = xb_xcc_id(); b.st = st;
    if (threadIdx.x == 0) (void)xb_add(&bar[XB_XCNT(b.x)], 1u);
    return b;
}
__device__ __forceinline__ void xcd_barrier_complete(unsigned* bar, unsigned x, unsigned& nloc, unsigned& nx) {
    const unsigned G = gridDim.x * gridDim.y * gridDim.z;
    unsigned sum, cnt, mine, sp = 0u;
    for (;;) {
        sum = 0u; cnt = 0u; mine = 0u;
#pragma unroll
        for (unsigned j = 0; j < 16; ++j) { const unsigned c = xb_ld(&bar[XB_XCNT(j)]); sum += c; cnt += (c > 0u) ? 1u : 0u; mine = (j == x) ? c : mine; }
        if (sum == G) break;
        __builtin_amdgcn_s_sleep(1);
        if ((++sp & 255u) == 0u) { if (xb_ld(&bar[XB_TMO])) break; if (sp > XB_SPIN_CAP) { atomicAdd(&bar[XB_TMO], 1u); break; } }
    }
    nloc = mine > 0u ? mine : 1u; nx = cnt > 0u ? cnt : 1u;
}

__device__ __forceinline__ void xcd_barrier(const XcdBarrier& b) {
    asm volatile("s_waitcnt vmcnt(0)" ::: "memory");
    __syncthreads();
    if (threadIdx.x == 0) {
        unsigned* bar = b.bar;
        __builtin_amdgcn_s_waitcnt(0);
        unsigned nloc = b.st[0], nx = b.st[1];
        if (nloc == 0u) { xcd_barrier_complete(bar, b.x, nloc, nx); b.st[0] = nloc; b.st[1] = nx; }
        const unsigned old = xb_add(&bar[XB_XSUB(b.x)], 1u);
        const unsigned gen = old / nloc;
        if (old + 1u == (gen + 1u) * nloc) {
#ifndef PROBE_NOWBL2
            __builtin_amdgcn_fence(__ATOMIC_RELEASE, "agent");
#endif
            asm volatile("s_waitcnt vmcnt(0)" ::: "memory");
            const unsigned og = xb_add(&bar[XB_TOP], 1u);
            const unsigned tg = og / nx;
            if (og + 1u == (tg + 1u) * nx) xb_add(&bar[XB_TOPGEN], 1u);
            else XB_SPIN(xb_ld(&bar[XB_TOPGEN]) == tg, bar);
            __builtin_amdgcn_fence(__ATOMIC_ACQUIRE, "agent");
            xb_add(&bar[XB_XGEN(b.x)], 1u);
            asm volatile("s_waitcnt vmcnt(0)" ::: "memory");
        } else {
            XB_SPIN(xb_ld(&bar[XB_XGEN(b.x)]) == gen, bar);
            __builtin_amdgcn_fence(__ATOMIC_ACQUIRE, "agent");
            asm volatile("s_waitcnt vmcnt(0)" ::: "memory");
        }
    }
    __syncthreads();
}

namespace at {
#define AT_LAS __attribute__((address_space(3)))
typedef short bf16x8 __attribute__((ext_vector_type(8)));
typedef short s16x4 __attribute__((ext_vector_type(4)));
typedef float f32x16 __attribute__((ext_vector_type(16)));
typedef float f32x4 __attribute__((ext_vector_type(4)));
typedef unsigned u32x4 __attribute__((ext_vector_type(4)));
typedef unsigned u32x2 __attribute__((ext_vector_type(2)));
typedef unsigned short bf16_t;
constexpr int MP = 16384, PITCH = 1024, SEQ = 2048;
constexpr int KCS = 1040;
constexpr int KT_BYTES = 8 * KCS;
constexpr float THR = 8.0f;
constexpr int WSF_OFF = 132096;
constexpr int QIMG_OFF = 99328;
__device__ __forceinline__ int crow(int r, int hi) { return (r & 3) + 8 * (r >> 2) + 4 * hi; }
__device__ __forceinline__ unsigned cvtpk(float lo, float hi) { typedef float f2 __attribute__((ext_vector_type(2))); typedef __bf16 b2 __attribute__((ext_vector_type(2))); f2 v = {lo, hi}; b2 b = __builtin_convertvector(v, b2); return __builtin_bit_cast(unsigned, b); }
__device__ __forceinline__ s16x4 vtr(const AT_LAS unsigned char* p) { typedef short v4i16_t __attribute__((ext_vector_type(4))); return __builtin_bit_cast(s16x4, __builtin_amdgcn_ds_read_tr16_b64_v4i16((AT_LAS v4i16_t*)p)); }
#define AT_SYNC() __syncthreads()

template <bool QLDS>
__device__ __forceinline__ void qk_tile(f32x16& p0, f32x16& p1, const AT_LAS unsigned char* kt, const bf16x8 (&qr_)[4], const AT_LAS unsigned char* qimg, int r32, int hi) {
    p0 = f32x16{}; p1 = f32x16{};
#pragma unroll
    for (int d0 = 0; d0 < 4; ++d0) {
        bf16x8 qr[4]; if (QLDS) qr[d0] = *(const AT_LAS bf16x8*)(qimg + (2 * d0 + hi) * 512 + r32 * 16); else qr[d0] = qr_[d0];
        const bf16x8 a0 = *(const AT_LAS bf16x8*)(kt + (2 * d0 + hi) * KCS + r32 * 16);
        const bf16x8 a1 = *(const AT_LAS bf16x8*)(kt + (2 * d0 + hi) * KCS + r32 * 16 + 512);
        p0 = __builtin_amdgcn_mfma_f32_32x32x16_bf16(a0, qr[d0], p0, 0, 0, 0);
        p1 = __builtin_amdgcn_mfma_f32_32x32x16_bf16(a1, qr[d0], p1, 0, 0, 0);
    }
}
template <int ND0>
__device__ __forceinline__ void softmax_tile(f32x16& p0, f32x16& p1, float& m, float& l, f32x16 (&o)[ND0], AT_LAS float* wsf, int r32, int hi) {
    float rm = fmaxf(p0[0], p1[0]);
#pragma unroll
    for (int r = 1; r < 16; ++r) rm = fmaxf(rm, fmaxf(p0[r], p1[r]));
    rm = fmaxf(rm, __shfl_xor(rm, 32));
    if (__any(rm > m + THR)) {
        const float mn = fmaxf(m, rm), f = __builtin_amdgcn_exp2f(m - mn);
        l *= f; m = mn;
        if (hi == 0) wsf[r32] = f;
        asm volatile("s_waitcnt lgkmcnt(0)" ::: "memory");
#pragma unroll
        for (int r = 0; r < 16; ++r) { const float fr_ = wsf[crow(r, hi)];
#pragma unroll
            for (int d0 = 0; d0 < ND0; ++d0) o[d0][r] *= fr_; }
        asm volatile("s_waitcnt lgkmcnt(0)" ::: "memory");
    }
    float s = 0.f;
#pragma unroll
    for (int r = 0; r < 16; ++r) { p0[r] = __builtin_amdgcn_exp2f(p0[r] - m); p1[r] = __builtin_amdgcn_exp2f(p1[r] - m); s += p0[r] + p1[r]; }
    l += s;
}
__device__ __forceinline__ void pack_p(bf16x8 (&pa)[4], const f32x16& p0, const f32x16& p1) {
#pragma unroll
    for (int ks = 0; ks < 4; ++ks) {
        u32x4 w;
        if (ks < 2) { const int b = 8 * ks; w.x = cvtpk(p0[b], p0[b + 1]); w.y = cvtpk(p0[b + 2], p0[b + 3]); w.z = cvtpk(p0[b + 4], p0[b + 5]); w.w = cvtpk(p0[b + 6], p0[b + 7]); }
        else { const int b = 8 * (ks - 2); w.x = cvtpk(p1[b], p1[b + 1]); w.y = cvtpk(p1[b + 2], p1[b + 3]); w.z = cvtpk(p1[b + 4], p1[b + 5]); w.w = cvtpk(p1[b + 6], p1[b + 7]); }
        pa[ks] = __builtin_bit_cast(bf16x8, w);
    }
}
template <int ND0>
__device__ __forceinline__ void pv_packed(f32x16 (&o)[ND0], const AT_LAS unsigned char* vt, const bf16x8 (&pa)[4], int lane, int hi) {
    const AT_LAS unsigned char* vb = vt + ((lane >> 4) & 1) * 32 + (lane & 3) * 8 + (4 * hi + ((lane & 15) >> 2)) * 64;
#pragma unroll
    for (int d0 = 0; d0 < ND0; ++d0)
#pragma unroll
        for (int ks = 0; ks < 4; ++ks) {
            const s16x4 lo = vtr(vb + d0 * 4096 + ks * 1024), hh = vtr(vb + d0 * 4096 + ks * 1024 + 512);
            const bf16x8 bfr = {lo[0], lo[1], lo[2], lo[3], hh[0], hh[1], hh[2], hh[3]};
            o[d0] = __builtin_amdgcn_mfma_f32_32x32x16_bf16(pa[ks], bfr, o[d0], 0, 0, 0);
        }
}
template <int ND0>
__device__ __forceinline__ void pv_tile(f32x16 (&o)[ND0], const AT_LAS unsigned char* vt, const f32x16& p0, const f32x16& p1, int lane, int hi) {
    bf16x8 pa[4]; pack_p(pa, p0, p1); pv_packed<ND0>(o, vt, pa, lane, hi);
}
__device__ __forceinline__ u32x4 ld16(const void* p) { return *(const u32x4*)p; }
__device__ __forceinline__ u32x2 f4_to_bf4(u32x4 v) { u32x2 w; w.x = cvtpk(__uint_as_float(v.x), __uint_as_float(v.y)); w.y = cvtpk(__uint_as_float(v.z), __uint_as_float(v.w)); return w; }

struct Ctx {
    const bf16_t *Q, *K, *V; bf16_t* O;
    const float *cache_k, *cache_v;
    const float *lam_p, *subln;
    const float* rel;
    void* stamp;
};
#ifndef PROBE_CLK
#define PROBE_CLK() __builtin_amdgcn_s_memtime()
#endif
#ifndef PROBE_STAMP_B
#define PROBE_STAMP_B 1
#endif
#ifndef PROBE_BLK
#define PROBE_BLK 0
#endif
#ifndef PROBE_TID
#define PROBE_TID 0
#endif

template <int NK, int DV>
__device__ __forceinline__ void ld_bf(u32x4 (&st)[NK + DV / 64], const bf16_t* kbase, const bf16_t* vbase, int nrows, int tid) {
    const int row = tid >> 3, ch = tid & 7; const unsigned koff = (unsigned)row * PITCH + ch * 8;
#pragma unroll
    for (int c = 0; c < NK; ++c) st[c] = (row < nrows) ? ld16(kbase + koff + c * 64) : (u32x4){0u, 0u, 0u, 0u};
    if (DV == 64) { st[NK] = (row < nrows) ? ld16(vbase + koff) : (u32x4){0u, 0u, 0u, 0u}; }
    else {
        const int vrow = tid >> 4; const unsigned voff = (unsigned)vrow * PITCH + (tid & 15) * 8;
#pragma unroll
        for (int i = 0; i < 2; ++i) st[NK + i] = (vrow + 32 * i < nrows) ? ld16(vbase + voff + (size_t)i * 32 * PITCH) : (u32x4){0u, 0u, 0u, 0u};
    }
}
template <int NK, int DV>
__device__ __forceinline__ void wr_bf(const u32x4 (&st)[NK + DV / 64], AT_LAS unsigned char* sb, int tid) {
    const int row = tid >> 3, ch = tid & 7;
#pragma unroll
    for (int c = 0; c < NK; ++c) *(AT_LAS u32x4*)(sb + c * KT_BYTES + ch * KCS + row * 16) = st[c];
    AT_LAS unsigned char* vb = sb + NK * KT_BYTES;
    if (DV == 64) { const int col = ch * 8; *(AT_LAS u32x4*)(vb + ((col >> 5) * 4 + (row >> 4)) * 1024 + (row & 15) * 64 + (col & 31) * 2) = st[NK]; }
    else {
        const int vrow = tid >> 4, col = (tid & 15) * 8;
#pragma unroll
        for (int i = 0; i < 2; ++i) *(AT_LAS u32x4*)(vb + ((col >> 5) * 4 + ((vrow + 32 * i) >> 4)) * 1024 + (vrow & 15) * 64 + (col & 31) * 2) = st[NK + i];
    }
}
__device__ __forceinline__ void glds16(const void* gsrc, unsigned lds_dst) { unsigned keep;
    asm volatile("s_mov_b32 %0, m0\n\ts_mov_b32 m0, %2\n\ts_nop 0\n\tglobal_load_lds_dwordx4 %1, off\n\ts_mov_b32 m0, %0" : "=&s"(keep) : "v"(gsrc), "s"(lds_dst) : "memory"); }
template <int NK, int DV>
__device__ __forceinline__ void dma_bf(const bf16_t* kbase, const bf16_t* vbase, AT_LAS unsigned char* sb, int w, int lane) {
    const unsigned s0 = (unsigned)__builtin_amdgcn_readfirstlane((int)(unsigned)(uintptr_t)sb);
#pragma unroll
    for (int c = 0; c < NK; ++c) glds16(kbase + (size_t)lane * PITCH + c * 64 + w * 8, (unsigned)__builtin_amdgcn_readfirstlane((int)(s0 + c * KT_BYTES + w * KCS)));
#pragma unroll
    for (int i = 0; i < DV / 64; ++i) { const int d0 = 2 * i + (w >> 2), rg = w & 3;
        glds16(vbase + (size_t)(16 * rg + (lane >> 2)) * PITCH + d0 * 32 + (lane & 3) * 8, (unsigned)__builtin_amdgcn_readfirstlane((int)(s0 + NK * KT_BYTES + (d0 * 4 + rg) * 1024))); }
}
__device__ __forceinline__ void dma_prompt(const bf16_t* kbase, const bf16_t* vbase, AT_LAS unsigned char* sb, int w, int lane) {
    const unsigned s0 = (unsigned)__builtin_amdgcn_readfirstlane((int)(unsigned)(uintptr_t)sb);
#pragma unroll
    for (int i = 0; i < 2; ++i) { const int j = 2 * w + i, R = 4 * j + (lane >> 4), c = (lane & 15) ^ (R & 15);
        glds16(kbase + (size_t)R * PITCH + c * 8, (unsigned)__builtin_amdgcn_readfirstlane((int)(s0 + j * 1024))); }
#pragma unroll
    for (int i = 0; i < 2; ++i) { const int d0 = 2 * i + (w >> 2), rg = w & 3;
        glds16(vbase + (size_t)(16 * rg + (lane >> 2)) * PITCH + d0 * 32 + (lane & 3) * 8, (unsigned)__builtin_amdgcn_readfirstlane((int)(s0 + 16384 + (d0 * 4 + rg) * 1024))); }
}
__device__ __forceinline__ void dma_promptB(const bf16_t* kbase, const bf16_t* vbase, AT_LAS unsigned char* sb, int w, int lane) {
    const unsigned s0 = (unsigned)__builtin_amdgcn_readfirstlane((int)(unsigned)(uintptr_t)sb);
    { const int R = 8 * w + (lane >> 3), c = (lane & 7) ^ ((R >> 1) & 7);
      glds16(kbase + (size_t)R * PITCH + c * 8, (unsigned)__builtin_amdgcn_readfirstlane((int)(s0 + w * 1024))); }
    { const int d0 = w >> 2, rg = w & 3;
      glds16(vbase + (size_t)(16 * rg + (lane >> 2)) * PITCH + d0 * 32 + (lane & 3) * 8, (unsigned)__builtin_amdgcn_readfirstlane((int)(s0 + 8192 + (d0 * 4 + rg) * 1024))); }
}
template <int NK, int DV>
__device__ __forceinline__ void ld_f32(u32x4 (&st)[2 * NK + DV / 32], const float* kbase, const float* vbase, int tid) {
    { const unsigned off = (unsigned)(tid >> 4) * 1024 + (tid & 15) * 4;
#pragma unroll
      for (int c = 0; c < NK; ++c)
#pragma unroll
          for (int i = 0; i < 2; ++i) st[c * 2 + i] = ld16(kbase + off + c * 64 + (size_t)i * 32 * 1024); }
    if (DV == 64) { const unsigned off = (unsigned)(tid >> 4) * 1024 + (tid & 15) * 4;
#pragma unroll
        for (int i = 0; i < 2; ++i) st[2 * NK + i] = ld16(vbase + off + (size_t)i * 32 * 1024); }
    else { const unsigned off = (unsigned)(tid >> 5) * 1024 + (tid & 31) * 4;
#pragma unroll
        for (int i = 0; i < 4; ++i) st[2 * NK + i] = ld16(vbase + off + (size_t)i * 16 * 1024); }
}
template <int NK, int DV>
__device__ __forceinline__ void wr_f32(const u32x4 (&st)[2 * NK + DV / 32], AT_LAS unsigned char* sb, int tid) {
    { const int row = tid >> 4, c4 = tid & 15;
#pragma unroll
      for (int c = 0; c < NK; ++c)
#pragma unroll
          for (int i = 0; i < 2; ++i) *(AT_LAS u32x2*)(sb + c * KT_BYTES + (c4 >> 1) * KCS + (row + 32 * i) * 16 + (c4 & 1) * 8) = f4_to_bf4(st[c * 2 + i]); }
    AT_LAS unsigned char* vb = sb + NK * KT_BYTES;
    if (DV == 64) { const int row = tid >> 4, col = (tid & 15) * 4;
#pragma unroll
        for (int i = 0; i < 2; ++i) *(AT_LAS u32x2*)(vb + ((col >> 5) * 4 + ((row + 32 * i) >> 4)) * 1024 + (row & 15) * 64 + (col & 31) * 2) = f4_to_bf4(st[2 * NK + i]); }
    else { const int row = tid >> 5, col = (tid & 31) * 4;
#pragma unroll
        for (int i = 0; i < 4; ++i) *(AT_LAS u32x2*)(vb + ((col >> 5) * 4 + ((row + 16 * i) >> 4)) * 1024 + (row & 15) * 64 + (col & 31) * 2) = f4_to_bf4(st[2 * NK + i]); }
}

constexpr int A_STAGE = 2 * KT_BYTES + 16384;
constexpr int A_TP = 132;
constexpr int S_TAB = WSF_OFF + 2048;
template <bool ISB>
__device__ __forceinline__ void attn_sample_unit(AT_LAS unsigned char* lds, int b, int cg, const Ctx& C) {
    constexpr int ND0 = ISB ? 2 : 4, NT = ISB ? 8 : 16, PAST = ISB ? 512 : 1024;
    const int tid = pg8::opaque_tid(), lane = tid & 63, r32 = lane & 31, hi = lane >> 5;
    const int w = __builtin_amdgcn_readfirstlane(tid >> 6), g = w >> 2;
    AT_LAS float* wsf = (AT_LAS float*)(lds + WSF_OFF) + w * 64;
    AT_LAS float* tab = (AT_LAS float*)(lds + S_TAB) + g * 264;
    const bool active = (w & 3) == 0;
    const int qrow0 = MP + b * 32, qpos = 1024 + r32;
    if (ISB) { for (int i = tid; i < 2 * 257; i += 512) { const int hh = i >= 257 ? 1 : 0, j = i - hh * 257; ((AT_LAS float*)(lds + S_TAB))[hh * 264 + j] = C.rel[(2 * cg + hh) * 257 + j] * 1.4426950408889634f; } }
    float lam = 0.f;
    if (!ISB) { const float a_ = C.lam_p[lane] * C.lam_p[64 + lane], c_ = C.lam_p[128 + lane] * C.lam_p[192 + lane];
      float sa = a_, sc = c_;
#pragma unroll
      for (int o_ = 1; o_ < 64; o_ <<= 1) { sa += __shfl_xor(sa, o_); sc += __shfl_xor(sc, o_); }
      lam = __expf(sa) - __expf(sc) + 0.2f; }
    bf16x8 qr[4];
    AT_LAS unsigned char* qimg = lds + QIMG_OFF + w * 4096;
#pragma unroll
    for (int d0 = 0; d0 < 4; ++d0) { qr[d0] = *(const bf16x8*)(C.Q + (size_t)(qrow0 + r32) * PITCH + cg * 128 + g * 64 + d0 * 16 + hi * 8);
        *(AT_LAS bf16x8*)(qimg + (2 * d0 + hi) * 512 + r32 * 16) = qr[d0]; }
    f32x16 o[ND0];
#pragma unroll
    for (int d0 = 0; d0 < ND0; ++d0) o[d0] = f32x16{};
    float m = -1e30f, l = 0.f;
    const bf16_t* kb0 = C.K + (size_t)qrow0 * PITCH + cg * 128;
    const bf16_t* vb0 = C.V + (size_t)qrow0 * PITCH + cg * 128;
    const float* kc0 = C.cache_k + (size_t)b * PAST * 1024 + cg * 128;
    const float* vc0 = C.cache_v + (size_t)b * PAST * 1024 + cg * 128;
    { u32x4 sn[4]; ld_bf<2, 128>(sn, kb0, vb0, 32, tid); wr_bf<2, 128>(sn, lds + 2 * A_STAGE, tid); }
    u32x4 st[8];
    ld_f32<2, 128>(st, kc0, vc0, tid);
    for (int t = 0; t < NT; ++t) {
        AT_LAS unsigned char* sb = lds + (t & 1) * A_STAGE;
        wr_f32<2, 128>(st, sb, tid);
        AT_SYNC();
        if (t + 1 < NT) ld_f32<2, 128>(st, kc0 + (size_t)(t + 1) * 64 * 1024, vc0 + (size_t)(t + 1) * 64 * 1024, tid);
        if (active) {
            const int nsub = (t == 0) ? 2 : 1;
#pragma unroll 1
            for (int sub = 0; sub < nsub; ++sub) {
                const AT_LAS unsigned char* sc = sub ? (lds + 2 * A_STAGE) : sb;
                f32x16 p0, p1;
                qk_tile<true>(p0, p1, sc + g * KT_BYTES, qr, qimg, r32, hi);
                if (ISB) {
                    const int kpos0 = sub ? 1024 : 512 + t * 64;
                    if (1024 - (kpos0 + 63) >= 128) { const float cb = tab[256];
#pragma unroll
                        for (int r = 0; r < 16; ++r) { p0[r] += cb; p1[r] += cb; } }
                    else {
#pragma unroll
                        for (int r = 0; r < 16; ++r) { const int rel = qpos - (kpos0 + crow(r, hi));
                            const int i0 = rel < -128 ? -128 : (rel > 128 ? 128 : rel), i1 = (rel - 32) < -128 ? -128 : ((rel - 32) > 128 ? 128 : (rel - 32));
                            p0[r] += tab[i0 + 128]; p1[r] += tab[i1 + 128]; } }
                }
                if (sub) {
#pragma unroll
                    for (int r = 0; r < 16; ++r) p1[r] = -INFINITY;
                }
                softmax_tile<ND0>(p0, p1, m, l, o, wsf, r32, hi);
                pv_tile<ND0>(o, sc + 2 * KT_BYTES + (ISB ? g * 8192 : 0), p0, p1, lane, hi);
            }
        }
    }
    AT_SYNC();
    const float lt = l + __shfl_xor(l, 32);
    if (!ISB) {
        { float inv = 1.0f / lt; if (g == 1) inv *= lam; if (hi == 0) wsf[r32] = inv; asm volatile("s_waitcnt lgkmcnt(0)" ::: "memory"); }
        AT_LAS float* T2 = (AT_LAS float*)lds;
        if (active && g == 1) {
#pragma unroll
            for (int r = 0; r < 16; ++r) { const int q = crow(r, hi); const float f = wsf[q];
#pragma unroll
                for (int d0 = 0; d0 < ND0; ++d0) T2[q * A_TP + d0 * 32 + r32] = o[d0][r] * f; }
        }
        AT_SYNC();
        if (active && g == 0) {
#pragma unroll
            for (int r = 0; r < 16; ++r) { const int q = crow(r, hi); const float f = wsf[q];
#pragma unroll
                for (int d0 = 0; d0 < ND0; ++d0) { const int ix = q * A_TP + d0 * 32 + r32; T2[ix] = o[d0][r] * f - T2[ix]; } }
            asm volatile("s_waitcnt lgkmcnt(0)" ::: "memory");
            const int row = lane & 31, half = lane >> 5;
            f32x4 x[16]; float ss = 0.f;
#pragma unroll
            for (int i = 0; i < 16; ++i) { x[i] = *(const AT_LAS f32x4*)(T2 + row * A_TP + half * 64 + 4 * i); ss += (x[i][0] * x[i][0] + x[i][1] * x[i][1]) + (x[i][2] * x[i][2] + x[i][3] * x[i][3]); }
            ss += __shfl_xor(ss, 32);
            const float rinv = 0.8f / sqrtf(ss * (1.0f / 128.0f) + 1e-6f);
            bf16_t* op = C.O + (size_t)(qrow0 + row) * PITCH + cg * 128 + half * 64;
#pragma unroll
            for (int i = 0; i < 16; i += 2) {
                const f32x4 g0 = *(const f32x4*)(C.subln + half * 64 + 4 * i), g1 = *(const f32x4*)(C.subln + half * 64 + 4 * i + 4);
                const f32x4 y0 = x[i] * g0 * rinv, y1 = x[i + 1] * g1 * rinv;
                u32x4 wv; wv.x = cvtpk(y0[0], y0[1]); wv.y = cvtpk(y0[2], y0[3]); wv.z = cvtpk(y1[0], y1[1]); wv.w = cvtpk(y1[2], y1[3]);
                *(u32x4*)(op + 4 * i) = wv;
            }
        }
    } else if (active) {
        { const float inv = 1.0f / lt; if (hi == 0) wsf[r32] = inv; asm volatile("s_waitcnt lgkmcnt(0)" ::: "memory"); }
        AT_LAS bf16_t* stg = (AT_LAS bf16_t*)lds + g * 2048;
#pragma unroll
        for (int r = 0; r < 16; ++r) { const int q = crow(r, hi); const float f = wsf[q];
#pragma unroll
            for (int d0 = 0; d0 < ND0; ++d0) { const unsigned pk = cvtpk(o[d0][r] * f, 0.f); stg[q * 64 + d0 * 32 + r32] = (bf16_t)(pk & 0xffffu); } }
        asm volatile("s_waitcnt lgkmcnt(0)" ::: "memory");
        bf16_t* op = C.O + (size_t)qrow0 * PITCH + cg * 128 + g * 64;
#pragma unroll
        for (int i = 0; i < 4; ++i) { const int row = i * 8 + (lane >> 3), ch = lane & 7; const u32x4 v = *(const AT_LAS u32x4*)(stg + row * 64 + ch * 8); *(u32x4*)(op + (size_t)row * PITCH + ch * 8) = v; }
    }
    AT_SYNC();
}

constexpr int P_STAGE = 16384 + 16384;
constexpr int P_WSF = 4 * P_STAGE;
constexpr int P_TAB = P_WSF + 2048;
template <bool ISB>
__device__ __forceinline__ void attn_prompt_unit(AT_LAS unsigned char* lds, int b, int cg, int ub, const Ctx& C) {
#ifdef PROBE_STAMP
    const unsigned long long tsA_ = PROBE_CLK();
#endif
    constexpr int ND0 = ISB ? 2 : 4, NS = ISB ? 8 : 4, STG = ISB ? 16384 : P_STAGE, DIST = ISB ? 4 : 2, VOFF = ISB ? 8192 : 16384, KR2 = ISB ? 4096 : 8192;
    const int tid = pg8::opaque_tid(), lane = tid & 63, r32 = lane & 31, hi = lane >> 5;
#ifdef PROBE_PARITY
    const int w = __builtin_amdgcn_readfirstlane(tid >> 6), g = ISB ? 0 : (w >> 2), qi = w & 3;
#else
    const int w = __builtin_amdgcn_readfirstlane(tid >> 6), g = w >> 2, qi = w & 3;
#endif
    AT_LAS float* wsf = (AT_LAS float*)(lds + P_WSF) + w * 64;
    AT_LAS float* tab = (AT_LAS float*)(lds + P_TAB);
    const int cw = ISB ? 4 * ub + (w >> 1) : 2 * ub + (qi >> 1);
    const int kt0 = ISB ? ((4 * ub - 8) > 0 ? (4 * ub - 8) : 0) : 0, NT = (ISB ? 4 * ub + 4 : 2 * ub + 2) - kt0;
    const int fv = ISB ? ((cw - 8) > 0 ? (cw - 8) : 0) : 0;
    const int qoff = ISB ? ub * 256 + w * 32 : ub * 128 + qi * 32, qrow0 = b * SEQ + qoff, qpos = qoff + r32;
    const int ccol = ISB ? cg * 64 : cg * 128;
    if (ISB) { if (tid < 257) tab[tid] = C.rel[cg * 257 + tid] * 1.4426950408889634f; }
    AT_LAS float* subl = (AT_LAS float*)(lds + P_TAB);
    if (!ISB) { if (tid < 128) subl[tid] = C.subln[tid]; }
    float lam = 0.f;
    if (!ISB) { const float a_ = C.lam_p[lane] * C.lam_p[64 + lane], c_ = C.lam_p[128 + lane] * C.lam_p[192 + lane];
      float sa = a_, sc = c_;
#pragma unroll
      for (int o_ = 1; o_ < 64; o_ <<= 1) { sa += __shfl_xor(sa, o_); sc += __shfl_xor(sc, o_); }
      lam = __expf(sa) - __expf(sc) + 0.2f; }
    bf16x8 qr[4];
#pragma unroll
    for (int d0 = 0; d0 < 4; ++d0) qr[d0] = *(const bf16x8*)(C.Q + (size_t)(qrow0 + r32) * PITCH + ccol + (ISB ? 0 : g * 64) + d0 * 16 + hi * 8);
    f32x16 o[ND0];
#pragma unroll
    for (int d0 = 0; d0 < ND0; ++d0) o[d0] = f32x16{};
    f32x16 negm = f32x16{};
    float m = 0.f, l = 0.f;
    bf16x8 pa[4];
#pragma unroll
    for (int ks = 0; ks < 4; ++ks) pa[ks] = bf16x8{};
    const bf16_t* kb0 = C.K + (size_t)(b * SEQ + kt0 * 64) * PITCH + ccol;
    const bf16_t* vb0 = C.V + (size_t)(b * SEQ + kt0 * 64) * PITCH + ccol;
#define P_DMA(tt) do { if (ISB) dma_promptB(kb0 + (size_t)(tt) * 64 * PITCH, vb0 + (size_t)(tt) * 64 * PITCH, lds + ((tt) & (NS - 1)) * STG, w, lane); \
                       else dma_prompt(kb0 + (size_t)(tt) * 64 * PITCH, vb0 + (size_t)(tt) * 64 * PITCH, lds + ((tt) & (NS - 1)) * STG, w, lane); } while (0)
#pragma unroll
    for (int tt = 0; tt < DIST; ++tt) if (tt < NT) P_DMA(tt);
    const int vlane = ((lane >> 4) & 1) * 32 + (lane & 3) * 8 + (4 * hi + ((lane & 15) >> 2)) * 64 + VOFF;
    const int klane = ISB ? (r32 * 128 + ((hi ^ ((r32 >> 1) & 7)) << 4)) : (r32 * 256 + (((g * 8 + hi) ^ (r32 & 15)) << 4));
#define P_VRD(buf, blk) do { _Pragma("unroll") for (int ks = 0; ks < 4; ++ks) { buf[2 * ks] = vtr(vp + (blk) * 4096 + ks * 1024); buf[2 * ks + 1] = vtr(vp + (blk) * 4096 + ks * 1024 + 512); } } while (0)
#define P_VMM(buf, blk) do { _Pragma("unroll") for (int ks = 0; ks < 4; ++ks) { const bf16x8 bfr = {buf[2 * ks][0], buf[2 * ks][1], buf[2 * ks][2], buf[2 * ks][3], buf[2 * ks + 1][0], buf[2 * ks + 1][1], buf[2 * ks + 1][2], buf[2 * ks + 1][3]}; \
        o[blk] = __builtin_amdgcn_mfma_f32_32x32x16_bf16(pa[ks], bfr, o[blk], 0, 0, 0); } } while (0)
#define P_SB() __builtin_amdgcn_sched_barrier(0)
#define P_KRD(scur) do { \
        _Pragma("unroll") for (int d0 = 0; d0 < 4; ++d0) { ka[2 * d0] = *(const AT_LAS bf16x8*)(lds + (scur) + (klane ^ (d0 << 5))); ka[2 * d0 + 1] = *(const AT_LAS bf16x8*)(lds + (scur) + (klane ^ (d0 << 5)) + KR2); } } while (0)
#define P_PV(sprev, KRD_STMT) do { const AT_LAS unsigned char* vp = lds + (sprev) + vlane; \
        P_VMM(va, 0); \
        if (ND0 == 4) { P_VRD(va, 2); P_SB(); P_VMM(vb, 1); P_VRD(vb, 3); P_SB(); P_VMM(va, 2); KRD_STMT; P_SB(); P_VMM(vb, 3); } else { KRD_STMT; P_SB(); P_VMM(vb, 1); } P_SB(); } while (0)
#define P_PRE(sprev) do { const AT_LAS unsigned char* vp = lds + (sprev) + vlane; P_VRD(va, 0); P_VRD(vb, 1); } while (0)
#define P_BAR() do { __builtin_amdgcn_sched_barrier(0); asm volatile("s_barrier" ::: "memory"); __builtin_amdgcn_sched_barrier(0); } while (0)
#define P_BAR_V0() do { __builtin_amdgcn_sched_barrier(0); asm volatile("s_waitcnt vmcnt(0)\n\ts_barrier" ::: "memory"); __builtin_amdgcn_sched_barrier(0); } while (0)
#define P_BAR_V2() do { __builtin_amdgcn_sched_barrier(0); asm volatile("s_waitcnt vmcnt(2)\n\ts_barrier" ::: "memory"); __builtin_amdgcn_sched_barrier(0); } while (0)
#define P_BAR_V4() do { __builtin_amdgcn_sched_barrier(0); asm volatile("s_waitcnt vmcnt(4)\n\ts_barrier" ::: "memory"); __builtin_amdgcn_sched_barrier(0); } while (0)
    asm volatile("s_waitcnt vmcnt(0) lgkmcnt(0)\n\ts_barrier" ::: "memory");
    if (g == 1) P_BAR();
    f32x16 p0, p1;
    s16x4 va[8], vb[8]; bf16x8 ka[8];
#ifdef PROBE_STAMP
    unsigned long long stamp_acc = 0;
#endif
    P_PRE(0);
#ifdef PROBE_STAMP
    const unsigned long long tsB_ = PROBE_CLK();
#endif
    for (int t = 0; t < NT; ++t) {
#ifdef PROBE_PARITY
        if (t > 0 && !ISB) P_BAR();
#else
        if (t > 0) P_BAR();
#endif
#ifdef PROBE_STAMP
        const unsigned long long ts0_ = PROBE_CLK();
#endif
        P_PV((t > 0 ? ((t - 1) & (NS - 1)) : 0) * STG, P_KRD((t & (NS - 1)) * STG));
        p0 = __builtin_amdgcn_mfma_f32_32x32x16_bf16(ka[0], qr[0], negm, 0, 0, 0); p1 = __builtin_amdgcn_mfma_f32_32x32x16_bf16(ka[1], qr[0], negm, 0, 0, 0);
#pragma unroll
        for (int d0 = 1; d0 < 4; ++d0) { p0 = __builtin_amdgcn_mfma_f32_32x32x16_bf16(ka[2 * d0], qr[d0], p0, 0, 0, 0); p1 = __builtin_amdgcn_mfma_f32_32x32x16_bf16(ka[2 * d0 + 1], qr[d0], p1, 0, 0, 0); }
        if (ISB) { const int nn = NT - 2 - t; if (nn >= 2) P_BAR_V4(); else if (nn == 1) P_BAR_V2(); else P_BAR_V0(); }
        else P_BAR_V0();
#ifdef PROBE_STAMP
        const unsigned long long ts1_ = PROBE_CLK();
#endif
        if (t + DIST < NT) P_DMA(t + DIST);
        const int kt = kt0 + t;
        const bool vis = ISB ? (kt <= cw && kt >= cw - 8) : (kt <= cw);
        if (vis) {
            if (ISB) {
                const int relmin = cw * 64 + (w & 1) * 32 - (kt * 64 + 63);
                if (relmin >= 128) { const float cb = tab[256];
#pragma unroll
                    for (int r = 0; r < 16; ++r) { p0[r] += cb; p1[r] += cb; } }
                else {
#pragma unroll
                    for (int r = 0; r < 16; ++r) { const int rel = qpos - (kt * 64 + crow(r, hi));
                        const int i0 = rel < -128 ? -128 : (rel > 128 ? 128 : rel), i1 = (rel - 32) < -128 ? -128 : ((rel - 32) > 128 ? 128 : (rel - 32));
                        p0[r] += tab[i0 + 128]; p1[r] += tab[i1 + 128]; } }
            }
            float ra = __builtin_fmaxf(__builtin_fmaxf(p0[0], p0[1]), p1[0]), rb = __builtin_fmaxf(__builtin_fmaxf(p0[2], p0[3]), p1[1]);
            ra = __builtin_fmaxf(__builtin_fmaxf(ra, p1[2]), p1[3]);
#pragma unroll
            for (int r = 4; r < 16; r += 4) { ra = __builtin_fmaxf(__builtin_fmaxf(ra, p0[r]), p0[r + 1]); rb = __builtin_fmaxf(__builtin_fmaxf(rb, p0[r + 2]), p0[r + 3]);
                                              ra = __builtin_fmaxf(__builtin_fmaxf(ra, p1[r]), p1[r + 1]); rb = __builtin_fmaxf(__builtin_fmaxf(rb, p1[r + 2]), p1[r + 3]); }
            float rm = __builtin_fmaxf(ra, rb);
            { auto rr = __builtin_amdgcn_permlane32_swap(__float_as_uint(rm), __float_as_uint(rm), false, false); rm = __builtin_fmaxf(__uint_as_float(rr[0]), __uint_as_float(rr[1])); }
            const bool first = (kt == fv);
            if (first || __any(rm > THR)) {
                const float dl = first ? rm : __builtin_fmaxf(rm, 0.f);
                m += dl;
#pragma unroll
                for (int r = 0; r < 16; ++r) { p0[r] -= dl; p1[r] -= dl; }
#pragma unroll
                for (int r = 0; r < 16; ++r) negm[r] = -m;
                if (!first) {
                    const float f = __builtin_amdgcn_exp2f(-dl); l *= f;
                    if (hi == 0) wsf[r32] = f;
                    asm volatile("s_waitcnt lgkmcnt(0)" ::: "memory");
#pragma unroll
                    for (int r = 0; r < 16; ++r) { const float fr_ = wsf[crow(r, hi)];
#pragma unroll
                        for (int d0 = 0; d0 < ND0; ++d0) o[d0][r] *= fr_; }
                    asm volatile("s_waitcnt lgkmcnt(0)" ::: "memory");
                }
            }
            float s = 0.f;
#pragma unroll
            for (int r = 0; r < 16; ++r) { p0[r] = __builtin_amdgcn_exp2f(p0[r]); p1[r] = __builtin_amdgcn_exp2f(p1[r]); s += p0[r] + p1[r]; }
            l += s;
#ifdef PROBE_S2X
            { float xs = 0.f;
              for (int rep = 0; rep < PROBE_S2X; ++rep) {
#pragma unroll
              for (int r = 0; r < 16; ++r) { xs += __builtin_amdgcn_exp2f(p0[r] - 20.f - xs) + __builtin_amdgcn_exp2f(p1[r] - 21.f - xs); } }
              asm volatile("" :: "v"(xs)); }
#endif
            pack_p(pa, p0, p1);
        } else {
#pragma unroll
            for (int ks = 0; ks < 4; ++ks) pa[ks] = bf16x8{};
        }
        P_PRE((t & (NS - 1)) * STG);
#ifdef PROBE_STAMP
        { const unsigned long long ts2_ = PROBE_CLK(); if (ISB == (PROBE_STAMP_B != 0)) { if (PROBE_STAMP == 1) stamp_acc += ts1_ - ts0_; else if (PROBE_STAMP == 2) stamp_acc += ts2_ - ts1_; else stamp_acc += ts2_ - ts0_; } }
#endif
    }
#ifdef PROBE_STAMP
    const unsigned long long tsC_ = PROBE_CLK();
#endif
#ifdef PROBE_PARITY
    if (!ISB) P_BAR();
#else
    P_BAR();
#endif
    P_PV(((NT - 1) & (NS - 1)) * STG, (void)0);
    asm volatile("s_waitcnt lgkmcnt(0)" ::: "memory");
    if (g == 0) P_BAR();
    P_BAR();
#undef P_KRD
#undef P_PRE
#undef P_BAR
#undef P_BAR_V0
#undef P_BAR_V2
#undef P_BAR_V4
#undef P_DMA
#undef P_VRD
#undef P_VMM
#undef P_SB
#undef P_PV
    const float lt = l + __shfl_xor(l, 32);
    if (!ISB) {
        { float inv = 1.0f / lt; if (g == 1) inv *= lam; if (hi == 0) wsf[r32] = inv; asm volatile("s_waitcnt lgkmcnt(0)" ::: "memory"); }
        AT_LAS float* T2 = (AT_LAS float*)lds + qi * (32 * A_TP);
        if (g == 1) {
#pragma unroll
            for (int r = 0; r < 16; ++r) { const int q = crow(r, hi); const float f = wsf[q];
#pragma unroll
                for (int d0 = 0; d0 < ND0; ++d0) T2[q * A_TP + d0 * 32 + r32] = o[d0][r] * f; }
        }
        AT_SYNC();
        if (g == 0) {
#pragma unroll
            for (int r = 0; r < 16; ++r) { const int q = crow(r, hi); const float f = wsf[q];
#pragma unroll
                for (int d0 = 0; d0 < ND0; ++d0) { const int ix = q * A_TP + d0 * 32 + r32; T2[ix] = o[d0][r] * f - T2[ix]; } }
            asm volatile("s_waitcnt lgkmcnt(0)" ::: "memory");
            const int row = lane & 31, half = lane >> 5;
            f32x4 x[16]; float ss = 0.f;
#pragma unroll
            for (int i = 0; i < 16; ++i) { x[i] = *(const AT_LAS f32x4*)(T2 + row * A_TP + half * 64 + 4 * i); ss += (x[i][0] * x[i][0] + x[i][1] * x[i][1]) + (x[i][2] * x[i][2] + x[i][3] * x[i][3]); }
            ss += __shfl_xor(ss, 32);
            const float rinv = 0.8f / sqrtf(ss * (1.0f / 128.0f) + 1e-6f);
            bf16_t* op = C.O + (size_t)(qrow0 + row) * PITCH + cg * 128 + half * 64;
#pragma unroll
            for (int i = 0; i < 16; i += 2) {
                const f32x4 g0 = *(const AT_LAS f32x4*)(subl + half * 64 + 4 * i), g1 = *(const AT_LAS f32x4*)(subl + half * 64 + 4 * i + 4);
                const f32x4 y0 = x[i] * g0 * rinv, y1 = x[i + 1] * g1 * rinv;
                u32x4 wv; wv.x = cvtpk(y0[0], y0[1]); wv.y = cvtpk(y0[2], y0[3]); wv.z = cvtpk(y1[0], y1[1]); wv.w = cvtpk(y1[2], y1[3]);
                *(u32x4*)(op + 4 * i) = wv;
            }
        }
    } else {
        { const float inv = 1.0f / lt; if (hi == 0) wsf[r32] = inv; asm volatile("s_waitcnt lgkmcnt(0)" ::: "memory"); }
        AT_LAS bf16_t* stg = (AT_LAS bf16_t*)lds + w * 2048;
#pragma unroll
        for (int r = 0; r < 16; ++r) { const int q = crow(r, hi); const float f = wsf[q];
#pragma unroll
            for (int d0 = 0; d0 < ND0; ++d0) { const unsigned pk = cvtpk(o[d0][r] * f, 0.f); stg[q * 64 + d0 * 32 + r32] = (bf16_t)(pk & 0xffffu); } }
        asm volatile("s_waitcnt lgkmcnt(0)" ::: "memory");
        bf16_t* op = C.O + (size_t)qrow0 * PITCH + ccol;
#pragma unroll
        for (int i = 0; i < 4; ++i) { const int row = i * 8 + (lane >> 3), ch = lane & 7; const u32x4 v = *(const AT_LAS u32x4*)(stg + row * 64 + ch * 8); *(u32x4*)(op + (size_t)row * PITCH + ch * 8) = v; }
    }
    asm volatile("s_waitcnt lgkmcnt(0)\n\ts_barrier" ::: "memory");
#ifdef PROBE_STAMP
    { const unsigned long long tsD_ = PROBE_CLK(); if (ISB == (PROBE_STAMP_B != 0)) { if (PROBE_STAMP == 4) stamp_acc = tsB_ - tsA_; else if (PROBE_STAMP == 5) stamp_acc = tsD_ - tsC_; else if (PROBE_STAMP == 6) stamp_acc = tsD_ - tsA_; }
      if (blockIdx.x == PROBE_BLK && tid == PROBE_TID) atomicAdd((unsigned long long*)C.stamp, stamp_acc); }
#endif
}
}

constexpr int NWAVES = 8;
#ifndef MK_N_LAUNCHES
#define MK_N_LAUNCHES 1
#endif
constexpr int N_PHASES = 12;
constexpr int DMODEL = 1024, SEQ = 2048, NBATCH = 8, MP = NBATCH * SEQ, MS = 1024, M = MP + MS, FF = 4096;
constexpr size_t O_Y = 0, O_AKP = 17825792, O_AVP = 34603008, O_BKP = 51380224, O_BVP = 55574528, O_AKS = 59768832, O_AVS = 60817408, O_BKS = 61865984, O_BVS = 62914560, O_END = 63963136;
constexpr size_t MiB = 1u << 20;
constexpr size_t WS_CTL = 0, CTL_ZERO_BYTES = 1 * MiB;
constexpr size_t WS_WQKV = 2 * MiB, WS_WAO = 8 * MiB, WS_WKVQ = 10 * MiB, WS_WBO = 16 * MiB, WS_W1 = 18 * MiB  , WS_W2 = 34 * MiB  ;
constexpr size_t WS_CS = 50 * MiB;
constexpr size_t WS_SS = 51 * MiB;
constexpr size_t WS_HB = 54 * MiB, WS_Q = 90 * MiB, WS_K = 126 * MiB, WS_V = 162 * MiB, WS_O = 198 * MiB;
constexpr size_t WS_U = 234 * MiB;
constexpr size_t WS_END = 372 * MiB;
constexpr int CW_TMO = 0, CW_CODE = 1, CW_BAR = 4096, CW_FIN = 8192;
constexpr int RS_OFF = 139264;
constexpr int RING_OFF = 0, RING_BYTES = 131072, LDS_BYTES = 163840, LDSCTL_OFF = LDS_BYTES - 1024, MISC_OFF = LDSCTL_OFF + 320;

struct Args { const float* in[20]; float* out; unsigned char* ws; int ph_lo, ph_hi, li, pad; };

struct Frame {
    LAS unsigned char* lds; volatile LAS unsigned* MISC; gu32* ctl;
    int tid, lane, wave, vcu, G;
};

__device__ __forceinline__ float wave_sum(float v) {
#pragma unroll
    for (int o = 1; o < 64; o <<= 1) v += __shfl_xor(v, o);
    return v;
}
__device__ __forceinline__ int pi64(int d) { return d < 32 ? 32 * (d >> 4) + (d & 15) : 32 * ((d - 32) >> 4) + 16 + ((d - 32) & 15); }
template <bool PERMQK>
__device__ __forceinline__ void p0_transpose_item(const float* W, const float* g, int K, int N, bf16* WT, int row_off, LAS float* scr, int item, int lane) {
    const int nblk = N / 32, kb = item / nblk, nb = item % nblk, k0 = 64 * kb, n0 = 32 * nb;
    float wv[32];
#pragma unroll
    for (int i = 0; i < 32; ++i) { const int kk = 2 * i + (lane >> 5); wv[i] = W[(size_t)(k0 + kk) * N + n0 + (lane & 31)]; }
#pragma unroll
    for (int i = 0; i < 32; ++i) { const int kk = 2 * i + (lane >> 5); const float gv = g ? g[k0 + kk] : 1.0f; scr[kk * 33 + (lane & 31)] = wv[i] * gv; }
    LDS_WAIT(); asm volatile("" ::: "memory");
    const int c = lane & 7;
#pragma unroll
    for (int j = 0; j < 4; ++j) { const int n = (lane >> 3) + 8 * j; const LAS float* s = scr + (8 * c) * 33 + n;
        v4u o; o.x = pk2(s[0 * 33], s[1 * 33]); o.y = pk2(s[2 * 33], s[3 * 33]); o.z = pk2(s[4 * 33], s[5 * 33]); o.w = pk2(s[6 * 33], s[7 * 33]);
        int nn = n0 + n; if (PERMQK && nn < 2048) nn = (nn & ~63) + pi64(nn & 63);
        *(GAS v4u*)(WT + (size_t)(row_off + nn) * K + k0 + 8 * c) = o; }
    LDS_WAIT(); asm volatile("" ::: "memory");
}
__device__ __forceinline__ void p0_prologue(Frame& F, const Args& A) {
    unsigned char* ws = A.ws;
    LAS float* scr = (LAS float*)(F.lds + RING_OFF + F.wave * 16384);
    const int gw = F.vcu * NWAVES + F.wave, NGW = F.G * NWAVES;
    constexpr int I_QKV = 16 * 96, I_SQ = 16 * 32, I_KV = 16 * 64, I_F1 = 16 * 128, I_F2 = 64 * 32;
    constexpr int NITEMS = I_QKV + I_SQ + I_KV + I_SQ + I_SQ + 2 * I_F1 + 2 * I_F2;
    const float* g_attn = A.in[6]; const float* g_mlp = A.in[16];
    for (int it = gw; it < NITEMS; it += NGW) {
        int r = it;
        if (r < I_QKV) { p0_transpose_item<true>(A.in[7], g_attn, 1024, 3072, (bf16*)(ws + WS_WQKV), 0, scr, r, F.lane); continue; } r -= I_QKV;
        if (r < I_SQ) { p0_transpose_item<false>(A.in[10], nullptr, 1024, 1024, (bf16*)(ws + WS_WAO), 0, scr, r, F.lane); continue; } r -= I_SQ;
        if (r < I_KV) { p0_transpose_item<false>(A.in[12], A.in[11], 1024, 2048, (bf16*)(ws + WS_WKVQ), 0, scr, r, F.lane); continue; } r -= I_KV;
        if (r < I_SQ) { p0_transpose_item<false>(A.in[13], g_attn + 1024, 1024, 1024, (bf16*)(ws + WS_WKVQ), 2048, scr, r, F.lane); continue; } r -= I_SQ;
        if (r < I_SQ) { p0_transpose_item<false>(A.in[15], nullptr, 1024, 1024, (bf16*)(ws + WS_WBO), 0, scr, r, F.lane); continue; } r -= I_SQ;
        if (r < I_F1) { p0_transpose_item<false>(A.in[17], g_mlp, 1024, 4096, (bf16*)(ws + WS_W1), 0, scr, r, F.lane); continue; } r -= I_F1;
        if (r < I_F1) { p0_transpose_item<false>(A.in[17] + (size_t)1024 * 4096, g_mlp + 1024, 1024, 4096, (bf16*)(ws + WS_W1 + 8 * MiB), 0, scr, r, F.lane); continue; } r -= I_F1;
        if (r < I_F2) { p0_transpose_item<false>(A.in[18], nullptr, 4096, 1024, (bf16*)(ws + WS_W2), 0, scr, r, F.lane); continue; } r -= I_F2;
        p0_transpose_item<false>(A.in[18] + (size_t)4096 * 1024, nullptr, 4096, 1024, (bf16*)(ws + WS_W2 + 8 * MiB), 0, scr, r, F.lane);
    }
    bf16* HB = (bf16*)(ws + WS_HB); float* SS = (float*)(ws + WS_SS);
    for (int m = gw; m < M; m += NGW) {
        const float* xrow = (m < MP) ? A.in[0] + (size_t)m * 1024 : A.in[1] + (size_t)(m - MP) * 1024;
        const GAS f32x4* xr = (const GAS f32x4*)xrow + F.lane;
        f32x4 v[4]; float s = 0.f;
#pragma unroll
        for (int j = 0; j < 4; ++j) { v[j] = xr[64 * j]; s += (v[j].x * v[j].x + v[j].y * v[j].y) + (v[j].z * v[j].z + v[j].w * v[j].w); }
        s = wave_sum(s);
        GAS unsigned long long* o8 = (GAS unsigned long long*)(HB + (size_t)m * 1024) + F.lane;
#pragma unroll
        for (int j = 0; j < 4; ++j) o8[64 * j] = (unsigned long long)pk2(v[j].x, v[j].y) | ((unsigned long long)pk2(v[j].z, v[j].w) << 32);
        if (F.lane < 16) SS[(size_t)m * 16 + F.lane] = (F.lane == 0) ? s : 0.f;
    }
    float* cs = (float*)(ws + WS_CS);
    for (int e = (F.vcu * NWAVES + F.wave) * 64 + F.lane; e < 2048 * 32; e += F.G * NWAVES * 64) {
        const int pos = e >> 5, i = e & 31;
        const float inv = 1.0f / powf(10000.0f, (float)i * (1.0f / 32.0f));
        const float ang = (float)pos * inv;
        float sv, cv; sincosf(ang, &sv, &cv);
        cs[(size_t)pos * 64 + i] = cv; cs[(size_t)pos * 64 + 32 + i] = sv;
    }
}
__device__ __forceinline__ void final_norm(Frame& F, const Args& A) {
    const int gw = F.vcu * NWAVES + F.wave, NGW = F.G * NWAVES;
    const float* SS = (const float*)(A.ws + WS_SS); const float* gf = A.in[19]; const bf16* HB = (const bf16*)(A.ws + WS_HB);
    f32x4 g[4];
#pragma unroll
    for (int j = 0; j < 4; ++j) g[j] = *((const f32x4*)gf + 4 * F.lane + j);
    for (int m = gw; m < M; m += NGW) {
        float s = (F.lane < 16) ? SS[(size_t)m * 16 + F.lane] : 0.f;
        s = wave_sum(s);
        const float r = 1.0f / sqrtf(s * (1.0f / 1024.0f) + 1e-6f);
        const v4u h0 = *((const GAS v4u*)(HB + (size_t)m * 1024) + 2 * F.lane), h1 = *((const GAS v4u*)(HB + (size_t)m * 1024) + 2 * F.lane + 1);
        GAS f32x4* yr = (GAS f32x4*)(A.out + (size_t)m * 1024) + 4 * F.lane;
        const unsigned w[8] = {h0.x, h0.y, h0.z, h0.w, h1.x, h1.y, h1.z, h1.w};
#pragma unroll
        for (int j = 0; j < 4; ++j) { f32x4 v; v.x = __uint_as_float(w[2 * j] << 16); v.y = __uint_as_float(w[2 * j] & 0xffff0000u); v.z = __uint_as_float(w[2 * j + 1] << 16); v.w = __uint_as_float(w[2 * j + 1] & 0xffff0000u);
            yr[j] = v * g[j] * r; }
    }
}

#ifndef PHASE_MASK
#define PHASE_MASK 0xFFFF
#endif
#ifndef REPEAT_MASK
#define REPEAT_MASK 0
#endif
template <int PH, bool DRY = false>
__device__ __forceinline__ void run_phase(Frame& F, const Args& args) {
    unsigned char* const ws = args.ws;
    pg8::bf16_t* const HB = (pg8::bf16_t*)(ws + WS_HB); pg8::bf16_t* const QB = (pg8::bf16_t*)(ws + WS_Q); pg8::bf16_t* const KB = (pg8::bf16_t*)(ws + WS_K);
    pg8::bf16_t* const VB = (pg8::bf16_t*)(ws + WS_V); pg8::bf16_t* const OB = (pg8::bf16_t*)(ws + WS_O); pg8::bf16_t* const UB = (pg8::bf16_t*)(ws + WS_U);
    float* const SS = (float*)(ws + WS_SS); float* const H = args.out + O_Y;
    if constexpr (PH == 0) p0_prologue(F, args);
    if constexpr (PH == 1) {
        pg8::Gemm g{HB, (const pg8::bf16_t*)(ws + WS_WQKV), M, 3072, 1024}; pg8::StaticOrder S; S.init(MP, 3072, F.G, (int)blockIdx.x);
        pg8::RsTab RSA{nullptr, 0, 0}, RSB{nullptr, 0, 0};
        { LAS float* rst = (LAS float*)(F.lds + RS_OFF); pg8::Unit u0; const int tile_ = F.vcu;
          if (S.next(0, u0)) { pg8::rs_fill(SS, rst, u0.pm * 256, 256); RSA = pg8::RsTab{rst, u0.pm * 256, 256}; }
          if (tile_ < 8 * (g.N / 128)) { pg8::rs_fill(SS, rst + 256, MP + (tile_ % 8) * 128, 128); RSB = pg8::RsTab{rst + 256, MP + (tile_ % 8) * 128, 128}; }
          __syncthreads(); }
        pg8::EpiQKV E{SS, (const float*)(ws + WS_CS), QB, KB, VB, args.out, RSA, RSB};
        pg8::gemm_phase<pg8::EpiQKV, pg8::StaticOrder, true, true>(F.lds + RING_OFF, g, S, E);
        pg8::gemm_small<pg8::GeoS128, pg8::EpiQKV>(F.lds + RING_OFF, g.A, g.Bt, g.K, MP, 8, g.N / 128, F.vcu, F.G, E);
    }
    if constexpr (PH == 2) {
        at::Ctx C{QB, KB, VB, OB, args.in[2], args.in[3], args.in[8], args.in[9], nullptr, (void*)(ws + WS_CTL + 64)};
#ifndef AS_REPS
#define AS_REPS 1
#endif
#ifndef AP_REPS
#define AP_REPS 1
#endif
        for (int vv = F.vcu; vv < 256; vv += F.G) {
            const int x = vv >> 5, c = vv & 31, u = c & 15, par = x & 1;
#pragma unroll 1
            for (int i = 0; i < 5; ++i) {
                const int j = par ? ((i + 1) % 5) : i;
                if (j == 0) { for (int r_ = 0; r_ < AS_REPS; ++r_) at::attn_sample_unit<false>(F.lds, vv >> 3, vv & 7, C); }
                else { const int r = j - 1, bh = r * 16 + x * 2 + (c >> 4), ub = (r & 1) ? 15 - u : u; for (int r_ = 0; r_ < AP_REPS; ++r_) at::attn_prompt_unit<false>(F.lds, bh >> 3, bh & 7, ub, C); }
            }
        }
    }
    if constexpr (PH == 3 || PH == 8) {
        pg8::Gemm g{OB, (const pg8::bf16_t*)(ws + (PH == 3 ? WS_WAO : WS_WBO)), M, 1024, 1024}; pg8::StaticOrder S; S.init(MP, 1024, F.G, (int)blockIdx.x);
        pg8::EpiRes E{HB, SS, DRY ? 0.f : 1.f};
        pg8::gemm_phase<pg8::EpiRes, pg8::StaticOrder, true, true>(F.lds + RING_OFF, g, S, E);
        pg8::gemm_small<pg8::GeoS64, pg8::EpiRes>(F.lds + RING_OFF, g.A, g.Bt, g.K, MP, 16, g.N / 64, F.vcu, F.G, E);
    }
    if constexpr (PH == 4 || PH == 9) {
        pg8::Gemm g{HB, (const pg8::bf16_t*)(ws + WS_W1 + (PH == 9 ? 8 * MiB : 0)), M, FF, 1024}; pg8::StaticOrder S; S.init(MP, FF, F.G, (int)blockIdx.x);
        pg8::RsTab RSA{nullptr, 0, 0}, RSB{nullptr, 0, 0};
        { LAS float* rst = (LAS float*)(F.lds + RS_OFF); pg8::Unit u0; const int tile_ = F.vcu;
          if (S.next(0, u0)) { pg8::rs_fill(SS, rst, u0.pm * 256, 256); RSA = pg8::RsTab{rst, u0.pm * 256, 256}; }
          if (tile_ < 8 * (g.N / 128)) { pg8::rs_fill(SS, rst + 256, MP + (tile_ % 8) * 128, 128); RSB = pg8::RsTab{rst + 256, MP + (tile_ % 8) * 128, 128}; }
          __syncthreads(); }
        pg8::EpiFF1 E{SS, UB, FF, RSA, RSB};
        pg8::gemm_phase<pg8::EpiFF1, pg8::StaticOrder, true, true>(F.lds + RING_OFF, g, S, E);
#ifndef SMALL_REPS
#define SMALL_REPS 1
#endif
#ifndef BIG_REPS
#define BIG_REPS 0
#endif
        for (int sr_ = 0; sr_ < BIG_REPS; ++sr_) pg8::gemm_phase<pg8::EpiFF1, pg8::StaticOrder, true, true>(F.lds + RING_OFF, g, S, E);
        for (int sr_ = 0; sr_ < SMALL_REPS; ++sr_) pg8::gemm_small<pg8::GeoS128, pg8::EpiFF1>(F.lds + RING_OFF, g.A, g.Bt, g.K, MP, 8, g.N / 128, F.vcu, F.G, E);
    }
    if constexpr (PH == 5 || PH == 10) {
        pg8::Gemm g{UB, (const pg8::bf16_t*)(ws + WS_W2 + (PH == 10 ? 8 * MiB : 0)), M, 1024, FF}; pg8::StaticOrder S; S.init(MP, 1024, F.G, (int)blockIdx.x);
        pg8::EpiRes E{HB, SS, DRY ? 0.f : 1.f};
        pg8::gemm_phase<pg8::EpiRes, pg8::StaticOrder, true, true>(F.lds + RING_OFF, g, S, E);
        pg8::gemm_small<pg8::GeoS64, pg8::EpiRes>(F.lds + RING_OFF, g.A, g.Bt, g.K, MP, 16, g.N / 64, F.vcu, F.G, E);
    }
    if constexpr (PH == 6) {
        pg8::Gemm g{HB, (const pg8::bf16_t*)(ws + WS_WKVQ), M, 3072, 1024}; pg8::StaticOrder S; S.init(MP, 3072, F.G, (int)blockIdx.x);
        pg8::RsTab RSA{nullptr, 0, 0}, RSB{nullptr, 0, 0};
        { LAS float* rst = (LAS float*)(F.lds + RS_OFF); pg8::Unit u0; const int tile_ = F.vcu;
          if (S.next(0, u0)) { pg8::rs_fill(SS, rst, u0.pm * 256, 256); RSA = pg8::RsTab{rst, u0.pm * 256, 256}; }
          if (tile_ < 8 * (g.N / 128)) { pg8::rs_fill(SS, rst + 256, MP + (tile_ % 8) * 128, 128); RSB = pg8::RsTab{rst + 256, MP + (tile_ % 8) * 128, 128}; }
          __syncthreads(); }
        pg8::EpiKVQ E{SS, QB, KB, args.out, RSA, RSB};
#ifdef KVQ_BIG_REPS
        for (int sr_ = 0; sr_ < KVQ_BIG_REPS; ++sr_) pg8::gemm_phase<pg8::EpiKVQ, pg8::StaticOrder, true, true>(F.lds + RING_OFF, g, S, E);
#endif
#ifdef KVQ_SMALL_REPS
        for (int sr_ = 0; sr_ < KVQ_SMALL_REPS; ++sr_) pg8::gemm_small<pg8::GeoS128, pg8::EpiKVQ>(F.lds + RING_OFF, g.A, g.Bt, g.K, MP, 8, g.N / 128, F.vcu, F.G, E);
#endif
        pg8::gemm_phase<pg8::EpiKVQ, pg8::StaticOrder, true, true>(F.lds + RING_OFF, g, S, E);
        pg8::gemm_small<pg8::GeoS128, pg8::EpiKVQ>(F.lds + RING_OFF, g.A, g.Bt, g.K, MP, 8, g.N / 128, F.vcu, F.G, E);
    }
    if constexpr (PH == 11) final_norm(F, args);
    if constexpr (PH == 7) {
        at::Ctx C{QB, KB, VB, OB, args.in[4], args.in[5], nullptr, nullptr, args.in[14], (void*)(ws + WS_CTL + 64)};
#ifndef BS_REPS
#define BS_REPS 1
#endif
#ifndef BP_REPS
#define BP_REPS 1
#endif
        for (int vv = F.vcu; vv < 256; vv += F.G) {
            const int x = vv >> 5, c = vv & 31, u = c & 15;
#pragma unroll 1
            for (int i = 0; i < 4 * BP_REPS; ++i) { const int k_ = i & 3, bhh = vv >> 1, par = vv & 1, qb = 4 * (k_ >> 1) + ((k_ & 1) ? 3 - par : par); at::attn_prompt_unit<true>(F.lds, bhh >> 4, bhh & 15, qb, C); }
#pragma unroll 1
            for (int i = 0; i < BS_REPS; ++i) at::attn_sample_unit<true>(F.lds, vv >> 3, vv & 7, C);
        }
    }
}
__global__ void __launch_bounds__(NWAVES * 64, 2) skel_fwd(Args args) {
    extern __shared__ __attribute__((aligned(16))) unsigned char lds[];
    Frame F;
    F.lds = (LAS unsigned char*)lds;
    F.MISC = (volatile LAS unsigned*)(F.lds + MISC_OFF);
    F.tid = threadIdx.x; F.lane = F.tid & 63; F.wave = __builtin_amdgcn_readfirstlane(F.tid >> 6);
    F.G = gridDim.x; { const int bx = blockIdx.x; F.vcu = (F.G % 8 == 0) ? (bx % 8) * (F.G / 8) + bx / 8 : bx; }
    F.ctl = (gu32*)(args.ws + WS_CTL);
    for (int u = F.tid; u < (LDS_BYTES - LDSCTL_OFF) / 4; u += NWAVES * 64) ((LAS unsigned*)(F.lds + LDSCTL_OFF))[u] = 0u;
    __syncthreads();
    XcdBarrier bar = xcd_barrier_post((unsigned*)(F.ctl + CW_BAR), F.MISC + 8);
#ifdef PROBE_BARSTAMP
    unsigned long long bar_acc = 0;
#define RT_STAMP(v) asm volatile("s_memrealtime %0\n\ts_waitcnt lgkmcnt(0)" : "=s"(v) :: "memory")
#define TIMED_BAR(k) do { unsigned long long b0_, b1_; RT_STAMP(b0_); xcd_barrier(bar); RT_STAMP(b1_); if (((PROBE_BARSTAMP) >> (k)) & 1) bar_acc += b1_ - b0_; } while (0)
#elif defined(PROBE_DBLBAR)
#define TIMED_BAR(k) do { xcd_barrier(bar); xcd_barrier(bar); } while (0)
#else
#define TIMED_BAR(k) xcd_barrier(bar)
#endif
#define DO_PHASE(k) do { if constexpr (((PHASE_MASK) >> (k)) & 1) { run_phase<k>(F, args); \
        if constexpr (((REPEAT_MASK) >> (k)) & 1) { xcd_barrier(bar); run_phase<k, true>(F, args); } \
        if constexpr ((k) != N_PHASES - 1) TIMED_BAR(k); } } while (0)
    DO_PHASE(0); DO_PHASE(1); DO_PHASE(2); DO_PHASE(3); DO_PHASE(4); DO_PHASE(5); DO_PHASE(6); DO_PHASE(7); DO_PHASE(8); DO_PHASE(9); DO_PHASE(10); DO_PHASE(11);
#undef DO_PHASE
#ifdef PROBE_BARSTAMP
    if (blockIdx.x == PROBE_BLK && F.tid == 0) { const unsigned long long t0 = __builtin_amdgcn_s_memrealtime(); while (__builtin_amdgcn_s_memrealtime() - t0 < bar_acc) __builtin_amdgcn_s_sleep(8); }
#endif
#ifdef PROBE_STAMP
    if (blockIdx.x == 0 && F.tid == 0) { const unsigned long long v = __hip_atomic_load((unsigned long long*)(args.ws + WS_CTL + 64), __ATOMIC_RELAXED, __HIP_MEMORY_SCOPE_AGENT); const unsigned long long t0 = __builtin_amdgcn_s_memrealtime(); while (__builtin_amdgcn_s_memrealtime() - t0 < v / PROBE_DIV) __builtin_amdgcn_s_sleep(8); }
#endif
}

extern "C" void kernel_launch(void* const* d_in, const int* in_sizes, int n_in, void* d_out, int out_size, void* d_ws, size_t ws_size, hipStream_t stream) {
    static int grid = 0;
    if (grid == 0) {
        if (n_in != 20 || out_size != (int)O_END || ws_size < WS_END) { fprintf(stderr, "kernel_launch: unexpected problem (n_in %d out %d ws %zu)\n", n_in, out_size, ws_size); grid = -1; return; }
        int dev = 0, cus = 0, per_cu = 0;
        if (hipGetDevice(&dev) != hipSuccess || hipDeviceGetAttribute(&cus, hipDeviceAttributeMultiprocessorCount, dev) != hipSuccess) { grid = -1; return; }
        if (hipFuncSetAttribute((const void*)skel_fwd, hipFuncAttributeMaxDynamicSharedMemorySize, LDS_BYTES) != hipSuccess) { fprintf(stderr, "kernel_launch: hipFuncSetAttribute failed\n"); grid = -1; return; }
        if (hipOccupancyMaxActiveBlocksPerMultiprocessor(&per_cu, (const void*)skel_fwd, NWAVES * 64, LDS_BYTES) != hipSuccess || per_cu < 1) { fprintf(stderr, "kernel_launch: occupancy query reports %d\n", per_cu); per_cu = 1; }
        (void)hipGetLastError();
        grid = cus;
        if (grid > 256) grid = 256;
    }
    if (grid < 0) return;
    (void)hipMemsetAsync((char*)d_ws + WS_CTL, 0, CTL_ZERO_BYTES, stream);
    Args a{};
    for (int i = 0; i < 20; ++i) a.in[i] = (const float*)d_in[i];
    a.out = (float*)d_out; a.ws = (unsigned char*)d_ws;
    hipLaunchKernelGGL(skel_fwd, dim3(grid), dim3(NWAVES * 64), LDS_BYTES, stream, a);
}
```

```cpp
#include <hip/hip_runtime.h>
#include <cstdio>
#include <cstdint>
#include <cmath>
namespace pg8 {
__device__ __forceinline__ int opaque_tid() { int t = threadIdx.x; asm volatile("" : "+v"(t)); return t; }
#define PG8_LAS __attribute__((address_space(3)))
typedef unsigned short bf16_t;
typedef short bf16x8 __attribute__((ext_vector_type(8)));
typedef float f32x4 __attribute__((ext_vector_type(4)));
typedef unsigned u32x4 __attribute__((ext_vector_type(4)));
constexpr int BM = 256, BK = 64, HALF = 128, HTB = HALF * BK * 2  , STAGE_BYTES = 8 * HTB, NXCD = 8, WGM = 8;

__host__ __device__ __forceinline__ int lds_byte(int r, int c) { const int st = (r >> 4) * 2 + (c >> 5), rr = r & 15, cc = c & 31, ob = rr * 64 + cc * 2; return st * 1024 + (ob ^ (((ob >> 9) & 1) << 5)); }
__host__ __device__ __forceinline__ void stage_rc(int b, int& R, int& C) { const int st = b / 1024, sb = b % 1024, swz = sb ^ (((sb >> 9) & 1) << 5); R = (st >> 1) * 16 + swz / 64; C = (st & 1) * 32 + (swz % 64) / 2; }
__host__ __device__ __forceinline__ int perm32(int rho) { const int n = rho >> 4, i = rho & 15; return 8 * (i >> 2) + 4 * n + (i & 3); }

struct Unit { int pm, pn; };
struct Gemm { const bf16_t* A; const bf16_t* Bt; int M, N, K; };

struct StaticOrder {
    int nM, nN, nwg, G, c;
    __host__ __device__ void init(int M, int N, int G_, int c_) { nM = M / BM; nN = N / BM; nwg = nM * nN; G = G_; c = c_; }
    __host__ __device__ bool next(int i, Unit& u) const {
        const long L = (long)i * G + c; if (L >= nwg) return false;
        int wgid = (int)L; { const int q = nwg / NXCD, r = nwg % NXCD, xcd = wgid % NXCD, off = wgid / NXCD; wgid = (xcd < r ? xcd * (q + 1) : r * (q + 1) + (xcd - r) * q) + off; }
        const int nig = WGM * nN, gid = wgid / nig, fm = gid * WGM, gsz = (nM - fm) < WGM ? (nM - fm) : WGM;
        u.pm = fm + ((wgid % nig) % gsz); u.pn = (wgid % nig) / gsz; return true;
    }
    __device__ __forceinline__ void a_ready(const Unit&) const {}
    __device__ __forceinline__ void done(const Unit&) const {}
};
__device__ __forceinline__ unsigned cvt_pk_bf16(float lo, float hi) { unsigned r; asm volatile("v_cvt_pk_bf16_f32 %0, %1, %2" : "=v"(r) : "v"(lo), "v"(hi)); return r; }
typedef float f32x2 __attribute__((ext_vector_type(2)));

constexpr size_t PO_AKP = 17825792, PO_AVP = 34603008, PO_BKP = 51380224, PO_BVP = 55574528, PO_AKS = 59768832, PO_AVS = 60817408, PO_BKS = 61865984, PO_BVS = 62914560;
constexpr size_t PW_KV = (size_t)36 * 1048576 / 2;
constexpr int P_MP = 16384;
constexpr float P_EPS = 1e-6f;
constexpr float P_C2 = 0.125f * 1.4426950408889634f;
typedef unsigned u32x2 __attribute__((ext_vector_type(2)));
struct GeoBig  { static constexpr int NAI = 2, NBJ = 2, NM = 4, NN = 2, RS_WR = 64, CS_WC = 32, WCN = 4; };
struct GeoS128 { static constexpr int NAI = 1, NBJ = 1, NM = 4, NN = 2, RS_WR = 64, CS_WC = 32, WCN = 4; };
struct GeoS64  { static constexpr int NAI = 1, NBJ = 1, NM = 1, NN = 2, RS_WR = 16, CS_WC = 32, WCN = 2; };
struct Tile { int row0, col0; };

template <class G>
__device__ __forceinline__ void row_rstd(const float* SS, int row0, int fq, float (&rs)[2][4]) {
#pragma unroll
    for (int ai = 0; ai < G::NAI; ++ai)
#pragma unroll
        for (int m = 0; m < G::NM; ++m) {
            const f32x4 v = *(const f32x4*)(SS + (size_t)(row0 + ai * HALF + m * 16) * 16 + 4 * fq);
            float s = (v[0] + v[1]) + (v[2] + v[3]);
            s += __shfl_xor(s, 16); s += __shfl_xor(s, 32);
            rs[ai][m] = 1.0f / sqrtf(s * (1.0f / 1024.0f) + P_EPS);
        }
}
struct RsTab { PG8_LAS const float* t; int row0, nrows; };
__device__ __forceinline__ void rs_fill(const float* SS, PG8_LAS float* t, int row0, int nrows) {
    const int r = threadIdx.x;
    if (r < nrows) {
        const f32x4* p = (const f32x4*)(SS + (size_t)(row0 + r) * 16);
        const f32x4 a = p[0], b = p[1], c = p[2], d = p[3];
        const float s = (((a[0] + a[1]) + (a[2] + a[3])) + ((b[0] + b[1]) + (b[2] + b[3]))) + (((c[0] + c[1]) + (c[2] + c[3])) + ((d[0] + d[1]) + (d[2] + d[3])));
        t[r] = 1.0f / sqrtf(s * (1.0f / 1024.0f) + P_EPS);
    }
}
template <class G>
__device__ __forceinline__ void row_rstd_tab(const RsTab& R, const float* SS, int tile_row0, int row0, int fq, float (&rs)[2][4]) {
    if (tile_row0 >= R.row0 && tile_row0 + (G::NAI == 2 ? 256 : 128) <= R.row0 + R.nrows) {
#pragma unroll
        for (int ai = 0; ai < G::NAI; ++ai)
#pragma unroll
            for (int m = 0; m < G::NM; ++m) rs[ai][m] = R.t[row0 - R.row0 + ai * HALF + m * 16];
    } else row_rstd<G>(SS, row0, fq, rs);
}

struct EpiQKV {
    static constexpr bool PERM = false, AFTER_DRAIN = false;
    const float* SS; const float* cs;
    bf16_t *Qb, *Kb, *Vb; float* out;
    RsTab rsA, rsB;
    __device__ __forceinline__ void operator()(const f32x4 (&acc)[2][2][4][2], const Unit& u, int wr, int wc, int fr, int fq) const { run<GeoBig>(acc, Tile{u.pm * BM, u.pn * BM}, wr, wc, fr, fq, nullptr); }
    template <class G> __device__ __forceinline__ void run(const f32x4 (&acc)[2][2][4][2], const Tile T, int wr, int wc, int fr, int fq, PG8_LAS float* scr) const {
        const int row0 = T.row0 + wr * G::RS_WR + fr;
        float rs[2][4]; row_rstd_tab<G>(G::NAI == 2 ? rsA : rsB, SS, T.row0, row0, fq, rs);
        const int sec = T.col0 >> 10, ct = T.col0 & 1023;
        const bool smp = T.row0 >= P_MP;
#pragma unroll
        for (int ai = 0; ai < G::NAI; ++ai)
#pragma unroll
            for (int m = 0; m < G::NM; ++m) {
                const int row = row0 + ai * HALF + m * 16; const float r = rs[ai][m];
                const int pos = smp ? (1024 + ((row - P_MP) & 31)) : (row & 2047);
                const size_t orow = smp ? (size_t)(row - P_MP) * 1024 : (size_t)row * 1024;
                if (sec < 2) {
                    const int dl = 16 * (wc & 1) + 4 * fq;
                    const f32x4 c4 = *(const f32x4*)(cs + (size_t)pos * 64 + dl), s4 = *(const f32x4*)(cs + (size_t)pos * 64 + 32 + dl);
#pragma unroll
                    for (int bj = 0; bj < G::NBJ; ++bj) {
                        const int col = ct + 128 * bj + 64 * (wc >> 1) + dl;
                        const f32x4 x1 = acc[ai][bj][m][0] * r, x2 = acc[ai][bj][m][1] * r;
                        f32x4 y1 = x1 * c4 - x2 * s4, y2 = x2 * c4 + x1 * s4;
                        if (sec == 0) {
                            y1 = y1 * P_C2; y2 = y2 * P_C2;
                            u32x2 w1, w2; w1.x = cvt_pk_bf16(y1[0], y1[1]); w1.y = cvt_pk_bf16(y1[2], y1[3]); w2.x = cvt_pk_bf16(y2[0], y2[1]); w2.y = cvt_pk_bf16(y2[2], y2[3]);
                            *(u32x2*)(Qb + (size_t)row * 1024 + col) = w1; *(u32x2*)(Qb + (size_t)row * 1024 + col + 32) = w2;
                        } else {
                            float* ok = out + (smp ? PO_AKS : PO_AKP) + orow + col;
                            *(f32x4*)ok = y1; *(f32x4*)(ok + 32) = y2;
                            u32x2 w1, w2; w1.x = cvt_pk_bf16(y1[0], y1[1]); w1.y = cvt_pk_bf16(y1[2], y1[3]); w2.x = cvt_pk_bf16(y2[0], y2[1]); w2.y = cvt_pk_bf16(y2[2], y2[3]);
                            *(u32x2*)(Kb + (size_t)row * 1024 + col) = w1; *(u32x2*)(Kb + (size_t)row * 1024 + col + 32) = w2;
                        }
                    }
                } else {
#pragma unroll
                    for (int bj = 0; bj < G::NBJ; ++bj)
#pragma unroll
                        for (int n = 0; n < G::NN; ++n) {
                            const int col = ct + 128 * bj + G::CS_WC * wc + 16 * n + 4 * fq;
                            const f32x4 v = acc[ai][bj][m][n] * r;
                            *(f32x4*)(out + (smp ? PO_AVS : PO_AVP) + orow + col) = v;
                            u32x2 w; w.x = cvt_pk_bf16(v[0], v[1]); w.y = cvt_pk_bf16(v[2], v[3]);
                            *(u32x2*)(Vb + (size_t)row * 1024 + col) = w;
                        }
                }
            }
    }
};

struct EpiKVQ {
    static constexpr bool PERM = true, AFTER_DRAIN = false;
    const float* SS; bf16_t *Qb, *Kb; float* out;
    RsTab rsA, rsB;
    __device__ __forceinline__ void operator()(const f32x4 (&acc)[2][2][4][2], const Unit& u, int wr, int wc, int fr, int fq) const { run<GeoBig>(acc, Tile{u.pm * BM, u.pn * BM}, wr, wc, fr, fq, nullptr); }
    template <class G> __device__ __forceinline__ void run(const f32x4 (&acc)[2][2][4][2], const Tile T, int wr, int wc, int fr, int fq, PG8_LAS float* scr) const {
        const int row0 = T.row0 + wr * G::RS_WR + fr;
        float rs[2][4]; row_rstd_tab<G>(G::NAI == 2 ? rsA : rsB, SS, T.row0, row0, fq, rs);
        const int sec = T.col0 >> 10, ct = T.col0 & 1023;
        const bool smp = T.row0 >= P_MP;
        const bool keep = smp || (((T.row0 >> 8) & 7) >= 6);
        const int col0 = ct + wc * 32 + 8 * fq;
#pragma unroll
        for (int ai = 0; ai < G::NAI; ++ai)
#pragma unroll
            for (int m = 0; m < G::NM; ++m) {
                const int row = row0 + ai * HALF + m * 16; const float r = rs[ai][m];
                const size_t orow = smp ? (size_t)(row - P_MP) * 1024 : ((size_t)(row >> 11) * 512 + (size_t)((row & 2047) - 1536)) * 1024;
#pragma unroll
                for (int bj = 0; bj < G::NBJ; ++bj) {
                    const int col = col0 + bj * HALF;
                    f32x4 v0 = acc[ai][bj][m][0] * r, v1 = acc[ai][bj][m][1] * r;
                    if (sec == 2) {
                        v0 = v0 * P_C2; v1 = v1 * P_C2;
                        u32x4 w; w.x = cvt_pk_bf16(v0[0], v0[1]); w.y = cvt_pk_bf16(v0[2], v0[3]); w.z = cvt_pk_bf16(v1[0], v1[1]); w.w = cvt_pk_bf16(v1[2], v1[3]);
                        *(u32x4*)(Qb + (size_t)row * 1024 + col) = w;
                    } else {
                        if (keep) { float* op = out + (sec == 0 ? (smp ? PO_BKS : PO_BKP) : (smp ? PO_BVS : PO_BVP)) + orow + col; *(f32x4*)op = v0; *(f32x4*)(op + 4) = v1; }
                        u32x4 w; w.x = cvt_pk_bf16(v0[0], v0[1]); w.y = cvt_pk_bf16(v0[2], v0[3]); w.z = cvt_pk_bf16(v1[0], v1[1]); w.w = cvt_pk_bf16(v1[2], v1[3]);
                        *(u32x4*)(Kb + (sec == 0 ? (size_t)0 : PW_KV) + (size_t)row * 1024 + col) = w;
                    }
                }
            }
    }
};

struct EpiRes {
    static constexpr bool PERM = true, AFTER_DRAIN = false;
    bf16_t* Hb; float* SS; float sc;
    __device__ __forceinline__ void operator()(const f32x4 (&acc)[2][2][4][2], const Unit& u, int wr, int wc, int fr, int fq) const { run<GeoBig>(acc, Tile{u.pm * BM, u.pn * BM}, wr, wc, fr, fq, nullptr); }
    template <class G> __device__ __forceinline__ void run(const f32x4 (&acc)[2][2][4][2], const Tile T, int wr, int wc, int fr, int fq, PG8_LAS float* scr) const {
        const int row0 = T.row0 + wr * G::RS_WR + fr, col0 = T.col0 + wc * 32 + 8 * fq;
#pragma unroll
        for (int ai = 0; ai < G::NAI; ++ai)
#pragma unroll
            for (int m = 0; m < G::NM; ++m) {
                const int row = row0 + ai * HALF + m * 16;
                float ssq = 0.f;
#pragma unroll
                for (int bj = 0; bj < G::NBJ; ++bj) {
                    bf16_t* p = Hb + (size_t)row * 1024 + col0 + bj * HALF;
                    const u32x4 o = *(const u32x4*)p;
                    f32x4 h0 = acc[ai][bj][m][0] * sc, h1 = acc[ai][bj][m][1] * sc;
                    h0[0] += __uint_as_float(o.x << 16); h0[1] += __uint_as_float(o.x & 0xffff0000u); h0[2] += __uint_as_float(o.y << 16); h0[3] += __uint_as_float(o.y & 0xffff0000u);
                    h1[0] += __uint_as_float(o.z << 16); h1[1] += __uint_as_float(o.z & 0xffff0000u); h1[2] += __uint_as_float(o.w << 16); h1[3] += __uint_as_float(o.w & 0xffff0000u);
                    u32x4 w; w.x = cvt_pk_bf16(h0[0], h0[1]); w.y = cvt_pk_bf16(h0[2], h0[3]); w.z = cvt_pk_bf16(h1[0], h1[1]); w.w = cvt_pk_bf16(h1[2], h1[3]);
                    *(u32x4*)p = w;
                    ssq += ((h0[0] * h0[0] + h0[1] * h0[1]) + (h0[2] * h0[2] + h0[3] * h0[3])) + ((h1[0] * h1[0] + h1[1] * h1[1]) + (h1[2] * h1[2] + h1[3] * h1[3]));
                }
                ssq += __shfl_xor(ssq, 16); ssq += __shfl_xor(ssq, 32);
                if (G::WCN == 4) { if (fq == 0) SS[(size_t)row * 16 + (T.col0 >> 8) * 4 + wc] = ssq; }
                else { if (fq == 0) scr[(wr * G::RS_WR + m * 16 + fr) * 2 + wc] = ssq; }
            }
        if (G::WCN != 4) {
            __syncthreads();
            const int t_ = threadIdx.x;
            if (t_ < 64) SS[(size_t)(T.row0 + t_) * 16 + (T.col0 >> 6)] = scr[t_ * 2] + scr[t_ * 2 + 1];
            __syncthreads();
        }
    }
};

struct EpiResFinal {
    static constexpr bool PERM = true, AFTER_DRAIN = true;
    const bf16_t* Hb; float* SS; float* out; const float* gf; unsigned* cnt; unsigned* tmo;
    __device__ __forceinline__ void fused(f32x4 (&acc)[2][2][4][2], const Unit& u, int wr, int wc, int fr, int fq, PG8_LAS unsigned char* lds, int wid, int lane) const { run<GeoBig>(acc, Tile{u.pm * BM, u.pn * BM}, wr, wc, fr, fq, (PG8_LAS float*)lds); }
    template <class G> __device__ __forceinline__ void run(f32x4 (&acc)[2][2][4][2], const Tile T, int wr, int wc, int fr, int fq, PG8_LAS float* scr) const {
        const int row0 = T.row0 + wr * G::RS_WR + fr, col0 = T.col0 + wc * 32 + 8 * fq;
        const int tid = threadIdx.x, lane = tid & 63, wid = __builtin_amdgcn_readfirstlane(tid >> 6);
#pragma unroll
        for (int ai = 0; ai < G::NAI; ++ai)
#pragma unroll
            for (int m = 0; m < G::NM; ++m) {
                const int row = row0 + ai * HALF + m * 16;
                float ssq = 0.f;
#pragma unroll
                for (int bj = 0; bj < G::NBJ; ++bj) {
                    const u32x4 o = *(const u32x4*)(Hb + (size_t)row * 1024 + col0 + bj * HALF);
                    f32x4 h0 = acc[ai][bj][m][0], h1 = acc[ai][bj][m][1];
                    h0[0] += __uint_as_float(o.x << 16); h0[1] += __uint_as_float(o.x & 0xffff0000u); h0[2] += __uint_as_float(o.y << 16); h0[3] += __uint_as_float(o.y & 0xffff0000u);
                    h1[0] += __uint_as_float(o.z << 16); h1[1] += __uint_as_float(o.z & 0xffff0000u); h1[2] += __uint_as_float(o.w << 16); h1[3] += __uint_as_float(o.w & 0xffff0000u);
                    acc[ai][bj][m][0] = h0; acc[ai][bj][m][1] = h1;
                    ssq += ((h0[0] * h0[0] + h0[1] * h0[1]) + (h0[2] * h0[2] + h0[3] * h0[3])) + ((h1[0] * h1[0] + h1[1] * h1[1]) + (h1[2] * h1[2] + h1[3] * h1[3]));
                }
                ssq += __shfl_xor(ssq, 16); ssq += __shfl_xor(ssq, 32);
                if (G::WCN == 4) { if (fq == 0) __hip_atomic_store(SS + (size_t)row * 16 + (T.col0 >> 8) * 4 + wc, ssq, __ATOMIC_RELAXED, __HIP_MEMORY_SCOPE_AGENT); }
                else { if (fq == 0) scr[(wr * G::RS_WR + m * 16 + fr) * 2 + wc] = ssq; }
            }
        unsigned* c; unsigned want;
        if (G::WCN == 4) {
            c = cnt + 64 * (T.row0 >> 8); want = 32u;
            asm volatile("s_waitcnt vmcnt(0)" ::: "memory");
            if (lane == 0) __hip_atomic_fetch_add(c, 1u, __ATOMIC_RELAXED, __HIP_MEMORY_SCOPE_AGENT);
        } else {
            c = cnt + 64 * (64 + ((T.row0 - P_MP) >> 6)); want = 16u;
            __syncthreads();
            if (tid < 64) __hip_atomic_store(SS + (size_t)(T.row0 + tid) * 16 + (T.col0 >> 6), scr[tid * 2] + scr[tid * 2 + 1], __ATOMIC_RELAXED, __HIP_MEMORY_SCOPE_AGENT);
            asm volatile("s_waitcnt vmcnt(0)" ::: "memory");
            if (tid == 0) __hip_atomic_fetch_add(c, 1u, __ATOMIC_RELAXED, __HIP_MEMORY_SCOPE_AGENT);
        }
        if (wid == 0) {
            const unsigned long long t0 = __builtin_amdgcn_s_memrealtime();
            for (;;) {
                if ((unsigned)__builtin_amdgcn_readfirstlane((int)__hip_atomic_load(c, __ATOMIC_RELAXED, __HIP_MEMORY_SCOPE_AGENT)) >= want) break;
                if (__builtin_amdgcn_s_memrealtime() - t0 > 2000000ull) { if (lane == 0) __hip_atomic_store(tmo, 1u, __ATOMIC_RELAXED, __HIP_MEMORY_SCOPE_AGENT); break; }
                __builtin_amdgcn_s_sleep(2);
            }
            __builtin_amdgcn_fence(__ATOMIC_ACQUIRE, "agent");
            asm volatile("s_waitcnt vmcnt(0)" ::: "memory");
        }
        __syncthreads();
        f32x4 gv[2][2];
#pragma unroll
        for (int bj = 0; bj < G::NBJ; ++bj) { gv[bj][0] = *(const f32x4*)(gf + col0 + bj * HALF); gv[bj][1] = *(const f32x4*)(gf + col0 + bj * HALF + 4); }
#pragma unroll
        for (int ai = 0; ai < G::NAI; ++ai)
#pragma unroll
            for (int m = 0; m < G::NM; ++m) {
                const int row = row0 + ai * HALF + m * 16;
                const f32x4 v = *(const f32x4*)(SS + (size_t)row * 16 + 4 * fq);
                float s = (v[0] + v[1]) + (v[2] + v[3]);
                s += __shfl_xor(s, 16); s += __shfl_xor(s, 32);
                const float r = 1.0f / sqrtf(s * (1.0f / 1024.0f) + P_EPS);
#pragma unroll
                for (int bj = 0; bj < G::NBJ; ++bj) { float* op = out + (size_t)row * 1024 + col0 + bj * HALF;
                    *(f32x4*)op = acc[ai][bj][m][0] * gv[bj][0] * r; *(f32x4*)(op + 4) = acc[ai][bj][m][1] * gv[bj][1] * r; }
            }
        if (G::WCN != 4) __syncthreads();
    }
};

struct EpiFF1 {
    static constexpr bool PERM = true, AFTER_DRAIN = false;
    const float* SS; bf16_t* U; int ldc;
    RsTab rsA, rsB;
    __device__ __forceinline__ void operator()(const f32x4 (&acc)[2][2][4][2], const Unit& u, int wr, int wc, int fr, int fq) const { run<GeoBig>(acc, Tile{u.pm * BM, u.pn * BM}, wr, wc, fr, fq, nullptr); }
    template <class G> __device__ __forceinline__ void run(const f32x4 (&acc)[2][2][4][2], const Tile T, int wr, int wc, int fr, int fq, PG8_LAS float* scr) const {
        const int row0 = T.row0 + wr * G::RS_WR + fr;
        float rs[2][4]; row_rstd_tab<G>(G::NAI == 2 ? rsA : rsB, SS, T.row0, row0, fq, rs);
        const int col0 = T.col0 + wc * 32 + 8 * fq;
#pragma unroll
        for (int ai = 0; ai < G::NAI; ++ai)
#pragma unroll
            for (int m = 0; m < G::NM; ++m) {
                const float r = rs[ai][m]; bf16_t* rowp = U + (size_t)(row0 + ai * HALF + m * 16) * ldc + col0;
#pragma unroll
                for (int bj = 0; bj < G::NBJ; ++bj) {
                    f32x4 v0 = acc[ai][bj][m][0] * r, v1 = acc[ai][bj][m][1] * r;
#pragma unroll
                    for (int i = 0; i < 4; ++i) { const float a = fmaxf(v0[i], 0.f), b = fmaxf(v1[i], 0.f); v0[i] = a * a; v1[i] = b * b; }
                    u32x4 w; w.x = cvt_pk_bf16(v0[0], v0[1]); w.y = cvt_pk_bf16(v0[2], v0[3]); w.z = cvt_pk_bf16(v1[0], v1[1]); w.w = cvt_pk_bf16(v1[2], v1[3]);
                    *(u32x4*)(rowp + bj * HALF) = w;
                }
            }
    }
};
template <class Epi, class Sched, bool ALIGN_EPI = false, bool SP2 = false>
__device__ __forceinline__ void gemm_phase(PG8_LAS unsigned char* lds, const Gemm g, const Sched& S, const Epi& E) {
    const int tid = opaque_tid(), wid = __builtin_amdgcn_readfirstlane(tid >> 6), lane = tid & 63, wr = wid >> 2, wc = wid & 3, fr = lane & 15, fq = lane >> 4;
    const int K = g.K, nt = K / BK;
    unsigned voffA[2], voffB[2];
#pragma unroll
    for (int i = 0; i < 2; ++i) { int R, C; stage_rc(tid * 16 + i * 8192, R, C); const int Rb = Epi::PERM ? ((R & ~31) + perm32(R & 31)) : R;
        voffA[i] = (unsigned)(R * K + C) * 2u; voffB[i] = (unsigned)(Rb * K + C) * 2u; }
    const size_t kstep = (size_t)(BK * 2);
    const size_t hstep = (size_t)HALF * K * 2;
    const size_t tstep = 2 * hstep;
    const unsigned ldsw = (unsigned)wid * 1024u;
    const int aoff = lds_byte(wr * 64 + fr, fq * 8), boff = lds_byte(wc * 32 + fr, fq * 8);
#define PG8_SA(b, h) (((b) * 2 + (h)) * HTB)
#define PG8_SB(b, h) ((4 + (b) * 2 + (h)) * HTB)
#define PG8_STAGE(bufoff, gbase, voff) do { _Pragma("unroll") for (int _i = 0; _i < 2; ++_i) \
        __builtin_amdgcn_global_load_lds((const unsigned*)((const char*)(gbase) + (voff)[_i]), (PG8_LAS unsigned*)(lds + (bufoff) + ldsw + _i * 8192), 16, 0, 0); } while (0)
#define PG8_LDA(dst, b, h) do { _Pragma("unroll") for (int m = 0; m < 4; ++m) _Pragma("unroll") for (int k = 0; k < 2; ++k) dst[m][k] = *(const PG8_LAS bf16x8*)(lds + PG8_SA(b, h) + aoff + m * 2048 + k * 1024); } while (0)
#define PG8_LDB(dst, b, h) do { _Pragma("unroll") for (int n = 0; n < 2; ++n) _Pragma("unroll") for (int k = 0; k < 2; ++k) dst[n][k] = *(const PG8_LAS bf16x8*)(lds + PG8_SB(b, h) + boff + n * 2048 + k * 1024); } while (0)
#define PG8_MMA(ai, bj, At, Bt) do { __builtin_amdgcn_s_setprio(1); _Pragma("unroll") for (int m = 0; m < 4; ++m) _Pragma("unroll") for (int n = 0; n < 2; ++n) _Pragma("unroll") for (int k = 0; k < 2; ++k) \
        acc[ai][bj][m][n] = __builtin_amdgcn_mfma_f32_16x16x32_bf16(Bt[n][k], At[m][k], acc[ai][bj][m][n], 0, 0, 0); __builtin_amdgcn_s_setprio(0); } while (0)
#define PG8_WAIT_V(n) asm volatile("s_waitcnt vmcnt(" #n ")" ::: "memory")
#define PG8_WAIT_L(n) asm volatile("s_waitcnt lgkmcnt(" #n ")" ::: "memory")
#define PG8_BAR __builtin_amdgcn_s_barrier()
#define PG8_SCHED __builtin_amdgcn_sched_barrier(0)
    Unit cur, nxt; int ui = 0;
    if (!S.next(0, cur)) return;
    f32x4 acc[2][2][4][2];
#pragma unroll
    for (int a = 0; a < 2; ++a)
#pragma unroll
        for (int b = 0; b < 2; ++b)
#pragma unroll
            for (int m = 0; m < 4; ++m)
#pragma unroll
                for (int n = 0; n < 2; ++n) acc[a][b][m][n] = (f32x4){0.f, 0.f, 0.f, 0.f};
    bf16x8 At[4][2], B0[2][2], B1[2][2];
    const char* cA = (const char*)g.A + (size_t)cur.pm * tstep; const char* cB = (const char*)g.Bt + (size_t)cur.pn * tstep;
    S.a_ready(cur);
    if constexpr (SP2) {
        PG8_STAGE(PG8_SB(0, 0), cB, voffB); PG8_STAGE(PG8_SB(0, 1), cB + hstep, voffB); PG8_STAGE(PG8_SA(0, 0), cA, voffA); PG8_STAGE(PG8_SA(0, 1), cA + hstep, voffA);
        if (wr == 1) PG8_BAR;
        PG8_WAIT_V(2); PG8_BAR;
        PG8_STAGE(PG8_SB(1, 0), cB + kstep, voffB); PG8_STAGE(PG8_SA(1, 0), cA + kstep, voffA); PG8_STAGE(PG8_SB(1, 1), cB + hstep + kstep, voffB);
        PG8_WAIT_V(6); PG8_BAR;
    } else {
        PG8_STAGE(PG8_SB(0, 0), cB, voffB); PG8_STAGE(PG8_SA(0, 0), cA, voffA); PG8_STAGE(PG8_SB(0, 1), cB + hstep, voffB); PG8_STAGE(PG8_SA(0, 1), cA + hstep, voffA);
        if (wr == 1) PG8_BAR;
        PG8_WAIT_V(4); PG8_BAR;
        PG8_STAGE(PG8_SB(1, 0), cB + kstep, voffB); PG8_STAGE(PG8_SA(1, 0), cA + kstep, voffA); PG8_STAGE(PG8_SB(1, 1), cB + hstep + kstep, voffB);
        PG8_WAIT_V(6); PG8_BAR;
    }
    for (;;) {
        const bool has_next = S.next(ui + 1, nxt);
        const char* nA = has_next ? (const char*)g.A + (size_t)nxt.pm * tstep : cA; const char* nB = has_next ? (const char*)g.Bt + (size_t)nxt.pn * tstep : cB;
        for (int t = 0; t < nt; t += 2) {
            const bool last = (t == nt - 2);
            const char* a1 = cA + (size_t)(t + 1) * kstep;
            const char* a2 = last ? nA : cA + (size_t)(t + 2) * kstep; const char* b2 = last ? nB : cB + (size_t)(t + 2) * kstep;
            const char* a3 = a2 + kstep; const char* b3 = b2 + kstep;
            if (last && has_next) S.a_ready(nxt);
            if constexpr (SP2) {
            PG8_LDB(B0, 0, 0); PG8_LDB(B1, 0, 1); PG8_SCHED; PG8_LDA(At, 0, 0); PG8_STAGE(PG8_SA(1, 1), a1 + hstep, voffA);
            PG8_WAIT_V(8); PG8_WAIT_L(0); PG8_BAR; PG8_MMA(0, 0, At, B0); PG8_MMA(0, 1, At, B1); PG8_BAR; PG8_SCHED;
            PG8_LDA(At, 0, 1); PG8_STAGE(PG8_SB(0, 0), b2, voffB); PG8_STAGE(PG8_SB(0, 1), b2 + hstep, voffB); PG8_STAGE(PG8_SA(0, 0), a2, voffA);
            PG8_WAIT_V(8); PG8_WAIT_L(0); PG8_BAR; PG8_MMA(1, 0, At, B0); PG8_MMA(1, 1, At, B1); PG8_BAR; PG8_SCHED;
            PG8_LDB(B0, 1, 0); PG8_LDB(B1, 1, 1); PG8_SCHED; PG8_LDA(At, 1, 0); PG8_STAGE(PG8_SA(0, 1), a2 + hstep, voffA);
            PG8_WAIT_V(8); PG8_WAIT_L(0); PG8_BAR; PG8_MMA(0, 0, At, B0); PG8_MMA(0, 1, At, B1); PG8_BAR; PG8_SCHED;
            PG8_LDA(At, 1, 1); PG8_STAGE(PG8_SB(1, 0), b3, voffB); PG8_STAGE(PG8_SB(1, 1), b3 + hstep, voffB); PG8_STAGE(PG8_SA(1, 0), a3, voffA);
            PG8_WAIT_V(8); PG8_WAIT_L(0); PG8_BAR; PG8_MMA(1, 0, At, B0); PG8_MMA(1, 1, At, B1); PG8_BAR; PG8_SCHED;
            } else {
            PG8_LDB(B0, 0, 0); PG8_SCHED; PG8_LDA(At, 0, 0); PG8_STAGE(PG8_SA(1, 1), a1 + hstep, voffA);
            PG8_WAIT_L(8); PG8_BAR; PG8_WAIT_L(0); PG8_MMA(0, 0, At, B0); PG8_BAR; PG8_SCHED;
            PG8_LDB(B1, 0, 1); PG8_STAGE(PG8_SB(0, 0), b2, voffB);
            PG8_BAR; PG8_WAIT_L(0); PG8_MMA(0, 1, At, B1); PG8_BAR;
            PG8_LDA(At, 0, 1); PG8_STAGE(PG8_SA(0, 0), a2, voffA);
            PG8_BAR; PG8_WAIT_L(0); PG8_MMA(1, 0, At, B0); PG8_BAR; PG8_SCHED;
            PG8_STAGE(PG8_SB(0, 1), b2 + hstep, voffB);
            PG8_WAIT_V(6); PG8_BAR; PG8_MMA(1, 1, At, B1); PG8_BAR;
            PG8_LDB(B0, 1, 0); PG8_SCHED; PG8_LDA(At, 1, 0); PG8_STAGE(PG8_SA(0, 1), a2 + hstep, voffA);
            PG8_WAIT_L(8); PG8_BAR; PG8_WAIT_L(0); PG8_MMA(0, 0, At, B0); PG8_BAR; PG8_SCHED;
            PG8_LDB(B1, 1, 1); PG8_STAGE(PG8_SB(1, 0), b3, voffB);
            PG8_BAR; PG8_WAIT_L(0); PG8_MMA(0, 1, At, B1); PG8_BAR;
            PG8_LDA(At, 1, 1); PG8_STAGE(PG8_SA(1, 0), a3, voffA);
            PG8_BAR; PG8_WAIT_L(0); PG8_MMA(1, 0, At, B0); PG8_BAR; PG8_SCHED;
            PG8_STAGE(PG8_SB(1, 1), b3 + hstep, voffB);
            PG8_WAIT_V(6); PG8_BAR; PG8_MMA(1, 1, At, B1); PG8_BAR;
            }
        }
        if constexpr (ALIGN_EPI) { if (wr == 0) PG8_BAR; }
        if constexpr (!Epi::AFTER_DRAIN) { E(acc, cur, wr, wc, fr, fq); S.done(cur); }
        if (!has_next) break;
#pragma unroll
        for (int a = 0; a < 2; ++a)
#pragma unroll
            for (int b = 0; b < 2; ++b)
#pragma unroll
                for (int m = 0; m < 4; ++m)
#pragma unroll
                    for (int n = 0; n < 2; ++n) acc[a][b][m][n] = (f32x4){0.f, 0.f, 0.f, 0.f};
        cur = nxt; cA = nA; cB = nB; ++ui;
        if constexpr (ALIGN_EPI) { if (wr == 1) PG8_BAR; }
    }
    PG8_WAIT_V(0);
    if constexpr (!ALIGN_EPI) { if (wr == 0) PG8_BAR; }
    PG8_BAR;
    if constexpr (Epi::AFTER_DRAIN) { E.fused(acc, cur, wr, wc, fr, fq, lds, wid, lane); S.done(cur); }
#undef PG8_SA
#undef PG8_SB
#undef PG8_STAGE
#undef PG8_LDA
#undef PG8_LDB
#undef PG8_MMA
#undef PG8_WAIT_V
#undef PG8_WAIT_L
#undef PG8_BAR
#undef PG8_SCHED
}

template <class G, class Epi>
__device__ __forceinline__ void gemm_small(PG8_LAS unsigned char* lds, const bf16_t* A, const bf16_t* Bt, int K, int row_base, int ntm, int ntn, int vcu, int nwg, const Epi& E) {
    constexpr int TM = (8 / G::WCN) * G::RS_WR * (G::NM * 16 / G::RS_WR), TN = G::WCN * G::CS_WC, SBK = 64, STG = (TM + TN) * 128, NPA = TM / 64, NPB = TN / 64, NP = NPA + NPB;
    static_assert(NP == 4 || NP == 2, "gemm_small: 128 x 128 or 64 x 64 tiles");
    const int tid = opaque_tid(), wid = __builtin_amdgcn_readfirstlane(tid >> 6), lane = tid & 63, wr = wid / G::WCN, wc = wid % G::WCN, fr = lane & 15, fq = lane >> 4;
    const int nk = K / SBK;
    for (int tile = vcu; tile < ntm * ntn; tile += nwg) {
        const int tm = tile % ntm, tn = tile / ntm;
        const bf16_t* Ab = A + (size_t)(row_base + tm * TM) * K; const bf16_t* Bb = Bt + (size_t)(tn * TN) * K;
        f32x4 acc[2][2][4][2];
#pragma unroll
        for (int m = 0; m < G::NM; ++m)
#pragma unroll
            for (int n = 0; n < G::NN; ++n) acc[0][0][m][n] = (f32x4){0.f, 0.f, 0.f, 0.f};
        unsigned goff[NP];
#pragma unroll
        for (int i = 0; i < NP; ++i) { const bool isB = i >= NPA; const int p = wid + 8 * (isB ? i - NPA : i), R = 8 * p + (lane >> 3), c = (lane & 7) ^ ((R >> 1) & 7);
            const int Rs = (isB && Epi::PERM) ? ((R & ~31) + perm32(R & 31)) : R; goff[i] = (unsigned)Rs * K + c * 8; }
#define SM_DMA(stage, kt_) do { _Pragma("unroll") for (int i = 0; i < NP; ++i) { const bool isB = i >= NPA; const int p = wid + 8 * (isB ? i - NPA : i); \
            __builtin_amdgcn_global_load_lds((const unsigned*)((isB ? Bb : Ab) + goff[i] + (size_t)(kt_) * SBK), (PG8_LAS unsigned*)(lds + (stage) * STG + (isB ? TM * 128 : 0) + p * 1024), 16, 0, 0); } } while (0)
#define SM_WAIT(n) asm volatile("s_waitcnt vmcnt(" #n ")" ::: "memory")
#define SM_MMA(stage) do { PG8_LAS unsigned char* sb = lds + (stage) * STG; \
            _Pragma("unroll") for (int kh = 0; kh < 2; ++kh) { bf16x8 af[G::NM], bfr[G::NN]; \
                _Pragma("unroll") for (int m = 0; m < G::NM; ++m) { const int R = wr * G::RS_WR + m * 16 + fr; af[m] = *(const PG8_LAS bf16x8*)(sb + R * 128 + (((kh * 4 + fq) ^ ((R >> 1) & 7)) * 16)); } \
                _Pragma("unroll") for (int n = 0; n < G::NN; ++n) { const int R = wc * G::CS_WC + n * 16 + fr; bfr[n] = *(const PG8_LAS bf16x8*)(sb + TM * 128 + R * 128 + (((kh * 4 + fq) ^ ((R >> 1) & 7)) * 16)); } \
                _Pragma("unroll") for (int m = 0; m < G::NM; ++m) _Pragma("unroll") for (int n = 0; n < G::NN; ++n) acc[0][0][m][n] = __builtin_amdgcn_mfma_f32_16x16x32_bf16(bfr[n], af[m], acc[0][0][m][n], 0, 0, 0); } } while (0)
#define SM_STEP(s, kt_) do { if ((kt_) + 2 < nk) { if (NP == 4) SM_WAIT(8); else SM_WAIT(4); } else if ((kt_) + 1 < nk) { if (NP == 4) SM_WAIT(4); else SM_WAIT(2); } else SM_WAIT(0); \
            asm volatile("s_waitcnt lgkmcnt(0)" ::: "memory"); __builtin_amdgcn_s_barrier(); asm volatile("" ::: "memory"); \
            if ((kt_) + 3 < nk) SM_DMA(((s) + 3) & 3, (kt_) + 3); \
            SM_MMA(s); } while (0)
        SM_DMA(0, 0); SM_DMA(1, 1); SM_DMA(2, 2);
        for (int kt = 0; kt < nk; kt += 4) { SM_STEP(0, kt); SM_STEP(1, kt + 1); SM_STEP(2, kt + 2); SM_STEP(3, kt + 3); }
#undef SM_DMA
#undef SM_WAIT
#undef SM_MMA
#undef SM_STEP
        asm volatile("s_waitcnt lgkmcnt(0)" ::: "memory"); __builtin_amdgcn_s_barrier(); asm volatile("" ::: "memory");
        E.template run<G>(acc, Tile{row_base + tm * TM, tn * TN}, wr, wc, fr, fq, (PG8_LAS float*)(lds + 4 * STG));
    }
}
}
#define GAS __attribute__((address_space(1)))
#define LAS __attribute__((address_space(3)))
typedef unsigned short bf16;
typedef unsigned v4u __attribute__((ext_vector_type(4)));
typedef float f32x4 __attribute__((ext_vector_type(4)));
typedef short bf16x8 __attribute__((ext_vector_type(8)));
typedef GAS unsigned gu32;
typedef GAS unsigned long long gu64;
#define RLX_AGENT __ATOMIC_RELAXED, __HIP_MEMORY_SCOPE_AGENT
#define LDS_WAIT() asm volatile("s_waitcnt lgkmcnt(0)" ::: "memory")
#define VM_WAIT() asm volatile("s_waitcnt vmcnt(0)" ::: "memory")
__device__ __forceinline__ unsigned long long rt() { return __builtin_amdgcn_s_memrealtime(); }
__device__ __forceinline__ unsigned f2bf(float f) { unsigned u = __builtin_bit_cast(unsigned, f); return (u + 0x7fffu + ((u >> 16) & 1u)) >> 16; }
__device__ __forceinline__ unsigned pk2(float lo, float hi) { return f2bf(lo) | (f2bf(hi) << 16); }

#define XB_TMO      128
#define XB_XCNT(j)  (256  + 64 * (j))
#define XB_XSUB(j)  (1280 + 64 * (j))
#define XB_XGEN(j)  (2304 + 64 * (j))
#define XB_TOP      3328
#define XB_TOPGEN   3392
#define XCD_BAR_WORDS 3456
#define XB_SPIN_CAP (1u << 18)

__device__ __forceinline__ unsigned xb_ld(unsigned* p)              { return __hip_atomic_load(p, __ATOMIC_RELAXED, __HIP_MEMORY_SCOPE_AGENT); }
__device__ __forceinline__ unsigned xb_add(unsigned* p, unsigned v) { return __hip_atomic_fetch_add(p, v, __ATOMIC_RELAXED, __HIP_MEMORY_SCOPE_AGENT); }
__device__ __forceinline__ unsigned xb_xcc_id() { return (unsigned)__builtin_amdgcn_s_getreg((3 << 11) | 20) & 0xFu; }
#define XB_SPIN(cond, bar) do { unsigned _sp = 0; while (cond) { __builtin_amdgcn_s_sleep(1); \
    if ((++_sp & 255u) == 0u) { if (xb_ld(&(bar)[XB_TMO])) break; if (_sp > XB_SPIN_CAP) { atomicAdd(&(bar)[XB_TMO], 1u); break; } } } } while (0)

struct XcdBarrier {
    unsigned* bar; unsigned x;
    volatile LAS unsigned* st;
};

__device__ __forceinline__ XcdBarrier xcd_barrier_post(unsigned* bar, volatile LAS unsigned* st) {
    XcdBarrier b; b.bar = bar; b.x = xb_xcc_id(); b.st = st;
    if (threadIdx.x == 0) (void)xb_add(&bar[XB_XCNT(b.x)], 1u);
    return b;
}
__device__ __forceinline__ void xcd_barrier_complete(unsigned* bar, unsigned x, unsigned& nloc, unsigned& nx) {
    const unsigned G = gridDim.x * gridDim.y * gridDim.z;
    unsigned sum, cnt, mine, sp = 0u;
    for (;;) {
        sum = 0u; cnt = 0u; mine = 0u;
#pragma unroll
        for (unsigned j = 0; j < 16; ++j) { const unsigned c = xb_ld(&bar[XB_XCNT(j)]); sum += c; cnt += (c > 0u) ? 1u : 0u; mine = (j == x) ? c : mine; }
        if (sum == G) break;
        __builtin_amdgcn_s_sleep(1);
        if ((++sp & 255u) == 0u) { if (xb_ld(&bar[XB_TMO])) break; if (sp > XB_SPIN_CAP) { atomicAdd(&bar[XB_TMO], 1u); break; } }
    }
    nloc = mine > 0u ? mine : 1u; nx = cnt > 0u ? cnt : 1u;
}

__device__ __forceinline__ void xcd_barrier(const XcdBarrier& b) {
    asm volatile("s_waitcnt vmcnt(0)" ::: "memory");
    __syncthreads();
    if (threadIdx.x == 0) {
        unsigned* bar = b.bar;
        __builtin_amdgcn_s_waitcnt(0);
        unsigned nloc = b.st[0], nx = b.st[1];
        if (nloc == 0u) { xcd_barrier_complete(bar, b.x, nloc, nx); b.st[0] = nloc; b.st[1] = nx; }
        const unsigned old = xb_add(&bar[XB_XSUB(b.x)], 1u);
        const unsigned gen = old / nloc;
        if (old + 1u == (gen + 1u) * nloc) {
#ifndef PROBE_NOWBL2
            __builtin_amdgcn_fence(__ATOMIC_RELEASE, "agent");
#endif
            asm volatile("s_waitcnt vmcnt(0)" ::: "memory");
            const unsigned og = xb_add(&bar[XB_TOP], 1u);
            const unsigned tg = og / nx;
            if (og + 1u == (tg + 1u) * nx) xb_add(&bar[XB_TOPGEN], 1u);
            else XB_SPIN(xb_ld(&bar[XB_TOPGEN]) == tg, bar);
            __builtin_amdgcn_fence(__ATOMIC_ACQUIRE, "agent");
            xb_add(&bar[XB_XGEN(b.x)], 1u);
            asm volatile("s_waitcnt vmcnt(0)" ::: "memory");
        } else {
            XB_SPIN(xb_ld(&bar[XB_XGEN(b.x)]) == gen, bar);
            __builtin_amdgcn_fence(__ATOMIC_ACQUIRE, "agent");
            asm volatile("s_waitcnt vmcnt(0)" ::: "memory");
        }
    }
    __syncthreads();
}

#ifndef THR_VALUE
#define THR_VALUE 8.0f
#endif
namespace at {
#define AT_LAS __attribute__((address_space(3)))
typedef short bf16x8 __attribute__((ext_vector_type(8)));
typedef short s16x4 __attribute__((ext_vector_type(4)));
typedef float f32x16 __attribute__((ext_vector_type(16)));
typedef float f32x4 __attribute__((ext_vector_type(4)));
typedef unsigned u32x4 __attribute__((ext_vector_type(4)));
typedef unsigned u32x2 __attribute__((ext_vector_type(2)));
typedef unsigned short bf16_t;
constexpr int MP = 16384, PITCH = 1024, SEQ = 2048;
constexpr int KCS = 1040;
constexpr int KT_BYTES = 8 * KCS;
constexpr float THR = THR_VALUE;
constexpr int WSF_OFF = 132096;
constexpr int QIMG_OFF = 99328;
__device__ __forceinline__ int crow(int r, int hi) { return (r & 3) + 8 * (r >> 2) + 4 * hi; }
__device__ __forceinline__ unsigned cvtpk(float lo, float hi) { typedef float f2 __attribute__((ext_vector_type(2))); typedef __bf16 b2 __attribute__((ext_vector_type(2))); f2 v = {lo, hi}; b2 b = __builtin_convertvector(v, b2); return __builtin_bit_cast(unsigned, b); }
__device__ __forceinline__ s16x4 vtr(const AT_LAS unsigned char* p) { typedef short v4i16_t __attribute__((ext_vector_type(4))); return __builtin_bit_cast(s16x4, __builtin_amdgcn_ds_read_tr16_b64_v4i16((AT_LAS v4i16_t*)p)); }
#define AT_SYNC() __syncthreads()

template <bool QLDS>
__device__ __forceinline__ void qk_tile(f32x16& p0, f32x16& p1, const AT_LAS unsigned char* kt, const bf16x8 (&qr_)[4], const AT_LAS unsigned char* qimg, int r32, int hi) {
    p0 = f32x16{}; p1 = f32x16{};
#pragma unroll
    for (int d0 = 0; d0 < 4; ++d0) {
        bf16x8 qr[4]; if (QLDS) qr[d0] = *(const AT_LAS bf16x8*)(qimg + (2 * d0 + hi) * 512 + r32 * 16); else qr[d0] = qr_[d0];
        const bf16x8 a0 = *(const AT_LAS bf16x8*)(kt + (2 * d0 + hi) * KCS + r32 * 16);
        const bf16x8 a1 = *(const AT_LAS bf16x8*)(kt + (2 * d0 + hi) * KCS + r32 * 16 + 512);
        p0 = __builtin_amdgcn_mfma_f32_32x32x16_bf16(a0, qr[d0], p0, 0, 0, 0);
        p1 = __builtin_amdgcn_mfma_f32_32x32x16_bf16(a1, qr[d0], p1, 0, 0, 0);
    }
}
template <int ND0>
__device__ __forceinline__ void softmax_tile(f32x16& p0, f32x16& p1, float& m, float& l, f32x16 (&o)[ND0], AT_LAS float* wsf, int r32, int hi) {
    float rm = fmaxf(p0[0], p1[0]);
#pragma unroll
    for (int r = 1; r < 16; ++r) rm = fmaxf(rm, fmaxf(p0[r], p1[r]));
    rm = fmaxf(rm, __shfl_xor(rm, 32));
    if (__any(rm > m + THR)) {
        const float mn = fmaxf(m, rm), f = __builtin_amdgcn_exp2f(m - mn);
        l *= f; m = mn;
        if (hi == 0) wsf[r32] = f;
        asm volatile("s_waitcnt lgkmcnt(0)" ::: "memory");
#pragma unroll
        for (int r = 0; r < 16; ++r) { const float fr_ = wsf[crow(r, hi)];
#pragma unroll
            for (int d0 = 0; d0 < ND0; ++d0) o[d0][r] *= fr_; }
        asm volatile("s_waitcnt lgkmcnt(0)" ::: "memory");
    }
    float s = 0.f;
#pragma unroll
    for (int r = 0; r < 16; ++r) { p0[r] = __builtin_amdgcn_exp2f(p0[r] - m); p1[r] = __builtin_amdgcn_exp2f(p1[r] - m); s += p0[r] + p1[r]; }
    l += s;
}
__device__ __forceinline__ void pack_p(bf16x8 (&pa)[4], const f32x16& p0, const f32x16& p1) {
#pragma unroll
    for (int ks = 0; ks < 4; ++ks) {
        u32x4 w;
        if (ks < 2) { const int b = 8 * ks; w.x = cvtpk(p0[b], p0[b + 1]); w.y = cvtpk(p0[b + 2], p0[b + 3]); w.z = cvtpk(p0[b + 4], p0[b + 5]); w.w = cvtpk(p0[b + 6], p0[b + 7]); }
        else { const int b = 8 * (ks - 2); w.x = cvtpk(p1[b], p1[b + 1]); w.y = cvtpk(p1[b + 2], p1[b + 3]); w.z = cvtpk(p1[b + 4], p1[b + 5]); w.w = cvtpk(p1[b + 6], p1[b + 7]); }
        pa[ks] = __builtin_bit_cast(bf16x8, w);
    }
}
template <int ND0>
__device__ __forceinline__ void pv_packed(f32x16 (&o)[ND0], const AT_LAS unsigned char* vt, const bf16x8 (&pa)[4], int lane, int hi) {
    const AT_LAS unsigned char* vb = vt + ((lane >> 4) & 1) * 32 + (lane & 3) * 8 + (4 * hi + ((lane & 15) >> 2)) * 64;
#pragma unroll
    for (int d0 = 0; d0 < ND0; ++d0)
#pragma unroll
        for (int ks = 0; ks < 4; ++ks) {
            const s16x4 lo = vtr(vb + d0 * 4096 + ks * 1024), hh = vtr(vb + d0 * 4096 + ks * 1024 + 512);
            const bf16x8 bfr = {lo[0], lo[1], lo[2], lo[3], hh[0], hh[1], hh[2], hh[3]};
            o[d0] = __builtin_amdgcn_mfma_f32_32x32x16_bf16(pa[ks], bfr, o[d0], 0, 0, 0);
        }
}
template <int ND0>
__device__ __forceinline__ void pv_tile(f32x16 (&o)[ND0], const AT_LAS unsigned char* vt, const f32x16& p0, const f32x16& p1, int lane, int hi) {
    bf16x8 pa[4]; pack_p(pa, p0, p1); pv_packed<ND0>(o, vt, pa, lane, hi);
}
__device__ __forceinline__ u32x4 ld16(const void* p) { return *(const u32x4*)p; }
__device__ __forceinline__ u32x2 f4_to_bf4(u32x4 v) { u32x2 w; w.x = cvtpk(__uint_as_float(v.x), __uint_as_float(v.y)); w.y = cvtpk(__uint_as_float(v.z), __uint_as_float(v.w)); return w; }

struct Ctx {
    const bf16_t *Q, *K, *V; bf16_t* O;
    const float *cache_k, *cache_v;
    const float *lam_p, *subln;
    const float* rel;
    void* stamp;
    float lam;
};
__device__ __forceinline__ float diff_lambda(const float* lp) {
    const int lane = threadIdx.x & 63;
    float sa = lp[lane] * lp[64 + lane], sc = lp[128 + lane] * lp[192 + lane];
#pragma unroll
    for (int o_ = 1; o_ < 64; o_ <<= 1) { sa += __shfl_xor(sa, o_); sc += __shfl_xor(sc, o_); }
    return __expf(sa) - __expf(sc) + 0.2f;
}
#ifndef PROBE_CLK
#define PROBE_CLK() __builtin_amdgcn_s_memtime()
#endif
#ifndef PROBE_STAMP_B
#define PROBE_STAMP_B 1
#endif
#ifndef PROBE_BLK
#define PROBE_BLK 0
#endif
#ifndef PROBE_TID
#define PROBE_TID 0
#endif

template <int NK, int DV>
__device__ __forceinline__ void ld_bf(u32x4 (&st)[NK + DV / 64], const bf16_t* kbase, const bf16_t* vbase, int nrows, int tid) {
    const int row = tid >> 3, ch = tid & 7; const unsigned koff = (unsigned)row * PITCH + ch * 8;
#pragma unroll
    for (int c = 0; c < NK; ++c) st[c] = (row < nrows) ? ld16(kbase + koff + c * 64) : (u32x4){0u, 0u, 0u, 0u};
    if (DV == 64) { st[NK] = (row < nrows) ? ld16(vbase + koff) : (u32x4){0u, 0u, 0u, 0u}; }
    else {
        const int vrow = tid >> 4; const unsigned voff = (unsigned)vrow * PITCH + (tid & 15) * 8;
#pragma unroll
        for (int i = 0; i < 2; ++i) st[NK + i] = (vrow + 32 * i < nrows) ? ld16(vbase + voff + (size_t)i * 32 * PITCH) : (u32x4){0u, 0u, 0u, 0u};
    }
}
template <int NK, int DV>
__device__ __forceinline__ void wr_bf(const u32x4 (&st)[NK + DV / 64], AT_LAS unsigned char* sb, int tid) {
    const int row = tid >> 3, ch = tid & 7;
#pragma unroll
    for (int c = 0; c < NK; ++c) *(AT_LAS u32x4*)(sb + c * KT_BYTES + ch * KCS + row * 16) = st[c];
    AT_LAS unsigned char* vb = sb + NK * KT_BYTES;
    if (DV == 64) { const int col = ch * 8; *(AT_LAS u32x4*)(vb + ((col >> 5) * 4 + (row >> 4)) * 1024 + (row & 15) * 64 + (col & 31) * 2) = st[NK]; }
    else {
        const int vrow = tid >> 4, col = (tid & 15) * 8;
#pragma unroll
        for (int i = 0; i < 2; ++i) *(AT_LAS u32x4*)(vb + ((col >> 5) * 4 + ((vrow + 32 * i) >> 4)) * 1024 + (vrow & 15) * 64 + (col & 31) * 2) = st[NK + i];
    }
}
__device__ __forceinline__ void glds16(const void* gsrc, unsigned lds_dst) { unsigned keep;
    asm volatile("s_mov_b32 %0, m0\n\ts_mov_b32 m0, %2\n\ts_nop 0\n\tglobal_load_lds_dwordx4 %1, off\n\ts_mov_b32 m0, %0" : "=&s"(keep) : "v"(gsrc), "s"(lds_dst) : "memory"); }
template <int NK, int DV>
__device__ __forceinline__ void dma_bf(const bf16_t* kbase, const bf16_t* vbase, AT_LAS unsigned char* sb, int w, int lane) {
    const unsigned s0 = (unsigned)__builtin_amdgcn_readfirstlane((int)(unsigned)(uintptr_t)sb);
#pragma unroll
    for (int c = 0; c < NK; ++c) glds16(kbase + (size_t)lane * PITCH + c * 64 + w * 8, (unsigned)__builtin_amdgcn_readfirstlane((int)(s0 + c * KT_BYTES + w * KCS)));
#pragma unroll
    for (int i = 0; i < DV / 64; ++i) { const int d0 = 2 * i + (w >> 2), rg = w & 3;
        glds16(vbase + (size_t)(16 * rg + (lane >> 2)) * PITCH + d0 * 32 + (lane & 3) * 8, (unsigned)__builtin_amdgcn_readfirstlane((int)(s0 + NK * KT_BYTES + (d0 * 4 + rg) * 1024))); }
}
__device__ __forceinline__ void dma_prompt(const bf16_t* kbase, const bf16_t* vbase, AT_LAS unsigned char* sb, int w, int lane) {
    const unsigned s0 = (unsigned)__builtin_amdgcn_readfirstlane((int)(unsigned)(uintptr_t)sb);
#pragma unroll
    for (int i = 0; i < 2; ++i) { const int j = 2 * w + i, R = 4 * j + (lane >> 4), c = (lane & 15) ^ (R & 15);
        glds16(kbase + (size_t)R * PITCH + c * 8, (unsigned)__builtin_amdgcn_readfirstlane((int)(s0 + j * 1024))); }
#pragma unroll
    for (int i = 0; i < 2; ++i) { const int d0 = 2 * i + (w >> 2), rg = w & 3;
        glds16(vbase + (size_t)(16 * rg + (lane >> 2)) * PITCH + d0 * 32 + (lane & 3) * 8, (unsigned)__builtin_amdgcn_readfirstlane((int)(s0 + 16384 + (d0 * 4 + rg) * 1024))); }
}
__device__ __forceinline__ void dma_promptB(const bf16_t* kbase, const bf16_t* vbase, AT_LAS unsigned char* sb, int w, int lane) {
    const unsigned s0 = (unsigned)__builtin_amdgcn_readfirstlane((int)(unsigned)(uintptr_t)sb);
    { const int R = 8 * w + (lane >> 3), c = (lane & 7) ^ ((R >> 1) & 7);
      glds16(kbase + (size_t)R * PITCH + c * 8, (unsigned)__builtin_amdgcn_readfirstlane((int)(s0 + w * 1024))); }
    { const int d0 = w >> 2, rg = w & 3;
      glds16(vbase + (size_t)(16 * rg + (lane >> 2)) * PITCH + d0 * 32 + (lane & 3) * 8, (unsigned)__builtin_amdgcn_readfirstlane((int)(s0 + 8192 + (d0 * 4 + rg) * 1024))); }
}
template <int NK, int DV>
__device__ __forceinline__ void ld_f32(u32x4 (&st)[2 * NK + DV / 32], const float* kbase, const float* vbase, int tid) {
    { const unsigned off = (unsigned)(tid >> 4) * 1024 + (tid & 15) * 4;
#pragma unroll
      for (int c = 0; c < NK; ++c)
#pragma unroll
          for (int i = 0; i < 2; ++i) st[c * 2 + i] = ld16(kbase + off + c * 64 + (size_t)i * 32 * 1024); }
    if (DV == 64) { const unsigned off = (unsigned)(tid >> 4) * 1024 + (tid & 15) * 4;
#pragma unroll
        for (int i = 0; i < 2; ++i) st[2 * NK + i] = ld16(vbase + off + (size_t)i * 32 * 1024); }
    else { const unsigned off = (unsigned)(tid >> 5) * 1024 + (tid & 31) * 4;
#pragma unroll
        for (int i = 0; i < 4; ++i) st[2 * NK + i] = ld16(vbase + off + (size_t)i * 16 * 1024); }
}
template <int NK, int DV>
__device__ __forceinline__ void wr_f32(const u32x4 (&st)[2 * NK + DV / 32], AT_LAS unsigned char* sb, int tid) {
    { const int row = tid >> 4, c4 = tid & 15;
#pragma unroll
      for (int c = 0; c < NK; ++c)
#pragma unroll
          for (int i = 0; i < 2; ++i) *(AT_LAS u32x2*)(sb + c * KT_BYTES + (c4 >> 1) * KCS + (row + 32 * i) * 16 + (c4 & 1) * 8) = f4_to_bf4(st[c * 2 + i]); }
    AT_LAS unsigned char* vb = sb + NK * KT_BYTES;
    if (DV == 64) { const int row = tid >> 4, col = (tid & 15) * 4;
#pragma unroll
        for (int i = 0; i < 2; ++i) *(AT_LAS u32x2*)(vb + ((col >> 5) * 4 + ((row + 32 * i) >> 4)) * 1024 + (row & 15) * 64 + (col & 31) * 2) = f4_to_bf4(st[2 * NK + i]); }
    else { const int row = tid >> 5, col = (tid & 31) * 4;
#pragma unroll
        for (int i = 0; i < 4; ++i) *(AT_LAS u32x2*)(vb + ((col >> 5) * 4 + ((row + 16 * i) >> 4)) * 1024 + (row & 15) * 64 + (col & 31) * 2) = f4_to_bf4(st[2 * NK + i]); }
}

constexpr int A_STAGE = 2 * KT_BYTES + 16384;
constexpr int A_TP = 132;
constexpr int S_TAB = WSF_OFF + 2048;
template <bool ISB>
__device__ __forceinline__ void attn_sample_unit(AT_LAS unsigned char* lds, int b, int cg, const Ctx& C) {
    constexpr int ND0 = ISB ? 2 : 4, NT = ISB ? 8 : 16, PAST = ISB ? 512 : 1024;
    const int tid = pg8::opaque_tid(), lane = tid & 63, r32 = lane & 31, hi = lane >> 5;
    const int w = __builtin_amdgcn_readfirstlane(tid >> 6), g = w >> 2;
    AT_LAS float* wsf = (AT_LAS float*)(lds + WSF_OFF) + w * 64;
    AT_LAS float* tab = (AT_LAS float*)(lds + S_TAB) + g * 264;
    const bool active = (w & 3) == 0;
    const int qrow0 = MP + b * 32, qpos = 1024 + r32;
    if (ISB) { for (int i = tid; i < 2 * 257; i += 512) { const int hh = i >= 257 ? 1 : 0, j = i - hh * 257; ((AT_LAS float*)(lds + S_TAB))[hh * 264 + j] = C.rel[(2 * cg + hh) * 257 + j] * 1.4426950408889634f; } }
    const float lam = C.lam;
    bf16x8 qr[4];
    AT_LAS unsigned char* qimg = lds + QIMG_OFF + w * 4096;
#pragma unroll
    for (int d0 = 0; d0 < 4; ++d0) { qr[d0] = *(const bf16x8*)(C.Q + (size_t)(qrow0 + r32) * PITCH + cg * 128 + g * 64 + d0 * 16 + hi * 8);
        *(AT_LAS bf16x8*)(qimg + (2 * d0 + hi) * 512 + r32 * 16) = qr[d0]; }
    f32x16 o[ND0];
#pragma unroll
    for (int d0 = 0; d0 < ND0; ++d0) o[d0] = f32x16{};
    float m = -1e30f, l = 0.f;
    const bf16_t* kb0 = C.K + (size_t)qrow0 * PITCH + cg * 128;
    const bf16_t* vb0 = C.V + (size_t)qrow0 * PITCH + cg * 128;
    const float* kc0 = C.cache_k + (size_t)b * PAST * 1024 + cg * 128;
    const float* vc0 = C.cache_v + (size_t)b * PAST * 1024 + cg * 128;
    { u32x4 sn[4]; ld_bf<2, 128>(sn, kb0, vb0, 32, tid); wr_bf<2, 128>(sn, lds + 2 * A_STAGE, tid); }
    u32x4 st[8];
    ld_f32<2, 128>(st, kc0, vc0, tid);
    for (int t = 0; t < NT; ++t) {
        AT_LAS unsigned char* sb = lds + (t & 1) * A_STAGE;
        wr_f32<2, 128>(st, sb, tid);
        AT_SYNC();
        if (t + 1 < NT) ld_f32<2, 128>(st, kc0 + (size_t)(t + 1) * 64 * 1024, vc0 + (size_t)(t + 1) * 64 * 1024, tid);
        if (active) {
            const int nsub = (t == 0) ? 2 : 1;
#pragma unroll 1
            for (int sub = 0; sub < nsub; ++sub) {
                const AT_LAS unsigned char* sc = sub ? (lds + 2 * A_STAGE) : sb;
                f32x16 p0, p1;
                qk_tile<true>(p0, p1, sc + g * KT_BYTES, qr, qimg, r32, hi);
                if (ISB) {
                    const int kpos0 = sub ? 1024 : 512 + t * 64;
                    if (1024 - (kpos0 + 63) >= 128) { const float cb = tab[256];
#pragma unroll
                        for (int r = 0; r < 16; ++r) { p0[r] += cb; p1[r] += cb; } }
                    else {
#pragma unroll
                        for (int r = 0; r < 16; ++r) { const int rel = qpos - (kpos0 + crow(r, hi));
                            const int i0 = rel < -128 ? -128 : (rel > 128 ? 128 : rel), i1 = (rel - 32) < -128 ? -128 : ((rel - 32) > 128 ? 128 : (rel - 32));
                            p0[r] += tab[i0 + 128]; p1[r] += tab[i1 + 128]; } }
                }
                if (sub) {
#pragma unroll
                    for (int r = 0; r < 16; ++r) p1[r] = -INFINITY;
                }
                softmax_tile<ND0>(p0, p1, m, l, o, wsf, r32, hi);
                pv_tile<ND0>(o, sc + 2 * KT_BYTES + (ISB ? g * 8192 : 0), p0, p1, lane, hi);
            }
        }
    }
    AT_SYNC();
    const float lt = l + __shfl_xor(l, 32);
    if (!ISB) {
        { float inv = 1.0f / lt; if (g == 1) inv *= lam; if (hi == 0) wsf[r32] = inv; asm volatile("s_waitcnt lgkmcnt(0)" ::: "memory"); }
        AT_LAS float* T2 = (AT_LAS float*)lds;
        if (active && g == 1) {
#pragma unroll
            for (int r = 0; r < 16; ++r) { const int q = crow(r, hi); const float f = wsf[q];
#pragma unroll
                for (int d0 = 0; d0 < ND0; ++d0) T2[q * A_TP + d0 * 32 + r32] = o[d0][r] * f; }
        }
        AT_SYNC();
        if (active && g == 0) {
#pragma unroll
            for (int r = 0; r < 16; ++r) { const int q = crow(r, hi); const float f = wsf[q];
#pragma unroll
                for (int d0 = 0; d0 < ND0; ++d0) { const int ix = q * A_TP + d0 * 32 + r32; T2[ix] = o[d0][r] * f - T2[ix]; } }
            asm volatile("s_waitcnt lgkmcnt(0)" ::: "memory");
            const int row = lane & 31, half = lane >> 5;
            f32x4 x[16]; float ss = 0.f;
#pragma unroll
            for (int i = 0; i < 16; ++i) { x[i] = *(const AT_LAS f32x4*)(T2 + row * A_TP + half * 64 + 4 * i); ss += (x[i][0] * x[i][0] + x[i][1] * x[i][1]) + (x[i][2] * x[i][2] + x[i][3] * x[i][3]); }
            ss += __shfl_xor(ss, 32);
            const float rinv = 0.8f / sqrtf(ss * (1.0f / 128.0f) + 1e-6f);
            bf16_t* op = C.O + (size_t)(qrow0 + row) * PITCH + cg * 128 + half * 64;
#pragma unroll
            for (int i = 0; i < 16; i += 2) {
                const f32x4 g0 = *(const f32x4*)(C.subln + half * 64 + 4 * i), g1 = *(const f32x4*)(C.subln + half * 64 + 4 * i + 4);
                const f32x4 y0 = x[i] * g0 * rinv, y1 = x[i + 1] * g1 * rinv;
                u32x4 wv; wv.x = cvtpk(y0[0], y0[1]); wv.y = cvtpk(y0[2], y0[3]); wv.z = cvtpk(y1[0], y1[1]); wv.w = cvtpk(y1[2], y1[3]);
                *(u32x4*)(op + 4 * i) = wv;
            }
        }
    } else if (active) {
        { const float inv = 1.0f / lt; if (hi == 0) wsf[r32] = inv; asm volatile("s_waitcnt lgkmcnt(0)" ::: "memory"); }
        AT_LAS bf16_t* stg = (AT_LAS bf16_t*)lds + g * 2048;
#pragma unroll
        for (int r = 0; r < 16; ++r) { const int q = crow(r, hi); const float f = wsf[q];
#pragma unroll
            for (int d0 = 0; d0 < ND0; ++d0) { const unsigned pk = cvtpk(o[d0][r] * f, 0.f); stg[q * 64 + d0 * 32 + r32] = (bf16_t)(pk & 0xffffu); } }
        asm volatile("s_waitcnt lgkmcnt(0)" ::: "memory");
        bf16_t* op = C.O + (size_t)qrow0 * PITCH + cg * 128 + g * 64;
#pragma unroll
        for (int i = 0; i < 4; ++i) { const int row = i * 8 + (lane >> 3), ch = lane & 7; const u32x4 v = *(const AT_LAS u32x4*)(stg + row * 64 + ch * 8); *(u32x4*)(op + (size_t)row * PITCH + ch * 8) = v; }
    }
    AT_SYNC();
}

constexpr int P_STAGE = 16384 + 16384;
constexpr int P_WSF = 135168;
constexpr int P_TAB = P_WSF + 2048;
template <bool ISB>
__device__ __forceinline__ void attn_prompt_unit(AT_LAS unsigned char* lds, int b, int cg, int ub, const Ctx& C) {
#ifdef PROBE_STAMP
    const unsigned long long tsA_ = PROBE_CLK();
#endif
    constexpr int ND0 = ISB ? 2 : 4, NS = ISB ? 8 : 4, STG = ISB ? 16384 : P_STAGE, DIST = ISB ? 4 : 2, VOFF = ISB ? 8192 : 16384, KR2 = ISB ? 4096 : 8192;
    const int tid = pg8::opaque_tid(), lane = tid & 63, r32 = lane & 31, hi = lane >> 5;
#ifdef PROBE_PARITY
    const int w = __builtin_amdgcn_readfirstlane(tid >> 6), g = ISB ? 0 : (w >> 2), qi = w & 3;
#else
    const int w = __builtin_amdgcn_readfirstlane(tid >> 6), g = w >> 2, qi = w & 3;
#endif
    AT_LAS float* wsf = (AT_LAS float*)(lds + P_WSF) + w * 64;
    AT_LAS float* tab = (AT_LAS float*)(lds + P_TAB);
    const int cw = ISB ? 4 * ub + (w >> 1) : 2 * ub + (qi >> 1);
    const int kt0 = ISB ? ((4 * ub - 8) > 0 ? (4 * ub - 8) : 0) : 0, NT = (ISB ? 4 * ub + 4 : 2 * ub + 2) - kt0;
    const int fv = ISB ? ((cw - 8) > 0 ? (cw - 8) : 0) : 0;
    const int qoff = ISB ? ub * 256 + w * 32 : ub * 128 + qi * 32, qrow0 = b * SEQ + qoff, qpos = qoff + r32;
    const int ccol = ISB ? cg * 64 : cg * 128;
    if (ISB) { if (tid < 257) tab[tid] = C.rel[cg * 257 + tid] * 1.4426950408889634f; }
    AT_LAS float* subl = (AT_LAS float*)(lds + P_TAB);
    if (!ISB) { if (tid < 128) subl[tid] = C.subln[tid]; }
    const float lam = C.lam;
    bf16x8 qr[4];
#pragma unroll
    for (int d0 = 0; d0 < 4; ++d0) qr[d0] = *(const bf16x8*)(C.Q + (size_t)(qrow0 + r32) * PITCH + ccol + (ISB ? 0 : g * 64) + d0 * 16 + hi * 8);
    f32x16 o[ND0];
#pragma unroll
    for (int d0 = 0; d0 < ND0; ++d0) o[d0] = f32x16{};
    f32x16 negm = f32x16{};
    float m = 0.f, l = 0.f;
    bf16x8 pa[4];
#pragma unroll
    for (int ks = 0; ks < 4; ++ks) pa[ks] = bf16x8{};
    const bf16_t* kb0 = C.K + (size_t)(b * SEQ + kt0 * 64) * PITCH + ccol;
    const bf16_t* vb0 = C.V + (size_t)(b * SEQ + kt0 * 64) * PITCH + ccol;
#define P_DMA(tt) do { if (ISB) dma_promptB(kb0 + (size_t)(tt) * 64 * PITCH, vb0 + (size_t)(tt) * 64 * PITCH, lds + ((tt) & (NS - 1)) * STG, w, lane); \
                       else dma_prompt(kb0 + (size_t)(tt) * 64 * PITCH, vb0 + (size_t)(tt) * 64 * PITCH, lds + ((tt) & (NS - 1)) * STG, w, lane); } while (0)
#pragma unroll
    for (int tt = 0; tt < DIST; ++tt) if (tt < NT) P_DMA(tt);
    const int vlane = ((lane >> 4) & 1) * 32 + (lane & 3) * 8 + (4 * hi + ((lane & 15) >> 2)) * 64 + VOFF;
    const int klane = ISB ? (r32 * 128 + ((hi ^ ((r32 >> 1) & 7)) << 4)) : (r32 * 256 + (((g * 8 + hi) ^ (r32 & 15)) << 4));
#define P_VRD(buf, blk) do { _Pragma("unroll") for (int ks = 0; ks < 4; ++ks) { buf[2 * ks] = vtr(vp + (blk) * 4096 + ks * 1024); buf[2 * ks + 1] = vtr(vp + (blk) * 4096 + ks * 1024 + 512); } } while (0)
#define P_VMM(buf, blk) do { _Pragma("unroll") for (int ks = 0; ks < 4; ++ks) { const bf16x8 bfr = {buf[2 * ks][0], buf[2 * ks][1], buf[2 * ks][2], buf[2 * ks][3], buf[2 * ks + 1][0], buf[2 * ks + 1][1], buf[2 * ks + 1][2], buf[2 * ks + 1][3]}; \
        o[blk] = __builtin_amdgcn_mfma_f32_32x32x16_bf16(pa[ks], bfr, o[blk], 0, 0, 0); } } while (0)
#define P_SB() __builtin_amdgcn_sched_barrier(0)
#define P_KRD(scur) do { \
        _Pragma("unroll") for (int d0 = 0; d0 < 4; ++d0) { ka[2 * d0] = *(const AT_LAS bf16x8*)(lds + (scur) + (klane ^ (d0 << 5))); ka[2 * d0 + 1] = *(const AT_LAS bf16x8*)(lds + (scur) + (klane ^ (d0 << 5)) + KR2); } } while (0)
#define P_PV(sprev, KRD_STMT) do { const AT_LAS unsigned char* vp = lds + (sprev) + vlane; \
        P_VMM(va, 0); \
        if (ND0 == 4) { P_VRD(va, 2); P_SB(); P_VMM(vb, 1); P_VRD(vb, 3); P_SB(); P_VMM(va, 2); KRD_STMT; P_SB(); P_VMM(vb, 3); } else { KRD_STMT; P_SB(); P_VMM(vb, 1); } P_SB(); } while (0)
#define P_PRE(sprev) do { const AT_LAS unsigned char* vp = lds + (sprev) + vlane; P_VRD(va, 0); P_VRD(vb, 1); } while (0)
#define P_BAR() do { __builtin_amdgcn_sched_barrier(0); asm volatile("s_barrier" ::: "memory"); __builtin_amdgcn_sched_barrier(0); } while (0)
#define P_BAR_V0() do { __builtin_amdgcn_sched_barrier(0); asm volatile("s_waitcnt vmcnt(0)\n\ts_barrier" ::: "memory"); __builtin_amdgcn_sched_barrier(0); } while (0)
#define P_BAR_V2() do { __builtin_amdgcn_sched_barrier(0); asm volatile("s_waitcnt vmcnt(2)\n\ts_barrier" ::: "memory"); __builtin_amdgcn_sched_barrier(0); } while (0)
#define P_BAR_V4() do { __builtin_amdgcn_sched_barrier(0); asm volatile("s_waitcnt vmcnt(4)\n\ts_barrier" ::: "memory"); __builtin_amdgcn_sched_barrier(0); } while (0)
    asm volatile("s_waitcnt vmcnt(0) lgkmcnt(0)\n\ts_barrier" ::: "memory");
    if (g == 1) P_BAR();
    f32x16 p0, p1;
    s16x4 va[8], vb[8]; bf16x8 ka[8];
#ifdef PROBE_STAMP
    unsigned long long stamp_acc = 0;
#endif
    P_PRE(0);
#ifdef PROBE_STAMP
    const unsigned long long tsB_ = PROBE_CLK();
#endif
    for (int t = 0; t < NT; ++t) {
#ifdef PROBE_PARITY
        if (t > 0 && !ISB) P_BAR();
#else
        if (t > 0) P_BAR();
#endif
#ifdef PROBE_STAMP
        const unsigned long long ts0_ = PROBE_CLK();
#endif
        P_PV((t > 0 ? ((t - 1) & (NS - 1)) : 0) * STG, P_KRD((t & (NS - 1)) * STG));
        p0 = __builtin_amdgcn_mfma_f32_32x32x16_bf16(ka[0], qr[0], negm, 0, 0, 0); p1 = __builtin_amdgcn_mfma_f32_32x32x16_bf16(ka[1], qr[0], negm, 0, 0, 0);
#pragma unroll
        for (int d0 = 1; d0 < 4; ++d0) { p0 = __builtin_amdgcn_mfma_f32_32x32x16_bf16(ka[2 * d0], qr[d0], p0, 0, 0, 0); p1 = __builtin_amdgcn_mfma_f32_32x32x16_bf16(ka[2 * d0 + 1], qr[d0], p1, 0, 0, 0); }
        if (ISB) { const int nn = NT - 2 - t; if (nn >= 2) P_BAR_V4(); else if (nn == 1) P_BAR_V2(); else P_BAR_V0(); }
        else P_BAR_V0();
#ifdef PROBE_STAMP
        const unsigned long long ts1_ = PROBE_CLK();
#endif
        if (t + DIST < NT) P_DMA(t + DIST);
        const int kt = kt0 + t;
        const bool vis = ISB ? (kt <= cw && kt >= cw - 8) : (kt <= cw);
        if (vis) {
            if (ISB) {
                const int relmin = cw * 64 + (w & 1) * 32 - (kt * 64 + 63);
                if (relmin >= 128) { const float cb = tab[256];
#pragma unroll
                    for (int r = 0; r < 16; ++r) { p0[r] += cb; p1[r] += cb; } }
                else {
#pragma unroll
                    for (int r = 0; r < 16; ++r) { const int rel = qpos - (kt * 64 + crow(r, hi));
                        const int i0 = rel < -128 ? -128 : (rel > 128 ? 128 : rel), i1 = (rel - 32) < -128 ? -128 : ((rel - 32) > 128 ? 128 : (rel - 32));
                        p0[r] += tab[i0 + 128]; p1[r] += tab[i1 + 128]; } }
            }
            float ra = __builtin_fmaxf(__builtin_fmaxf(p0[0], p0[1]), p1[0]), rb = __builtin_fmaxf(__builtin_fmaxf(p0[2], p0[3]), p1[1]);
            ra = __builtin_fmaxf(__builtin_fmaxf(ra, p1[2]), p1[3]);
#pragma unroll
            for (int r = 4; r < 16; r += 4) { ra = __builtin_fmaxf(__builtin_fmaxf(ra, p0[r]), p0[r + 1]); rb = __builtin_fmaxf(__builtin_fmaxf(rb, p0[r + 2]), p0[r + 3]);
                                              ra = __builtin_fmaxf(__builtin_fmaxf(ra, p1[r]), p1[r + 1]); rb = __builtin_fmaxf(__builtin_fmaxf(rb, p1[r + 2]), p1[r + 3]); }
            float rm = __builtin_fmaxf(ra, rb);
            { auto rr = __builtin_amdgcn_permlane32_swap(__float_as_uint(rm), __float_as_uint(rm), false, false); rm = __builtin_fmaxf(__uint_as_float(rr[0]), __uint_as_float(rr[1])); }
            const bool first = (kt == fv);
            if (first || __any(rm > THR)) {
                const float dl = first ? rm : __builtin_fmaxf(rm, 0.f);
                m += dl;
#pragma unroll
                for (int r = 0; r < 16; ++r) { p0[r] -= dl; p1[r] -= dl; }
#pragma unroll
                for (int r = 0; r < 16; ++r) negm[r] = -m;
                if (!first) {
                    const float f = __builtin_amdgcn_exp2f(-dl); l *= f;
                    if (hi == 0) wsf[r32] = f;
                    asm volatile("s_waitcnt lgkmcnt(0)" ::: "memory");
#pragma unroll
                    for (int r = 0; r < 16; ++r) { const float fr_ = wsf[crow(r, hi)];
#pragma unroll
                        for (int d0 = 0; d0 < ND0; ++d0) o[d0][r] *= fr_; }
                    asm volatile("s_waitcnt lgkmcnt(0)" ::: "memory");
                }
            }
            float s = 0.f;
#pragma unroll
            for (int r = 0; r < 16; ++r) { p0[r] = __builtin_amdgcn_exp2f(p0[r]); p1[r] = __builtin_amdgcn_exp2f(p1[r]); s += p0[r] + p1[r]; }
            l += s;
#ifdef PROBE_S2X
            { float xs = 0.f;
              for (int rep = 0; rep < PROBE_S2X; ++rep) {
#pragma unroll
              for (int r = 0; r < 16; ++r) { xs += __builtin_amdgcn_exp2f(p0[r] - 20.f - xs) + __builtin_amdgcn_exp2f(p1[r] - 21.f - xs); } }
              asm volatile("" :: "v"(xs)); }
#endif
            pack_p(pa, p0, p1);
        } else {
#pragma unroll
            for (int ks = 0; ks < 4; ++ks) pa[ks] = bf16x8{};
        }
        P_PRE((t & (NS - 1)) * STG);
#ifdef PROBE_STAMP
        { const unsigned long long ts2_ = PROBE_CLK(); if (ISB == (PROBE_STAMP_B != 0)) { if (PROBE_STAMP == 1) stamp_acc += ts1_ - ts0_; else if (PROBE_STAMP == 2) stamp_acc += ts2_ - ts1_; else stamp_acc += ts2_ - ts0_; } }
#endif
    }
#ifdef PROBE_STAMP
    const unsigned long long tsC_ = PROBE_CLK();
#endif
#ifdef PROBE_PARITY
    if (!ISB) P_BAR();
#else
    P_BAR();
#endif
    P_PV(((NT - 1) & (NS - 1)) * STG, (void)0);
    asm volatile("s_waitcnt lgkmcnt(0)" ::: "memory");
    if (g == 0) P_BAR();
    P_BAR();
#undef P_KRD
#undef P_PRE
#undef P_BAR
#undef P_BAR_V0
#undef P_BAR_V2
#undef P_BAR_V4
#undef P_DMA
#undef P_VRD
#undef P_VMM
#undef P_SB
#undef P_PV
    const float lt = l + __shfl_xor(l, 32);
    if (!ISB) {
        { float inv = 1.0f / lt; if (g == 1) inv *= lam; if (hi == 0) wsf[r32] = inv; asm volatile("s_waitcnt lgkmcnt(0)" ::: "memory"); }
        AT_LAS float* Tm = (AT_LAS float*)lds + (g * 4 + qi) * (32 * A_TP);
#pragma unroll
        for (int r = 0; r < 16; ++r) { const int q = crow(r, hi); const float f = wsf[q];
#pragma unroll
            for (int d0 = 0; d0 < ND0; ++d0) Tm[q * A_TP + d0 * 32 + r32] = o[d0][r] * f; }
        asm volatile("s_waitcnt lgkmcnt(0)\n\ts_barrier" ::: "memory");
        {
            const AT_LAS float* T1 = (const AT_LAS float*)lds + qi * (32 * A_TP); const AT_LAS float* T2 = T1 + 4 * (32 * A_TP);
            const int row = 16 * g + (lane & 15), qt = lane >> 4;
            f32x4 x[8]; float ss = 0.f;
#pragma unroll
            for (int i = 0; i < 8; ++i) { x[i] = *(const AT_LAS f32x4*)(T1 + row * A_TP + qt * 32 + 4 * i) - *(const AT_LAS f32x4*)(T2 + row * A_TP + qt * 32 + 4 * i);
                ss += (x[i][0] * x[i][0] + x[i][1] * x[i][1]) + (x[i][2] * x[i][2] + x[i][3] * x[i][3]); }
            ss += __shfl_xor(ss, 16); ss += __shfl_xor(ss, 32);
            const float rinv = 0.8f / sqrtf(ss * (1.0f / 128.0f) + 1e-6f);
            bf16_t* op = C.O + (size_t)(qrow0 + row) * PITCH + cg * 128 + qt * 32;
#pragma unroll
            for (int i = 0; i < 8; i += 2) {
                const f32x4 g0 = *(const AT_LAS f32x4*)(subl + qt * 32 + 4 * i), g1 = *(const AT_LAS f32x4*)(subl + qt * 32 + 4 * i + 4);
                const f32x4 y0 = x[i] * g0 * rinv, y1 = x[i + 1] * g1 * rinv;
                u32x4 wv; wv.x = cvtpk(y0[0], y0[1]); wv.y = cvtpk(y0[2], y0[3]); wv.z = cvtpk(y1[0], y1[1]); wv.w = cvtpk(y1[2], y1[3]);
                *(u32x4*)(op + 4 * i) = wv;
            }
        }
    } else {
        { const float inv = 1.0f / lt; if (hi == 0) wsf[r32] = inv; asm volatile("s_waitcnt lgkmcnt(0)" ::: "memory"); }
        AT_LAS bf16_t* stg = (AT_LAS bf16_t*)lds + w * 2048;
#pragma unroll
        for (int r = 0; r < 16; ++r) { const int q = crow(r, hi); const float f = wsf[q];
#pragma unroll
            for (int d0 = 0; d0 < ND0; ++d0) { const unsigned pk = cvtpk(o[d0][r] * f, 0.f); stg[q * 64 + d0 * 32 + r32] = (bf16_t)(pk & 0xffffu); } }
        asm volatile("s_waitcnt lgkmcnt(0)" ::: "memory");
        bf16_t* op = C.O + (size_t)qrow0 * PITCH + ccol;
#pragma unroll
        for (int i = 0; i < 4; ++i) { const int row = i * 8 + (lane >> 3), ch = lane & 7; const u32x4 v = *(const AT_LAS u32x4*)(stg + row * 64 + ch * 8); *(u32x4*)(op + (size_t)row * PITCH + ch * 8) = v; }
    }
    asm volatile("s_waitcnt lgkmcnt(0)\n\ts_barrier" ::: "memory");
#ifdef PROBE_STAMP
    { const unsigned long long tsD_ = PROBE_CLK(); if (ISB == (PROBE_STAMP_B != 0)) { if (PROBE_STAMP == 4) stamp_acc = tsB_ - tsA_; else if (PROBE_STAMP == 5) stamp_acc = tsD_ - tsC_; else if (PROBE_STAMP == 6) stamp_acc = tsD_ - tsA_; }
      if (blockIdx.x == PROBE_BLK && tid == PROBE_TID) atomicAdd((unsigned long long*)C.stamp, stamp_acc); }
#endif
}
}

constexpr int NWAVES = 8;
#ifndef MK_N_LAUNCHES
#define MK_N_LAUNCHES 1
#endif
constexpr int N_PHASES = 12;
constexpr int DMODEL = 1024, SEQ = 2048, NBATCH = 8, MP = NBATCH * SEQ, MS = 1024, M = MP + MS, FF = 4096;
constexpr size_t O_Y = 0, O_AKP = 17825792, O_AVP = 34603008, O_BKP = 51380224, O_BVP = 55574528, O_AKS = 59768832, O_AVS = 60817408, O_BKS = 61865984, O_BVS = 62914560, O_END = 63963136;
constexpr size_t MiB = 1u << 20;
constexpr size_t WS_CTL = 0, CTL_ZERO_BYTES = 1 * MiB;
constexpr size_t WS_WQKV = 2 * MiB, WS_WAO = 8 * MiB, WS_WKVQ = 10 * MiB, WS_WBO = 16 * MiB, WS_W1 = 18 * MiB  , WS_W2 = 34 * MiB  ;
constexpr size_t WS_CS = 50 * MiB;
constexpr size_t WS_SS = 51 * MiB;
constexpr size_t WS_HB = 54 * MiB, WS_Q = 90 * MiB, WS_K = 126 * MiB, WS_V = 162 * MiB, WS_O = 198 * MiB;
constexpr size_t WS_U = 234 * MiB;
constexpr size_t WS_END = 372 * MiB;
constexpr int CW_TMO = 0, CW_CODE = 1, CW_BAR = 4096, CW_FIN = 8192;
constexpr int RS_OFF = 139264;
constexpr int RING_OFF = 0, RING_BYTES = 131072, LDS_BYTES = 163840, LDSCTL_OFF = LDS_BYTES - 1024, MISC_OFF = LDSCTL_OFF + 320;

struct Args { const float* in[20]; float* out; unsigned char* ws; int ph_lo, ph_hi, li, pad; };

struct Frame {
    LAS unsigned char* lds; volatile LAS unsigned* MISC; gu32* ctl;
    int tid, lane, wave, vcu, G;
};

__device__ __forceinline__ float wave_sum(float v) {
#pragma unroll
    for (int o = 1; o < 64; o <<= 1) v += __shfl_xor(v, o);
    return v;
}
__device__ __forceinline__ int pi64(int d) { return d < 32 ? 32 * (d >> 4) + (d & 15) : 32 * ((d - 32) >> 4) + 16 + ((d - 32) & 15); }
template <bool PERMQK>
__device__ __forceinline__ void p0_transpose_item(const float* W, const float* g, int K, int N, bf16* WT, int row_off, LAS float* scr, int item, int lane) {
    const int nblk = N / 32, kb = item / nblk, nb = item % nblk, k0 = 64 * kb, n0 = 32 * nb;
    float wv[32];
#pragma unroll
    for (int i = 0; i < 32; ++i) { const int kk = 2 * i + (lane >> 5); wv[i] = W[(size_t)(k0 + kk) * N + n0 + (lane & 31)]; }
#pragma unroll
    for (int i = 0; i < 32; ++i) { const int kk = 2 * i + (lane >> 5); const float gv = g ? g[k0 + kk] : 1.0f; scr[kk * 33 + (lane & 31)] = wv[i] * gv; }
    LDS_WAIT(); asm volatile("" ::: "memory");
    const int c = lane & 7;
#pragma unroll
    for (int j = 0; j < 4; ++j) { const int n = (lane >> 3) + 8 * j; const LAS float* s = scr + (8 * c) * 33 + n;
        v4u o; o.x = pk2(s[0 * 33], s[1 * 33]); o.y = pk2(s[2 * 33], s[3 * 33]); o.z = pk2(s[4 * 33], s[5 * 33]); o.w = pk2(s[6 * 33], s[7 * 33]);
        int nn = n0 + n; if (PERMQK && nn < 2048) nn = (nn & ~63) + pi64(nn & 63);
        *(GAS v4u*)(WT + (size_t)(row_off + nn) * K + k0 + 8 * c) = o; }
    LDS_WAIT(); asm volatile("" ::: "memory");
}
__device__ __forceinline__ void p0_prologue(Frame& F, const Args& A) {
    unsigned char* ws = A.ws;
    LAS float* scr = (LAS float*)(F.lds + RING_OFF + F.wave * 16384);
    const int gw = F.vcu * NWAVES + F.wave, NGW = F.G * NWAVES;
    constexpr int I_QKV = 16 * 96, I_SQ = 16 * 32, I_KV = 16 * 64, I_F1 = 16 * 128, I_F2 = 64 * 32;
    constexpr int NITEMS = I_QKV + I_SQ + I_KV + I_SQ + I_SQ + 2 * I_F1 + 2 * I_F2;
    const float* g_attn = A.in[6]; const float* g_mlp = A.in[16];
    for (int it = gw; it < NITEMS; it += NGW) {
        int r = it;
        if (r < I_QKV) { p0_transpose_item<true>(A.in[7], g_attn, 1024, 3072, (bf16*)(ws + WS_WQKV), 0, scr, r, F.lane); continue; } r -= I_QKV;
        if (r < I_SQ) { p0_transpose_item<false>(A.in[10], nullptr, 1024, 1024, (bf16*)(ws + WS_WAO), 0, scr, r, F.lane); continue; } r -= I_SQ;
        if (r < I_KV) { p0_transpose_item<false>(A.in[12], A.in[11], 1024, 2048, (bf16*)(ws + WS_WKVQ), 0, scr, r, F.lane); continue; } r -= I_KV;
        if (r < I_SQ) { p0_transpose_item<false>(A.in[13], g_attn + 1024, 1024, 1024, (bf16*)(ws + WS_WKVQ), 2048, scr, r, F.lane); continue; } r -= I_SQ;
        if (r < I_SQ) { p0_transpose_item<false>(A.in[15], nullptr, 1024, 1024, (bf16*)(ws + WS_WBO), 0, scr, r, F.lane); continue; } r -= I_SQ;
        if (r < I_F1) { p0_transpose_item<false>(A.in[17], g_mlp, 1024, 4096, (bf16*)(ws + WS_W1), 0, scr, r, F.lane); continue; } r -= I_F1;
        if (r < I_F1) { p0_transpose_item<false>(A.in[17] + (size_t)1024 * 4096, g_mlp + 1024, 1024, 4096, (bf16*)(ws + WS_W1 + 8 * MiB), 0, scr, r, F.lane); continue; } r -= I_F1;
        if (r < I_F2) { p0_transpose_item<false>(A.in[18], nullptr, 4096, 1024, (bf16*)(ws + WS_W2), 0, scr, r, F.lane); continue; } r -= I_F2;
        p0_transpose_item<false>(A.in[18] + (size_t)4096 * 1024, nullptr, 4096, 1024, (bf16*)(ws + WS_W2 + 8 * MiB), 0, scr, r, F.lane);
    }
    bf16* HB = (bf16*)(ws + WS_HB); float* SS = (float*)(ws + WS_SS);
    for (int m = gw; m < M; m += NGW) {
        const float* xrow = (m < MP) ? A.in[0] + (size_t)m * 1024 : A.in[1] + (size_t)(m - MP) * 1024;
        const GAS f32x4* xr = (const GAS f32x4*)xrow + F.lane;
        f32x4 v[4]; float s = 0.f;
#pragma unroll
        for (int j = 0; j < 4; ++j) { v[j] = xr[64 * j]; s += (v[j].x * v[j].x + v[j].y * v[j].y) + (v[j].z * v[j].z + v[j].w * v[j].w); }
        s = wave_sum(s);
        GAS unsigned long long* o8 = (GAS unsigned long long*)(HB + (size_t)m * 1024) + F.lane;
#pragma unroll
        for (int j = 0; j < 4; ++j) o8[64 * j] = (unsigned long long)pk2(v[j].x, v[j].y) | ((unsigned long long)pk2(v[j].z, v[j].w) << 32);
        if (F.lane < 16) SS[(size_t)m * 16 + F.lane] = (F.lane == 0) ? s : 0.f;
    }
    float* cs = (float*)(ws + WS_CS);
    for (int e = (F.vcu * NWAVES + F.wave) * 64 + F.lane; e < 2048 * 32; e += F.G * NWAVES * 64) {
        const int pos = e >> 5, i = e & 31;
        const float inv = 1.0f / powf(10000.0f, (float)i * (1.0f / 32.0f));
        const float ang = (float)pos * inv;
        float sv, cv; sincosf(ang, &sv, &cv);
        cs[(size_t)pos * 64 + i] = cv; cs[(size_t)pos * 64 + 32 + i] = sv;
    }
}
__device__ __forceinline__ void final_norm(Frame& F, const Args& A, int m_lo, int m_hi) {
    const int gw = F.vcu * NWAVES + F.wave, NGW = F.G * NWAVES;
    const float* SS = (const float*)(A.ws + WS_SS); const float* gf = A.in[19]; const bf16* HB = (const bf16*)(A.ws + WS_HB);
    f32x4 g[4];
#pragma unroll
    for (int j = 0; j < 4; ++j) g[j] = *((const f32x4*)gf + 4 * F.lane + j);
    for (int m = m_lo + gw; m < m_hi; m += NGW) {
        float s = (F.lane < 16) ? SS[(size_t)m * 16 + F.lane] : 0.f;
        s = wave_sum(s);
        const float r = 1.0f / sqrtf(s * (1.0f / 1024.0f) + 1e-6f);
        const v4u h0 = *((const GAS v4u*)(HB + (size_t)m * 1024) + 2 * F.lane), h1 = *((const GAS v4u*)(HB + (size_t)m * 1024) + 2 * F.lane + 1);
        GAS f32x4* yr = (GAS f32x4*)(A.out + (size_t)m * 1024) + 4 * F.lane;
        const unsigned w[8] = {h0.x, h0.y, h0.z, h0.w, h1.x, h1.y, h1.z, h1.w};
#pragma unroll
        for (int j = 0; j < 4; ++j) { f32x4 v; v.x = __uint_as_float(w[2 * j] << 16); v.y = __uint_as_float(w[2 * j] & 0xffff0000u); v.z = __uint_as_float(w[2 * j + 1] << 16); v.w = __uint_as_float(w[2 * j + 1] & 0xffff0000u);
            yr[j] = v * g[j] * r; }
    }
}

struct SplitBar { unsigned* bar; unsigned narr; };
__device__ __forceinline__ void sbar_arrive(SplitBar& sb, const XcdBarrier& b) {
    asm volatile("s_waitcnt vmcnt(0)" ::: "memory");
    __syncthreads();
    if (threadIdx.x == 0) {
        unsigned* bar = sb.bar;
        __builtin_amdgcn_s_waitcnt(0);
        const unsigned nloc = b.st[0], nx = b.st[1];
        const unsigned old = xb_add(&bar[XB_XSUB(b.x)], 1u);
        if ((old + 1u) % nloc == 0u) {
            __builtin_amdgcn_fence(__ATOMIC_RELEASE, "agent");
            asm volatile("s_waitcnt vmcnt(0)" ::: "memory");
            const unsigned og = xb_add(&bar[XB_TOP], 1u);
            if ((og + 1u) % nx == 0u) xb_add(&bar[XB_TOPGEN], 1u);
        }
    }
    ++sb.narr;
}
__device__ __forceinline__ void sbar_wait(const SplitBar& sb, const XcdBarrier& b) {
    if (threadIdx.x == 0) {
        unsigned* bar = sb.bar; unsigned* tb = b.bar;
        XB_SPIN(xb_ld(&bar[XB_TOPGEN]) < sb.narr, tb);
        __builtin_amdgcn_fence(__ATOMIC_ACQUIRE, "agent");
        asm volatile("s_waitcnt vmcnt(0)" ::: "memory");
    }
    __syncthreads();
}

template <int PH, int STREAM>
__device__ __forceinline__ void run_part(Frame& F, const Args& args) {
    unsigned char* const ws = args.ws;
    pg8::bf16_t* const HB = (pg8::bf16_t*)(ws + WS_HB); pg8::bf16_t* const QB = (pg8::bf16_t*)(ws + WS_Q); pg8::bf16_t* const KB = (pg8::bf16_t*)(ws + WS_K);
    pg8::bf16_t* const VB = (pg8::bf16_t*)(ws + WS_V); pg8::bf16_t* const OB = (pg8::bf16_t*)(ws + WS_O); pg8::bf16_t* const UB = (pg8::bf16_t*)(ws + WS_U);
    float* const SS = (float*)(ws + WS_SS);
    LAS float* const rst = (LAS float*)(F.lds + RS_OFF);
#define FILL_RS(N_) pg8::RsTab RSA{nullptr, 0, 0}, RSB{nullptr, 0, 0}; \
        if (STREAM == 1) { pg8::Unit u0; if (S.next(0, u0)) { pg8::rs_fill(SS, rst, u0.pm * 256, 256); RSA = pg8::RsTab{rst, u0.pm * 256, 256}; } } \
        else if (F.vcu < 8 * ((N_) / 128)) { pg8::rs_fill(SS, rst + 256, MP + (F.vcu % 8) * 128, 128); RSB = pg8::RsTab{rst + 256, MP + (F.vcu % 8) * 128, 128}; } \
        __syncthreads();
#define RUN_GEMM(EPI, GEO, NTM, TN_) do { if (STREAM == 1) pg8::gemm_phase<pg8::EPI, pg8::StaticOrder, true, true>(F.lds + RING_OFF, g, S, E); \
        else pg8::gemm_small<pg8::GEO, pg8::EPI>(F.lds + RING_OFF, g.A, g.Bt, g.K, MP, NTM, g.N / (TN_), F.vcu, F.G, E); } while (0)
    if constexpr (PH == 1) {
        pg8::Gemm g{HB, (const pg8::bf16_t*)(ws + WS_WQKV), M, 3072, 1024}; pg8::StaticOrder S; S.init(MP, 3072, F.G, (int)blockIdx.x);
        FILL_RS(3072)
        pg8::EpiQKV E{SS, (const float*)(ws + WS_CS), QB, KB, VB, args.out, RSA, RSB};
        RUN_GEMM(EpiQKV, GeoS128, 8, 128);
    }
    if constexpr (PH == 2) {
        at::Ctx C{QB, KB, VB, OB, args.in[2], args.in[3], args.in[8], args.in[9], nullptr, nullptr, at::diff_lambda(args.in[8])};
        for (int vv = F.vcu; vv < 256; vv += F.G) {
            if (STREAM == 0) at::attn_sample_unit<false>(F.lds, vv >> 3, vv & 7, C);
            else { const int x = vv >> 5, c = vv & 31, u = c & 15;
#pragma unroll 1
                for (int r = 0; r < 4; ++r) { const int bh = r * 16 + x * 2 + (c >> 4), ub = (r & 1) ? 15 - u : u; at::attn_prompt_unit<false>(F.lds, bh >> 3, bh & 7, ub, C); } }
        }
    }
    if constexpr (PH == 3 || PH == 8) {
        pg8::Gemm g{OB, (const pg8::bf16_t*)(ws + (PH == 3 ? WS_WAO : WS_WBO)), M, 1024, 1024}; pg8::StaticOrder S; S.init(MP, 1024, F.G, (int)blockIdx.x);
        pg8::EpiRes E{HB, SS, 1.f};
        RUN_GEMM(EpiRes, GeoS64, 16, 64);
    }
    if constexpr (PH == 4 || PH == 9) {
        pg8::Gemm g{HB, (const pg8::bf16_t*)(ws + WS_W1 + (PH == 9 ? 8 * MiB : 0)), M, FF, 1024}; pg8::StaticOrder S; S.init(MP, FF, F.G, (int)blockIdx.x);
        FILL_RS(FF)
        pg8::EpiFF1 E{SS, UB, FF, RSA, RSB};
        RUN_GEMM(EpiFF1, GeoS128, 8, 128);
    }
    if constexpr (PH == 5 || PH == 10) {
        pg8::Gemm g{UB, (const pg8::bf16_t*)(ws + WS_W2 + (PH == 10 ? 8 * MiB : 0)), M, 1024, FF}; pg8::StaticOrder S; S.init(MP, 1024, F.G, (int)blockIdx.x);
        pg8::EpiRes E{HB, SS, 1.f};
        RUN_GEMM(EpiRes, GeoS64, 16, 64);
    }
    if constexpr (PH == 6) {
        pg8::Gemm g{HB, (const pg8::bf16_t*)(ws + WS_WKVQ), M, 3072, 1024}; pg8::StaticOrder S; S.init(MP, 3072, F.G, (int)blockIdx.x);
        FILL_RS(3072)
        pg8::EpiKVQ E{SS, QB, KB, args.out, RSA, RSB};
        RUN_GEMM(EpiKVQ, GeoS128, 8, 128);
    }
    if constexpr (PH == 7) {
        at::Ctx C{QB, KB, VB, OB, args.in[4], args.in[5], nullptr, nullptr, args.in[14], nullptr, 0.f};
        for (int vv = F.vcu; vv < 256; vv += F.G) {
            if (STREAM == 0) at::attn_sample_unit<true>(F.lds, vv >> 3, vv & 7, C);
            else {
#pragma unroll 1
                for (int i = 0; i < 4; ++i) { const int bhh = vv >> 1, par = vv & 1, qb = 4 * (i >> 1) + ((i & 1) ? 3 - par : par); at::attn_prompt_unit<true>(F.lds, bhh >> 4, bhh & 15, qb, C); } }
        }
    }
    if constexpr (PH == 11) final_norm(F, args, STREAM == 0 ? MP : 0, STREAM == 0 ? M : MP);
#undef FILL_RS
#undef RUN_GEMM
}
__global__ void __launch_bounds__(NWAVES * 64, 2) skel_fwd(Args args) {
    extern __shared__ __attribute__((aligned(16))) unsigned char lds[];
    Frame F;
    F.lds = (LAS unsigned char*)lds;
    F.MISC = (volatile LAS unsigned*)(F.lds + MISC_OFF);
    F.tid = threadIdx.x; F.lane = F.tid & 63; F.wave = __builtin_amdgcn_readfirstlane(F.tid >> 6);
    F.G = gridDim.x; { const int bx = blockIdx.x; F.vcu = (F.G % 8 == 0) ? (bx % 8) * (F.G / 8) + bx / 8 : bx; }
    F.ctl = (gu32*)(args.ws + WS_CTL);
    for (int u = F.tid; u < (LDS_BYTES - LDSCTL_OFF) / 4; u += NWAVES * 64) ((LAS unsigned*)(F.lds + LDSCTL_OFF))[u] = 0u;
    __syncthreads();
    XcdBarrier bar = xcd_barrier_post((unsigned*)(F.ctl + CW_BAR), F.MISC + 8);
    SplitBar sbS{(unsigned*)(F.ctl + CW_BAR) + 4096, 0u}, sbP{(unsigned*)(F.ctl + CW_BAR) + 8192, 0u};
    p0_prologue(F, args);
    xcd_barrier(bar);
#define DO_PHASE(k, FIRST) do { if (!(FIRST)) sbar_wait(sbS, bar); run_part<k, 0>(F, args); sbar_arrive(sbS, bar); \
                                 if (!(FIRST)) sbar_wait(sbP, bar); run_part<k, 1>(F, args); sbar_arrive(sbP, bar); } while (0)
    DO_PHASE(1, true); DO_PHASE(2, false); DO_PHASE(3, false); DO_PHASE(4, false); DO_PHASE(5, false); DO_PHASE(6, false); DO_PHASE(7, false); DO_PHASE(8, false); DO_PHASE(9, false); DO_PHASE(10, false);
#undef DO_PHASE
    sbar_wait(sbS, bar); run_part<11, 0>(F, args);
    sbar_wait(sbP, bar); run_part<11, 1>(F, args);
}

extern "C" void kernel_launch(void* const* d_in, const int* in_sizes, int n_in, void* d_out, int out_size, void* d_ws, size_t ws_size, hipStream_t stream) {
    static int grid = 0;
    if (grid == 0) {
        if (n_in != 20 || out_size != (int)O_END || ws_size < WS_END) { fprintf(stderr, "kernel_launch: unexpected problem (n_in %d out %d ws %zu)\n", n_in, out_size, ws_size); grid = -1; return; }
        int dev = 0, cus = 0, per_cu = 0;
        if (hipGetDevice(&dev) != hipSuccess || hipDeviceGetAttribute(&cus, hipDeviceAttributeMultiprocessorCount, dev) != hipSuccess) { grid = -1; return; }
        if (hipFuncSetAttribute((const void*)skel_fwd, hipFuncAttributeMaxDynamicSharedMemorySize, LDS_BYTES) != hipSuccess) { fprintf(stderr, "kernel_launch: hipFuncSetAttribute failed\n"); grid = -1; return; }
        if (hipOccupancyMaxActiveBlocksPerMultiprocessor(&per_cu, (const void*)skel_fwd, NWAVES * 64, LDS_BYTES) != hipSuccess || per_cu < 1) { fprintf(stderr, "kernel_launch: occupancy query reports %d\n", per_cu); per_cu = 1; }
        (void)hipGetLastError();
        grid = cus;
        if (grid > 256) grid = 256;
    }
    if (grid < 0) return;
    (void)hipMemsetAsync((char*)d_ws + WS_CTL, 0, CTL_ZERO_BYTES, stream);
    Args a{};
    for (int i = 0; i < 20; ++i) a.in[i] = (const float*)d_in[i];
    a.out = (float*)d_out; a.ws = (unsigned char*)d_ws;
    hipLaunchKernelGGL(skel_fwd, dim3(grid), dim3(NWAVES * 64), LDS_BYTES, stream, a);
}
```

```cpp
#include <hip/hip_runtime.h>
#include <cstdio>
#include <cstdint>
#include <cmath>
namespace pg8 {
__device__ __forceinline__ int opaque_tid() { int t = threadIdx.x; asm volatile("" : "+v"(t)); return t; }
#define PG8_LAS __attribute__((address_space(3)))
typedef unsigned short bf16_t;
typedef short bf16x8 __attribute__((ext_vector_type(8)));
typedef float f32x4 __attribute__((ext_vector_type(4)));
typedef unsigned u32x4 __attribute__((ext_vector_type(4)));
constexpr int BM = 256, BK = 64, HALF = 128, HTB = HALF * BK * 2  , STAGE_BYTES = 8 * HTB, NXCD = 8, WGM = 8;

__host__ __device__ __forceinline__ int lds_byte(int r, int c) { const int st = (r >> 4) * 2 + (c >> 5), rr = r & 15, cc = c & 31, ob = rr * 64 + cc * 2; return st * 1024 + (ob ^ (((ob >> 9) & 1) << 5)); }
__host__ __device__ __forceinline__ void stage_rc(int b, int& R, int& C) { const int st = b / 1024, sb = b % 1024, swz = sb ^ (((sb >> 9) & 1) << 5); R = (st >> 1) * 16 + swz / 64; C = (st & 1) * 32 + (swz % 64) / 2; }
__host__ __device__ __forceinline__ int perm32(int rho) { const int n = rho >> 4, i = rho & 15; return 8 * (i >> 2) + 4 * n + (i & 3); }

struct Unit { int pm, pn; };
struct Gemm { const bf16_t* A; const bf16_t* Bt; int M, N, K; };

struct StaticOrder {
    int nM, nN, nwg, G, c;
    __host__ __device__ void init(int M, int N, int G_, int c_) { nM = M / BM; nN = N / BM; nwg = nM * nN; G = G_; c = c_; }
    __host__ __device__ bool next(int i, Unit& u) const {
        const long L = (long)i * G + c; if (L >= nwg) return false;
        int wgid = (int)L; { const int q = nwg / NXCD, r = nwg % NXCD, xcd = wgid % NXCD, off = wgid / NXCD; wgid = (xcd < r ? xcd * (q + 1) : r * (q + 1) + (xcd - r) * q) + off; }
        const int nig = WGM * nN, gid = wgid / nig, fm = gid * WGM, gsz = (nM - fm) < WGM ? (nM - fm) : WGM;
        u.pm = fm + ((wgid % nig) % gsz); u.pn = (wgid % nig) / gsz; return true;
    }
    __device__ __forceinline__ void a_ready(const Unit&) const {}
    __device__ __forceinline__ void done(const Unit&) const {}
};
__device__ __forceinline__ unsigned cvt_pk_bf16(float lo, float hi) { unsigned r; asm volatile("v_cvt_pk_bf16_f32 %0, %1, %2" : "=v"(r) : "v"(lo), "v"(hi)); return r; }
typedef float f32x2 __attribute__((ext_vector_type(2)));

constexpr size_t PO_AKP = 17825792, PO_AVP = 34603008, PO_BKP = 51380224, PO_BVP = 55574528, PO_AKS = 59768832, PO_AVS = 60817408, PO_BKS = 61865984, PO_BVS = 62914560;
constexpr size_t PW_KV = (size_t)36 * 1048576 / 2;
constexpr int P_MP = 16384;
constexpr float P_EPS = 1e-6f;
constexpr float P_C2 = 0.125f * 1.4426950408889634f;
typedef unsigned u32x2 __attribute__((ext_vector_type(2)));
struct GeoBig  { static constexpr int NAI = 2, NBJ = 2, NM = 4, NN = 2, RS_WR = 64, CS_WC = 32, WCN = 4; };
struct GeoS128 { static constexpr int NAI = 1, NBJ = 1, NM = 4, NN = 2, RS_WR = 64, CS_WC = 32, WCN = 4; };
struct GeoS64  { static constexpr int NAI = 1, NBJ = 1, NM = 1, NN = 2, RS_WR = 16, CS_WC = 32, WCN = 2; };
struct Tile { int row0, col0; };

template <class G>
__device__ __forceinline__ void row_rstd(const float* SS, int row0, int fq, float (&rs)[2][4]) {
#pragma unroll
    for (int ai = 0; ai < G::NAI; ++ai)
#pragma unroll
        for (int m = 0; m < G::NM; ++m) {
            const f32x4 v = *(const f32x4*)(SS + (size_t)(row0 + ai * HALF + m * 16) * 16 + 4 * fq);
            float s = (v[0] + v[1]) + (v[2] + v[3]);
            s += __shfl_xor(s, 16); s += __shfl_xor(s, 32);
            rs[ai][m] = 1.0f / sqrtf(s * (1.0f / 1024.0f) + P_EPS);
        }
}
struct RsTab { PG8_LAS const float* t; int row0, nrows; };
__device__ __forceinline__ void rs_fill(const float* SS, PG8_LAS float* t, int row0, int nrows) {
    const int r = threadIdx.x;
    if (r < nrows) {
        const f32x4* p = (const f32x4*)(SS + (size_t)(row0 + r) * 16);
        const f32x4 a = p[0], b = p[1], c = p[2], d = p[3];
        const float s = (((a[0] + a[1]) + (a[2] + a[3])) + ((b[0] + b[1]) + (b[2] + b[3]))) + (((c[0] + c[1]) + (c[2] + c[3])) + ((d[0] + d[1]) + (d[2] + d[3])));
        t[r] = 1.0f / sqrtf(s * (1.0f / 1024.0f) + P_EPS);
    }
}
template <class G>
__device__ __forceinline__ void row_rstd_tab(const RsTab& R, const float* SS, int tile_row0, int row0, int fq, float (&rs)[2][4]) {
    if (tile_row0 >= R.row0 && tile_row0 + (G::NAI == 2 ? 256 : 128) <= R.row0 + R.nrows) {
#pragma unroll
        for (int ai = 0; ai < G::NAI; ++ai)
#pragma unroll
            for (int m = 0; m < G::NM; ++m) rs[ai][m] = R.t[row0 - R.row0 + ai * HALF + m * 16];
    } else row_rstd<G>(SS, row0, fq, rs);
}

struct EpiQKV {
    static constexpr bool PERM = false, AFTER_DRAIN = false;
    const float* SS; const float* cs;
    bf16_t *Qb, *Kb, *Vb; float* out;
    RsTab rsA, rsB;
    __device__ __forceinline__ void operator()(const f32x4 (&acc)[2][2][4][2], const Unit& u, int wr, int wc, int fr, int fq) const { run<GeoBig>(acc, Tile{u.pm * BM, u.pn * BM}, wr, wc, fr, fq, nullptr); }
    template <class G> __device__ __forceinline__ void run(const f32x4 (&acc)[2][2][4][2], const Tile T, int wr, int wc, int fr, int fq, PG8_LAS float* scr) const {
        const int row0 = T.row0 + wr * G::RS_WR + fr;
        float rs[2][4]; row_rstd_tab<G>(G::NAI == 2 ? rsA : rsB, SS, T.row0, row0, fq, rs);
        const int sec = T.col0 >> 10, ct = T.col0 & 1023;
        const bool smp = T.row0 >= P_MP;
#pragma unroll
        for (int ai = 0; ai < G::NAI; ++ai)
#pragma unroll
            for (int m = 0; m < G::NM; ++m) {
                const int row = row0 + ai * HALF + m * 16; const float r = rs[ai][m];
                const int pos = smp ? (1024 + ((row - P_MP) & 31)) : (row & 2047);
                const size_t orow = smp ? (size_t)(row - P_MP) * 1024 : (size_t)row * 1024;
                if (sec < 2) {
                    const int dl = 16 * (wc & 1) + 4 * fq;
                    const f32x4 c4 = *(const f32x4*)(cs + (size_t)pos * 64 + dl), s4 = *(const f32x4*)(cs + (size_t)pos * 64 + 32 + dl);
#pragma unroll
                    for (int bj = 0; bj < G::NBJ; ++bj) {
                        const int col = ct + 128 * bj + 64 * (wc >> 1) + dl;
                        const f32x4 x1 = acc[ai][bj][m][0] * r, x2 = acc[ai][bj][m][1] * r;
                        f32x4 y1 = x1 * c4 - x2 * s4, y2 = x2 * c4 + x1 * s4;
                        if (sec == 0) {
                            y1 = y1 * P_C2; y2 = y2 * P_C2;
                            u32x2 w1, w2; w1.x = cvt_pk_bf16(y1[0], y1[1]); w1.y = cvt_pk_bf16(y1[2], y1[3]); w2.x = cvt_pk_bf16(y2[0], y2[1]); w2.y = cvt_pk_bf16(y2[2], y2[3]);
                            *(u32x2*)(Qb + (size_t)row * 1024 + col) = w1; *(u32x2*)(Qb + (size_t)row * 1024 + col + 32) = w2;
                        } else {
                            float* ok = out + (smp ? PO_AKS : PO_AKP) + orow + col;
                            *(f32x4*)ok = y1; *(f32x4*)(ok + 32) = y2;
                            u32x2 w1, w2; w1.x = cvt_pk_bf16(y1[0], y1[1]); w1.y = cvt_pk_bf16(y1[2], y1[3]); w2.x = cvt_pk_bf16(y2[0], y2[1]); w2.y = cvt_pk_bf16(y2[2], y2[3]);
                            *(u32x2*)(Kb + (size_t)row * 1024 + col) = w1; *(u32x2*)(Kb + (size_t)row * 1024 + col + 32) = w2;
                        }
                    }
                } else {
#pragma unroll
                    for (int bj = 0; bj < G::NBJ; ++bj)
#pragma unroll
                        for (int n = 0; n < G::NN; ++n) {
                            const int col = ct + 128 * bj + G::CS_WC * wc + 16 * n + 4 * fq;
                            const f32x4 v = acc[ai][bj][m][n] * r;
                            *(f32x4*)(out + (smp ? PO_AVS : PO_AVP) + orow + col) = v;
                            u32x2 w; w.x = cvt_pk_bf16(v[0], v[1]); w.y = cvt_pk_bf16(v[2], v[3]);
                            *(u32x2*)(Vb + (size_t)row * 1024 + col) = w;
                        }
                }
            }
    }
};

struct EpiKVQ {
    static constexpr bool PERM = true, AFTER_DRAIN = false;
    const float* SS; bf16_t *Qb, *Kb; float* out;
    RsTab rsA, rsB;
    __device__ __forceinline__ void operator()(const f32x4 (&acc)[2][2][4][2], const Unit& u, int wr, int wc, int fr, int fq) const { run<GeoBig>(acc, Tile{u.pm * BM, u.pn * BM}, wr, wc, fr, fq, nullptr); }
    template <class G> __device__ __forceinline__ void run(const f32x4 (&acc)[2][2][4][2], const Tile T, int wr, int wc, int fr, int fq, PG8_LAS float* scr) const {
        const int row0 = T.row0 + wr * G::RS_WR + fr;
        float rs[2][4]; row_rstd_tab<G>(G::NAI == 2 ? rsA : rsB, SS, T.row0, row0, fq, rs);
        const int sec = T.col0 >> 10, ct = T.col0 & 1023;
        const bool smp = T.row0 >= P_MP;
        const bool keep = smp || (((T.row0 >> 8) & 7) >= 6);
        const int col0 = ct + wc * 32 + 8 * fq;
#pragma unroll
        for (int ai = 0; ai < G::NAI; ++ai)
#pragma unroll
            for (int m = 0; m < G::NM; ++m) {
                const int row = row0 + ai * HALF + m * 16; const float r = rs[ai][m];
                const size_t orow = smp ? (size_t)(row - P_MP) * 1024 : ((size_t)(row >> 11) * 512 + (size_t)((row & 2047) - 1536)) * 1024;
#pragma unroll
                for (int bj = 0; bj < G::NBJ; ++bj) {
                    const int col = col0 + bj * HALF;
                    f32x4 v0 = acc[ai][bj][m][0] * r, v1 = acc[ai][bj][m][1] * r;
                    if (sec == 2) {
                        v0 = v0 * P_C2; v1 = v1 * P_C2;
                        u32x4 w; w.x = cvt_pk_bf16(v0[0], v0[1]); w.y = cvt_pk_bf16(v0[2], v0[3]); w.z = cvt_pk_bf16(v1[0], v1[1]); w.w = cvt_pk_bf16(v1[2], v1[3]);
                        *(u32x4*)(Qb + (size_t)row * 1024 + col) = w;
                    } else {
                        if (keep) { float* op = out + (sec == 0 ? (smp ? PO_BKS : PO_BKP) : (smp ? PO_BVS : PO_BVP)) + orow + col; *(f32x4*)op = v0; *(f32x4*)(op + 4) = v1; }
                        u32x4 w; w.x = cvt_pk_bf16(v0[0], v0[1]); w.y = cvt_pk_bf16(v0[2], v0[3]); w.z = cvt_pk_bf16(v1[0], v1[1]); w.w = cvt_pk_bf16(v1[2], v1[3]);
                        *(u32x4*)(Kb + (sec == 0 ? (size_t)0 : PW_KV) + (size_t)row * 1024 + col) = w;
                    }
                }
            }
    }
};

struct EpiRes {
    static constexpr bool PERM = true, AFTER_DRAIN = false;
    bf16_t* Hb; float* SS; float sc;
    __device__ __forceinline__ void operator()(const f32x4 (&acc)[2][2][4][2], const Unit& u, int wr, int wc, int fr, int fq) const { run<GeoBig>(acc, Tile{u.pm * BM, u.pn * BM}, wr, wc, fr, fq, nullptr); }
    template <class G> __device__ __forceinline__ void run(const f32x4 (&acc)[2][2][4][2], const Tile T, int wr, int wc, int fr, int fq, PG8_LAS float* scr) const {
        const int row0 = T.row0 + wr * G::RS_WR + fr, col0 = T.col0 + wc * 32 + 8 * fq;
#pragma unroll
        for (int ai = 0; ai < G::NAI; ++ai)
#pragma unroll
            for (int m = 0; m < G::NM; ++m) {
                const int row = row0 + ai * HALF + m * 16;
                float ssq = 0.f;
#pragma unroll
                for (int bj = 0; bj < G::NBJ; ++bj) {
                    bf16_t* p = Hb + (size_t)row * 1024 + col0 + bj * HALF;
                    const u32x4 o = *(const u32x4*)p;
                    f32x4 h0 = acc[ai][bj][m][0] * sc, h1 = acc[ai][bj][m][1] * sc;
                    h0[0] += __uint_as_float(o.x << 16); h0[1] += __uint_as_float(o.x & 0xffff0000u); h0[2] += __uint_as_float(o.y << 16); h0[3] += __uint_as_float(o.y & 0xffff0000u);
                    h1[0] += __uint_as_float(o.z << 16); h1[1] += __uint_as_float(o.z & 0xffff0000u); h1[2] += __uint_as_float(o.w << 16); h1[3] += __uint_as_float(o.w & 0xffff0000u);
                    u32x4 w; w.x = cvt_pk_bf16(h0[0], h0[1]); w.y = cvt_pk_bf16(h0[2], h0[3]); w.z = cvt_pk_bf16(h1[0], h1[1]); w.w = cvt_pk_bf16(h1[2], h1[3]);
                    *(u32x4*)p = w;
                    ssq += ((h0[0] * h0[0] + h0[1] * h0[1]) + (h0[2] * h0[2] + h0[3] * h0[3])) + ((h1[0] * h1[0] + h1[1] * h1[1]) + (h1[2] * h1[2] + h1[3] * h1[3]));
                }
                ssq += __shfl_xor(ssq, 16); ssq += __shfl_xor(ssq, 32);
                if (G::WCN == 4) { if (fq == 0) SS[(size_t)row * 16 + (T.col0 >> 8) * 4 + wc] = ssq; }
                else { if (fq == 0) scr[(wr * G::RS_WR + m * 16 + fr) * 2 + wc] = ssq; }
            }
        if (G::WCN != 4) {
            __syncthreads();
            const int t_ = threadIdx.x;
            if (t_ < 64) SS[(size_t)(T.row0 + t_) * 16 + (T.col0 >> 6)] = scr[t_ * 2] + scr[t_ * 2 + 1];
            __syncthreads();
        }
    }
};

struct EpiResFinal {
    static constexpr bool PERM = true, AFTER_DRAIN = true;
    const bf16_t* Hb; float* SS; float* out; const float* gf; unsigned* cnt; unsigned* tmo;
    __device__ __forceinline__ void fused(f32x4 (&acc)[2][2][4][2], const Unit& u, int wr, int wc, int fr, int fq, PG8_LAS unsigned char* lds, int wid, int lane) const { run<GeoBig>(acc, Tile{u.pm * BM, u.pn * BM}, wr, wc, fr, fq, (PG8_LAS float*)lds); }
    template <class G> __device__ __forceinline__ void run(f32x4 (&acc)[2][2][4][2], const Tile T, int wr, int wc, int fr, int fq, PG8_LAS float* scr) const {
        const int row0 = T.row0 + wr * G::RS_WR + fr, col0 = T.col0 + wc * 32 + 8 * fq;
        const int tid = threadIdx.x, lane = tid & 63, wid = __builtin_amdgcn_readfirstlane(tid >> 6);
#pragma unroll
        for (int ai = 0; ai < G::NAI; ++ai)
#pragma unroll
            for (int m = 0; m < G::NM; ++m) {
                const int row = row0 + ai * HALF + m * 16;
                float ssq = 0.f;
#pragma unroll
                for (int bj = 0; bj < G::NBJ; ++bj) {
                    const u32x4 o = *(const u32x4*)(Hb + (size_t)row * 1024 + col0 + bj * HALF);
                    f32x4 h0 = acc[ai][bj][m][0], h1 = acc[ai][bj][m][1];
                    h0[0] += __uint_as_float(o.x << 16); h0[1] += __uint_as_float(o.x & 0xffff0000u); h0[2] += __uint_as_float(o.y << 16); h0[3] += __uint_as_float(o.y & 0xffff0000u);
                    h1[0] += __uint_as_float(o.z << 16); h1[1] += __uint_as_float(o.z & 0xffff0000u); h1[2] += __uint_as_float(o.w << 16); h1[3] += __uint_as_float(o.w & 0xffff0000u);
                    acc[ai][bj][m][0] = h0; acc[ai][bj][m][1] = h1;
                    ssq += ((h0[0] * h0[0] + h0[1] * h0[1]) + (h0[2] * h0[2] + h0[3] * h0[3])) + ((h1[0] * h1[0] + h1[1] * h1[1]) + (h1[2] * h1[2] + h1[3] * h1[3]));
                }
                ssq += __shfl_xor(ssq, 16); ssq += __shfl_xor(ssq, 32);
                if (G::WCN == 4) { if (fq == 0) __hip_atomic_store(SS + (size_t)row * 16 + (T.col0 >> 8) * 4 + wc, ssq, __ATOMIC_RELAXED, __HIP_MEMORY_SCOPE_AGENT); }
                else { if (fq == 0) scr[(wr * G::RS_WR + m * 16 + fr) * 2 + wc] = ssq; }
            }
        unsigned* c; unsigned want;
        if (G::WCN == 4) {
            c = cnt + 64 * (T.row0 >> 8); want = 32u;
            asm volatile("s_waitcnt vmcnt(0)" ::: "memory");
            if (lane == 0) __hip_atomic_fetch_add(c, 1u, __ATOMIC_RELAXED, __HIP_MEMORY_SCOPE_AGENT);
        } else {
            c = cnt + 64 * (64 + ((T.row0 - P_MP) >> 6)); want = 16u;
            __syncthreads();
            if (tid < 64) __hip_atomic_store(SS + (size_t)(T.row0 + tid) * 16 + (T.col0 >> 6), scr[tid * 2] + scr[tid * 2 + 1], __ATOMIC_RELAXED, __HIP_MEMORY_SCOPE_AGENT);
            asm volatile("s_waitcnt vmcnt(0)" ::: "memory");
            if (tid == 0) __hip_atomic_fetch_add(c, 1u, __ATOMIC_RELAXED, __HIP_MEMORY_SCOPE_AGENT);
        }
        if (wid == 0) {
            const unsigned long long t0 = __builtin_amdgcn_s_memrealtime();
            for (;;) {
                if ((unsigned)__builtin_amdgcn_readfirstlane((int)__hip_atomic_load(c, __ATOMIC_RELAXED, __HIP_MEMORY_SCOPE_AGENT)) >= want) break;
                if (__builtin_amdgcn_s_memrealtime() - t0 > 2000000ull) { if (lane == 0) __hip_atomic_store(tmo, 1u, __ATOMIC_RELAXED, __HIP_MEMORY_SCOPE_AGENT); break; }
                __builtin_amdgcn_s_sleep(2);
            }
            __builtin_amdgcn_fence(__ATOMIC_ACQUIRE, "agent");
            asm volatile("s_waitcnt vmcnt(0)" ::: "memory");
        }
        __syncthreads();
        f32x4 gv[2][2];
#pragma unroll
        for (int bj = 0; bj < G::NBJ; ++bj) { gv[bj][0] = *(const f32x4*)(gf + col0 + bj * HALF); gv[bj][1] = *(const f32x4*)(gf + col0 + bj * HALF + 4); }
#pragma unroll
        for (int ai = 0; ai < G::NAI; ++ai)
#pragma unroll
            for (int m = 0; m < G::NM; ++m) {
                const int row = row0 + ai * HALF + m * 16;
                const f32x4 v = *(const f32x4*)(SS + (size_t)row * 16 + 4 * fq);
                float s = (v[0] + v[1]) + (v[2] + v[3]);
                s += __shfl_xor(s, 16); s += __shfl_xor(s, 32);
                const float r = 1.0f / sqrtf(s * (1.0f / 1024.0f) + P_EPS);
#pragma unroll
                for (int bj = 0; bj < G::NBJ; ++bj) { float* op = out + (size_t)row * 1024 + col0 + bj * HALF;
                    *(f32x4*)op = acc[ai][bj][m][0] * gv[bj][0] * r; *(f32x4*)(op + 4) = acc[ai][bj][m][1] * gv[bj][1] * r; }
            }
        if (G::WCN != 4) __syncthreads();
    }
};

struct EpiFF1 {
    static constexpr bool PERM = true, AFTER_DRAIN = false;
    const float* SS; bf16_t* U; int ldc;
    RsTab rsA, rsB;
    __device__ __forceinline__ void operator()(const f32x4 (&acc)[2][2][4][2], const Unit& u, int wr, int wc, int fr, int fq) const { run<GeoBig>(acc, Tile{u.pm * BM, u.pn * BM}, wr, wc, fr, fq, nullptr); }
    template <class G> __device__ __forceinline__ void run(const f32x4 (&acc)[2][2][4][2], const Tile T, int wr, int wc, int fr, int fq, PG8_LAS float* scr) const {
        const int row0 = T.row0 + wr * G::RS_WR + fr;
        float rs[2][4]; row_rstd_tab<G>(G::NAI == 2 ? rsA : rsB, SS, T.row0, row0, fq, rs);
        const int col0 = T.col0 + wc * 32 + 8 * fq;
#pragma unroll
        for (int ai = 0; ai < G::NAI; ++ai)
#pragma unroll
            for (int m = 0; m < G::NM; ++m) {
                const float r = rs[ai][m]; bf16_t* rowp = U + (size_t)(row0 + ai * HALF + m * 16) * ldc + col0;
#pragma unroll
                for (int bj = 0; bj < G::NBJ; ++bj) {
                    f32x4 v0 = acc[ai][bj][m][0] * r, v1 = acc[ai][bj][m][1] * r;
#pragma unroll
                    for (int i = 0; i < 4; ++i) { const float a = fmaxf(v0[i], 0.f), b = fmaxf(v1[i], 0.f); v0[i] = a * a; v1[i] = b * b; }
                    u32x4 w; w.x = cvt_pk_bf16(v0[0], v0[1]); w.y = cvt_pk_bf16(v0[2], v0[3]); w.z = cvt_pk_bf16(v1[0], v1[1]); w.w = cvt_pk_bf16(v1[2], v1[3]);
                    *(u32x4*)(rowp + bj * HALF) = w;
                }
            }
    }
};
template <class Epi, class Sched, bool ALIGN_EPI = false, bool SP2 = false>
__device__ __forceinline__ void gemm_phase(PG8_LAS unsigned char* lds, const Gemm g, const Sched& S, const Epi& E) {
    const int tid = opaque_tid(), wid = __builtin_amdgcn_readfirstlane(tid >> 6), lane = tid & 63, wr = wid >> 2, wc = wid & 3, fr = lane & 15, fq = lane >> 4;
    const int K = g.K, nt = K / BK;
    unsigned voffA[2], voffB[2];
#pragma unroll
    for (int i = 0; i < 2; ++i) { int R, C; stage_rc(tid * 16 + i * 8192, R, C); const int Rb = Epi::PERM ? ((R & ~31) + perm32(R & 31)) : R;
        voffA[i] = (unsigned)(R * K + C) * 2u; voffB[i] = (unsigned)(Rb * K + C) * 2u; }
    const size_t kstep = (size_t)(BK * 2);
    const size_t hstep = (size_t)HALF * K * 2;
    const size_t tstep = 2 * hstep;
    const unsigned ldsw = (unsigned)wid * 1024u;
    const int aoff = lds_byte(wr * 64 + fr, fq * 8), boff = lds_byte(wc * 32 + fr, fq * 8);
#define PG8_SA(b, h) (((b) * 2 + (h)) * HTB)
#define PG8_SB(b, h) ((4 + (b) * 2 + (h)) * HTB)
#define PG8_STAGE(bufoff, gbase, voff) do { _Pragma("unroll") for (int _i = 0; _i < 2; ++_i) \
        __builtin_amdgcn_global_load_lds((const unsigned*)((const char*)(gbase) + (voff)[_i]), (PG8_LAS unsigned*)(lds + (bufoff) + ldsw + _i * 8192), 16, 0, 0); } while (0)
#define PG8_LDA(dst, b, h) do { _Pragma("unroll") for (int m = 0; m < 4; ++m) _Pragma("unroll") for (int k = 0; k < 2; ++k) dst[m][k] = *(const PG8_LAS bf16x8*)(lds + PG8_SA(b, h) + aoff + m * 2048 + k * 1024); } while (0)
#define PG8_LDB(dst, b, h) do { _Pragma("unroll") for (int n = 0; n < 2; ++n) _Pragma("unroll") for (int k = 0; k < 2; ++k) dst[n][k] = *(const PG8_LAS bf16x8*)(lds + PG8_SB(b, h) + boff + n * 2048 + k * 1024); } while (0)
#define PG8_MMA(ai, bj, At, Bt) do { __builtin_amdgcn_s_setprio(1); _Pragma("unroll") for (int m = 0; m < 4; ++m) _Pragma("unroll") for (int n = 0; n < 2; ++n) _Pragma("unroll") for (int k = 0; k < 2; ++k) \
        acc[ai][bj][m][n] = __builtin_amdgcn_mfma_f32_16x16x32_bf16(Bt[n][k], At[m][k], acc[ai][bj][m][n], 0, 0, 0); __builtin_amdgcn_s_setprio(0); } while (0)
#define PG8_WAIT_V(n) asm volatile("s_waitcnt vmcnt(" #n ")" ::: "memory")
#define PG8_WAIT_L(n) asm volatile("s_waitcnt lgkmcnt(" #n ")" ::: "memory")
#define PG8_BAR __builtin_amdgcn_s_barrier()
#define PG8_SCHED __builtin_amdgcn_sched_barrier(0)
    Unit cur, nxt; int ui = 0;
    if (!S.next(0, cur)) return;
    f32x4 acc[2][2][4][2];
#pragma unroll
    for (int a = 0; a < 2; ++a)
#pragma unroll
        for (int b = 0; b < 2; ++b)
#pragma unroll
            for (int m = 0; m < 4; ++m)
#pragma unroll
                for (int n = 0; n < 2; ++n) acc[a][b][m][n] = (f32x4){0.f, 0.f, 0.f, 0.f};
    bf16x8 At[4][2], B0[2][2], B1[2][2];
    const char* cA = (const char*)g.A + (size_t)cur.pm * tstep; const char* cB = (const char*)g.Bt + (size_t)cur.pn * tstep;
    S.a_ready(cur);
    if constexpr (SP2) {
        PG8_STAGE(PG8_SB(0, 0), cB, voffB); PG8_STAGE(PG8_SB(0, 1), cB + hstep, voffB); PG8_STAGE(PG8_SA(0, 0), cA, voffA); PG8_STAGE(PG8_SA(0, 1), cA + hstep, voffA);
        if (wr == 1) PG8_BAR;
        PG8_WAIT_V(2); PG8_BAR;
        PG8_STAGE(PG8_SB(1, 0), cB + kstep, voffB); PG8_STAGE(PG8_SA(1, 0), cA + kstep, voffA); PG8_STAGE(PG8_SB(1, 1), cB + hstep + kstep, voffB);
        PG8_WAIT_V(6); PG8_BAR;
    } else {
        PG8_STAGE(PG8_SB(0, 0), cB, voffB); PG8_STAGE(PG8_SA(0, 0), cA, voffA); PG8_STAGE(PG8_SB(0, 1), cB + hstep, voffB); PG8_STAGE(PG8_SA(0, 1), cA + hstep, voffA);
        if (wr == 1) PG8_BAR;
        PG8_WAIT_V(4); PG8_BAR;
        PG8_STAGE(PG8_SB(1, 0), cB + kstep, voffB); PG8_STAGE(PG8_SA(1, 0), cA + kstep, voffA); PG8_STAGE(PG8_SB(1, 1), cB + hstep + kstep, voffB);
        PG8_WAIT_V(6); PG8_BAR;
    }
    for (;;) {
        const bool has_next = S.next(ui + 1, nxt);
        const char* nA = has_next ? (const char*)g.A + (size_t)nxt.pm * tstep : cA; const char* nB = has_next ? (const char*)g.Bt + (size_t)nxt.pn * tstep : cB;
        for (int t = 0; t < nt; t += 2) {
            const bool last = (t == nt - 2);
            const char* a1 = cA + (size_t)(t + 1) * kstep;
            const char* a2 = last ? nA : cA + (size_t)(t + 2) * kstep; const char* b2 = last ? nB : cB + (size_t)(t + 2) * kstep;
            const char* a3 = a2 + kstep; const char* b3 = b2 + kstep;
            if (last && has_next) S.a_ready(nxt);
            if constexpr (SP2) {
            PG8_LDB(B0, 0, 0); PG8_LDB(B1, 0, 1); PG8_SCHED; PG8_LDA(At, 0, 0); PG8_STAGE(PG8_SA(1, 1), a1 + hstep, voffA);
            PG8_WAIT_V(8); PG8_WAIT_L(0); PG8_BAR; PG8_MMA(0, 0, At, B0); PG8_MMA(0, 1, At, B1); PG8_BAR; PG8_SCHED;
            PG8_LDA(At, 0, 1); PG8_STAGE(PG8_SB(0, 0), b2, voffB); PG8_STAGE(PG8_SB(0, 1), b2 + hstep, voffB); PG8_STAGE(PG8_SA(0, 0), a2, voffA);
            PG8_WAIT_V(8); PG8_WAIT_L(0); PG8_BAR; PG8_MMA(1, 0, At, B0); PG8_MMA(1, 1, At, B1); PG8_BAR; PG8_SCHED;
            PG8_LDB(B0, 1, 0); PG8_LDB(B1, 1, 1); PG8_SCHED; PG8_LDA(At, 1, 0); PG8_STAGE(PG8_SA(0, 1), a2 + hstep, voffA);
            PG8_WAIT_V(8); PG8_WAIT_L(0); PG8_BAR; PG8_MMA(0, 0, At, B0); PG8_MMA(0, 1, At, B1); PG8_BAR; PG8_SCHED;
            PG8_LDA(At, 1, 1); PG8_STAGE(PG8_SB(1, 0), b3, voffB); PG8_STAGE(PG8_SB(1, 1), b3 + hstep, voffB); PG8_STAGE(PG8_SA(1, 0), a3, voffA);
            PG8_WAIT_V(8); PG8_WAIT_L(0); PG8_BAR; PG8_MMA(1, 0, At, B0); PG8_MMA(1, 1, At, B1); PG8_BAR; PG8_SCHED;
            } else {
            PG8_LDB(B0, 0, 0); PG8_SCHED; PG8_LDA(At, 0, 0); PG8_STAGE(PG8_SA(1, 1), a1 + hstep, voffA);
            PG8_WAIT_L(8); PG8_BAR; PG8_WAIT_L(0); PG8_MMA(0, 0, At, B0); PG8_BAR; PG8_SCHED;
            PG8_LDB(B1, 0, 1); PG8_STAGE(PG8_SB(0, 0), b2, voffB);
            PG8_BAR; PG8_WAIT_L(0); PG8_MMA(0, 1, At, B1); PG8_BAR;
            PG8_LDA(At, 0, 1); PG8_STAGE(PG8_SA(0, 0), a2, voffA);
            PG8_BAR; PG8_WAIT_L(0); PG8_MMA(1, 0, At, B0); PG8_BAR; PG8_SCHED;
            PG8_STAGE(PG8_SB(0, 1), b2 + hstep, voffB);
            PG8_WAIT_V(6); PG8_BAR; PG8_MMA(1, 1, At, B1); PG8_BAR;
            PG8_LDB(B0, 1, 0); PG8_SCHED; PG8_LDA(At, 1, 0); PG8_STAGE(PG8_SA(0, 1), a2 + hstep, voffA);
            PG8_WAIT_L(8); PG8_BAR; PG8_WAIT_L(0); PG8_MMA(0, 0, At, B0); PG8_BAR; PG8_SCHED;
            PG8_LDB(B1, 1, 1); PG8_STAGE(PG8_SB(1, 0), b3, voffB);
            PG8_BAR; PG8_WAIT_L(0); PG8_MMA(0, 1, At, B1); PG8_BAR;
            PG8_LDA(At, 1, 1); PG8_STAGE(PG8_SA(1, 0), a3, voffA);
            PG8_BAR; PG8_WAIT_L(0); PG8_MMA(1, 0, At, B0); PG8_BAR; PG8_SCHED;
            PG8_STAGE(PG8_SB(1, 1), b3 + hstep, voffB);
            PG8_WAIT_V(6); PG8_BAR; PG8_MMA(1, 1, At, B1); PG8_BAR;
            }
        }
        if constexpr (ALIGN_EPI) { if (wr == 0) PG8_BAR; }
        if constexpr (!Epi::AFTER_DRAIN) { E(acc, cur, wr, wc, fr, fq); S.done(cur); }
        if (!has_next) break;
#pragma unroll
        for (int a = 0; a < 2; ++a)
#pragma unroll
            for (int b = 0; b < 2; ++b)
#pragma unroll
                for (int m = 0; m < 4; ++m)
#pragma unroll
                    for (int n = 0; n < 2; ++n) acc[a][b][m][n] = (f32x4){0.f, 0.f, 0.f, 0.f};
        cur = nxt; cA = nA; cB = nB; ++ui;
        if constexpr (ALIGN_EPI) { if (wr == 1) PG8_BAR; }
    }
    PG8_WAIT_V(0);
    if constexpr (!ALIGN_EPI) { if (wr == 0) PG8_BAR; }
    PG8_BAR;
    if constexpr (Epi::AFTER_DRAIN) { E.fused(acc, cur, wr, wc, fr, fq, lds, wid, lane); S.done(cur); }
#undef PG8_SA
#undef PG8_SB
#undef PG8_STAGE
#undef PG8_LDA
#undef PG8_LDB
#undef PG8_MMA
#undef PG8_WAIT_V
#undef PG8_WAIT_L
#undef PG8_BAR
#undef PG8_SCHED
}

template <class G, class Epi>
__device__ __forceinline__ void gemm_small(PG8_LAS unsigned char* lds, const bf16_t* A, const bf16_t* Bt, int K, int row_base, int ntm, int ntn, int vcu, int nwg, const Epi& E) {
    constexpr int TM = (8 / G::WCN) * G::RS_WR * (G::NM * 16 / G::RS_WR), TN = G::WCN * G::CS_WC, SBK = 64, STG = (TM + TN) * 128, NPA = TM / 64, NPB = TN / 64, NP = NPA + NPB;
    static_assert(NP == 4 || NP == 2, "gemm_small: 128 x 128 or 64 x 64 tiles");
    const int tid = opaque_tid(), wid = __builtin_amdgcn_readfirstlane(tid >> 6), lane = tid & 63, wr = wid / G::WCN, wc = wid % G::WCN, fr = lane & 15, fq = lane >> 4;
    const int nk = K / SBK;
    for (int tile = vcu; tile < ntm * ntn; tile += nwg) {
        const int tm = tile % ntm, tn = tile / ntm;
        const bf16_t* Ab = A + (size_t)(row_base + tm * TM) * K; const bf16_t* Bb = Bt + (size_t)(tn * TN) * K;
        f32x4 acc[2][2][4][2];
#pragma unroll
        for (int m = 0; m < G::NM; ++m)
#pragma unroll
            for (int n = 0; n < G::NN; ++n) acc[0][0][m][n] = (f32x4){0.f, 0.f, 0.f, 0.f};
        unsigned goff[NP];
#pragma unroll
        for (int i = 0; i < NP; ++i) { const bool isB = i >= NPA; const int p = wid + 8 * (isB ? i - NPA : i), R = 8 * p + (lane >> 3), c = (lane & 7) ^ ((R >> 1) & 7);
            const int Rs = (isB && Epi::PERM) ? ((R & ~31) + perm32(R & 31)) : R; goff[i] = (unsigned)Rs * K + c * 8; }
#define SM_DMA(stage, kt_) do { _Pragma("unroll") for (int i = 0; i < NP; ++i) { const bool isB = i >= NPA; const int p = wid + 8 * (isB ? i - NPA : i); \
            __builtin_amdgcn_global_load_lds((const unsigned*)((isB ? Bb : Ab) + goff[i] + (size_t)(kt_) * SBK), (PG8_LAS unsigned*)(lds + (stage) * STG + (isB ? TM * 128 : 0) + p * 1024), 16, 0, 0); } } while (0)
#define SM_WAIT(n) asm volatile("s_waitcnt vmcnt(" #n ")" ::: "memory")
#define SM_MMA(stage) do { PG8_LAS unsigned char* sb = lds + (stage) * STG; \
            _Pragma("unroll") for (int kh = 0; kh < 2; ++kh) { bf16x8 af[G::NM], bfr[G::NN]; \
                _Pragma("unroll") for (int m = 0; m < G::NM; ++m) { const int R = wr * G::RS_WR + m * 16 + fr; af[m] = *(const PG8_LAS bf16x8*)(sb + R * 128 + (((kh * 4 + fq) ^ ((R >> 1) & 7)) * 16)); } \
                _Pragma("unroll") for (int n = 0; n < G::NN; ++n) { const int R = wc * G::CS_WC + n * 16 + fr; bfr[n] = *(const PG8_LAS bf16x8*)(sb + TM * 128 + R * 128 + (((kh * 4 + fq) ^ ((R >> 1) & 7)) * 16)); } \
                _Pragma("unroll") for (int m = 0; m < G::NM; ++m) _Pragma("unroll") for (int n = 0; n < G::NN; ++n) acc[0][0][m][n] = __builtin_amdgcn_mfma_f32_16x16x32_bf16(bfr[n], af[m], acc[0][0][m][n], 0, 0, 0); } } while (0)
#define SM_STEP(s, kt_) do { if ((kt_) + 2 < nk) { if (NP == 4) SM_WAIT(8); else SM_WAIT(4); } else if ((kt_) + 1 < nk) { if (NP == 4) SM_WAIT(4); else SM_WAIT(2); } else SM_WAIT(0); \
            asm volatile("s_waitcnt lgkmcnt(0)" ::: "memory"); __builtin_amdgcn_s_barrier(); asm volatile("" ::: "memory"); \
            if ((kt_) + 3 < nk) SM_DMA(((s) + 3) & 3, (kt_) + 3); \
            SM_MMA(s); } while (0)
        SM_DMA(0, 0); SM_DMA(1, 1); SM_DMA(2, 2);
        for (int kt = 0; kt < nk; kt += 4) { SM_STEP(0, kt); SM_STEP(1, kt + 1); SM_STEP(2, kt + 2); SM_STEP(3, kt + 3); }
#undef SM_DMA
#undef SM_WAIT
#undef SM_MMA
#undef SM_STEP
        asm volatile("s_waitcnt lgkmcnt(0)" ::: "memory"); __builtin_amdgcn_s_barrier(); asm volatile("" ::: "memory");
        E.template run<G>(acc, Tile{row_base + tm * TM, tn * TN}, wr, wc, fr, fq, (PG8_LAS float*)(lds + 4 * STG));
    }
}
}
#define GAS __attribute__((address_space(1)))
#define LAS __attribute__((address_space(3)))
typedef unsigned short bf16;
typedef unsigned v4u __attribute__((ext_vector_type(4)));
typedef float f32x4 __attribute__((ext_vector_type(4)));
typedef short bf16x8 __attribute__((ext_vector_type(8)));
typedef GAS unsigned gu32;
typedef GAS unsigned long long gu64;
#define RLX_AGENT __ATOMIC_RELAXED, __HIP_MEMORY_SCOPE_AGENT
#define LDS_WAIT() asm volatile("s_waitcnt lgkmcnt(0)" ::: "memory")
#define VM_WAIT() asm volatile("s_waitcnt vmcnt(0)" ::: "memory")
__device__ __forceinline__ unsigned long long rt() { return __builtin_amdgcn_s_memrealtime(); }
__device__ __forceinline__ unsigned f2bf(float f) { unsigned u = __builtin_bit_cast(unsigned, f); return (u + 0x7fffu + ((u >> 16) & 1u)) >> 16; }
__device__ __forceinline__ unsigned pk2(float lo, float hi) { return f2bf(lo) | (f2bf(hi) << 16); }

#define XB_TMO      128
#define XB_XCNT(j)  (256  + 64 * (j))
#define XB_XSUB(j)  (1280 + 64 * (j))
#define XB_XGEN(j)  (2304 + 64 * (j))
#define XB_TOP      3328
#define XB_TOPGEN   3392
#define XCD_BAR_WORDS 3456
#define XB_SPIN_CAP (1u << 18)

__device__ __forceinline__ unsigned xb_ld(unsigned* p)              { return __hip_atomic_load(p, __ATOMIC_RELAXED, __HIP_MEMORY_SCOPE_AGENT); }
__device__ __forceinline__ unsigned xb_add(unsigned* p, unsigned v) { return __hip_atomic_fetch_add(p, v, __ATOMIC_RELAXED, __HIP_MEMORY_SCOPE_AGENT); }
__device__ __forceinline__ unsigned xb_xcc_id() { return (unsigned)__builtin_amdgcn_s_getreg((3 << 11) | 20) & 0xFu; }
#define XB_SPIN(cond, bar) do { unsigned _sp = 0; while (cond) { __builtin_amdgcn_s_sleep(1); \
    if ((++_sp & 255u) == 0u) { if (xb_ld(&(bar)[XB_TMO])) break; if (_sp > XB_SPIN_CAP) { atomicAdd(&(bar)[XB_TMO], 1u); break; } } } } while (0)

struct XcdBarrier {
    unsigned* bar; unsigned x;
    volatile LAS unsigned* st;
};

__device__ __forceinline__ XcdBarrier xcd_barrier_post(unsigned* bar, volatile LAS unsigned* st) {
    XcdBarrier b; b.bar = bar; b.x = xb_xcc_id(); b.st = st;
    if (threadIdx.x == 0) (void)xb_add(&bar[XB_XCNT(b.x)], 1u);
    return b;
}
__device__ __forceinline__ void xcd_barrier_complete(unsigned* bar, unsigned x, unsigned& nloc, unsigned& nx) {
    const unsigned G = gridDim.x * gridDim.y * gridDim.z;
    unsigned sum, cnt, mine, sp = 0u;
    for (;;) {
        sum = 0u; cnt = 0u; mine = 0u;
#pragma unroll
        for (unsigned j = 0; j < 16; ++j) { const unsigned c = xb_ld(&bar[XB_XCNT(j)]); sum += c; cnt += (c > 0u) ? 1u : 0u; mine = (j == x) ? c : mine; }
        if (sum == G) break;
        __builtin_amdgcn_s_sleep(1);
        if ((++sp & 255u) == 0u) { if (xb_ld(&bar[XB_TMO])) break; if (sp > XB_SPIN_CAP) { atomicAdd(&bar[XB_TMO], 1u); break; } }
    }
    nloc = mine > 0u ? mine : 1u; nx = cnt > 0u ? cnt : 1u;
}

__device__ __forceinline__ void xcd_barrier(const XcdBarrier& b) {
    asm volatile("s_waitcnt vmcnt(0)" ::: "memory");
    __syncthreads();
    if (threadIdx.x == 0) {
        unsigned* bar = b.bar;
        __builtin_amdgcn_s_waitcnt(0);
        unsigned nloc = b.st[0], nx = b.st[1];
        if (nloc == 0u) { xcd_barrier_complete(bar, b.x, nloc, nx); b.st[0] = nloc; b.st[1] = nx; }
        const unsigned old = xb_add(&bar[XB_XSUB(b.x)], 1u);
        const unsigned gen = old / nloc;
        if (old + 1u == (gen + 1u) * nloc) {
#ifndef PROBE_NOWBL2
            __builtin_amdgcn_fence(__ATOMIC_RELEASE, "agent");
#endif
            asm volatile("s_waitcnt vmcnt(0)" ::: "memory");
            const unsigned og = xb_add(&bar[XB_TOP], 1u);
            const unsigned tg = og / nx;
            if (og + 1u == (tg + 1u) * nx) xb_add(&bar[XB_TOPGEN], 1u);
            else XB_SPIN(xb_ld(&bar[XB_TOPGEN]) == tg, bar);
            __builtin_amdgcn_fence(__ATOMIC_ACQUIRE, "agent");
            xb_add(&bar[XB_XGEN(b.x)], 1u);
            asm volatile("s_waitcnt vmcnt(0)" ::: "memory");
        } else {
            XB_SPIN(xb_ld(&bar[XB_XGEN(b.x)]) == gen, bar);
            __builtin_amdgcn_fence(__ATOMIC_ACQUIRE, "agent");
            asm volatile("s_waitcnt vmcnt(0)" ::: "memory");
        }
    }
    __syncthreads();
}

#ifndef THR_VALUE
#define THR_VALUE 8.0f
#endif
namespace at {
#define AT_LAS __attribute__((address_space(3)))
typedef short bf16x8 __attribute__((ext_vector_type(8)));
typedef short s16x4 __attribute__((ext_vector_type(4)));
typedef float f32x16 __attribute__((ext_vector_type(16)));
typedef float f32x4 __attribute__((ext_vector_type(4)));
typedef unsigned u32x4 __attribute__((ext_vector_type(4)));
typedef unsigned u32x2 __attribute__((ext_vector_type(2)));
typedef unsigned short bf16_t;
constexpr int MP = 16384, PITCH = 1024, SEQ = 2048;
constexpr int KCS = 1040;
constexpr int KT_BYTES = 8 * KCS;
constexpr float THR = THR_VALUE;
constexpr int WSF_OFF = 132096;
constexpr int QIMG_OFF = 99328;
__device__ __forceinline__ int crow(int r, int hi) { return (r & 3) + 8 * (r >> 2) + 4 * hi; }
__device__ __forceinline__ unsigned cvtpk(float lo, float hi) { typedef float f2 __attribute__((ext_vector_type(2))); typedef __bf16 b2 __attribute__((ext_vector_type(2))); f2 v = {lo, hi}; b2 b = __builtin_convertvector(v, b2); return __builtin_bit_cast(unsigned, b); }
__device__ __forceinline__ s16x4 vtr(const AT_LAS unsigned char* p) { typedef short v4i16_t __attribute__((ext_vector_type(4))); return __builtin_bit_cast(s16x4, __builtin_amdgcn_ds_read_tr16_b64_v4i16((AT_LAS v4i16_t*)p)); }
#define AT_SYNC() __syncthreads()

template <bool QLDS>
__device__ __forceinline__ void qk_tile(f32x16& p0, f32x16& p1, const AT_LAS unsigned char* kt, const bf16x8 (&qr_)[4], const AT_LAS unsigned char* qimg, int r32, int hi) {
    p0 = f32x16{}; p1 = f32x16{};
#pragma unroll
    for (int d0 = 0; d0 < 4; ++d0) {
        bf16x8 qr[4]; if (QLDS) qr[d0] = *(const AT_LAS bf16x8*)(qimg + (2 * d0 + hi) * 512 + r32 * 16); else qr[d0] = qr_[d0];
        const bf16x8 a0 = *(const AT_LAS bf16x8*)(kt + (2 * d0 + hi) * KCS + r32 * 16);
        const bf16x8 a1 = *(const AT_LAS bf16x8*)(kt + (2 * d0 + hi) * KCS + r32 * 16 + 512);
        p0 = __builtin_amdgcn_mfma_f32_32x32x16_bf16(a0, qr[d0], p0, 0, 0, 0);
        p1 = __builtin_amdgcn_mfma_f32_32x32x16_bf16(a1, qr[d0], p1, 0, 0, 0);
    }
}
template <int ND0>
__device__ __forceinline__ void softmax_tile(f32x16& p0, f32x16& p1, float& m, float& l, f32x16 (&o)[ND0], AT_LAS float* wsf, int r32, int hi) {
    float rm = fmaxf(p0[0], p1[0]);
#pragma unroll
    for (int r = 1; r < 16; ++r) rm = fmaxf(rm, fmaxf(p0[r], p1[r]));
    rm = fmaxf(rm, __shfl_xor(rm, 32));
    if (__any(rm > m + THR)) {
        const float mn = fmaxf(m, rm), f = __builtin_amdgcn_exp2f(m - mn);
        l *= f; m = mn;
        if (hi == 0) wsf[r32] = f;
        asm volatile("s_waitcnt lgkmcnt(0)" ::: "memory");
#pragma unroll
        for (int r = 0; r < 16; ++r) { const float fr_ = wsf[crow(r, hi)];
#pragma unroll
            for (int d0 = 0; d0 < ND0; ++d0) o[d0][r] *= fr_; }
        asm volatile("s_waitcnt lgkmcnt(0)" ::: "memory");
    }
    float s = 0.f;
#pragma unroll
    for (int r = 0; r < 16; ++r) { p0[r] = __builtin_amdgcn_exp2f(p0[r] - m); p1[r] = __builtin_amdgcn_exp2f(p1[r] - m); s += p0[r] + p1[r]; }
    l += s;
}
__device__ __forceinline__ void pack_p(bf16x8 (&pa)[4], const f32x16& p0, const f32x16& p1) {
#pragma unroll
    for (int ks = 0; ks < 4; ++ks) {
        u32x4 w;
        if (ks < 2) { const int b = 8 * ks; w.x = cvtpk(p0[b], p0[b + 1]); w.y = cvtpk(p0[b + 2], p0[b + 3]); w.z = cvtpk(p0[b + 4], p0[b + 5]); w.w = cvtpk(p0[b + 6], p0[b + 7]); }
        else { const int b = 8 * (ks - 2); w.x = cvtpk(p1[b], p1[b + 1]); w.y = cvtpk(p1[b + 2], p1[b + 3]); w.z = cvtpk(p1[b + 4], p1[b + 5]); w.w = cvtpk(p1[b + 6], p1[b + 7]); }
        pa[ks] = __builtin_bit_cast(bf16x8, w);
    }
}
template <int ND0>
__device__ __forceinline__ void pv_packed(f32x16 (&o)[ND0], const AT_LAS unsigned char* vt, const bf16x8 (&pa)[4], int lane, int hi) {
    const AT_LAS unsigned char* vb = vt + ((lane >> 4) & 1) * 32 + (lane & 3) * 8 + (4 * hi + ((lane & 15) >> 2)) * 64;
#pragma unroll
    for (int d0 = 0; d0 < ND0; ++d0)
#pragma unroll
        for (int ks = 0; ks < 4; ++ks) {
            const s16x4 lo = vtr(vb + d0 * 4096 + ks * 1024), hh = vtr(vb + d0 * 4096 + ks * 1024 + 512);
            const bf16x8 bfr = {lo[0], lo[1], lo[2], lo[3], hh[0], hh[1], hh[2], hh[3]};
            o[d0] = __builtin_amdgcn_mfma_f32_32x32x16_bf16(pa[ks], bfr, o[d0], 0, 0, 0);
        }
}
template <int ND0>
__device__ __forceinline__ void pv_tile(f32x16 (&o)[ND0], const AT_LAS unsigned char* vt, const f32x16& p0, const f32x16& p1, int lane, int hi) {
    bf16x8 pa[4]; pack_p(pa, p0, p1); pv_packed<ND0>(o, vt, pa, lane, hi);
}
__device__ __forceinline__ u32x4 ld16(const void* p) { return *(const u32x4*)p; }
__device__ __forceinline__ u32x2 f4_to_bf4(u32x4 v) { u32x2 w; w.x = cvtpk(__uint_as_float(v.x), __uint_as_float(v.y)); w.y = cvtpk(__uint_as_float(v.z), __uint_as_float(v.w)); return w; }

struct Ctx {
    const bf16_t *Q, *K, *V; bf16_t* O;
    const float *cache_k, *cache_v;
    const float *lam_p, *subln;
    const float* rel;
    void* stamp;
    float lam;
};
__device__ __forceinline__ float diff_lambda(const float* lp) {
    const int lane = threadIdx.x & 63;
    float sa = lp[lane] * lp[64 + lane], sc = lp[128 + lane] * lp[192 + lane];
#pragma unroll
    for (int o_ = 1; o_ < 64; o_ <<= 1) { sa += __shfl_xor(sa, o_); sc += __shfl_xor(sc, o_); }
    return __expf(sa) - __expf(sc) + 0.2f;
}
#ifndef PROBE_CLK
#define PROBE_CLK() __builtin_amdgcn_s_memtime()
#endif
#ifndef PROBE_STAMP_B
#define PROBE_STAMP_B 1
#endif
#ifndef PROBE_BLK
#define PROBE_BLK 0
#endif
#ifndef PROBE_TID
#define PROBE_TID 0
#endif

template <int NK, int DV>
__device__ __forceinline__ void ld_bf(u32x4 (&st)[NK + DV / 64], const bf16_t* kbase, const bf16_t* vbase, int nrows, int tid) {
    const int row = tid >> 3, ch = tid & 7; const unsigned koff = (unsigned)row * PITCH + ch * 8;
#pragma unroll
    for (int c = 0; c < NK; ++c) st[c] = (row < nrows) ? ld16(kbase + koff + c * 64) : (u32x4){0u, 0u, 0u, 0u};
    if (DV == 64) { st[NK] = (row < nrows) ? ld16(vbase + koff) : (u32x4){0u, 0u, 0u, 0u}; }
    else {
        const int vrow = tid >> 4; const unsigned voff = (unsigned)vrow * PITCH + (tid & 15) * 8;
#pragma unroll
        for (int i = 0; i < 2; ++i) st[NK + i] = (vrow + 32 * i < nrows) ? ld16(vbase + voff + (size_t)i * 32 * PITCH) : (u32x4){0u, 0u, 0u, 0u};
    }
}
template <int NK, int DV>
__device__ __forceinline__ void wr_bf(const u32x4 (&st)[NK + DV / 64], AT_LAS unsigned char* sb, int tid) {
    const int row = tid >> 3, ch = tid & 7;
#pragma unroll
    for (int c = 0; c < NK; ++c) *(AT_LAS u32x4*)(sb + c * KT_BYTES + ch * KCS + row * 16) = st[c];
    AT_LAS unsigned char* vb = sb + NK * KT_BYTES;
    if (DV == 64) { const int col = ch * 8; *(AT_LAS u32x4*)(vb + ((col >> 5) * 4 + (row >> 4)) * 1024 + (row & 15) * 64 + (col & 31) * 2) = st[NK]; }
    else {
        const int vrow = tid >> 4, col = (tid & 15) * 8;
#pragma unroll
        for (int i = 0; i < 2; ++i) *(AT_LAS u32x4*)(vb + ((col >> 5) * 4 + ((vrow + 32 * i) >> 4)) * 1024 + (vrow & 15) * 64 + (col & 31) * 2) = st[NK + i];
    }
}
__device__ __forceinline__ void glds16(const void* gsrc, unsigned lds_dst) { unsigned keep;
    asm volatile("s_mov_b32 %0, m0\n\ts_mov_b32 m0, %2\n\ts_nop 0\n\tglobal_load_lds_dwordx4 %1, off\n\ts_mov_b32 m0, %0" : "=&s"(keep) : "v"(gsrc), "s"(lds_dst) : "memory"); }
template <int NK, int DV>
__device__ __forceinline__ void dma_bf(const bf16_t* kbase, const bf16_t* vbase, AT_LAS unsigned char* sb, int w, int lane) {
    const unsigned s0 = (unsigned)__builtin_amdgcn_readfirstlane((int)(unsigned)(uintptr_t)sb);
#pragma unroll
    for (int c = 0; c < NK; ++c) glds16(kbase + (size_t)lane * PITCH + c * 64 + w * 8, (unsigned)__builtin_amdgcn_readfirstlane((int)(s0 + c * KT_BYTES + w * KCS)));
#pragma unroll
    for (int i = 0; i < DV / 64; ++i) { const int d0 = 2 * i + (w >> 2), rg = w & 3;
        glds16(vbase + (size_t)(16 * rg + (lane >> 2)) * PITCH + d0 * 32 + (lane & 3) * 8, (unsigned)__builtin_amdgcn_readfirstlane((int)(s0 + NK * KT_BYTES + (d0 * 4 + rg) * 1024))); }
}
__device__ __forceinline__ void dma_prompt(const bf16_t* kbase, const bf16_t* vbase, AT_LAS unsigned char* sb, int w, int lane) {
    const unsigned s0 = (unsigned)__builtin_amdgcn_readfirstlane((int)(unsigned)(uintptr_t)sb);
#pragma unroll
    for (int i = 0; i < 2; ++i) { const int j = 2 * w + i, R = 4 * j + (lane >> 4), c = (lane & 15) ^ (R & 15);
        glds16(kbase + (size_t)R * PITCH + c * 8, (unsigned)__builtin_amdgcn_readfirstlane((int)(s0 + j * 1024))); }
#pragma unroll
    for (int i = 0; i < 2; ++i) { const int d0 = 2 * i + (w >> 2), rg = w & 3;
        glds16(vbase + (size_t)(16 * rg + (lane >> 2)) * PITCH + d0 * 32 + (lane & 3) * 8, (unsigned)__builtin_amdgcn_readfirstlane((int)(s0 + 16384 + (d0 * 4 + rg) * 1024))); }
}
__device__ __forceinline__ void dma_promptB(const bf16_t* kbase, const bf16_t* vbase, AT_LAS unsigned char* sb, int w, int lane) {
    const unsigned s0 = (unsigned)__builtin_amdgcn_readfirstlane((int)(unsigned)(uintptr_t)sb);
    { const int R = 8 * w + (lane >> 3), c = (lane & 7) ^ ((R >> 1) & 7);
      glds16(kbase + (size_t)R * PITCH + c * 8, (unsigned)__builtin_amdgcn_readfirstlane((int)(s0 + w * 1024))); }
    { const int d0 = w >> 2, rg = w & 3;
      glds16(vbase + (size_t)(16 * rg + (lane >> 2)) * PITCH + d0 * 32 + (lane & 3) * 8, (unsigned)__builtin_amdgcn_readfirstlane((int)(s0 + 8192 + (d0 * 4 + rg) * 1024))); }
}
template <int NK, int DV>
__device__ __forceinline__ void ld_f32(u32x4 (&st)[2 * NK + DV / 32], const float* kbase, const float* vbase, int tid) {
    { const unsigned off = (unsigned)(tid >> 4) * 1024 + (tid & 15) * 4;
#pragma unroll
      for (int c = 0; c < NK; ++c)
#pragma unroll
          for (int i = 0; i < 2; ++i) st[c * 2 + i] = ld16(kbase + off + c * 64 + (size_t)i * 32 * 1024); }
    if (DV == 64) { const unsigned off = (unsigned)(tid >> 4) * 1024 + (tid & 15) * 4;
#pragma unroll
        for (int i = 0; i < 2; ++i) st[2 * NK + i] = ld16(vbase + off + (size_t)i * 32 * 1024); }
    else { const unsigned off = (unsigned)(tid >> 5) * 1024 + (tid & 31) * 4;
#pragma unroll
        for (int i = 0; i < 4; ++i) st[2 * NK + i] = ld16(vbase + off + (size_t)i * 16 * 1024); }
}
template <int NK, int DV>
__device__ __forceinline__ void wr_f32(const u32x4 (&st)[2 * NK + DV / 32], AT_LAS unsigned char* sb, int tid) {
    { const int row = tid >> 4, c4 = tid & 15;
#pragma unroll
      for (int c = 0; c < NK; ++c)
#pragma unroll
          for (int i = 0; i < 2; ++i) *(AT_LAS u32x2*)(sb + c * KT_BYTES + (c4 >> 1) * KCS + (row + 32 * i) * 16 + (c4 & 1) * 8) = f4_to_bf4(st[c * 2 + i]); }
    AT_LAS unsigned char* vb = sb + NK * KT_BYTES;
    if (DV == 64) { const int row = tid >> 4, col = (tid & 15) * 4;
#pragma unroll
        for (int i = 0; i < 2; ++i) *(AT_LAS u32x2*)(vb + ((col >> 5) * 4 + ((row + 32 * i) >> 4)) * 1024 + (row & 15) * 64 + (col & 31) * 2) = f4_to_bf4(st[2 * NK + i]); }
    else { const int row = tid >> 5, col = (tid & 31) * 4;
#pragma unroll
        for (int i = 0; i < 4; ++i) *(AT_LAS u32x2*)(vb + ((col >> 5) * 4 + ((row + 16 * i) >> 4)) * 1024 + (row & 15) * 64 + (col & 31) * 2) = f4_to_bf4(st[2 * NK + i]); }
}

constexpr int A_STAGE = 2 * KT_BYTES + 16384;
constexpr int A_TP = 132;
constexpr int S_TAB = WSF_OFF + 2048;
template <bool ISB>
__device__ __forceinline__ void attn_sample_unit(AT_LAS unsigned char* lds, int b, int cg, const Ctx& C) {
    constexpr int ND0 = ISB ? 2 : 4, NT = ISB ? 8 : 16, PAST = ISB ? 512 : 1024;
    const int tid = pg8::opaque_tid(), lane = tid & 63, r32 = lane & 31, hi = lane >> 5;
    const int w = __builtin_amdgcn_readfirstlane(tid >> 6), g = w >> 2;
    AT_LAS float* wsf = (AT_LAS float*)(lds + WSF_OFF) + w * 64;
    AT_LAS float* tab = (AT_LAS float*)(lds + S_TAB) + g * 264;
    const bool active = (w & 3) == 0;
    const int qrow0 = MP + b * 32, qpos = 1024 + r32;
    if (ISB) { for (int i = tid; i < 2 * 257; i += 512) { const int hh = i >= 257 ? 1 : 0, j = i - hh * 257; ((AT_LAS float*)(lds + S_TAB))[hh * 264 + j] = C.rel[(2 * cg + hh) * 257 + j] * 1.4426950408889634f; } }
    const float lam = C.lam;
    bf16x8 qr[4];
    AT_LAS unsigned char* qimg = lds + QIMG_OFF + w * 4096;
#pragma unroll
    for (int d0 = 0; d0 < 4; ++d0) { qr[d0] = *(const bf16x8*)(C.Q + (size_t)(qrow0 + r32) * PITCH + cg * 128 + g * 64 + d0 * 16 + hi * 8);
        *(AT_LAS bf16x8*)(qimg + (2 * d0 + hi) * 512 + r32 * 16) = qr[d0]; }
    f32x16 o[ND0];
#pragma unroll
    for (int d0 = 0; d0 < ND0; ++d0) o[d0] = f32x16{};
    float m = -1e30f, l = 0.f;
    const bf16_t* kb0 = C.K + (size_t)qrow0 * PITCH + cg * 128;
    const bf16_t* vb0 = C.V + (size_t)qrow0 * PITCH + cg * 128;
    const float* kc0 = C.cache_k + (size_t)b * PAST * 1024 + cg * 128;
    const float* vc0 = C.cache_v + (size_t)b * PAST * 1024 + cg * 128;
    { u32x4 sn[4]; ld_bf<2, 128>(sn, kb0, vb0, 32, tid); wr_bf<2, 128>(sn, lds + 2 * A_STAGE, tid); }
    u32x4 st[8];
    ld_f32<2, 128>(st, kc0, vc0, tid);
    for (int t = 0; t < NT; ++t) {
        AT_LAS unsigned char* sb = lds + (t & 1) * A_STAGE;
        wr_f32<2, 128>(st, sb, tid);
        AT_SYNC();
        if (t + 1 < NT) ld_f32<2, 128>(st, kc0 + (size_t)(t + 1) * 64 * 1024, vc0 + (size_t)(t + 1) * 64 * 1024, tid);
        if (active) {
            const int nsub = (t == 0) ? 2 : 1;
#pragma unroll 1
            for (int sub = 0; sub < nsub; ++sub) {
                const AT_LAS unsigned char* sc = sub ? (lds + 2 * A_STAGE) : sb;
                f32x16 p0, p1;
                qk_tile<true>(p0, p1, sc + g * KT_BYTES, qr, qimg, r32, hi);
                if (ISB) {
                    const int kpos0 = sub ? 1024 : 512 + t * 64;
                    if (1024 - (kpos0 + 63) >= 128) { const float cb = tab[256];
#pragma unroll
                        for (int r = 0; r < 16; ++r) { p0[r] += cb; p1[r] += cb; } }
                    else {
#pragma unroll
                        for (int r = 0; r < 16; ++r) { const int rel = qpos - (kpos0 + crow(r, hi));
                            const int i0 = rel < -128 ? -128 : (rel > 128 ? 128 : rel), i1 = (rel - 32) < -128 ? -128 : ((rel - 32) > 128 ? 128 : (rel - 32));
                            p0[r] += tab[i0 + 128]; p1[r] += tab[i1 + 128]; } }
                }
                if (sub) {
#pragma unroll
                    for (int r = 0; r < 16; ++r) p1[r] = -INFINITY;
                }
                softmax_tile<ND0>(p0, p1, m, l, o, wsf, r32, hi);
                pv_tile<ND0>(o, sc + 2 * KT_BYTES + (ISB ? g * 8192 : 0), p0, p1, lane, hi);
            }
        }
    }
    AT_SYNC();
    const float lt = l + __shfl_xor(l, 32);
    if (!ISB) {
        { float inv = 1.0f / lt; if (g == 1) inv *= lam; if (hi == 0) wsf[r32] = inv; asm volatile("s_waitcnt lgkmcnt(0)" ::: "memory"); }
        AT_LAS float* T2 = (AT_LAS float*)lds;
        if (active && g == 1) {
#pragma unroll
            for (int r = 0; r < 16; ++r) { const int q = crow(r, hi); const float f = wsf[q];
#pragma unroll
                for (int d0 = 0; d0 < ND0; ++d0) T2[q * A_TP + d0 * 32 + r32] = o[d0][r] * f; }
        }
        AT_SYNC();
        if (active && g == 0) {
#pragma unroll
            for (int r = 0; r < 16; ++r) { const int q = crow(r, hi); const float f = wsf[q];
#pragma unroll
                for (int d0 = 0; d0 < ND0; ++d0) { const int ix = q * A_TP + d0 * 32 + r32; T2[ix] = o[d0][r] * f - T2[ix]; } }
            asm volatile("s_waitcnt lgkmcnt(0)" ::: "memory");
            const int row = lane & 31, half = lane >> 5;
            f32x4 x[16]; float ss = 0.f;
#pragma unroll
            for (int i = 0; i < 16; ++i) { x[i] = *(const AT_LAS f32x4*)(T2 + row * A_TP + half * 64 + 4 * i); ss += (x[i][0] * x[i][0] + x[i][1] * x[i][1]) + (x[i][2] * x[i][2] + x[i][3] * x[i][3]); }
            ss += __shfl_xor(ss, 32);
            const float rinv = 0.8f / sqrtf(ss * (1.0f / 128.0f) + 1e-6f);
            bf16_t* op = C.O + (size_t)(qrow0 + row) * PITCH + cg * 128 + half * 64;
#pragma unroll
            for (int i = 0; i < 16; i += 2) {
                const f32x4 g0 = *(const f32x4*)(C.subln + half * 64 + 4 * i), g1 = *(const f32x4*)(C.subln + half * 64 + 4 * i + 4);
                const f32x4 y0 = x[i] * g0 * rinv, y1 = x[i + 1] * g1 * rinv;
                u32x4 wv; wv.x = cvtpk(y0[0], y0[1]); wv.y = cvtpk(y0[2], y0[3]); wv.z = cvtpk(y1[0], y1[1]); wv.w = cvtpk(y1[2], y1[3]);
                *(u32x4*)(op + 4 * i) = wv;
            }
        }
    } else if (active) {
        { const float inv = 1.0f / lt; if (hi == 0) wsf[r32] = inv; asm volatile("s_waitcnt lgkmcnt(0)" ::: "memory"); }
        AT_LAS bf16_t* stg = (AT_LAS bf16_t*)lds + g * 2048;
#pragma unroll
        for (int r = 0; r < 16; ++r) { const int q = crow(r, hi); const float f = wsf[q];
#pragma unroll
            for (int d0 = 0; d0 < ND0; ++d0) { const unsigned pk = cvtpk(o[d0][r] * f, 0.f); stg[q * 64 + d0 * 32 + r32] = (bf16_t)(pk & 0xffffu); } }
        asm volatile("s_waitcnt lgkmcnt(0)" ::: "memory");
        bf16_t* op = C.O + (size_t)qrow0 * PITCH + cg * 128 + g * 64;
#pragma unroll
        for (int i = 0; i < 4; ++i) { const int row = i * 8 + (lane >> 3), ch = lane & 7; const u32x4 v = *(const AT_LAS u32x4*)(stg + row * 64 + ch * 8); *(u32x4*)(op + (size_t)row * PITCH + ch * 8) = v; }
    }
    AT_SYNC();
}

constexpr int P_STAGE = 16384 + 16384;
constexpr int P_EPI = 65536;
constexpr int P_WSF = 135168;
constexpr int P_TAB = P_WSF + 2048;
template <bool ISB>
__device__ __forceinline__ void attn_prompt_unit(AT_LAS unsigned char* lds, int b, int cg, int ub, const Ctx& C, bf16x8 (&qr)[4], bool pre, bool has_next, int nb, int ncg, int nub) {
#ifdef PROBE_STAMP
    const unsigned long long tsA_ = PROBE_CLK();
#endif
    constexpr int ND0 = ISB ? 2 : 4, NS = ISB ? 8 : 4, STG = ISB ? 16384 : P_STAGE, DIST = ISB ? 4 : 2, VOFF = ISB ? 8192 : 16384, KR2 = ISB ? 4096 : 8192;
    const int tid = pg8::opaque_tid(), lane = tid & 63, r32 = lane & 31, hi = lane >> 5;
#ifdef PROBE_PARITY
    const int w = __builtin_amdgcn_readfirstlane(tid >> 6), g = ISB ? 0 : (w >> 2), qi = w & 3;
#else
    const int w = __builtin_amdgcn_readfirstlane(tid >> 6), g = w >> 2, qi = w & 3;
#endif
    AT_LAS float* wsf = (AT_LAS float*)(lds + P_WSF) + w * 64;
    AT_LAS float* tab = (AT_LAS float*)(lds + P_TAB);
    const int cw = ISB ? 4 * ub + (w >> 1) : 2 * ub + (qi >> 1);
    const int kt0 = ISB ? ((4 * ub - 8) > 0 ? (4 * ub - 8) : 0) : 0, NT = (ISB ? 4 * ub + 4 : 2 * ub + 2) - kt0;
    const int fv = ISB ? ((cw - 8) > 0 ? (cw - 8) : 0) : 0;
    const int qoff = ISB ? ub * 256 + w * 32 : ub * 128 + qi * 32, qrow0 = b * SEQ + qoff, qpos = qoff + r32;
    const int ccol = ISB ? cg * 64 : cg * 128;
    if (!pre) { if (ISB) { if (tid < 257) tab[tid] = C.rel[cg * 257 + tid] * 1.4426950408889634f; } }
    AT_LAS float* subl = (AT_LAS float*)(lds + P_TAB);
    if (!ISB && !pre) { if (tid < 128) subl[tid] = C.subln[tid]; }
    const float lam = C.lam;
    if (!pre) {
#pragma unroll
        for (int d0 = 0; d0 < 4; ++d0) qr[d0] = *(const bf16x8*)(C.Q + (size_t)(qrow0 + r32) * PITCH + ccol + (ISB ? 0 : g * 64) + d0 * 16 + hi * 8);
    }
    f32x16 o[ND0];
#pragma unroll
    for (int d0 = 0; d0 < ND0; ++d0) o[d0] = f32x16{};
    f32x16 negm = f32x16{};
    float m = 0.f, l = 0.f;
    bf16x8 pa[4];
#pragma unroll
    for (int ks = 0; ks < 4; ++ks) pa[ks] = bf16x8{};
    const bf16_t* kb0 = C.K + (size_t)(b * SEQ + kt0 * 64) * PITCH + ccol;
    const bf16_t* vb0 = C.V + (size_t)(b * SEQ + kt0 * 64) * PITCH + ccol;
#define P_DMA(tt) do { if (ISB) dma_promptB(kb0 + (size_t)(tt) * 64 * PITCH, vb0 + (size_t)(tt) * 64 * PITCH, lds + ((tt) & (NS - 1)) * STG, w, lane); \
                       else dma_prompt(kb0 + (size_t)(tt) * 64 * PITCH, vb0 + (size_t)(tt) * 64 * PITCH, lds + ((tt) & (NS - 1)) * STG, w, lane); } while (0)
    if (!pre) {
#pragma unroll
        for (int tt = 0; tt < DIST; ++tt) if (tt < NT) P_DMA(tt);
    }
    const int vlane = ((lane >> 4) & 1) * 32 + (lane & 3) * 8 + (4 * hi + ((lane & 15) >> 2)) * 64 + VOFF;
    const int klane = ISB ? (r32 * 128 + ((hi ^ ((r32 >> 1) & 7)) << 4)) : (r32 * 256 + (((g * 8 + hi) ^ (r32 & 15)) << 4));
#define P_VRD(buf, blk) do { _Pragma("unroll") for (int ks = 0; ks < 4; ++ks) { buf[2 * ks] = vtr(vp + (blk) * 4096 + ks * 1024); buf[2 * ks + 1] = vtr(vp + (blk) * 4096 + ks * 1024 + 512); } } while (0)
#define P_VMM(buf, blk) do { _Pragma("unroll") for (int ks = 0; ks < 4; ++ks) { const bf16x8 bfr = {buf[2 * ks][0], buf[2 * ks][1], buf[2 * ks][2], buf[2 * ks][3], buf[2 * ks + 1][0], buf[2 * ks + 1][1], buf[2 * ks + 1][2], buf[2 * ks + 1][3]}; \
        o[blk] = __builtin_amdgcn_mfma_f32_32x32x16_bf16(pa[ks], bfr, o[blk], 0, 0, 0); } } while (0)
#define P_SB() __builtin_amdgcn_sched_barrier(0)
#define P_KRD(scur) do { \
        _Pragma("unroll") for (int d0 = 0; d0 < 4; ++d0) { ka[2 * d0] = *(const AT_LAS bf16x8*)(lds + (scur) + (klane ^ (d0 << 5))); ka[2 * d0 + 1] = *(const AT_LAS bf16x8*)(lds + (scur) + (klane ^ (d0 << 5)) + KR2); } } while (0)
#define P_PV(sprev, KRD_STMT) do { const AT_LAS unsigned char* vp = lds + (sprev) + vlane; \
        P_VMM(va, 0); \
        if (ND0 == 4) { P_VRD(va, 2); P_SB(); P_VMM(vb, 1); P_VRD(vb, 3); P_SB(); P_VMM(va, 2); KRD_STMT; P_SB(); P_VMM(vb, 3); } else { KRD_STMT; P_SB(); P_VMM(vb, 1); } P_SB(); } while (0)
#define P_PRE(sprev) do { const AT_LAS unsigned char* vp = lds + (sprev) + vlane; P_VRD(va, 0); P_VRD(vb, 1); } while (0)
#define P_BAR() do { __builtin_amdgcn_sched_barrier(0); asm volatile("s_barrier" ::: "memory"); __builtin_amdgcn_sched_barrier(0); } while (0)
#define P_BAR_V0() do { __builtin_amdgcn_sched_barrier(0); asm volatile("s_waitcnt vmcnt(0)\n\ts_barrier" ::: "memory"); __builtin_amdgcn_sched_barrier(0); } while (0)
#define P_BAR_V2() do { __builtin_amdgcn_sched_barrier(0); asm volatile("s_waitcnt vmcnt(2)\n\ts_barrier" ::: "memory"); __builtin_amdgcn_sched_barrier(0); } while (0)
#define P_BAR_V4() do { __builtin_amdgcn_sched_barrier(0); asm volatile("s_waitcnt vmcnt(4)\n\ts_barrier" ::: "memory"); __builtin_amdgcn_sched_barrier(0); } while (0)
    if (pre) {
        if (ISB) asm volatile("s_waitcnt vmcnt(4) lgkmcnt(0)\n\ts_barrier" ::: "memory");
        else if (g == 0) asm volatile("s_waitcnt vmcnt(8) lgkmcnt(0)\n\ts_barrier" ::: "memory");
        else asm volatile("s_waitcnt vmcnt(0) lgkmcnt(0)\n\ts_barrier" ::: "memory");
    }
    else asm volatile("s_waitcnt vmcnt(0) lgkmcnt(0)\n\ts_barrier" ::: "memory");
    if (g == 1) P_BAR();
    f32x16 p0, p1;
    s16x4 va[8], vb[8]; bf16x8 ka[8];
#ifdef PROBE_STAMP
    unsigned long long stamp_acc = 0;
#endif
    P_PRE(0);
#ifdef PROBE_STAMP
    const unsigned long long tsB_ = PROBE_CLK();
#endif
    for (int t = 0; t < NT; ++t) {
#ifdef PROBE_PARITY
        if (t > 0 && !ISB) P_BAR();
#else
        if (t > 0) P_BAR();
#endif
#ifdef PROBE_STAMP
        const unsigned long long ts0_ = PROBE_CLK();
#endif
        P_PV((t > 0 ? ((t - 1) & (NS - 1)) : 0) * STG, P_KRD((t & (NS - 1)) * STG));
        p0 = __builtin_amdgcn_mfma_f32_32x32x16_bf16(ka[0], qr[0], negm, 0, 0, 0); p1 = __builtin_amdgcn_mfma_f32_32x32x16_bf16(ka[1], qr[0], negm, 0, 0, 0);
#pragma unroll
        for (int d0 = 1; d0 < 4; ++d0) { p0 = __builtin_amdgcn_mfma_f32_32x32x16_bf16(ka[2 * d0], qr[d0], p0, 0, 0, 0); p1 = __builtin_amdgcn_mfma_f32_32x32x16_bf16(ka[2 * d0 + 1], qr[d0], p1, 0, 0, 0); }
        if (ISB) { const int nn = NT - 2 - t; if (nn >= 2) P_BAR_V4(); else if (nn == 1) P_BAR_V2(); else P_BAR_V0(); }
        else P_BAR_V0();
#ifdef PROBE_STAMP
        const unsigned long long ts1_ = PROBE_CLK();
#endif
        if (t + DIST < NT) P_DMA(t + DIST);
        const int kt = kt0 + t;
        const bool vis = ISB ? (kt <= cw && kt >= cw - 8) : (kt <= cw);
        if (vis) {
            if (ISB) {
                const int relmin = cw * 64 + (w & 1) * 32 - (kt * 64 + 63);
                if (relmin >= 128) { const float cb = tab[256];
#pragma unroll
                    for (int r = 0; r < 16; ++r) { p0[r] += cb; p1[r] += cb; } }
                else {
#pragma unroll
                    for (int r = 0; r < 16; ++r) { const int rel = qpos - (kt * 64 + crow(r, hi));
                        const int i0 = rel < -128 ? -128 : (rel > 128 ? 128 : rel), i1 = (rel - 32) < -128 ? -128 : ((rel - 32) > 128 ? 128 : (rel - 32));
                        p0[r] += tab[i0 + 128]; p1[r] += tab[i1 + 128]; } }
            }
            float ra = __builtin_fmaxf(__builtin_fmaxf(p0[0], p0[1]), p1[0]), rb = __builtin_fmaxf(__builtin_fmaxf(p0[2], p0[3]), p1[1]);
            ra = __builtin_fmaxf(__builtin_fmaxf(ra, p1[2]), p1[3]);
#pragma unroll
            for (int r = 4; r < 16; r += 4) { ra = __builtin_fmaxf(__builtin_fmaxf(ra, p0[r]), p0[r + 1]); rb = __builtin_fmaxf(__builtin_fmaxf(rb, p0[r + 2]), p0[r + 3]);
                                              ra = __builtin_fmaxf(__builtin_fmaxf(ra, p1[r]), p1[r + 1]); rb = __builtin_fmaxf(__builtin_fmaxf(rb, p1[r + 2]), p1[r + 3]); }
            float rm = __builtin_fmaxf(ra, rb);
            { auto rr = __builtin_amdgcn_permlane32_swap(__float_as_uint(rm), __float_as_uint(rm), false, false); rm = __builtin_fmaxf(__uint_as_float(rr[0]), __uint_as_float(rr[1])); }
            const bool first = (kt == fv);
            if (first || __any(rm > THR)) {
                const float dl = first ? rm : __builtin_fmaxf(rm, 0.f);
                m += dl;
#pragma unroll
                for (int r = 0; r < 16; ++r) { p0[r] -= dl; p1[r] -= dl; }
#pragma unroll
                for (int r = 0; r < 16; ++r) negm[r] = -m;
                if (!first) {
                    const float f = __builtin_amdgcn_exp2f(-dl); l *= f;
                    if (hi == 0) wsf[r32] = f;
                    asm volatile("s_waitcnt lgkmcnt(0)" ::: "memory");
#pragma unroll
                    for (int r = 0; r < 16; ++r) { const float fr_ = wsf[crow(r, hi)];
#pragma unroll
                        for (int d0 = 0; d0 < ND0; ++d0) o[d0][r] *= fr_; }
                    asm volatile("s_waitcnt lgkmcnt(0)" ::: "memory");
                }
            }
            float s = 0.f;
#pragma unroll
            for (int r = 0; r < 16; ++r) { p0[r] = __builtin_amdgcn_exp2f(p0[r]); p1[r] = __builtin_amdgcn_exp2f(p1[r]); s += p0[r] + p1[r]; }
            l += s;
#ifdef PROBE_S2X
            { float xs = 0.f;
              for (int rep = 0; rep < PROBE_S2X; ++rep) {
#pragma unroll
              for (int r = 0; r < 16; ++r) { xs += __builtin_amdgcn_exp2f(p0[r] - 20.f - xs) + __builtin_amdgcn_exp2f(p1[r] - 21.f - xs); } }
              asm volatile("" :: "v"(xs)); }
#endif
            pack_p(pa, p0, p1);
        } else {
#pragma unroll
            for (int ks = 0; ks < 4; ++ks) pa[ks] = bf16x8{};
        }
        P_PRE((t & (NS - 1)) * STG);
#ifdef PROBE_STAMP
        { const unsigned long long ts2_ = PROBE_CLK(); if (ISB == (PROBE_STAMP_B != 0)) { if (PROBE_STAMP == 1) stamp_acc += ts1_ - ts0_; else if (PROBE_STAMP == 2) stamp_acc += ts2_ - ts1_; else stamp_acc += ts2_ - ts0_; } }
#endif
    }
#ifdef PROBE_STAMP
    const unsigned long long tsC_ = PROBE_CLK();
#endif
#ifdef PROBE_PARITY
    if (!ISB) P_BAR();
#else
    P_BAR();
#endif
    P_PV(((NT - 1) & (NS - 1)) * STG, (void)0);
    asm volatile("s_waitcnt lgkmcnt(0)" ::: "memory");
    if (g == 0) P_BAR();
    P_BAR();
    if (has_next) {
        const int nkt0 = ISB ? ((4 * nub - 8) > 0 ? (4 * nub - 8) : 0) : 0, nNT = (ISB ? 4 * nub + 4 : 2 * nub + 2) - nkt0, nccol = ISB ? ncg * 64 : ncg * 128;
        const bf16_t* nk0 = C.K + (size_t)(nb * SEQ + nkt0 * 64) * PITCH + nccol; const bf16_t* nv0 = C.V + (size_t)(nb * SEQ + nkt0 * 64) * PITCH + nccol;
#pragma unroll
        for (int tt = 0; tt < DIST; ++tt) if (tt < nNT) { if (ISB) dma_promptB(nk0 + (size_t)tt * 64 * PITCH, nv0 + (size_t)tt * 64 * PITCH, lds + tt * STG, w, lane); else dma_prompt(nk0 + (size_t)tt * 64 * PITCH, nv0 + (size_t)tt * 64 * PITCH, lds + tt * STG, w, lane); }
        const int nqrow0 = nb * SEQ + (ISB ? nub * 256 + w * 32 : nub * 128 + qi * 32);
#pragma unroll
        for (int d0 = 0; d0 < 4; ++d0) qr[d0] = *(const bf16x8*)(C.Q + (size_t)(nqrow0 + r32) * PITCH + nccol + (ISB ? 0 : g * 64) + d0 * 16 + hi * 8);
    }
#undef P_KRD
#undef P_PRE
#undef P_BAR
#undef P_BAR_V0
#undef P_BAR_V2
#undef P_BAR_V4
#undef P_DMA
#undef P_VRD
#undef P_VMM
#undef P_SB
#undef P_PV
    const float lt = l + __shfl_xor(l, 32);
    if (!ISB) {
        { float inv = 1.0f / lt; if (g == 1) inv *= lam; if (hi == 0) wsf[r32] = inv; asm volatile("s_waitcnt lgkmcnt(0)" ::: "memory"); }
        AT_LAS float* T2 = (AT_LAS float*)(lds + P_EPI) + qi * (32 * A_TP);
        if (g == 1) {
#pragma unroll
            for (int r = 0; r < 16; ++r) { const int q = crow(r, hi); const float f = wsf[q];
#pragma unroll
                for (int d0 = 0; d0 < ND0; ++d0) T2[q * A_TP + d0 * 32 + r32] = o[d0][r] * f; }
        }
        asm volatile("s_waitcnt lgkmcnt(0)\n\ts_barrier" ::: "memory");
        if (g == 0) {
#pragma unroll
            for (int r = 0; r < 16; ++r) { const int q = crow(r, hi); const float f = wsf[q];
#pragma unroll
                for (int d0 = 0; d0 < ND0; ++d0) { const int ix = q * A_TP + d0 * 32 + r32; T2[ix] = o[d0][r] * f - T2[ix]; } }
            asm volatile("s_waitcnt lgkmcnt(0)" ::: "memory");
            const int row = lane & 31, half = lane >> 5;
            f32x4 x[16]; float ss = 0.f;
#pragma unroll
            for (int i = 0; i < 16; ++i) { x[i] = *(const AT_LAS f32x4*)(T2 + row * A_TP + half * 64 + 4 * i); ss += (x[i][0] * x[i][0] + x[i][1] * x[i][1]) + (x[i][2] * x[i][2] + x[i][3] * x[i][3]); }
            ss += __shfl_xor(ss, 32);
            const float rinv = 0.8f / sqrtf(ss * (1.0f / 128.0f) + 1e-6f);
            bf16_t* op = C.O + (size_t)(qrow0 + row) * PITCH + cg * 128 + half * 64;
#pragma unroll
            for (int i = 0; i < 16; i += 4) {
                const f32x4 g0 = *(const AT_LAS f32x4*)(subl + half * 64 + 4 * i), g1 = *(const AT_LAS f32x4*)(subl + half * 64 + 4 * i + 4), g2 = *(const AT_LAS f32x4*)(subl + half * 64 + 4 * i + 8), g3 = *(const AT_LAS f32x4*)(subl + half * 64 + 4 * i + 12);
                const f32x4 y0 = x[i] * g0 * rinv, y1 = x[i + 1] * g1 * rinv, y2 = x[i + 2] * g2 * rinv, y3 = x[i + 3] * g3 * rinv;
                u32x4 wv; wv.x = cvtpk(y0[0], y0[1]); wv.y = cvtpk(y0[2], y0[3]); wv.z = cvtpk(y1[0], y1[1]); wv.w = cvtpk(y1[2], y1[3]);
                u32x4 wz; wz.x = cvtpk(y2[0], y2[1]); wz.y = cvtpk(y2[2], y2[3]); wz.z = cvtpk(y3[0], y3[1]); wz.w = cvtpk(y3[2], y3[3]);
                *(u32x4*)(op + 4 * i) = wv; *(u32x4*)(op + 4 * i + 8) = wz;
            }
        }
    } else {
        { const float inv = 1.0f / lt; if (hi == 0) wsf[r32] = inv; asm volatile("s_waitcnt lgkmcnt(0)" ::: "memory"); }
        AT_LAS bf16_t* stg = (AT_LAS bf16_t*)(lds + P_EPI) + w * 2048;
#pragma unroll
        for (int r = 0; r < 16; ++r) { const int q = crow(r, hi); const float f = wsf[q];
#pragma unroll
            for (int d0 = 0; d0 < ND0; ++d0) { const unsigned pk = cvtpk(o[d0][r] * f, 0.f); stg[q * 64 + d0 * 32 + r32] = (bf16_t)(pk & 0xffffu); } }
        asm volatile("s_waitcnt lgkmcnt(0)" ::: "memory");
        bf16_t* op = C.O + (size_t)qrow0 * PITCH + ccol;
#pragma unroll
        for (int i = 0; i < 4; ++i) { const int row = i * 8 + (lane >> 3), ch = lane & 7; const u32x4 v = *(const AT_LAS u32x4*)(stg + row * 64 + ch * 8); *(u32x4*)(op + (size_t)row * PITCH + ch * 8) = v; }
    }
    asm volatile("s_waitcnt lgkmcnt(0)\n\ts_barrier" ::: "memory");
#ifdef PROBE_STAMP
    { const unsigned long long tsD_ = PROBE_CLK(); if (ISB == (PROBE_STAMP_B != 0)) { if (PROBE_STAMP == 4) stamp_acc = tsB_ - tsA_; else if (PROBE_STAMP == 5) stamp_acc = tsD_ - tsC_; else if (PROBE_STAMP == 6) stamp_acc = tsD_ - tsA_; }
      if (blockIdx.x == PROBE_BLK && tid == PROBE_TID) atomicAdd((unsigned long long*)C.stamp, stamp_acc); }
#endif
}
}

constexpr int NWAVES = 8;
#ifndef MK_N_LAUNCHES
#define MK_N_LAUNCHES 1
#endif
constexpr int N_PHASES = 12;
constexpr int DMODEL = 1024, SEQ = 2048, NBATCH = 8, MP = NBATCH * SEQ, MS = 1024, M = MP + MS, FF = 4096;
constexpr size_t O_Y = 0, O_AKP = 17825792, O_AVP = 34603008, O_BKP = 51380224, O_BVP = 55574528, O_AKS = 59768832, O_AVS = 60817408, O_BKS = 61865984, O_BVS = 62914560, O_END = 63963136;
constexpr size_t MiB = 1u << 20;
constexpr size_t WS_CTL = 0, CTL_ZERO_BYTES = 1 * MiB;
constexpr size_t WS_WQKV = 2 * MiB, WS_WAO = 8 * MiB, WS_WKVQ = 10 * MiB, WS_WBO = 16 * MiB, WS_W1 = 18 * MiB  , WS_W2 = 34 * MiB  ;
constexpr size_t WS_CS = 50 * MiB;
constexpr size_t WS_SS = 51 * MiB;
constexpr size_t WS_HB = 54 * MiB, WS_Q = 90 * MiB, WS_K = 126 * MiB, WS_V = 162 * MiB, WS_O = 198 * MiB;
constexpr size_t WS_U = 234 * MiB;
constexpr size_t WS_END = 372 * MiB;
constexpr int CW_TMO = 0, CW_CODE = 1, CW_BAR = 4096, CW_FIN = 8192;
constexpr int RS_OFF = 139264;
constexpr int RING_OFF = 0, RING_BYTES = 131072, LDS_BYTES = 163840, LDSCTL_OFF = LDS_BYTES - 1024, MISC_OFF = LDSCTL_OFF + 320;

struct Args { const float* in[20]; float* out; unsigned char* ws; int ph_lo, ph_hi, li, pad; };

struct Frame {
    LAS unsigned char* lds; volatile LAS unsigned* MISC; gu32* ctl;
    int tid, lane, wave, vcu, G;
};

__device__ __forceinline__ float wave_sum(float v) {
#pragma unroll
    for (int o = 1; o < 64; o <<= 1) v += __shfl_xor(v, o);
    return v;
}
__device__ __forceinline__ int pi64(int d) { return d < 32 ? 32 * (d >> 4) + (d & 15) : 32 * ((d - 32) >> 4) + 16 + ((d - 32) & 15); }
template <bool PERMQK>
__device__ __forceinline__ void p0_transpose_item(const float* W, const float* g, int K, int N, bf16* WT, int row_off, LAS float* scr, int item, int lane) {
    const int nblk = N / 32, kb = item / nblk, nb = item % nblk, k0 = 64 * kb, n0 = 32 * nb;
    float wv[32];
#pragma unroll
    for (int i = 0; i < 32; ++i) { const int kk = 2 * i + (lane >> 5); wv[i] = W[(size_t)(k0 + kk) * N + n0 + (lane & 31)]; }
#pragma unroll
    for (int i = 0; i < 32; ++i) { const int kk = 2 * i + (lane >> 5); const float gv = g ? g[k0 + kk] : 1.0f; scr[kk * 33 + (lane & 31)] = wv[i] * gv; }
    LDS_WAIT(); asm volatile("" ::: "memory");
    const int c = lane & 7;
#pragma unroll
    for (int j = 0; j < 4; ++j) { const int n = (lane >> 3) + 8 * j; const LAS float* s = scr + (8 * c) * 33 + n;
        v4u o; o.x = pk2(s[0 * 33], s[1 * 33]); o.y = pk2(s[2 * 33], s[3 * 33]); o.z = pk2(s[4 * 33], s[5 * 33]); o.w = pk2(s[6 * 33], s[7 * 33]);
        int nn = n0 + n; if (PERMQK && nn < 2048) nn = (nn & ~63) + pi64(nn & 63);
        *(GAS v4u*)(WT + (size_t)(row_off + nn) * K + k0 + 8 * c) = o; }
    LDS_WAIT(); asm volatile("" ::: "memory");
}
__device__ __forceinline__ void p0_prologue(Frame& F, const Args& A) {
    unsigned char* ws = A.ws;
    LAS float* scr = (LAS float*)(F.lds + RING_OFF + F.wave * 16384);
    const int gw = F.vcu * NWAVES + F.wave, NGW = F.G * NWAVES;
    constexpr int I_QKV = 16 * 96, I_SQ = 16 * 32, I_KV = 16 * 64, I_F1 = 16 * 128, I_F2 = 64 * 32;
    constexpr int NITEMS = I_QKV + I_SQ + I_KV + I_SQ + I_SQ + 2 * I_F1 + 2 * I_F2;
    const float* g_attn = A.in[6]; const float* g_mlp = A.in[16];
    for (int it = gw; it < NITEMS; it += NGW) {
        int r = it;
        if (r < I_QKV) { p0_transpose_item<true>(A.in[7], g_attn, 1024, 3072, (bf16*)(ws + WS_WQKV), 0, scr, r, F.lane); continue; } r -= I_QKV;
        if (r < I_SQ) { p0_transpose_item<false>(A.in[10], nullptr, 1024, 1024, (bf16*)(ws + WS_WAO), 0, scr, r, F.lane); continue; } r -= I_SQ;
        if (r < I_KV) { p0_transpose_item<false>(A.in[12], A.in[11], 1024, 2048, (bf16*)(ws + WS_WKVQ), 0, scr, r, F.lane); continue; } r -= I_KV;
        if (r < I_SQ) { p0_transpose_item<false>(A.in[13], g_attn + 1024, 1024, 1024, (bf16*)(ws + WS_WKVQ), 2048, scr, r, F.lane); continue; } r -= I_SQ;
        if (r < I_SQ) { p0_transpose_item<false>(A.in[15], nullptr, 1024, 1024, (bf16*)(ws + WS_WBO), 0, scr, r, F.lane); continue; } r -= I_SQ;
        if (r < I_F1) { p0_transpose_item<false>(A.in[17], g_mlp, 1024, 4096, (bf16*)(ws + WS_W1), 0, scr, r, F.lane); continue; } r -= I_F1;
        if (r < I_F1) { p0_transpose_item<false>(A.in[17] + (size_t)1024 * 4096, g_mlp + 1024, 1024, 4096, (bf16*)(ws + WS_W1 + 8 * MiB), 0, scr, r, F.lane); continue; } r -= I_F1;
        if (r < I_F2) { p0_transpose_item<false>(A.in[18], nullptr, 4096, 1024, (bf16*)(ws + WS_W2), 0, scr, r, F.lane); continue; } r -= I_F2;
        p0_transpose_item<false>(A.in[18] + (size_t)4096 * 1024, nullptr, 4096, 1024, (bf16*)(ws + WS_W2 + 8 * MiB), 0, scr, r, F.lane);
    }
    bf16* HB = (bf16*)(ws + WS_HB); float* SS = (float*)(ws + WS_SS);
    for (int m = gw; m < M; m += NGW) {
        const float* xrow = (m < MP) ? A.in[0] + (size_t)m * 1024 : A.in[1] + (size_t)(m - MP) * 1024;
        const GAS f32x4* xr = (const GAS f32x4*)xrow + F.lane;
        f32x4 v[4]; float s = 0.f;
#pragma unroll
        for (int j = 0; j < 4; ++j) { v[j] = xr[64 * j]; s += (v[j].x * v[j].x + v[j].y * v[j].y) + (v[j].z * v[j].z + v[j].w * v[j].w); }
        s = wave_sum(s);
        GAS unsigned long long* o8 = (GAS unsigned long long*)(HB + (size_t)m * 1024) + F.lane;
#pragma unroll
        for (int j = 0; j < 4; ++j) o8[64 * j] = (unsigned long long)pk2(v[j].x, v[j].y) | ((unsigned long long)pk2(v[j].z, v[j].w) << 32);
        if (F.lane < 16) SS[(size_t)m * 16 + F.lane] = (F.lane == 0) ? s : 0.f;
    }
    float* cs = (float*)(ws + WS_CS);
    for (int e = (F.vcu * NWAVES + F.wave) * 64 + F.lane; e < 2048 * 32; e += F.G * NWAVES * 64) {
        const int pos = e >> 5, i = e & 31;
        const float inv = 1.0f / powf(10000.0f, (float)i * (1.0f / 32.0f));
        const float ang = (float)pos * inv;
        float sv, cv; sincosf(ang, &sv, &cv);
        cs[(size_t)pos * 64 + i] = cv; cs[(size_t)pos * 64 + 32 + i] = sv;
    }
}
__device__ __forceinline__ void final_norm(Frame& F, const Args& A, int m_lo, int m_hi) {
    const int gw = F.vcu * NWAVES + F.wave, NGW = F.G * NWAVES;
    const float* SS = (const float*)(A.ws + WS_SS); const float* gf = A.in[19]; const bf16* HB = (const bf16*)(A.ws + WS_HB);
    f32x4 g[4];
#pragma unroll
    for (int j = 0; j < 4; ++j) g[j] = *((const f32x4*)gf + 4 * F.lane + j);
    for (int m = m_lo + gw; m < m_hi; m += NGW) {
        float s = (F.lane < 16) ? SS[(size_t)m * 16 + F.lane] : 0.f;
        s = wave_sum(s);
        const float r = 1.0f / sqrtf(s * (1.0f / 1024.0f) + 1e-6f);
        const v4u h0 = *((const GAS v4u*)(HB + (size_t)m * 1024) + 2 * F.lane), h1 = *((const GAS v4u*)(HB + (size_t)m * 1024) + 2 * F.lane + 1);
        GAS f32x4* yr = (GAS f32x4*)(A.out + (size_t)m * 1024) + 4 * F.lane;
        const unsigned w[8] = {h0.x, h0.y, h0.z, h0.w, h1.x, h1.y, h1.z, h1.w};
#pragma unroll
        for (int j = 0; j < 4; ++j) { f32x4 v; v.x = __uint_as_float(w[2 * j] << 16); v.y = __uint_as_float(w[2 * j] & 0xffff0000u); v.z = __uint_as_float(w[2 * j + 1] << 16); v.w = __uint_as_float(w[2 * j + 1] & 0xffff0000u);
            yr[j] = v * g[j] * r; }
    }
}

struct SplitBar { unsigned* bar; unsigned narr; };
__device__ __forceinline__ void sbar_arrive(SplitBar& sb, const XcdBarrier& b) {
    asm volatile("s_waitcnt vmcnt(0)" ::: "memory");
    __syncthreads();
    if (threadIdx.x == 0) {
        unsigned* bar = sb.bar;
        __builtin_amdgcn_s_waitcnt(0);
        const unsigned nloc = b.st[0], nx = b.st[1];
        const unsigned old = xb_add(&bar[XB_XSUB(b.x)], 1u);
        if ((old + 1u) % nloc == 0u) {
            __builtin_amdgcn_fence(__ATOMIC_RELEASE, "agent");
            asm volatile("s_waitcnt vmcnt(0)" ::: "memory");
            const unsigned og = xb_add(&bar[XB_TOP], 1u);
            if ((og + 1u) % nx == 0u) xb_add(&bar[XB_TOPGEN], 1u);
        }
    }
    ++sb.narr;
}
__device__ __forceinline__ void sbar_wait(const SplitBar& sb, const XcdBarrier& b) {
    if (threadIdx.x == 0) {
        unsigned* bar = sb.bar; unsigned* tb = b.bar;
        XB_SPIN(xb_ld(&bar[XB_TOPGEN]) < sb.narr, tb);
        __builtin_amdgcn_fence(__ATOMIC_ACQUIRE, "agent");
        asm volatile("s_waitcnt vmcnt(0)" ::: "memory");
    }
    __syncthreads();
}

template <int PH, int STREAM>
__device__ __forceinline__ void run_part(Frame& F, const Args& args) {
    unsigned char* const ws = args.ws;
    pg8::bf16_t* const HB = (pg8::bf16_t*)(ws + WS_HB); pg8::bf16_t* const QB = (pg8::bf16_t*)(ws + WS_Q); pg8::bf16_t* const KB = (pg8::bf16_t*)(ws + WS_K);
    pg8::bf16_t* const VB = (pg8::bf16_t*)(ws + WS_V); pg8::bf16_t* const OB = (pg8::bf16_t*)(ws + WS_O); pg8::bf16_t* const UB = (pg8::bf16_t*)(ws + WS_U);
    float* const SS = (float*)(ws + WS_SS);
    LAS float* const rst = (LAS float*)(F.lds + RS_OFF);
#define FILL_RS(N_) pg8::RsTab RSA{nullptr, 0, 0}, RSB{nullptr, 0, 0}; \
        if (STREAM == 1) { pg8::Unit u0; if (S.next(0, u0)) { pg8::rs_fill(SS, rst, u0.pm * 256, 256); RSA = pg8::RsTab{rst, u0.pm * 256, 256}; } } \
        else if (F.vcu < 8 * ((N_) / 128)) { pg8::rs_fill(SS, rst + 256, MP + (F.vcu % 8) * 128, 128); RSB = pg8::RsTab{rst + 256, MP + (F.vcu % 8) * 128, 128}; } \
        __syncthreads();
#define RUN_GEMM(EPI, GEO, NTM, TN_) do { if (STREAM == 1) pg8::gemm_phase<pg8::EPI, pg8::StaticOrder, true, true>(F.lds + RING_OFF, g, S, E); \
        else pg8::gemm_small<pg8::GEO, pg8::EPI>(F.lds + RING_OFF, g.A, g.Bt, g.K, MP, NTM, g.N / (TN_), F.vcu, F.G, E); } while (0)
    if constexpr (PH == 1) {
        pg8::Gemm g{HB, (const pg8::bf16_t*)(ws + WS_WQKV), M, 3072, 1024}; pg8::StaticOrder S; S.init(MP, 3072, F.G, (int)blockIdx.x);
        FILL_RS(3072)
        pg8::EpiQKV E{SS, (const float*)(ws + WS_CS), QB, KB, VB, args.out, RSA, RSB};
        RUN_GEMM(EpiQKV, GeoS128, 8, 128);
    }
    if constexpr (PH == 2) {
        at::Ctx C{QB, KB, VB, OB, args.in[2], args.in[3], args.in[8], args.in[9], nullptr, nullptr, at::diff_lambda(args.in[8])};
        for (int vv = F.vcu; vv < 256; vv += F.G) {
            if (STREAM == 0) at::attn_sample_unit<false>(F.lds, vv >> 3, vv & 7, C);
            else { const int x = vv >> 5, c = vv & 31, u = c & 15;
                at::bf16x8 qr[4]; bool pre = false;
#pragma unroll 1
                for (int r = 0; r < 4; ++r) { const int bh = r * 16 + x * 2 + (c >> 4), ub = (r & 1) ? 15 - u : u; const bool hn = r < 3; const int r2 = r + 1, bh2 = r2 * 16 + x * 2 + (c >> 4), ub2 = (r2 & 1) ? 15 - u : u;
                    at::attn_prompt_unit<false>(F.lds, bh >> 3, bh & 7, ub, C, qr, pre, hn, bh2 >> 3, bh2 & 7, ub2); pre = hn; } }
        }
    }
    if constexpr (PH == 3 || PH == 8) {
        pg8::Gemm g{OB, (const pg8::bf16_t*)(ws + (PH == 3 ? WS_WAO : WS_WBO)), M, 1024, 1024}; pg8::StaticOrder S; S.init(MP, 1024, F.G, (int)blockIdx.x);
        pg8::EpiRes E{HB, SS, 1.f};
        RUN_GEMM(EpiRes, GeoS64, 16, 64);
    }
    if constexpr (PH == 4 || PH == 9) {
        pg8::Gemm g{HB, (const pg8::bf16_t*)(ws + WS_W1 + (PH == 9 ? 8 * MiB : 0)), M, FF, 1024}; pg8::StaticOrder S; S.init(MP, FF, F.G, (int)blockIdx.x);
        FILL_RS(FF)
        pg8::EpiFF1 E{SS, UB, FF, RSA, RSB};
        RUN_GEMM(EpiFF1, GeoS128, 8, 128);
    }
    if constexpr (PH == 5 || PH == 10) {
        pg8::Gemm g{UB, (const pg8::bf16_t*)(ws + WS_W2 + (PH == 10 ? 8 * MiB : 0)), M, 1024, FF}; pg8::StaticOrder S; S.init(MP, 1024, F.G, (int)blockIdx.x);
        pg8::EpiRes E{HB, SS, 1.f};
        RUN_GEMM(EpiRes, GeoS64, 16, 64);
    }
    if constexpr (PH == 6) {
        pg8::Gemm g{HB, (const pg8::bf16_t*)(ws + WS_WKVQ), M, 3072, 1024}; pg8::StaticOrder S; S.init(MP, 3072, F.G, (int)blockIdx.x);
        FILL_RS(3072)
        pg8::EpiKVQ E{SS, QB, KB, args.out, RSA, RSB};
        RUN_GEMM(EpiKVQ, GeoS128, 8, 128);
    }
    if constexpr (PH == 7) {
        at::Ctx C{QB, KB, VB, OB, args.in[4], args.in[5], nullptr, nullptr, args.in[14], nullptr, 0.f};
        for (int vv = F.vcu; vv < 256; vv += F.G) {
            if (STREAM == 0) at::attn_sample_unit<true>(F.lds, vv >> 3, vv & 7, C);
            else {
                at::bf16x8 qr[4]; bool pre = false;
#pragma unroll 1
                for (int i = 0; i < 4; ++i) { const int bhh = vv >> 1, par = vv & 1, qb = 4 * (i >> 1) + ((i & 1) ? 3 - par : par); const bool hn = i < 3; const int i2 = i + 1, qb2 = 4 * (i2 >> 1) + ((i2 & 1) ? 3 - par : par);
                    at::attn_prompt_unit<true>(F.lds, bhh >> 4, bhh & 15, qb, C, qr, pre, hn, bhh >> 4, bhh & 15, qb2); pre = hn; } }
        }
    }
    if constexpr (PH == 11) final_norm(F, args, STREAM == 0 ? MP : 0, STREAM == 0 ? M : MP);
#undef FILL_RS
#undef RUN_GEMM
}
__global__ void __launch_bounds__(NWAVES * 64, 2) skel_fwd(Args args) {
    extern __shared__ __attribute__((aligned(16))) unsigned char lds[];
    Frame F;
    F.lds = (LAS unsigned char*)lds;
    F.MISC = (volatile LAS unsigned*)(F.lds + MISC_OFF);
    F.tid = threadIdx.x; F.lane = F.tid & 63; F.wave = __builtin_amdgcn_readfirstlane(F.tid >> 6);
    F.G = gridDim.x; { const int bx = blockIdx.x; F.vcu = (F.G % 8 == 0) ? (bx % 8) * (F.G / 8) + bx / 8 : bx; }
    F.ctl = (gu32*)(args.ws + WS_CTL);
    for (int u = F.tid; u < (LDS_BYTES - LDSCTL_OFF) / 4; u += NWAVES * 64) ((LAS unsigned*)(F.lds + LDSCTL_OFF))[u] = 0u;
    __syncthreads();
    XcdBarrier bar = xcd_barrier_post((unsigned*)(F.ctl + CW_BAR), F.MISC + 8);
    SplitBar sbS{(unsigned*)(F.ctl + CW_BAR) + 4096, 0u}, sbP{(unsigned*)(F.ctl + CW_BAR) + 8192, 0u};
    p0_prologue(F, args);
    xcd_barrier(bar);
#define DO_PHASE(k, FIRST) do { if (!(FIRST)) sbar_wait(sbS, bar); run_part<k, 0>(F, args); sbar_arrive(sbS, bar); \
                                 if (!(FIRST)) sbar_wait(sbP, bar); run_part<k, 1>(F, args); sbar_arrive(sbP, bar); } while (0)
    DO_PHASE(1, true); DO_PHASE(2, false); DO_PHASE(3, false); DO_PHASE(4, false); DO_PHASE(5, false); DO_PHASE(6, false); DO_PHASE(7, false); DO_PHASE(8, false); DO_PHASE(9, false); DO_PHASE(10, false);
#undef DO_PHASE
    sbar_wait(sbS, bar); run_part<11, 0>(F, args);
    sbar_wait(sbP, bar); run_part<11, 1>(F, args);
}

extern "C" void kernel_launch(void* const* d_in, const int* in_sizes, int n_in, void* d_out, int out_size, void* d_ws, size_t ws_size, hipStream_t stream) {
    static int grid = 0;
    if (grid == 0) {
        if (n_in != 20 || out_size != (int)O_END || ws_size < WS_END) { fprintf(stderr, "kernel_launch: unexpected problem (n_in %d out %d ws %zu)\n", n_in, out_size, ws_size); grid = -1; return; }
        int dev = 0, cus = 0, per_cu = 0;
        if (hipGetDevice(&dev) != hipSuccess || hipDeviceGetAttribute(&cus, hipDeviceAttributeMultiprocessorCount, dev) != hipSuccess) { grid = -1; return; }
        if (hipFuncSetAttribute((const void*)skel_fwd, hipFuncAttributeMaxDynamicSharedMemorySize, LDS_BYTES) != hipSuccess) { fprintf(stderr, "kernel_launch: hipFuncSetAttribute failed\n"); grid = -1; return; }
        if (hipOccupancyMaxActiveBlocksPerMultiprocessor(&per_cu, (const void*)skel_fwd, NWAVES * 64, LDS_BYTES) != hipSuccess || per_cu < 1) { fprintf(stderr, "kernel_launch: occupancy query reports %d\n", per_cu); per_cu = 1; }
        (void)hipGetLastError();
        grid = cus;
        if (grid > 256) grid = 256;
    }
    if (grid < 0) return;
    (void)hipMemsetAsync((char*)d_ws + WS_CTL, 0, CTL_ZERO_BYTES, stream);
    Args a{};
    for (int i = 0; i < 20; ++i) a.in[i] = (const float*)d_in[i];
    a.out = (float*)d_out; a.ws = (unsigned char*)d_ws;
    hipLaunchKernelGGL(skel_fwd, dim3(grid), dim3(NWAVES * 64), LDS_BYTES, stream, a);
}
```

```cpp
#include <hip/hip_runtime.h>
#include <cstdio>
#include <cstdint>
#include <cmath>
namespace pg8 {
__device__ __forceinline__ int opaque_tid() { int t = threadIdx.x; asm volatile("" : "+v"(t)); return t; }
#define PG8_LAS __attribute__((address_space(3)))
typedef unsigned short bf16_t;
typedef short bf16x8 __attribute__((ext_vector_type(8)));
typedef float f32x4 __attribute__((ext_vector_type(4)));
typedef unsigned u32x4 __attribute__((ext_vector_type(4)));
constexpr int BM = 256, BK = 64, HALF = 128, HTB = HALF * BK * 2  , STAGE_BYTES = 8 * HTB, NXCD = 8, WGM = 8;

__host__ __device__ __forceinline__ int lds_byte(int r, int c) { const int st = (r >> 4) * 2 + (c >> 5), rr = r & 15, cc = c & 31, ob = rr * 64 + cc * 2; return st * 1024 + (ob ^ (((ob >> 9) & 1) << 5)); }
__host__ __device__ __forceinline__ void stage_rc(int b, int& R, int& C) { const int st = b / 1024, sb = b % 1024, swz = sb ^ (((sb >> 9) & 1) << 5); R = (st >> 1) * 16 + swz / 64; C = (st & 1) * 32 + (swz % 64) / 2; }
__host__ __device__ __forceinline__ int perm32(int rho) { const int n = rho >> 4, i = rho & 15; return 8 * (i >> 2) + 4 * n + (i & 3); }

struct Unit { int pm, pn; };
struct Gemm { const bf16_t* A; const bf16_t* Bt; int M, N, K; };

struct StaticOrder {
    int nM, nN, nwg, G, c;
    __host__ __device__ void init(int M, int N, int G_, int c_) { nM = M / BM; nN = N / BM; nwg = nM * nN; G = G_; c = c_; }
    __host__ __device__ bool next(int i, Unit& u) const {
        const long L = (long)i * G + c; if (L >= nwg) return false;
        int wgid = (int)L; { const int q = nwg / NXCD, r = nwg % NXCD, xcd = wgid % NXCD, off = wgid / NXCD; wgid = (xcd < r ? xcd * (q + 1) : r * (q + 1) + (xcd - r) * q) + off; }
        const int nig = WGM * nN, gid = wgid / nig, fm = gid * WGM, gsz = (nM - fm) < WGM ? (nM - fm) : WGM;
        u.pm = fm + ((wgid % nig) % gsz); u.pn = (wgid % nig) / gsz; return true;
    }
    __device__ __forceinline__ void a_ready(const Unit&) const {}
    __device__ __forceinline__ void done(const Unit&) const {}
};
__device__ __forceinline__ unsigned cvt_pk_bf16(float lo, float hi) { unsigned r; asm volatile("v_cvt_pk_bf16_f32 %0, %1, %2" : "=v"(r) : "v"(lo), "v"(hi)); return r; }
typedef float f32x2 __attribute__((ext_vector_type(2)));

constexpr size_t PO_AKP = 17825792, PO_AVP = 34603008, PO_BKP = 51380224, PO_BVP = 55574528, PO_AKS = 59768832, PO_AVS = 60817408, PO_BKS = 61865984, PO_BVS = 62914560;
constexpr size_t PW_KV = (size_t)36 * 1048576 / 2;
constexpr int P_MP = 16384;
constexpr float P_EPS = 1e-6f;
constexpr float P_C2 = 0.125f * 1.4426950408889634f;
typedef unsigned u32x2 __attribute__((ext_vector_type(2)));
struct GeoBig  { static constexpr int NAI = 2, NBJ = 2, NM = 4, NN = 2, RS_WR = 64, CS_WC = 32, WCN = 4; };
struct GeoS128 { static constexpr int NAI = 1, NBJ = 1, NM = 4, NN = 2, RS_WR = 64, CS_WC = 32, WCN = 4; };
struct GeoS64  { static constexpr int NAI = 1, NBJ = 1, NM = 1, NN = 2, RS_WR = 16, CS_WC = 32, WCN = 2; };
struct Tile { int row0, col0; };

template <class G>
__device__ __forceinline__ void row_rstd(const float* SS, int row0, int fq, float (&rs)[2][4]) {
#pragma unroll
    for (int ai = 0; ai < G::NAI; ++ai)
#pragma unroll
        for (int m = 0; m < G::NM; ++m) {
            const f32x4 v = *(const f32x4*)(SS + (size_t)(row0 + ai * HALF + m * 16) * 16 + 4 * fq);
            float s = (v[0] + v[1]) + (v[2] + v[3]);
            s += __shfl_xor(s, 16); s += __shfl_xor(s, 32);
            rs[ai][m] = 1.0f / sqrtf(s * (1.0f / 1024.0f) + P_EPS);
        }
}
struct RsTab { PG8_LAS const float* t; int row0, nrows; };
__device__ __forceinline__ void rs_fill(const float* SS, PG8_LAS float* t, int row0, int nrows) {
    const int r = threadIdx.x;
    if (r < nrows) {
        const f32x4* p = (const f32x4*)(SS + (size_t)(row0 + r) * 16);
        const f32x4 a = p[0], b = p[1], c = p[2], d = p[3];
        const float s = (((a[0] + a[1]) + (a[2] + a[3])) + ((b[0] + b[1]) + (b[2] + b[3]))) + (((c[0] + c[1]) + (c[2] + c[3])) + ((d[0] + d[1]) + (d[2] + d[3])));
        t[r] = 1.0f / sqrtf(s * (1.0f / 1024.0f) + P_EPS);
    }
}
template <class G>
__device__ __forceinline__ void row_rstd_tab(const RsTab& R, const float* SS, int tile_row0, int row0, int fq, float (&rs)[2][4]) {
    if (tile_row0 >= R.row0 && tile_row0 + (G::NAI == 2 ? 256 : 128) <= R.row0 + R.nrows) {
#pragma unroll
        for (int ai = 0; ai < G::NAI; ++ai)
#pragma unroll
            for (int m = 0; m < G::NM; ++m) rs[ai][m] = R.t[row0 - R.row0 + ai * HALF + m * 16];
    } else row_rstd<G>(SS, row0, fq, rs);
}

struct EpiQKV {
    static constexpr bool PERM = false, AFTER_DRAIN = false;
    const float* SS; const float* cs;
    bf16_t *Qb, *Kb, *Vb; float* out;
    RsTab rsA, rsB;
    __device__ __forceinline__ void operator()(const f32x4 (&acc)[2][2][4][2], const Unit& u, int wr, int wc, int fr, int fq) const { run<GeoBig>(acc, Tile{u.pm * BM, u.pn * BM}, wr, wc, fr, fq, nullptr); }
    template <class G> __device__ __forceinline__ void run(const f32x4 (&acc)[2][2][4][2], const Tile T, int wr, int wc, int fr, int fq, PG8_LAS float* scr) const {
        const int row0 = T.row0 + wr * G::RS_WR + fr;
        float rs[2][4]; row_rstd_tab<G>(G::NAI == 2 ? rsA : rsB, SS, T.row0, row0, fq, rs);
        const int sec = T.col0 >> 10, ct = T.col0 & 1023;
        const bool smp = T.row0 >= P_MP;
#pragma unroll
        for (int ai = 0; ai < G::NAI; ++ai)
#pragma unroll
            for (int m = 0; m < G::NM; ++m) {
                const int row = row0 + ai * HALF + m * 16; const float r = rs[ai][m];
                const int pos = smp ? (1024 + ((row - P_MP) & 31)) : (row & 2047);
                const size_t orow = smp ? (size_t)(row - P_MP) * 1024 : (size_t)row * 1024;
                if (sec < 2) {
                    const int dl = 16 * (wc & 1) + 4 * fq;
                    const f32x4 c4 = *(const f32x4*)(cs + (size_t)pos * 64 + dl), s4 = *(const f32x4*)(cs + (size_t)pos * 64 + 32 + dl);
#pragma unroll
                    for (int bj = 0; bj < G::NBJ; ++bj) {
                        const int col = ct + 128 * bj + 64 * (wc >> 1) + dl;
                        const f32x4 x1 = acc[ai][bj][m][0] * r, x2 = acc[ai][bj][m][1] * r;
                        f32x4 y1 = x1 * c4 - x2 * s4, y2 = x2 * c4 + x1 * s4;
                        if (sec == 0) {
                            y1 = y1 * P_C2; y2 = y2 * P_C2;
                            u32x2 w1, w2; w1.x = cvt_pk_bf16(y1[0], y1[1]); w1.y = cvt_pk_bf16(y1[2], y1[3]); w2.x = cvt_pk_bf16(y2[0], y2[1]); w2.y = cvt_pk_bf16(y2[2], y2[3]);
                            *(u32x2*)(Qb + (size_t)row * 1024 + col) = w1; *(u32x2*)(Qb + (size_t)row * 1024 + col + 32) = w2;
                        } else {
                            float* ok = out + (smp ? PO_AKS : PO_AKP) + orow + col;
                            *(f32x4*)ok = y1; *(f32x4*)(ok + 32) = y2;
                            u32x2 w1, w2; w1.x = cvt_pk_bf16(y1[0], y1[1]); w1.y = cvt_pk_bf16(y1[2], y1[3]); w2.x = cvt_pk_bf16(y2[0], y2[1]); w2.y = cvt_pk_bf16(y2[2], y2[3]);
                            *(u32x2*)(Kb + (size_t)row * 1024 + col) = w1; *(u32x2*)(Kb + (size_t)row * 1024 + col + 32) = w2;
                        }
                    }
                } else {
#pragma unroll
                    for (int bj = 0; bj < G::NBJ; ++bj)
#pragma unroll
                        for (int n = 0; n < G::NN; ++n) {
                            const int col = ct + 128 * bj + G::CS_WC * wc + 16 * n + 4 * fq;
                            const f32x4 v = acc[ai][bj][m][n] * r;
                            *(f32x4*)(out + (smp ? PO_AVS : PO_AVP) + orow + col) = v;
                            u32x2 w; w.x = cvt_pk_bf16(v[0], v[1]); w.y = cvt_pk_bf16(v[2], v[3]);
                            *(u32x2*)(Vb + (size_t)row * 1024 + col) = w;
                        }
                }
            }
    }
};

struct EpiKVQ {
    static constexpr bool PERM = true, AFTER_DRAIN = false;
    const float* SS; bf16_t *Qb, *Kb; float* out;
    RsTab rsA, rsB;
    __device__ __forceinline__ void operator()(const f32x4 (&acc)[2][2][4][2], const Unit& u, int wr, int wc, int fr, int fq) const { run<GeoBig>(acc, Tile{u.pm * BM, u.pn * BM}, wr, wc, fr, fq, nullptr); }
    template <class G> __device__ __forceinline__ void run(const f32x4 (&acc)[2][2][4][2], const Tile T, int wr, int wc, int fr, int fq, PG8_LAS float* scr) const {
        const int row0 = T.row0 + wr * G::RS_WR + fr;
        float rs[2][4]; row_rstd_tab<G>(G::NAI == 2 ? rsA : rsB, SS, T.row0, row0, fq, rs);
        const int sec = T.col0 >> 10, ct = T.col0 & 1023;
        const bool smp = T.row0 >= P_MP;
        const bool keep = smp || (((T.row0 >> 8) & 7) >= 6);
        const int col0 = ct + wc * 32 + 8 * fq;
#pragma unroll
        for (int ai = 0; ai < G::NAI; ++ai)
#pragma unroll
            for (int m = 0; m < G::NM; ++m) {
                const int row = row0 + ai * HALF + m * 16; const float r = rs[ai][m];
                const size_t orow = smp ? (size_t)(row - P_MP) * 1024 : ((size_t)(row >> 11) * 512 + (size_t)((row & 2047) - 1536)) * 1024;
#pragma unroll
                for (int bj = 0; bj < G::NBJ; ++bj) {
                    const int col = col0 + bj * HALF;
                    f32x4 v0 = acc[ai][bj][m][0] * r, v1 = acc[ai][bj][m][1] * r;
                    if (sec == 2) {
                        v0 = v0 * P_C2; v1 = v1 * P_C2;
                        u32x4 w; w.x = cvt_pk_bf16(v0[0], v0[1]); w.y = cvt_pk_bf16(v0[2], v0[3]); w.z = cvt_pk_bf16(v1[0], v1[1]); w.w = cvt_pk_bf16(v1[2], v1[3]);
                        *(u32x4*)(Qb + (size_t)row * 1024 + col) = w;
                    } else {
                        if (keep) { float* op = out + (sec == 0 ? (smp ? PO_BKS : PO_BKP) : (smp ? PO_BVS : PO_BVP)) + orow + col; *(f32x4*)op = v0; *(f32x4*)(op + 4) = v1; }
                        u32x4 w; w.x = cvt_pk_bf16(v0[0], v0[1]); w.y = cvt_pk_bf16(v0[2], v0[3]); w.z = cvt_pk_bf16(v1[0], v1[1]); w.w = cvt_pk_bf16(v1[2], v1[3]);
                        *(u32x4*)(Kb + (sec == 0 ? (size_t)0 : PW_KV) + (size_t)row * 1024 + col) = w;
                    }
                }
            }
    }
};

struct EpiRes {
    static constexpr bool PERM = true, AFTER_DRAIN = false;
    bf16_t* Hb; float* SS; float sc;
    __device__ __forceinline__ void operator()(const f32x4 (&acc)[2][2][4][2], const Unit& u, int wr, int wc, int fr, int fq) const { run<GeoBig>(acc, Tile{u.pm * BM, u.pn * BM}, wr, wc, fr, fq, nullptr); }
    template <class G> __device__ __forceinline__ void run(const f32x4 (&acc)[2][2][4][2], const Tile T, int wr, int wc, int fr, int fq, PG8_LAS float* scr) const {
        const int row0 = T.row0 + wr * G::RS_WR + fr, col0 = T.col0 + wc * 32 + 8 * fq;
#pragma unroll
        for (int ai = 0; ai < G::NAI; ++ai)
#pragma unroll
            for (int m = 0; m < G::NM; ++m) {
                const int row = row0 + ai * HALF + m * 16;
                float ssq = 0.f;
#pragma unroll
                for (int bj = 0; bj < G::NBJ; ++bj) {
                    bf16_t* p = Hb + (size_t)row * 1024 + col0 + bj * HALF;
                    const u32x4 o = *(const u32x4*)p;
                    f32x4 h0 = acc[ai][bj][m][0] * sc, h1 = acc[ai][bj][m][1] * sc;
                    h0[0] += __uint_as_float(o.x << 16); h0[1] += __uint_as_float(o.x & 0xffff0000u); h0[2] += __uint_as_float(o.y << 16); h0[3] += __uint_as_float(o.y & 0xffff0000u);
                    h1[0] += __uint_as_float(o.z << 16); h1[1] += __uint_as_float(o.z & 0xffff0000u); h1[2] += __uint_as_float(o.w << 16); h1[3] += __uint_as_float(o.w & 0xffff0000u);
                    u32x4 w; w.x = cvt_pk_bf16(h0[0], h0[1]); w.y = cvt_pk_bf16(h0[2], h0[3]); w.z = cvt_pk_bf16(h1[0], h1[1]); w.w = cvt_pk_bf16(h1[2], h1[3]);
                    *(u32x4*)p = w;
                    ssq += ((h0[0] * h0[0] + h0[1] * h0[1]) + (h0[2] * h0[2] + h0[3] * h0[3])) + ((h1[0] * h1[0] + h1[1] * h1[1]) + (h1[2] * h1[2] + h1[3] * h1[3]));
                }
                ssq += __shfl_xor(ssq, 16); ssq += __shfl_xor(ssq, 32);
                if (G::WCN == 4) { if (fq == 0) SS[(size_t)row * 16 + (T.col0 >> 8) * 4 + wc] = ssq; }
                else { if (fq == 0) scr[(wr * G::RS_WR + m * 16 + fr) * 2 + wc] = ssq; }
            }
        if (G::WCN != 4) {
            __syncthreads();
            const int t_ = threadIdx.x;
            if (t_ < 64) SS[(size_t)(T.row0 + t_) * 16 + (T.col0 >> 6)] = scr[t_ * 2] + scr[t_ * 2 + 1];
            __syncthreads();
        }
    }
};

struct EpiResFinal {
    static constexpr bool PERM = true, AFTER_DRAIN = true;
    const bf16_t* Hb; float* SS; float* out; const float* gf; unsigned* cnt; unsigned* tmo;
    __device__ __forceinline__ void fused(f32x4 (&acc)[2][2][4][2], const Unit& u, int wr, int wc, int fr, int fq, PG8_LAS unsigned char* lds, int wid, int lane) const { run<GeoBig>(acc, Tile{u.pm * BM, u.pn * BM}, wr, wc, fr, fq, (PG8_LAS float*)lds); }
    template <class G> __device__ __forceinline__ void run(f32x4 (&acc)[2][2][4][2], const Tile T, int wr, int wc, int fr, int fq, PG8_LAS float* scr) const {
        const int row0 = T.row0 + wr * G::RS_WR + fr, col0 = T.col0 + wc * 32 + 8 * fq;
        const int tid = threadIdx.x, lane = tid & 63, wid = __builtin_amdgcn_readfirstlane(tid >> 6);
#pragma unroll
        for (int ai = 0; ai < G::NAI; ++ai)
#pragma unroll
            for (int m = 0; m < G::NM; ++m) {
                const int row = row0 + ai * HALF + m * 16;
                float ssq = 0.f;
#pragma unroll
                for (int bj = 0; bj < G::NBJ; ++bj) {
                    const u32x4 o = *(const u32x4*)(Hb + (size_t)row * 1024 + col0 + bj * HALF);
                    f32x4 h0 = acc[ai][bj][m][0], h1 = acc[ai][bj][m][1];
                    h0[0] += __uint_as_float(o.x << 16); h0[1] += __uint_as_float(o.x & 0xffff0000u); h0[2] += __uint_as_float(o.y << 16); h0[3] += __uint_as_float(o.y & 0xffff0000u);
                    h1[0] += __uint_as_float(o.z << 16); h1[1] += __uint_as_float(o.z & 0xffff0000u); h1[2] += __uint_as_float(o.w << 16); h1[3] += __uint_as_float(o.w & 0xffff0000u);
                    acc[ai][bj][m][0] = h0; acc[ai][bj][m][1] = h1;
                    ssq += ((h0[0] * h0[0] + h0[1] * h0[1]) + (h0[2] * h0[2] + h0[3] * h0[3])) + ((h1[0] * h1[0] + h1[1] * h1[1]) + (h1[2] * h1[2] + h1[3] * h1[3]));
                }
                ssq += __shfl_xor(ssq, 16); ssq += __shfl_xor(ssq, 32);
                if (G::WCN == 4) { if (fq == 0) __hip_atomic_store(SS + (size_t)row * 16 + (T.col0 >> 8) * 4 + wc, ssq, __ATOMIC_RELAXED, __HIP_MEMORY_SCOPE_AGENT); }
                else { if (fq == 0) scr[(wr * G::RS_WR + m * 16 + fr) * 2 + wc] = ssq; }
            }
        unsigned* c; unsigned want;
        if (G::WCN == 4) {
            c = cnt + 64 * (T.row0 >> 8); want = 32u;
            asm volatile("s_waitcnt vmcnt(0)" ::: "memory");
            if (lane == 0) __hip_atomic_fetch_add(c, 1u, __ATOMIC_RELAXED, __HIP_MEMORY_SCOPE_AGENT);
        } else {
            c = cnt + 64 * (64 + ((T.row0 - P_MP) >> 6)); want = 16u;
            __syncthreads();
            if (tid < 64) __hip_atomic_store(SS + (size_t)(T.row0 + tid) * 16 + (T.col0 >> 6), scr[tid * 2] + scr[tid * 2 + 1], __ATOMIC_RELAXED, __HIP_MEMORY_SCOPE_AGENT);
            asm volatile("s_waitcnt vmcnt(0)" ::: "memory");
            if (tid == 0) __hip_atomic_fetch_add(c, 1u, __ATOMIC_RELAXED, __HIP_MEMORY_SCOPE_AGENT);
        }
        if (wid == 0) {
            const unsigned long long t0 = __builtin_amdgcn_s_memrealtime();
            for (;;) {
                if ((unsigned)__builtin_amdgcn_readfirstlane((int)__hip_atomic_load(c, __ATOMIC_RELAXED, __HIP_MEMORY_SCOPE_AGENT)) >= want) break;
                if (__builtin_amdgcn_s_memrealtime() - t0 > 2000000ull) { if (lane == 0) __hip_atomic_store(tmo, 1u, __ATOMIC_RELAXED, __HIP_MEMORY_SCOPE_AGENT); break; }
                __builtin_amdgcn_s_sleep(2);
            }
            __builtin_amdgcn_fence(__ATOMIC_ACQUIRE, "agent");
            asm volatile("s_waitcnt vmcnt(0)" ::: "memory");
        }
        __syncthreads();
        f32x4 gv[2][2];
#pragma unroll
        for (int bj = 0; bj < G::NBJ; ++bj) { gv[bj][0] = *(const f32x4*)(gf + col0 + bj * HALF); gv[bj][1] = *(const f32x4*)(gf + col0 + bj * HALF + 4); }
#pragma unroll
        for (int ai = 0; ai < G::NAI; ++ai)
#pragma unroll
            for (int m = 0; m < G::NM; ++m) {
                const int row = row0 + ai * HALF + m * 16;
                const f32x4 v = *(const f32x4*)(SS + (size_t)row * 16 + 4 * fq);
                float s = (v[0] + v[1]) + (v[2] + v[3]);
                s += __shfl_xor(s, 16); s += __shfl_xor(s, 32);
                const float r = 1.0f / sqrtf(s * (1.0f / 1024.0f) + P_EPS);
#pragma unroll
                for (int bj = 0; bj < G::NBJ; ++bj) { float* op = out + (size_t)row * 1024 + col0 + bj * HALF;
                    *(f32x4*)op = acc[ai][bj][m][0] * gv[bj][0] * r; *(f32x4*)(op + 4) = acc[ai][bj][m][1] * gv[bj][1] * r; }
            }
        if (G::WCN != 4) __syncthreads();
    }
};

struct EpiFF1 {
    static constexpr bool PERM = true, AFTER_DRAIN = false;
    const float* SS; bf16_t* U; int ldc;
    RsTab rsA, rsB;
    __device__ __forceinline__ void operator()(const f32x4 (&acc)[2][2][4][2], const Unit& u, int wr, int wc, int fr, int fq) const { run<GeoBig>(acc, Tile{u.pm * BM, u.pn * BM}, wr, wc, fr, fq, nullptr); }
    template <class G> __device__ __forceinline__ void run(const f32x4 (&acc)[2][2][4][2], const Tile T, int wr, int wc, int fr, int fq, PG8_LAS float* scr) const {
        const int row0 = T.row0 + wr * G::RS_WR + fr;
        float rs[2][4]; row_rstd_tab<G>(G::NAI == 2 ? rsA : rsB, SS, T.row0, row0, fq, rs);
        const int col0 = T.col0 + wc * 32 + 8 * fq;
#pragma unroll
        for (int ai = 0; ai < G::NAI; ++ai)
#pragma unroll
            for (int m = 0; m < G::NM; ++m) {
                const float r = rs[ai][m]; bf16_t* rowp = U + (size_t)(row0 + ai * HALF + m * 16) * ldc + col0;
#pragma unroll
                for (int bj = 0; bj < G::NBJ; ++bj) {
                    f32x4 v0 = acc[ai][bj][m][0] * r, v1 = acc[ai][bj][m][1] * r;
#pragma unroll
                    for (int i = 0; i < 4; ++i) { const float a = fmaxf(v0[i], 0.f), b = fmaxf(v1[i], 0.f); v0[i] = a * a; v1[i] = b * b; }
                    u32x4 w; w.x = cvt_pk_bf16(v0[0], v0[1]); w.y = cvt_pk_bf16(v0[2], v0[3]); w.z = cvt_pk_bf16(v1[0], v1[1]); w.w = cvt_pk_bf16(v1[2], v1[3]);
                    *(u32x4*)(rowp + bj * HALF) = w;
                }
            }
    }
};
template <class Epi, class Sched, bool ALIGN_EPI = false, bool SP2 = false>
__device__ __forceinline__ void gemm_phase(PG8_LAS unsigned char* lds, const Gemm g, const Sched& S, const Epi& E) {
    const int tid = opaque_tid(), wid = __builtin_amdgcn_readfirstlane(tid >> 6), lane = tid & 63, wr = wid >> 2, wc = wid & 3, fr = lane & 15, fq = lane >> 4;
    const int K = g.K, nt = K / BK;
    unsigned voffA[2], voffB[2];
#pragma unroll
    for (int i = 0; i < 2; ++i) { int R, C; stage_rc(tid * 16 + i * 8192, R, C); const int Rb = Epi::PERM ? ((R & ~31) + perm32(R & 31)) : R;
        voffA[i] = (unsigned)(R * K + C) * 2u; voffB[i] = (unsigned)(Rb * K + C) * 2u; }
    const size_t kstep = (size_t)(BK * 2);
    const size_t hstep = (size_t)HALF * K * 2;
    const size_t tstep = 2 * hstep;
    const unsigned ldsw = (unsigned)wid * 1024u;
    const int aoff = lds_byte(wr * 64 + fr, fq * 8), boff = lds_byte(wc * 32 + fr, fq * 8);
#define PG8_SA(b, h) (((b) * 2 + (h)) * HTB)
#define PG8_SB(b, h) ((4 + (b) * 2 + (h)) * HTB)
#define PG8_STAGE(bufoff, gbase, voff) do { _Pragma("unroll") for (int _i = 0; _i < 2; ++_i) \
        __builtin_amdgcn_global_load_lds((const unsigned*)((const char*)(gbase) + (voff)[_i]), (PG8_LAS unsigned*)(lds + (bufoff) + ldsw + _i * 8192), 16, 0, 0); } while (0)
#define PG8_LDA(dst, b, h) do { _Pragma("unroll") for (int m = 0; m < 4; ++m) _Pragma("unroll") for (int k = 0; k < 2; ++k) dst[m][k] = *(const PG8_LAS bf16x8*)(lds + PG8_SA(b, h) + aoff + m * 2048 + k * 1024); } while (0)
#define PG8_LDB(dst, b, h) do { _Pragma("unroll") for (int n = 0; n < 2; ++n) _Pragma("unroll") for (int k = 0; k < 2; ++k) dst[n][k] = *(const PG8_LAS bf16x8*)(lds + PG8_SB(b, h) + boff + n * 2048 + k * 1024); } while (0)
#define PG8_MMA(ai, bj, At, Bt) do { __builtin_amdgcn_s_setprio(1); _Pragma("unroll") for (int m = 0; m < 4; ++m) _Pragma("unroll") for (int n = 0; n < 2; ++n) _Pragma("unroll") for (int k = 0; k < 2; ++k) \
        acc[ai][bj][m][n] = __builtin_amdgcn_mfma_f32_16x16x32_bf16(Bt[n][k], At[m][k], acc[ai][bj][m][n], 0, 0, 0); __builtin_amdgcn_s_setprio(0); } while (0)
#define PG8_WAIT_V(n) asm volatile("s_waitcnt vmcnt(" #n ")" ::: "memory")
#define PG8_WAIT_L(n) asm volatile("s_waitcnt lgkmcnt(" #n ")" ::: "memory")
#define PG8_BAR __builtin_amdgcn_s_barrier()
#define PG8_SCHED __builtin_amdgcn_sched_barrier(0)
    Unit cur, nxt; int ui = 0;
    if (!S.next(0, cur)) return;
    f32x4 acc[2][2][4][2];
#pragma unroll
    for (int a = 0; a < 2; ++a)
#pragma unroll
        for (int b = 0; b < 2; ++b)
#pragma unroll
            for (int m = 0; m < 4; ++m)
#pragma unroll
                for (int n = 0; n < 2; ++n) acc[a][b][m][n] = (f32x4){0.f, 0.f, 0.f, 0.f};
    bf16x8 At[4][2], B0[2][2], B1[2][2];
    const char* cA = (const char*)g.A + (size_t)cur.pm * tstep; const char* cB = (const char*)g.Bt + (size_t)cur.pn * tstep;
    S.a_ready(cur);
    if constexpr (SP2) {
        PG8_STAGE(PG8_SB(0, 0), cB, voffB); PG8_STAGE(PG8_SB(0, 1), cB + hstep, voffB); PG8_STAGE(PG8_SA(0, 0), cA, voffA); PG8_STAGE(PG8_SA(0, 1), cA + hstep, voffA);
        if (wr == 1) PG8_BAR;
        PG8_WAIT_V(2); PG8_BAR;
        PG8_STAGE(PG8_SB(1, 0), cB + kstep, voffB); PG8_STAGE(PG8_SA(1, 0), cA + kstep, voffA); PG8_STAGE(PG8_SB(1, 1), cB + hstep + kstep, voffB);
        PG8_WAIT_V(6); PG8_BAR;
    } else {
        PG8_STAGE(PG8_SB(0, 0), cB, voffB); PG8_STAGE(PG8_SA(0, 0), cA, voffA); PG8_STAGE(PG8_SB(0, 1), cB + hstep, voffB); PG8_STAGE(PG8_SA(0, 1), cA + hstep, voffA);
        if (wr == 1) PG8_BAR;
        PG8_WAIT_V(4); PG8_BAR;
        PG8_STAGE(PG8_SB(1, 0), cB + kstep, voffB); PG8_STAGE(PG8_SA(1, 0), cA + kstep, voffA); PG8_STAGE(PG8_SB(1, 1), cB + hstep + kstep, voffB);
        PG8_WAIT_V(6); PG8_BAR;
    }
    for (;;) {
        const bool has_next = S.next(ui + 1, nxt);
        const char* nA = has_next ? (const char*)g.A + (size_t)nxt.pm * tstep : cA; const char* nB = has_next ? (const char*)g.Bt + (size_t)nxt.pn * tstep : cB;
        for (int t = 0; t < nt; t += 2) {
            const bool last = (t == nt - 2);
            const char* a1 = cA + (size_t)(t + 1) * kstep;
            const char* a2 = last ? nA : cA + (size_t)(t + 2) * kstep; const char* b2 = last ? nB : cB + (size_t)(t + 2) * kstep;
            const char* a3 = a2 + kstep; const char* b3 = b2 + kstep;
            if (last && has_next) S.a_ready(nxt);
            if constexpr (SP2) {
            PG8_LDB(B0, 0, 0); PG8_LDB(B1, 0, 1); PG8_SCHED; PG8_LDA(At, 0, 0); PG8_STAGE(PG8_SA(1, 1), a1 + hstep, voffA);
            PG8_WAIT_V(8); PG8_WAIT_L(0); PG8_BAR; PG8_MMA(0, 0, At, B0); PG8_MMA(0, 1, At, B1); PG8_BAR; PG8_SCHED;
            PG8_LDA(At, 0, 1); PG8_STAGE(PG8_SB(0, 0), b2, voffB); PG8_STAGE(PG8_SB(0, 1), b2 + hstep, voffB); PG8_STAGE(PG8_SA(0, 0), a2, voffA);
            PG8_WAIT_V(8); PG8_WAIT_L(0); PG8_BAR; PG8_MMA(1, 0, At, B0); PG8_MMA(1, 1, At, B1); PG8_BAR; PG8_SCHED;
            PG8_LDB(B0, 1, 0); PG8_LDB(B1, 1, 1); PG8_SCHED; PG8_LDA(At, 1, 0); PG8_STAGE(PG8_SA(0, 1), a2 + hstep, voffA);
            PG8_WAIT_V(8); PG8_WAIT_L(0); PG8_BAR; PG8_MMA(0, 0, At, B0); PG8_MMA(0, 1, At, B1); PG8_BAR; PG8_SCHED;
            PG8_LDA(At, 1, 1); PG8_STAGE(PG8_SB(1, 0), b3, voffB); PG8_STAGE(PG8_SB(1, 1), b3 + hstep, voffB); PG8_STAGE(PG8_SA(1, 0), a3, voffA);
            PG8_WAIT_V(8); PG8_WAIT_L(0); PG8_BAR; PG8_MMA(1, 0, At, B0); PG8_MMA(1, 1, At, B1); PG8_BAR; PG8_SCHED;
            } else {
            PG8_LDB(B0, 0, 0); PG8_SCHED; PG8_LDA(At, 0, 0); PG8_STAGE(PG8_SA(1, 1), a1 + hstep, voffA);
            PG8_WAIT_L(8); PG8_BAR; PG8_WAIT_L(0); PG8_MMA(0, 0, At, B0); PG8_BAR; PG8_SCHED;
            PG8_LDB(B1, 0, 1); PG8_STAGE(PG8_SB(0, 0), b2, voffB);
            PG8_BAR; PG8_WAIT_L(0); PG8_MMA(0, 1, At, B1); PG8_BAR;
            PG8_LDA(At, 0, 1); PG8_STAGE(PG8_SA(0, 0), a2, voffA);
            PG8_BAR; PG8_WAIT_L(0); PG8_MMA(1, 0, At, B0); PG8_BAR; PG8_SCHED;
            PG8_STAGE(PG8_SB(0, 1), b2 + hstep, voffB);
            PG8_WAIT_V(6); PG8_BAR; PG8_MMA(1, 1, At, B1); PG8_BAR;
            PG8_LDB(B0, 1, 0); PG8_SCHED; PG8_LDA(At, 1, 0); PG8_STAGE(PG8_SA(0, 1), a2 + hstep, voffA);
            PG8_WAIT_L(8); PG8_BAR; PG8_WAIT_L(0); PG8_MMA(0, 0, At, B0); PG8_BAR; PG8_SCHED;
            PG8_LDB(B1, 1, 1); PG8_STAGE(PG8_SB(1, 0), b3, voffB);
            PG8_BAR; PG8_WAIT_L(0); PG8_MMA(0, 1, At, B1); PG8_BAR;
            PG8_LDA(At, 1, 1); PG8_STAGE(PG8_SA(1, 0), a3, voffA);
            PG8_BAR; PG8_WAIT_L(0); PG8_MMA(1, 0, At, B0); PG8_BAR; PG8_SCHED;
            PG8_STAGE(PG8_SB(1, 1), b3 + hstep, voffB);
            PG8_WAIT_V(6); PG8_BAR; PG8_MMA(1, 1, At, B1); PG8_BAR;
            }
        }
        if constexpr (ALIGN_EPI) { if (wr == 0) PG8_BAR; }
        if constexpr (!Epi::AFTER_DRAIN) { E(acc, cur, wr, wc, fr, fq); S.done(cur); }
        if (!has_next) break;
#pragma unroll
        for (int a = 0; a < 2; ++a)
#pragma unroll
            for (int b = 0; b < 2; ++b)
#pragma unroll
                for (int m = 0; m < 4; ++m)
#pragma unroll
                    for (int n = 0; n < 2; ++n) acc[a][b][m][n] = (f32x4){0.f, 0.f, 0.f, 0.f};
        cur = nxt; cA = nA; cB = nB; ++ui;
        if constexpr (ALIGN_EPI) { if (wr == 1) PG8_BAR; }
    }
    PG8_WAIT_V(0);
    if constexpr (!ALIGN_EPI) { if (wr == 0) PG8_BAR; }
    PG8_BAR;
    if constexpr (Epi::AFTER_DRAIN) { E.fused(acc, cur, wr, wc, fr, fq, lds, wid, lane); S.done(cur); }
#undef PG8_SA
#undef PG8_SB
#undef PG8_STAGE
#undef PG8_LDA
#undef PG8_LDB
#undef PG8_MMA
#undef PG8_WAIT_V
#undef PG8_WAIT_L
#undef PG8_BAR
#undef PG8_SCHED
}

template <class G, class Epi>
__device__ __forceinline__ void gemm_small(PG8_LAS unsigned char* lds, const bf16_t* A, const bf16_t* Bt, int K, int row_base, int ntm, int ntn, int vcu, int nwg, const Epi& E) {
    constexpr int TM = (8 / G::WCN) * G::RS_WR * (G::NM * 16 / G::RS_WR), TN = G::WCN * G::CS_WC, SBK = 64, STG = (TM + TN) * 128, NPA = TM / 64, NPB = TN / 64, NP = NPA + NPB;
    static_assert(NP == 4 || NP == 2, "gemm_small: 128 x 128 or 64 x 64 tiles");
    const int tid = opaque_tid(), wid = __builtin_amdgcn_readfirstlane(tid >> 6), lane = tid & 63, wr = wid / G::WCN, wc = wid % G::WCN, fr = lane & 15, fq = lane >> 4;
    const int nk = K / SBK;
    for (int tile = vcu; tile < ntm * ntn; tile += nwg) {
        const int tm = tile % ntm, tn = tile / ntm;
        const bf16_t* Ab = A + (size_t)(row_base + tm * TM) * K; const bf16_t* Bb = Bt + (size_t)(tn * TN) * K;
        f32x4 acc[2][2][4][2];
#pragma unroll
        for (int m = 0; m < G::NM; ++m)
#pragma unroll
            for (int n = 0; n < G::NN; ++n) acc[0][0][m][n] = (f32x4){0.f, 0.f, 0.f, 0.f};
        unsigned goff[NP];
#pragma unroll
        for (int i = 0; i < NP; ++i) { const bool isB = i >= NPA; const int p = wid + 8 * (isB ? i - NPA : i), R = 8 * p + (lane >> 3), c = (lane & 7) ^ ((R >> 1) & 7);
            const int Rs = (isB && Epi::PERM) ? ((R & ~31) + perm32(R & 31)) : R; goff[i] = (unsigned)Rs * K + c * 8; }
#define SM_DMA(stage, kt_) do { _Pragma("unroll") for (int i = 0; i < NP; ++i) { const bool isB = i >= NPA; const int p = wid + 8 * (isB ? i - NPA : i); \
            __builtin_amdgcn_global_load_lds((const unsigned*)((isB ? Bb : Ab) + goff[i] + (size_t)(kt_) * SBK), (PG8_LAS unsigned*)(lds + (stage) * STG + (isB ? TM * 128 : 0) + p * 1024), 16, 0, 0); } } while (0)
#define SM_WAIT(n) asm volatile("s_waitcnt vmcnt(" #n ")" ::: "memory")
#define SM_MMA(stage) do { PG8_LAS unsigned char* sb = lds + (stage) * STG; \
            _Pragma("unroll") for (int kh = 0; kh < 2; ++kh) { bf16x8 af[G::NM], bfr[G::NN]; \
                _Pragma("unroll") for (int m = 0; m < G::NM; ++m) { const int R = wr * G::RS_WR + m * 16 + fr; af[m] = *(const PG8_LAS bf16x8*)(sb + R * 128 + (((kh * 4 + fq) ^ ((R >> 1) & 7)) * 16)); } \
                _Pragma("unroll") for (int n = 0; n < G::NN; ++n) { const int R = wc * G::CS_WC + n * 16 + fr; bfr[n] = *(const PG8_LAS bf16x8*)(sb + TM * 128 + R * 128 + (((kh * 4 + fq) ^ ((R >> 1) & 7)) * 16)); } \
                _Pragma("unroll") for (int m = 0; m < G::NM; ++m) _Pragma("unroll") for (int n = 0; n < G::NN; ++n) acc[0][0][m][n] = __builtin_amdgcn_mfma_f32_16x16x32_bf16(bfr[n], af[m], acc[0][0][m][n], 0, 0, 0); } } while (0)
#define SM_STEP(s, kt_) do { if ((kt_) + 2 < nk) { if (NP == 4) SM_WAIT(8); else SM_WAIT(4); } else if ((kt_) + 1 < nk) { if (NP == 4) SM_WAIT(4); else SM_WAIT(2); } else SM_WAIT(0); \
            asm volatile("s_waitcnt lgkmcnt(0)" ::: "memory"); __builtin_amdgcn_s_barrier(); asm volatile("" ::: "memory"); \
            if ((kt_) + 3 < nk) SM_DMA(((s) + 3) & 3, (kt_) + 3); \
            SM_MMA(s); } while (0)
        SM_DMA(0, 0); SM_DMA(1, 1); SM_DMA(2, 2);
        for (int kt = 0; kt < nk; kt += 4) { SM_STEP(0, kt); SM_STEP(1, kt + 1); SM_STEP(2, kt + 2); SM_STEP(3, kt + 3); }
#undef SM_DMA
#undef SM_WAIT
#undef SM_MMA
#undef SM_STEP
        asm volatile("s_waitcnt lgkmcnt(0)" ::: "memory"); __builtin_amdgcn_s_barrier(); asm volatile("" ::: "memory");
        E.template run<G>(acc, Tile{row_base + tm * TM, tn * TN}, wr, wc, fr, fq, (PG8_LAS float*)(lds + 4 * STG));
    }
}
}
#define GAS __attribute__((address_space(1)))
#define LAS __attribute__((address_space(3)))
typedef unsigned short bf16;
typedef unsigned v4u __attribute__((ext_vector_type(4)));
typedef float f32x4 __attribute__((ext_vector_type(4)));
typedef short bf16x8 __attribute__((ext_vector_type(8)));
typedef GAS unsigned gu32;
typedef GAS unsigned long long gu64;
#define RLX_AGENT __ATOMIC_RELAXED, __HIP_MEMORY_SCOPE_AGENT
#define LDS_WAIT() asm volatile("s_waitcnt lgkmcnt(0)" ::: "memory")
#define VM_WAIT() asm volatile("s_waitcnt vmcnt(0)" ::: "memory")
__device__ __forceinline__ unsigned long long rt() { return __builtin_amdgcn_s_memrealtime(); }
__device__ __forceinline__ unsigned f2bf(float f) { unsigned u = __builtin_bit_cast(unsigned, f); return (u + 0x7fffu + ((u >> 16) & 1u)) >> 16; }
__device__ __forceinline__ unsigned pk2(float lo, float hi) { return f2bf(lo) | (f2bf(hi) << 16); }

#define XB_TMO      128
#define XB_XCNT(j)  (256  + 64 * (j))
#define XB_XSUB(j)  (1280 + 64 * (j))
#define XB_XGEN(j)  (2304 + 64 * (j))
#define XB_TOP      3328
#define XB_TOPGEN   3392
#define XCD_BAR_WORDS 3456
#define XB_SPIN_CAP (1u << 18)

__device__ __forceinline__ unsigned xb_ld(unsigned* p)              { return __hip_atomic_load(p, __ATOMIC_RELAXED, __HIP_MEMORY_SCOPE_AGENT); }
__device__ __forceinline__ unsigned xb_add(unsigned* p, unsigned v) { return __hip_atomic_fetch_add(p, v, __ATOMIC_RELAXED, __HIP_MEMORY_SCOPE_AGENT); }
__device__ __forceinline__ unsigned xb_xcc_id() { return (unsigned)__builtin_amdgcn_s_getreg((3 << 11) | 20) & 0xFu; }
#define XB_SPIN(cond, bar) do { unsigned _sp = 0; while (cond) { __builtin_amdgcn_s_sleep(1); \
    if ((++_sp & 255u) == 0u) { if (xb_ld(&(bar)[XB_TMO])) break; if (_sp > XB_SPIN_CAP) { atomicAdd(&(bar)[XB_TMO], 1u); break; } } } } while (0)

struct XcdBarrier {
    unsigned* bar; unsigned x;
    volatile LAS unsigned* st;
};

__device__ __forceinline__ XcdBarrier xcd_barrier_post(unsigned* bar, volatile LAS unsigned* st) {
    XcdBarrier b; b.bar = bar; b.x = xb_xcc_id(); b.st = st;
    if (threadIdx.x == 0) (void)xb_add(&bar[XB_XCNT(b.x)], 1u);
    return b;
}
__device__ __forceinline__ void xcd_barrier_complete(unsigned* bar, unsigned x, unsigned& nloc, unsigned& nx) {
    const unsigned G = gridDim.x * gridDim.y * gridDim.z;
    unsigned sum, cnt, mine, sp = 0u;
    for (;;) {
        sum = 0u; cnt = 0u; mine = 0u;
#pragma unroll
        for (unsigned j = 0; j < 16; ++j) { const unsigned c = xb_ld(&bar[XB_XCNT(j)]); sum += c; cnt += (c > 0u) ? 1u : 0u; mine = (j == x) ? c : mine; }
        if (sum == G) break;
        __builtin_amdgcn_s_sleep(1);
        if ((++sp & 255u) == 0u) { if (xb_ld(&bar[XB_TMO])) break; if (sp > XB_SPIN_CAP) { atomicAdd(&bar[XB_TMO], 1u); break; } }
    }
    nloc = mine > 0u ? mine : 1u; nx = cnt > 0u ? cnt : 1u;
}

__device__ __forceinline__ void xcd_barrier(const XcdBarrier& b) {
    asm volatile("s_waitcnt vmcnt(0)" ::: "memory");
    __syncthreads();
    if (threadIdx.x == 0) {
        unsigned* bar = b.bar;
        __builtin_amdgcn_s_waitcnt(0);
        unsigned nloc = b.st[0], nx = b.st[1];
        if (nloc == 0u) { xcd_barrier_complete(bar, b.x, nloc, nx); b.st[0] = nloc; b.st[1] = nx; }
        const unsigned old = xb_add(&bar[XB_XSUB(b.x)], 1u);
        const unsigned gen = old / nloc;
        if (old + 1u == (gen + 1u) * nloc) {
#ifndef PROBE_NOWBL2
            __builtin_amdgcn_fence(__ATOMIC_RELEASE, "agent");
#endif
            asm volatile("s_waitcnt vmcnt(0)" ::: "memory");
            const unsigned og = xb_add(&bar[XB_TOP], 1u);
            const unsigned tg = og / nx;
            if (og + 1u == (tg + 1u) * nx) xb_add(&bar[XB_TOPGEN], 1u);
            else XB_SPIN(xb_ld(&bar[XB_TOPGEN]) == tg, bar);
            __builtin_amdgcn_fence(__ATOMIC_ACQUIRE, "agent");
            xb_add(&bar[XB_XGEN(b.x)], 1u);
            asm volatile("s_waitcnt vmcnt(0)" ::: "memory");
        } else {
            XB_SPIN(xb_ld(&bar[XB_XGEN(b.x)]) == gen, bar);
            __builtin_amdgcn_fence(__ATOMIC_ACQUIRE, "agent");
            asm volatile("s_waitcnt vmcnt(0)" ::: "memory");
        }
    }
    __syncthreads();
}

#ifndef THR_VALUE
#define THR_VALUE 8.0f
#endif
namespace at {
#define AT_LAS __attribute__((address_space(3)))
typedef short bf16x8 __attribute__((ext_vector_type(8)));
typedef short s16x4 __attribute__((ext_vector_type(4)));
typedef float f32x16 __attribute__((ext_vector_type(16)));
typedef float f32x4 __attribute__((ext_vector_type(4)));
typedef unsigned u32x4 __attribute__((ext_vector_type(4)));
typedef unsigned u32x2 __attribute__((ext_vector_type(2)));
typedef unsigned short bf16_t;
constexpr int MP = 16384, PITCH = 1024, SEQ = 2048;
constexpr int KCS = 1040;
constexpr int KT_BYTES = 8 * KCS;
constexpr float THR = THR_VALUE;
constexpr int WSF_OFF = 132096;
constexpr int QIMG_OFF = 99328;
__device__ __forceinline__ int crow(int r, int hi) { return (r & 3) + 8 * (r >> 2) + 4 * hi; }
__device__ __forceinline__ unsigned cvtpk(float lo, float hi) { typedef float f2 __attribute__((ext_vector_type(2))); typedef __bf16 b2 __attribute__((ext_vector_type(2))); f2 v = {lo, hi}; b2 b = __builtin_convertvector(v, b2); return __builtin_bit_cast(unsigned, b); }
__device__ __forceinline__ s16x4 vtr(const AT_LAS unsigned char* p) { typedef short v4i16_t __attribute__((ext_vector_type(4))); return __builtin_bit_cast(s16x4, __builtin_amdgcn_ds_read_tr16_b64_v4i16((AT_LAS v4i16_t*)p)); }
#define AT_SYNC() __syncthreads()

template <bool QLDS>
__device__ __forceinline__ void qk_tile(f32x16& p0, f32x16& p1, const AT_LAS unsigned char* kt, const bf16x8 (&qr_)[4], const AT_LAS unsigned char* qimg, int r32, int hi) {
    p0 = f32x16{}; p1 = f32x16{};
#pragma unroll
    for (int d0 = 0; d0 < 4; ++d0) {
        bf16x8 qr[4]; if (QLDS) qr[d0] = *(const AT_LAS bf16x8*)(qimg + (2 * d0 + hi) * 512 + r32 * 16); else qr[d0] = qr_[d0];
        const bf16x8 a0 = *(const AT_LAS bf16x8*)(kt + (2 * d0 + hi) * KCS + r32 * 16);
        const bf16x8 a1 = *(const AT_LAS bf16x8*)(kt + (2 * d0 + hi) * KCS + r32 * 16 + 512);
        p0 = __builtin_amdgcn_mfma_f32_32x32x16_bf16(a0, qr[d0], p0, 0, 0, 0);
        p1 = __builtin_amdgcn_mfma_f32_32x32x16_bf16(a1, qr[d0], p1, 0, 0, 0);
    }
}
template <int ND0>
__device__ __forceinline__ void softmax_tile(f32x16& p0, f32x16& p1, float& m, float& l, f32x16 (&o)[ND0], AT_LAS float* wsf, int r32, int hi) {
    float rm = fmaxf(p0[0], p1[0]);
#pragma unroll
    for (int r = 1; r < 16; ++r) rm = fmaxf(rm, fmaxf(p0[r], p1[r]));
    rm = fmaxf(rm, __shfl_xor(rm, 32));
    if (__any(rm > m + THR)) {
        const float mn = fmaxf(m, rm), f = __builtin_amdgcn_exp2f(m - mn);
        l *= f; m = mn;
        if (hi == 0) wsf[r32] = f;
        asm volatile("s_waitcnt lgkmcnt(0)" ::: "memory");
#pragma unroll
        for (int r = 0; r < 16; ++r) { const float fr_ = wsf[crow(r, hi)];
#pragma unroll
            for (int d0 = 0; d0 < ND0; ++d0) o[d0][r] *= fr_; }
        asm volatile("s_waitcnt lgkmcnt(0)" ::: "memory");
    }
    float s = 0.f;
#pragma unroll
    for (int r = 0; r < 16; ++r) { p0[r] = __builtin_amdgcn_exp2f(p0[r] - m); p1[r] = __builtin_amdgcn_exp2f(p1[r] - m); s += p0[r] + p1[r]; }
    l += s;
}
__device__ __forceinline__ void pack_p(bf16x8 (&pa)[4], const f32x16& p0, const f32x16& p1) {
#pragma unroll
    for (int ks = 0; ks < 4; ++ks) {
        u32x4 w;
        if (ks < 2) { const int b = 8 * ks; w.x = cvtpk(p0[b], p0[b + 1]); w.y = cvtpk(p0[b + 2], p0[b + 3]); w.z = cvtpk(p0[b + 4], p0[b + 5]); w.w = cvtpk(p0[b + 6], p0[b + 7]); }
        else { const int b = 8 * (ks - 2); w.x = cvtpk(p1[b], p1[b + 1]); w.y = cvtpk(p1[b + 2], p1[b + 3]); w.z = cvtpk(p1[b + 4], p1[b + 5]); w.w = cvtpk(p1[b + 6], p1[b + 7]); }
        pa[ks] = __builtin_bit_cast(bf16x8, w);
    }
}
template <int ND0>
__device__ __forceinline__ void pv_packed(f32x16 (&o)[ND0], const AT_LAS unsigned char* vt, const bf16x8 (&pa)[4], int lane, int hi) {
    const AT_LAS unsigned char* vb = vt + ((lane >> 4) & 1) * 32 + (lane & 3) * 8 + (4 * hi + ((lane & 15) >> 2)) * 64;
#pragma unroll
    for (int d0 = 0; d0 < ND0; ++d0)
#pragma unroll
        for (int ks = 0; ks < 4; ++ks) {
            const s16x4 lo = vtr(vb + d0 * 4096 + ks * 1024), hh = vtr(vb + d0 * 4096 + ks * 1024 + 512);
            const bf16x8 bfr = {lo[0], lo[1], lo[2], lo[3], hh[0], hh[1], hh[2], hh[3]};
            o[d0] = __builtin_amdgcn_mfma_f32_32x32x16_bf16(pa[ks], bfr, o[d0], 0, 0, 0);
        }
}
template <int ND0>
__device__ __forceinline__ void pv_tile(f32x16 (&o)[ND0], const AT_LAS unsigned char* vt, const f32x16& p0, const f32x16& p1, int lane, int hi) {
    bf16x8 pa[4]; pack_p(pa, p0, p1); pv_packed<ND0>(o, vt, pa, lane, hi);
}
__device__ __forceinline__ u32x4 ld16(const void* p) { return *(const u32x4*)p; }
__device__ __forceinline__ u32x2 f4_to_bf4(u32x4 v) { u32x2 w; w.x = cvtpk(__uint_as_float(v.x), __uint_as_float(v.y)); w.y = cvtpk(__uint_as_float(v.z), __uint_as_float(v.w)); return w; }

struct Ctx {
    const bf16_t *Q, *K, *V; bf16_t* O;
    const float *cache_k, *cache_v;
    const float *lam_p, *subln;
    const float* rel;
    void* stamp;
    float lam;
};
__device__ __forceinline__ float diff_lambda(const float* lp) {
    const int lane = threadIdx.x & 63;
    float sa = lp[lane] * lp[64 + lane], sc = lp[128 + lane] * lp[192 + lane];
#pragma unroll
    for (int o_ = 1; o_ < 64; o_ <<= 1) { sa += __shfl_xor(sa, o_); sc += __shfl_xor(sc, o_); }
    return __expf(sa) - __expf(sc) + 0.2f;
}
#ifndef PROBE_CLK
#define PROBE_CLK() __builtin_amdgcn_s_memtime()
#endif
#ifndef PROBE_STAMP_B
#define PROBE_STAMP_B 1
#endif
#ifndef PROBE_BLK
#define PROBE_BLK 0
#endif
#ifndef PROBE_TID
#define PROBE_TID 0
#endif

template <int NK, int DV>
__device__ __forceinline__ void ld_bf(u32x4 (&st)[NK + DV / 64], const bf16_t* kbase, const bf16_t* vbase, int nrows, int tid) {
    const int row = tid >> 3, ch = tid & 7; const unsigned koff = (unsigned)row * PITCH + ch * 8;
#pragma unroll
    for (int c = 0; c < NK; ++c) st[c] = (row < nrows) ? ld16(kbase + koff + c * 64) : (u32x4){0u, 0u, 0u, 0u};
    if (DV == 64) { st[NK] = (row < nrows) ? ld16(vbase + koff) : (u32x4){0u, 0u, 0u, 0u}; }
    else {
        const int vrow = tid >> 4; const unsigned voff = (unsigned)vrow * PITCH + (tid & 15) * 8;
#pragma unroll
        for (int i = 0; i < 2; ++i) st[NK + i] = (vrow + 32 * i < nrows) ? ld16(vbase + voff + (size_t)i * 32 * PITCH) : (u32x4){0u, 0u, 0u, 0u};
    }
}
template <int NK, int DV>
__device__ __forceinline__ void wr_bf(const u32x4 (&st)[NK + DV / 64], AT_LAS unsigned char* sb, int tid) {
    const int row = tid >> 3, ch = tid & 7;
#pragma unroll
    for (int c = 0; c < NK; ++c) *(AT_LAS u32x4*)(sb + c * KT_BYTES + ch * KCS + row * 16) = st[c];
    AT_LAS unsigned char* vb = sb + NK * KT_BYTES;
    if (DV == 64) { const int col = ch * 8; *(AT_LAS u32x4*)(vb + ((col >> 5) * 4 + (row >> 4)) * 1024 + (row & 15) * 64 + (col & 31) * 2) = st[NK]; }
    else {
        const int vrow = tid >> 4, col = (tid & 15) * 8;
#pragma unroll
        for (int i = 0; i < 2; ++i) *(AT_LAS u32x4*)(vb + ((col >> 5) * 4 + ((vrow + 32 * i) >> 4)) * 1024 + (vrow & 15) * 64 + (col & 31) * 2) = st[NK + i];
    }
}
__device__ __forceinline__ void glds16(const void* gsrc, unsigned lds_dst) { unsigned keep;
    asm volatile("s_mov_b32 %0, m0\n\ts_mov_b32 m0, %2\n\ts_nop 0\n\tglobal_load_lds_dwordx4 %1, off\n\ts_mov_b32 m0, %0" : "=&s"(keep) : "v"(gsrc), "s"(lds_dst) : "memory"); }
template <int NK, int DV>
__device__ __forceinline__ void dma_bf(const bf16_t* kbase, const bf16_t* vbase, AT_LAS unsigned char* sb, int w, int lane) {
    const unsigned s0 = (unsigned)__builtin_amdgcn_readfirstlane((int)(unsigned)(uintptr_t)sb);
#pragma unroll
    for (int c = 0; c < NK; ++c) glds16(kbase + (size_t)lane * PITCH + c * 64 + w * 8, (unsigned)__builtin_amdgcn_readfirstlane((int)(s0 + c * KT_BYTES + w * KCS)));
#pragma unroll
    for (int i = 0; i < DV / 64; ++i) { const int d0 = 2 * i + (w >> 2), rg = w & 3;
        glds16(vbase + (size_t)(16 * rg + (lane >> 2)) * PITCH + d0 * 32 + (lane & 3) * 8, (unsigned)__builtin_amdgcn_readfirstlane((int)(s0 + NK * KT_BYTES + (d0 * 4 + rg) * 1024))); }
}
__device__ __forceinline__ void dma_prompt(const bf16_t* kbase, const bf16_t* vbase, AT_LAS unsigned char* sb, int w, int lane) {
    const unsigned s0 = (unsigned)__builtin_amdgcn_readfirstlane((int)(unsigned)(uintptr_t)sb);
#pragma unroll
    for (int i = 0; i < 2; ++i) { const int j = 2 * w + i, R = 4 * j + (lane >> 4), c = (lane & 15) ^ (R & 15);
        glds16(kbase + (size_t)R * PITCH + c * 8, (unsigned)__builtin_amdgcn_readfirstlane((int)(s0 + j * 1024))); }
#pragma unroll
    for (int i = 0; i < 2; ++i) { const int d0 = 2 * i + (w >> 2), rg = w & 3;
        glds16(vbase + (size_t)(16 * rg + (lane >> 2)) * PITCH + d0 * 32 + (lane & 3) * 8, (unsigned)__builtin_amdgcn_readfirstlane((int)(s0 + 16384 + (d0 * 4 + rg) * 1024))); }
}
__device__ __forceinline__ void dma_promptB(const bf16_t* kbase, const bf16_t* vbase, AT_LAS unsigned char* sb, int w, int lane) {
    const unsigned s0 = (unsigned)__builtin_amdgcn_readfirstlane((int)(unsigned)(uintptr_t)sb);
    { const int R = 8 * w + (lane >> 3), c = (lane & 7) ^ ((R >> 1) & 7);
      glds16(kbase + (size_t)R * PITCH + c * 8, (unsigned)__builtin_amdgcn_readfirstlane((int)(s0 + w * 1024))); }
    { const int d0 = w >> 2, rg = w & 3;
      glds16(vbase + (size_t)(16 * rg + (lane >> 2)) * PITCH + d0 * 32 + (lane & 3) * 8, (unsigned)__builtin_amdgcn_readfirstlane((int)(s0 + 8192 + (d0 * 4 + rg) * 1024))); }
}
template <int NK, int DV>
__device__ __forceinline__ void ld_f32(u32x4 (&st)[2 * NK + DV / 32], const float* kbase, const float* vbase, int tid) {
    { const unsigned off = (unsigned)(tid >> 4) * 1024 + (tid & 15) * 4;
#pragma unroll
      for (int c = 0; c < NK; ++c)
#pragma unroll
          for (int i = 0; i < 2; ++i) st[c * 2 + i] = ld16(kbase + off + c * 64 + (size_t)i * 32 * 1024); }
    if (DV == 64) { const unsigned off = (unsigned)(tid >> 4) * 1024 + (tid & 15) * 4;
#pragma unroll
        for (int i = 0; i < 2; ++i) st[2 * NK + i] = ld16(vbase + off + (size_t)i * 32 * 1024); }
    else { const unsigned off = (unsigned)(tid >> 5) * 1024 + (tid & 31) * 4;
#pragma unroll
        for (int i = 0; i < 4; ++i) st[2 * NK + i] = ld16(vbase + off + (size_t)i * 16 * 1024); }
}
template <int NK, int DV>
__device__ __forceinline__ void wr_f32(const u32x4 (&st)[2 * NK + DV / 32], AT_LAS unsigned char* sb, int tid) {
    { const int row = tid >> 4, c4 = tid & 15;
#pragma unroll
      for (int c = 0; c < NK; ++c)
#pragma unroll
          for (int i = 0; i < 2; ++i) *(AT_LAS u32x2*)(sb + c * KT_BYTES + (c4 >> 1) * KCS + (row + 32 * i) * 16 + (c4 & 1) * 8) = f4_to_bf4(st[c * 2 + i]); }
    AT_LAS unsigned char* vb = sb + NK * KT_BYTES;
    if (DV == 64) { const int row = tid >> 4, col = (tid & 15) * 4;
#pragma unroll
        for (int i = 0; i < 2; ++i) *(AT_LAS u32x2*)(vb + ((col >> 5) * 4 + ((row + 32 * i) >> 4)) * 1024 + (row & 15) * 64 + (col & 31) * 2) = f4_to_bf4(st[2 * NK + i]); }
    else { const int row = tid >> 5, col = (tid & 31) * 4;
#pragma unroll
        for (int i = 0; i < 4; ++i) *(AT_LAS u32x2*)(vb + ((col >> 5) * 4 + ((row + 16 * i) >> 4)) * 1024 + (row & 15) * 64 + (col & 31) * 2) = f4_to_bf4(st[2 * NK + i]); }
}

constexpr int A_STAGE = 2 * KT_BYTES + 16384;
constexpr int A_TP = 132;
constexpr int S_TAB = WSF_OFF + 2048;
template <bool ISB>
__device__ __forceinline__ void attn_sample_unit(AT_LAS unsigned char* lds, int b, int cg, const Ctx& C) {
    constexpr int ND0 = ISB ? 2 : 4, NT = ISB ? 8 : 16, PAST = ISB ? 512 : 1024;
    const int tid = pg8::opaque_tid(), lane = tid & 63, r32 = lane & 31, hi = lane >> 5;
    const int w = __builtin_amdgcn_readfirstlane(tid >> 6), g = w >> 2;
    AT_LAS float* wsf = (AT_LAS float*)(lds + WSF_OFF) + w * 64;
    AT_LAS float* tab = (AT_LAS float*)(lds + S_TAB) + g * 264;
    const bool active = (w & 3) == 0;
    const int qrow0 = MP + b * 32, qpos = 1024 + r32;
    if (ISB) { for (int i = tid; i < 2 * 257; i += 512) { const int hh = i >= 257 ? 1 : 0, j = i - hh * 257; ((AT_LAS float*)(lds + S_TAB))[hh * 264 + j] = C.rel[(2 * cg + hh) * 257 + j] * 1.4426950408889634f; } }
    const float lam = C.lam;
    bf16x8 qr[4];
    AT_LAS unsigned char* qimg = lds + QIMG_OFF + w * 4096;
#pragma unroll
    for (int d0 = 0; d0 < 4; ++d0) { qr[d0] = *(const bf16x8*)(C.Q + (size_t)(qrow0 + r32) * PITCH + cg * 128 + g * 64 + d0 * 16 + hi * 8);
        *(AT_LAS bf16x8*)(qimg + (2 * d0 + hi) * 512 + r32 * 16) = qr[d0]; }
    f32x16 o[ND0];
#pragma unroll
    for (int d0 = 0; d0 < ND0; ++d0) o[d0] = f32x16{};
    float m = -1e30f, l = 0.f;
    const bf16_t* kb0 = C.K + (size_t)qrow0 * PITCH + cg * 128;
    const bf16_t* vb0 = C.V + (size_t)qrow0 * PITCH + cg * 128;
    const float* kc0 = C.cache_k + (size_t)b * PAST * 1024 + cg * 128;
    const float* vc0 = C.cache_v + (size_t)b * PAST * 1024 + cg * 128;
    u32x4 st[8];
    ld_f32<2, 128>(st, kc0, vc0, tid);
    { u32x4 sn[4]; ld_bf<2, 128>(sn, kb0, vb0, 32, tid); wr_bf<2, 128>(sn, lds + 2 * A_STAGE, tid); }
    for (int t = 0; t < NT; ++t) {
        AT_LAS unsigned char* sb = lds + (t & 1) * A_STAGE;
        wr_f32<2, 128>(st, sb, tid);
        AT_SYNC();
        if (t + 1 < NT) ld_f32<2, 128>(st, kc0 + (size_t)(t + 1) * 64 * 1024, vc0 + (size_t)(t + 1) * 64 * 1024, tid);
        if (active) {
            const int nsub = (t == 0) ? 2 : 1;
#pragma unroll 1
            for (int sub = 0; sub < nsub; ++sub) {
                const AT_LAS unsigned char* sc = sub ? (lds + 2 * A_STAGE) : sb;
                f32x16 p0, p1;
                qk_tile<true>(p0, p1, sc + g * KT_BYTES, qr, qimg, r32, hi);
                if (ISB) {
                    const int kpos0 = sub ? 1024 : 512 + t * 64;
                    if (1024 - (kpos0 + 63) >= 128) { const float cb = tab[256];
#pragma unroll
                        for (int r = 0; r < 16; ++r) { p0[r] += cb; p1[r] += cb; } }
                    else {
#pragma unroll
                        for (int r = 0; r < 16; ++r) { const int rel = qpos - (kpos0 + crow(r, hi));
                            const int i0 = rel < -128 ? -128 : (rel > 128 ? 128 : rel), i1 = (rel - 32) < -128 ? -128 : ((rel - 32) > 128 ? 128 : (rel - 32));
                            p0[r] += tab[i0 + 128]; p1[r] += tab[i1 + 128]; } }
                }
                if (sub) {
#pragma unroll
                    for (int r = 0; r < 16; ++r) p1[r] = -INFINITY;
                }
                softmax_tile<ND0>(p0, p1, m, l, o, wsf, r32, hi);
                pv_tile<ND0>(o, sc + 2 * KT_BYTES + (ISB ? g * 8192 : 0), p0, p1, lane, hi);
            }
        }
    }
    AT_SYNC();
    const float lt = l + __shfl_xor(l, 32);
    if (!ISB) {
        { float inv = 1.0f / lt; if (g == 1) inv *= lam; if (hi == 0) wsf[r32] = inv; asm volatile("s_waitcnt lgkmcnt(0)" ::: "memory"); }
        AT_LAS float* T2 = (AT_LAS float*)lds;
        if (active && g == 1) {
#pragma unroll
            for (int r = 0; r < 16; ++r) { const int q = crow(r, hi); const float f = wsf[q];
#pragma unroll
                for (int d0 = 0; d0 < ND0; ++d0) T2[q * A_TP + d0 * 32 + r32] = o[d0][r] * f; }
        }
        AT_SYNC();
        if (active && g == 0) {
#pragma unroll
            for (int r = 0; r < 16; ++r) { const int q = crow(r, hi); const float f = wsf[q];
#pragma unroll
                for (int d0 = 0; d0 < ND0; ++d0) { const int ix = q * A_TP + d0 * 32 + r32; T2[ix] = o[d0][r] * f - T2[ix]; } }
            asm volatile("s_waitcnt lgkmcnt(0)" ::: "memory");
            const int row = lane & 31, half = lane >> 5;
            f32x4 x[16]; float ss = 0.f;
#pragma unroll
            for (int i = 0; i < 16; ++i) { x[i] = *(const AT_LAS f32x4*)(T2 + row * A_TP + half * 64 + 4 * i); ss += (x[i][0] * x[i][0] + x[i][1] * x[i][1]) + (x[i][2] * x[i][2] + x[i][3] * x[i][3]); }
            ss += __shfl_xor(ss, 32);
            const float rinv = 0.8f / sqrtf(ss * (1.0f / 128.0f) + 1e-6f);
            bf16_t* op = C.O + (size_t)(qrow0 + row) * PITCH + cg * 128 + half * 64;
#pragma unroll
            for (int i = 0; i < 16; i += 2) {
                const f32x4 g0 = *(const f32x4*)(C.subln + half * 64 + 4 * i), g1 = *(const f32x4*)(C.subln + half * 64 + 4 * i + 4);
                const f32x4 y0 = x[i] * g0 * rinv, y1 = x[i + 1] * g1 * rinv;
                u32x4 wv; wv.x = cvtpk(y0[0], y0[1]); wv.y = cvtpk(y0[2], y0[3]); wv.z = cvtpk(y1[0], y1[1]); wv.w = cvtpk(y1[2], y1[3]);
                *(u32x4*)(op + 4 * i) = wv;
            }
        }
    } else if (active) {
        { const float inv = 1.0f / lt; if (hi == 0) wsf[r32] = inv; asm volatile("s_waitcnt lgkmcnt(0)" ::: "memory"); }
        AT_LAS bf16_t* stg = (AT_LAS bf16_t*)lds + g * 2048;
#pragma unroll
        for (int r = 0; r < 16; ++r) { const int q = crow(r, hi); const float f = wsf[q];
#pragma unroll
            for (int d0 = 0; d0 < ND0; ++d0) { const unsigned pk = cvtpk(o[d0][r] * f, 0.f); stg[q * 64 + d0 * 32 + r32] = (bf16_t)(pk & 0xffffu); } }
        asm volatile("s_waitcnt lgkmcnt(0)" ::: "memory");
        bf16_t* op = C.O + (size_t)qrow0 * PITCH + cg * 128 + g * 64;
#pragma unroll
        for (int i = 0; i < 4; ++i) { const int row = i * 8 + (lane >> 3), ch = lane & 7; const u32x4 v = *(const AT_LAS u32x4*)(stg + row * 64 + ch * 8); *(u32x4*)(op + (size_t)row * PITCH + ch * 8) = v; }
    }
    AT_SYNC();
}

constexpr int P_STAGE = 16384 + 16384;
constexpr int P_EPI = 65536;
constexpr int P_WSF = 135168;
constexpr int P_TAB = P_WSF + 2048;
template <bool ISB>
__device__ __forceinline__ void attn_prompt_unit(AT_LAS unsigned char* lds, int b, int cg, int ub, const Ctx& C, bf16x8 (&qr)[4], bool pre, bool has_next, int nb, int ncg, int nub) {
#ifdef PROBE_STAMP
    const unsigned long long tsA_ = PROBE_CLK();
#endif
    constexpr int ND0 = ISB ? 2 : 4, NS = ISB ? 8 : 4, STG = ISB ? 16384 : P_STAGE, DIST = ISB ? 4 : 2, VOFF = ISB ? 8192 : 16384, KR2 = ISB ? 4096 : 8192;
    const int tid = pg8::opaque_tid(), lane = tid & 63, r32 = lane & 31, hi = lane >> 5;
#ifdef PROBE_PARITY
    const int w = __builtin_amdgcn_readfirstlane(tid >> 6), g = ISB ? 0 : (w >> 2), qi = w & 3;
#else
    const int w = __builtin_amdgcn_readfirstlane(tid >> 6), g = w >> 2, qi = w & 3;
#endif
    AT_LAS float* wsf = (AT_LAS float*)(lds + P_WSF) + w * 64;
    AT_LAS float* tab = (AT_LAS float*)(lds + P_TAB);
    const int cw = ISB ? 4 * ub + (w >> 1) : 2 * ub + (qi >> 1);
    const int kt0 = ISB ? ((4 * ub - 8) > 0 ? (4 * ub - 8) : 0) : 0, NT = (ISB ? 4 * ub + 4 : 2 * ub + 2) - kt0;
    const int fv = ISB ? ((cw - 8) > 0 ? (cw - 8) : 0) : 0;
    const int qoff = ISB ? ub * 256 + w * 32 : ub * 128 + qi * 32, qrow0 = b * SEQ + qoff, qpos = qoff + r32;
    const int ccol = ISB ? cg * 64 : cg * 128;
    if (!pre) { if (ISB) { if (tid < 257) tab[tid] = C.rel[cg * 257 + tid] * 1.4426950408889634f; } }
    AT_LAS float* subl = (AT_LAS float*)(lds + P_TAB);
    if (!ISB && !pre) { if (tid < 128) subl[tid] = C.subln[tid]; }
    const float lam = C.lam;
    if (!pre) {
#pragma unroll
        for (int d0 = 0; d0 < 4; ++d0) qr[d0] = *(const bf16x8*)(C.Q + (size_t)(qrow0 + r32) * PITCH + ccol + (ISB ? 0 : g * 64) + d0 * 16 + hi * 8);
    }
    f32x16 o[ND0];
#pragma unroll
    for (int d0 = 0; d0 < ND0; ++d0) o[d0] = f32x16{};
    f32x16 negm = f32x16{};
    float m = 0.f, l = 0.f;
    bf16x8 pa[4];
#pragma unroll
    for (int ks = 0; ks < 4; ++ks) pa[ks] = bf16x8{};
    const bf16_t* kb0 = C.K + (size_t)(b * SEQ + kt0 * 64) * PITCH + ccol;
    const bf16_t* vb0 = C.V + (size_t)(b * SEQ + kt0 * 64) * PITCH + ccol;
#define P_DMA(tt) do { if (ISB) dma_promptB(kb0 + (size_t)(tt) * 64 * PITCH, vb0 + (size_t)(tt) * 64 * PITCH, lds + ((tt) & (NS - 1)) * STG, w, lane); \
                       else dma_prompt(kb0 + (size_t)(tt) * 64 * PITCH, vb0 + (size_t)(tt) * 64 * PITCH, lds + ((tt) & (NS - 1)) * STG, w, lane); } while (0)
    if (!pre) {
#pragma unroll
        for (int tt = 0; tt < DIST; ++tt) if (tt < NT) P_DMA(tt);
    }
    const int vlane = ((lane >> 4) & 1) * 32 + (lane & 3) * 8 + (4 * hi + ((lane & 15) >> 2)) * 64 + VOFF;
    const int klane = ISB ? (r32 * 128 + ((hi ^ ((r32 >> 1) & 7)) << 4)) : (r32 * 256 + (((g * 8 + hi) ^ (r32 & 15)) << 4));
#define P_VRD(buf, blk) do { _Pragma("unroll") for (int ks = 0; ks < 4; ++ks) { buf[2 * ks] = vtr(vp + (blk) * 4096 + ks * 1024); buf[2 * ks + 1] = vtr(vp + (blk) * 4096 + ks * 1024 + 512); } } while (0)
#define P_VMM(buf, blk) do { _Pragma("unroll") for (int ks = 0; ks < 4; ++ks) { const bf16x8 bfr = {buf[2 * ks][0], buf[2 * ks][1], buf[2 * ks][2], buf[2 * ks][3], buf[2 * ks + 1][0], buf[2 * ks + 1][1], buf[2 * ks + 1][2], buf[2 * ks + 1][3]}; \
        o[blk] = __builtin_amdgcn_mfma_f32_32x32x16_bf16(pa[ks], bfr, o[blk], 0, 0, 0); } } while (0)
#define P_SB() __builtin_amdgcn_sched_barrier(0)
#define P_KRD(scur) do { \
        _Pragma("unroll") for (int d0 = 0; d0 < 4; ++d0) { ka[2 * d0] = *(const AT_LAS bf16x8*)(lds + (scur) + (klane ^ (d0 << 5))); ka[2 * d0 + 1] = *(const AT_LAS bf16x8*)(lds + (scur) + (klane ^ (d0 << 5)) + KR2); } } while (0)
#define P_PV(sprev, KRD_STMT) do { const AT_LAS unsigned char* vp = lds + (sprev) + vlane; \
        P_VMM(va, 0); \
        if (ND0 == 4) { P_VRD(va, 2); P_SB(); P_VMM(vb, 1); P_VRD(vb, 3); P_SB(); P_VMM(va, 2); KRD_STMT; P_SB(); P_VMM(vb, 3); } else { KRD_STMT; P_SB(); P_VMM(vb, 1); } P_SB(); } while (0)
#define P_PRE(sprev) do { const AT_LAS unsigned char* vp = lds + (sprev) + vlane; P_VRD(va, 0); P_VRD(vb, 1); } while (0)
#define P_BAR() do { __builtin_amdgcn_sched_barrier(0); asm volatile("s_barrier" ::: "memory"); __builtin_amdgcn_sched_barrier(0); } while (0)
#define P_BAR_V0() do { __builtin_amdgcn_sched_barrier(0); asm volatile("s_waitcnt vmcnt(0)\n\ts_barrier" ::: "memory"); __builtin_amdgcn_sched_barrier(0); } while (0)
#define P_BAR_V2() do { __builtin_amdgcn_sched_barrier(0); asm volatile("s_waitcnt vmcnt(2)\n\ts_barrier" ::: "memory"); __builtin_amdgcn_sched_barrier(0); } while (0)
#define P_BAR_V4() do { __builtin_amdgcn_sched_barrier(0); asm volatile("s_waitcnt vmcnt(4)\n\ts_barrier" ::: "memory"); __builtin_amdgcn_sched_barrier(0); } while (0)
    if (pre) {
        if (ISB) asm volatile("s_waitcnt vmcnt(4) lgkmcnt(0)\n\ts_barrier" ::: "memory");
        else if (g == 0) asm volatile("s_waitcnt vmcnt(8) lgkmcnt(0)\n\ts_barrier" ::: "memory");
        else asm volatile("s_waitcnt vmcnt(0) lgkmcnt(0)\n\ts_barrier" ::: "memory");
    }
    else asm volatile("s_waitcnt vmcnt(0) lgkmcnt(0)\n\ts_barrier" ::: "memory");
    if (g == 1) P_BAR();
    f32x16 p0, p1;
    s16x4 va[8], vb[8]; bf16x8 ka[8];
#ifdef PROBE_STAMP
    unsigned long long stamp_acc = 0;
#endif
    P_PRE(0);
#ifdef PROBE_STAMP
    const unsigned long long tsB_ = PROBE_CLK();
#endif
    for (int t = 0; t < NT; ++t) {
#ifdef PROBE_PARITY
        if (t > 0 && !ISB) P_BAR();
#else
        if (t > 0) P_BAR();
#endif
#ifdef PROBE_STAMP
        const unsigned long long ts0_ = PROBE_CLK();
#endif
        P_PV((t > 0 ? ((t - 1) & (NS - 1)) : 0) * STG, P_KRD((t & (NS - 1)) * STG));
        p0 = __builtin_amdgcn_mfma_f32_32x32x16_bf16(ka[0], qr[0], negm, 0, 0, 0); p1 = __builtin_amdgcn_mfma_f32_32x32x16_bf16(ka[1], qr[0], negm, 0, 0, 0);
#pragma unroll
        for (int d0 = 1; d0 < 4; ++d0) { p0 = __builtin_amdgcn_mfma_f32_32x32x16_bf16(ka[2 * d0], qr[d0], p0, 0, 0, 0); p1 = __builtin_amdgcn_mfma_f32_32x32x16_bf16(ka[2 * d0 + 1], qr[d0], p1, 0, 0, 0); }
        if (ISB) { const int nn = NT - 2 - t; if (nn >= 2) P_BAR_V4(); else if (nn == 1) P_BAR_V2(); else P_BAR_V0(); }
        else P_BAR_V0();
#ifdef PROBE_STAMP
        const unsigned long long ts1_ = PROBE_CLK();
#endif
        if (t + DIST < NT) P_DMA(t + DIST);
        const int kt = kt0 + t;
        const bool vis = ISB ? (kt <= cw && kt >= cw - 8) : (kt <= cw);
        if (vis) {
            if (ISB) {
                const int relmin = cw * 64 + (w & 1) * 32 - (kt * 64 + 63);
                if (relmin >= 128) { const float cb = tab[256];
#pragma unroll
                    for (int r = 0; r < 16; ++r) { p0[r] += cb; p1[r] += cb; } }
                else {
#pragma unroll
                    for (int r = 0; r < 16; ++r) { const int rel = qpos - (kt * 64 + crow(r, hi));
                        const int i0 = rel < -128 ? -128 : (rel > 128 ? 128 : rel), i1 = (rel - 32) < -128 ? -128 : ((rel - 32) > 128 ? 128 : (rel - 32));
                        p0[r] += tab[i0 + 128]; p1[r] += tab[i1 + 128]; } }
            }
            float ra = __builtin_fmaxf(__builtin_fmaxf(p0[0], p0[1]), p1[0]), rb = __builtin_fmaxf(__builtin_fmaxf(p0[2], p0[3]), p1[1]);
            ra = __builtin_fmaxf(__builtin_fmaxf(ra, p1[2]), p1[3]);
#pragma unroll
            for (int r = 4; r < 16; r += 4) { ra = __builtin_fmaxf(__builtin_fmaxf(ra, p0[r]), p0[r + 1]); rb = __builtin_fmaxf(__builtin_fmaxf(rb, p0[r + 2]), p0[r + 3]);
                                              ra = __builtin_fmaxf(__builtin_fmaxf(ra, p1[r]), p1[r + 1]); rb = __builtin_fmaxf(__builtin_fmaxf(rb, p1[r + 2]), p1[r + 3]); }
            float rm = __builtin_fmaxf(ra, rb);
            { auto rr = __builtin_amdgcn_permlane32_swap(__float_as_uint(rm), __float_as_uint(rm), false, false); rm = __builtin_fmaxf(__uint_as_float(rr[0]), __uint_as_float(rr[1])); }
            const bool first = (kt == fv);
            if (first || __any(rm > THR)) {
                const float dl = first ? rm : __builtin_fmaxf(rm, 0.f);
                m += dl;
#pragma unroll
                for (int r = 0; r < 16; ++r) { p0[r] -= dl; p1[r] -= dl; }
#pragma unroll
                for (int r = 0; r < 16; ++r) negm[r] = -m;
                if (!first) {
                    const float f = __builtin_amdgcn_exp2f(-dl); l *= f;
                    if (hi == 0) wsf[r32] = f;
                    asm volatile("s_waitcnt lgkmcnt(0)" ::: "memory");
#pragma unroll
                    for (int r = 0; r < 16; ++r) { const float fr_ = wsf[crow(r, hi)];
#pragma unroll
                        for (int d0 = 0; d0 < ND0; ++d0) o[d0][r] *= fr_; }
                    asm volatile("s_waitcnt lgkmcnt(0)" ::: "memory");
                }
            }
            float s = 0.f;
#pragma unroll
            for (int r = 0; r < 16; ++r) { p0[r] = __builtin_amdgcn_exp2f(p0[r]); p1[r] = __builtin_amdgcn_exp2f(p1[r]); s += p0[r] + p1[r]; }
            l += s;
#ifdef PROBE_S2X
            { float xs = 0.f;
              for (int rep = 0; rep < PROBE_S2X; ++rep) {
#pragma unroll
              for (int r = 0; r < 16; ++r) { xs += __builtin_amdgcn_exp2f(p0[r] - 20.f - xs) + __builtin_amdgcn_exp2f(p1[r] - 21.f - xs); } }
              asm volatile("" :: "v"(xs)); }
#endif
            pack_p(pa, p0, p1);
        } else {
#pragma unroll
            for (int ks = 0; ks < 4; ++ks) pa[ks] = bf16x8{};
        }
        P_PRE((t & (NS - 1)) * STG);
#ifdef PROBE_STAMP
        { const unsigned long long ts2_ = PROBE_CLK(); if (ISB == (PROBE_STAMP_B != 0)) { if (PROBE_STAMP == 1) stamp_acc += ts1_ - ts0_; else if (PROBE_STAMP == 2) stamp_acc += ts2_ - ts1_; else stamp_acc += ts2_ - ts0_; } }
#endif
    }
#ifdef PROBE_STAMP
    const unsigned long long tsC_ = PROBE_CLK();
#endif
#ifdef PROBE_PARITY
    if (!ISB) P_BAR();
#else
    P_BAR();
#endif
    P_PV(((NT - 1) & (NS - 1)) * STG, (void)0);
    asm volatile("s_waitcnt lgkmcnt(0)" ::: "memory");
    if (g == 0) P_BAR();
    P_BAR();
    if (has_next) {
        const int nkt0 = ISB ? ((4 * nub - 8) > 0 ? (4 * nub - 8) : 0) : 0, nNT = (ISB ? 4 * nub + 4 : 2 * nub + 2) - nkt0, nccol = ISB ? ncg * 64 : ncg * 128;
        const bf16_t* nk0 = C.K + (size_t)(nb * SEQ + nkt0 * 64) * PITCH + nccol; const bf16_t* nv0 = C.V + (size_t)(nb * SEQ + nkt0 * 64) * PITCH + nccol;
#pragma unroll
        for (int tt = 0; tt < DIST; ++tt) if (tt < nNT) { if (ISB) dma_promptB(nk0 + (size_t)tt * 64 * PITCH, nv0 + (size_t)tt * 64 * PITCH, lds + tt * STG, w, lane); else dma_prompt(nk0 + (size_t)tt * 64 * PITCH, nv0 + (size_t)tt * 64 * PITCH, lds + tt * STG, w, lane); }
        const int nqrow0 = nb * SEQ + (ISB ? nub * 256 + w * 32 : nub * 128 + qi * 32);
#pragma unroll
        for (int d0 = 0; d0 < 4; ++d0) qr[d0] = *(const bf16x8*)(C.Q + (size_t)(nqrow0 + r32) * PITCH + nccol + (ISB ? 0 : g * 64) + d0 * 16 + hi * 8);
    }
#undef P_KRD
#undef P_PRE
#undef P_BAR
#undef P_BAR_V0
#undef P_BAR_V2
#undef P_BAR_V4
#undef P_DMA
#undef P_VRD
#undef P_VMM
#undef P_SB
#undef P_PV
    const float lt = l + __shfl_xor(l, 32);
    if (!ISB) {
        { float inv = 1.0f / lt; if (g == 1) inv *= lam; if (hi == 0) wsf[r32] = inv; asm volatile("s_waitcnt lgkmcnt(0)" ::: "memory"); }
        AT_LAS float* T2 = (AT_LAS float*)(lds + P_EPI) + qi * (32 * A_TP);
        if (g == 1) {
#pragma unroll
            for (int r = 0; r < 16; ++r) { const int q = crow(r, hi); const float f = wsf[q];
#pragma unroll
                for (int d0 = 0; d0 < ND0; ++d0) T2[q * A_TP + d0 * 32 + r32] = o[d0][r] * f; }
        }
        asm volatile("s_waitcnt lgkmcnt(0)\n\ts_barrier" ::: "memory");
        if (g == 0) {
#pragma unroll
            for (int r = 0; r < 16; ++r) { const int q = crow(r, hi); const float f = wsf[q];
#pragma unroll
                for (int d0 = 0; d0 < ND0; ++d0) { const int ix = q * A_TP + d0 * 32 + r32; T2[ix] = o[d0][r] * f - T2[ix]; } }
            asm volatile("s_waitcnt lgkmcnt(0)" ::: "memory");
            const int row = lane & 31, half = lane >> 5;
            f32x4 x[16]; float ss = 0.f;
#pragma unroll
            for (int i = 0; i < 16; ++i) { x[i] = *(const AT_LAS f32x4*)(T2 + row * A_TP + half * 64 + 4 * i); ss += (x[i][0] * x[i][0] + x[i][1] * x[i][1]) + (x[i][2] * x[i][2] + x[i][3] * x[i][3]); }
            ss += __shfl_xor(ss, 32);
            const float rinv = 0.8f / sqrtf(ss * (1.0f / 128.0f) + 1e-6f);
            bf16_t* op = C.O + (size_t)(qrow0 + row) * PITCH + cg * 128 + half * 64;
#pragma unroll
            for (int i = 0; i < 16; i += 4) {
                const f32x4 g0 = *(const AT_LAS f32x4*)(subl + half * 64 + 4 * i), g1 = *(const AT_LAS f32x4*)(subl + half * 64 + 4 * i + 4), g2 = *(const AT_LAS f32x4*)(subl + half * 64 + 4 * i + 8), g3 = *(const AT_LAS f32x4*)(subl + half * 64 + 4 * i + 12);
                const f32x4 y0 = x[i] * g0 * rinv, y1 = x[i + 1] * g1 * rinv, y2 = x[i + 2] * g2 * rinv, y3 = x[i + 3] * g3 * rinv;
                u32x4 wv; wv.x = cvtpk(y0[0], y0[1]); wv.y = cvtpk(y0[2], y0[3]); wv.z = cvtpk(y1[0], y1[1]); wv.w = cvtpk(y1[2], y1[3]);
                u32x4 wz; wz.x = cvtpk(y2[0], y2[1]); wz.y = cvtpk(y2[2], y2[3]); wz.z = cvtpk(y3[0], y3[1]); wz.w = cvtpk(y3[2], y3[3]);
                *(u32x4*)(op + 4 * i) = wv; *(u32x4*)(op + 4 * i + 8) = wz;
            }
        }
    } else {
        { const float inv = 1.0f / lt; if (hi == 0) wsf[r32] = inv; asm volatile("s_waitcnt lgkmcnt(0)" ::: "memory"); }
        AT_LAS bf16_t* stg = (AT_LAS bf16_t*)(lds + P_EPI) + w * 2048;
#pragma unroll
        for (int r = 0; r < 16; ++r) { const int q = crow(r, hi); const float f = wsf[q];
#pragma unroll
            for (int d0 = 0; d0 < ND0; ++d0) { const unsigned pk = cvtpk(o[d0][r] * f, 0.f); stg[q * 64 + d0 * 32 + r32] = (bf16_t)(pk & 0xffffu); } }
        asm volatile("s_waitcnt lgkmcnt(0)" ::: "memory");
        bf16_t* op = C.O + (size_t)qrow0 * PITCH + ccol;
#pragma unroll
        for (int i = 0; i < 4; ++i) { const int row = i * 8 + (lane >> 3), ch = lane & 7; const u32x4 v = *(const AT_LAS u32x4*)(stg + row * 64 + ch * 8); *(u32x4*)(op + (size_t)row * PITCH + ch * 8) = v; }
    }
    asm volatile("s_waitcnt lgkmcnt(0)\n\ts_barrier" ::: "memory");
#ifdef PROBE_STAMP
    { const unsigned long long tsD_ = PROBE_CLK(); if (ISB == (PROBE_STAMP_B != 0)) { if (PROBE_STAMP == 4) stamp_acc = tsB_ - tsA_; else if (PROBE_STAMP == 5) stamp_acc = tsD_ - tsC_; else if (PROBE_STAMP == 6) stamp_acc = tsD_ - tsA_; }
      if (blockIdx.x == PROBE_BLK && tid == PROBE_TID) atomicAdd((unsigned long long*)C.stamp, stamp_acc); }
#endif
}
}

constexpr int NWAVES = 8;
#ifndef MK_N_LAUNCHES
#define MK_N_LAUNCHES 1
#endif
constexpr int N_PHASES = 12;
constexpr int DMODEL = 1024, SEQ = 2048, NBATCH = 8, MP = NBATCH * SEQ, MS = 1024, M = MP + MS, FF = 4096;
constexpr size_t O_Y = 0, O_AKP = 17825792, O_AVP = 34603008, O_BKP = 51380224, O_BVP = 55574528, O_AKS = 59768832, O_AVS = 60817408, O_BKS = 61865984, O_BVS = 62914560, O_END = 63963136;
constexpr size_t MiB = 1u << 20;
constexpr size_t WS_CTL = 0, CTL_ZERO_BYTES = 1 * MiB;
constexpr size_t WS_WQKV = 2 * MiB, WS_WAO = 8 * MiB, WS_WKVQ = 10 * MiB, WS_WBO = 16 * MiB, WS_W1 = 18 * MiB  , WS_W2 = 34 * MiB  ;
constexpr size_t WS_CS = 50 * MiB;
constexpr size_t WS_SS = 51 * MiB;
constexpr size_t WS_HB = 54 * MiB, WS_Q = 90 * MiB, WS_K = 126 * MiB, WS_V = 162 * MiB, WS_O = 198 * MiB;
constexpr size_t WS_U = 234 * MiB;
constexpr size_t WS_END = 372 * MiB;
constexpr int CW_TMO = 0, CW_CODE = 1, CW_BAR = 4096, CW_FIN = 8192;
constexpr int RS_OFF = 139264;
constexpr int RING_OFF = 0, RING_BYTES = 131072, LDS_BYTES = 163840, LDSCTL_OFF = LDS_BYTES - 1024, MISC_OFF = LDSCTL_OFF + 320;

struct Args { const float* in[20]; float* out; unsigned char* ws; int ph_lo, ph_hi, li, pad; };

struct Frame {
    LAS unsigned char* lds; volatile LAS unsigned* MISC; gu32* ctl;
    int tid, lane, wave, vcu, G;
};

__device__ __forceinline__ float wave_sum(float v) {
#pragma unroll
    for (int o = 1; o < 64; o <<= 1) v += __shfl_xor(v, o);
    return v;
}
__device__ __forceinline__ int pi64(int d) { return d < 32 ? 32 * (d >> 4) + (d & 15) : 32 * ((d - 32) >> 4) + 16 + ((d - 32) & 15); }
template <bool PERMQK>
__device__ __forceinline__ void p0_transpose_item(const float* W, const float* g, int K, int N, bf16* WT, int row_off, LAS float* scr, int item, int lane) {
    const int nblk = N / 32, kb = item / nblk, nb = item % nblk, k0 = 64 * kb, n0 = 32 * nb;
    float wv[32];
#pragma unroll
    for (int i = 0; i < 32; ++i) { const int kk = 2 * i + (lane >> 5); wv[i] = W[(size_t)(k0 + kk) * N + n0 + (lane & 31)]; }
#pragma unroll
    for (int i = 0; i < 32; ++i) { const int kk = 2 * i + (lane >> 5); const float gv = g ? g[k0 + kk] : 1.0f; scr[kk * 33 + (lane & 31)] = wv[i] * gv; }
    LDS_WAIT(); asm volatile("" ::: "memory");
    const int c = lane & 7;
#pragma unroll
    for (int j = 0; j < 4; ++j) { const int n = (lane >> 3) + 8 * j; const LAS float* s = scr + (8 * c) * 33 + n;
        v4u o; o.x = pk2(s[0 * 33], s[1 * 33]); o.y = pk2(s[2 * 33], s[3 * 33]); o.z = pk2(s[4 * 33], s[5 * 33]); o.w = pk2(s[6 * 33], s[7 * 33]);
        int nn = n0 + n; if (PERMQK && nn < 2048) nn = (nn & ~63) + pi64(nn & 63);
        *(GAS v4u*)(WT + (size_t)(row_off + nn) * K + k0 + 8 * c) = o; }
    LDS_WAIT(); asm volatile("" ::: "memory");
}
__device__ __forceinline__ void p0_prologue(Frame& F, const Args& A) {
    unsigned char* ws = A.ws;
    LAS float* scr = (LAS float*)(F.lds + RING_OFF + F.wave * 16384);
    const int gw = F.vcu * NWAVES + F.wave, NGW = F.G * NWAVES;
    constexpr int I_QKV = 16 * 96, I_SQ = 16 * 32, I_KV = 16 * 64, I_F1 = 16 * 128, I_F2 = 64 * 32;
    constexpr int NITEMS = I_QKV + I_SQ + I_KV + I_SQ + I_SQ + 2 * I_F1 + 2 * I_F2;
    const float* g_attn = A.in[6]; const float* g_mlp = A.in[16];
    for (int it = gw; it < NITEMS; it += NGW) {
        int r = it;
        if (r < I_QKV) { p0_transpose_item<true>(A.in[7], g_attn, 1024, 3072, (bf16*)(ws + WS_WQKV), 0, scr, r, F.lane); continue; } r -= I_QKV;
        if (r < I_SQ) { p0_transpose_item<false>(A.in[10], nullptr, 1024, 1024, (bf16*)(ws + WS_WAO), 0, scr, r, F.lane); continue; } r -= I_SQ;
        if (r < I_KV) { p0_transpose_item<false>(A.in[12], A.in[11], 1024, 2048, (bf16*)(ws + WS_WKVQ), 0, scr, r, F.lane); continue; } r -= I_KV;
        if (r < I_SQ) { p0_transpose_item<false>(A.in[13], g_attn + 1024, 1024, 1024, (bf16*)(ws + WS_WKVQ), 2048, scr, r, F.lane); continue; } r -= I_SQ;
        if (r < I_SQ) { p0_transpose_item<false>(A.in[15], nullptr, 1024, 1024, (bf16*)(ws + WS_WBO), 0, scr, r, F.lane); continue; } r -= I_SQ;
        if (r < I_F1) { p0_transpose_item<false>(A.in[17], g_mlp, 1024, 4096, (bf16*)(ws + WS_W1), 0, scr, r, F.lane); continue; } r -= I_F1;
        if (r < I_F1) { p0_transpose_item<false>(A.in[17] + (size_t)1024 * 4096, g_mlp + 1024, 1024, 4096, (bf16*)(ws + WS_W1 + 8 * MiB), 0, scr, r, F.lane); continue; } r -= I_F1;
        if (r < I_F2) { p0_transpose_item<false>(A.in[18], nullptr, 4096, 1024, (bf16*)(ws + WS_W2), 0, scr, r, F.lane); continue; } r -= I_F2;
        p0_transpose_item<false>(A.in[18] + (size_t)4096 * 1024, nullptr, 4096, 1024, (bf16*)(ws + WS_W2 + 8 * MiB), 0, scr, r, F.lane);
    }
    bf16* HB = (bf16*)(ws + WS_HB); float* SS = (float*)(ws + WS_SS);
    for (int m = gw; m < M; m += NGW) {
        const float* xrow = (m < MP) ? A.in[0] + (size_t)m * 1024 : A.in[1] + (size_t)(m - MP) * 1024;
        const GAS f32x4* xr = (const GAS f32x4*)xrow + F.lane;
        f32x4 v[4]; float s = 0.f;
#pragma unroll
        for (int j = 0; j < 4; ++j) { v[j] = xr[64 * j]; s += (v[j].x * v[j].x + v[j].y * v[j].y) + (v[j].z * v[j].z + v[j].w * v[j].w); }
        s = wave_sum(s);
        GAS unsigned long long* o8 = (GAS unsigned long long*)(HB + (size_t)m * 1024) + F.lane;
#pragma unroll
        for (int j = 0; j < 4; ++j) o8[64 * j] = (unsigned long long)pk2(v[j].x, v[j].y) | ((unsigned long long)pk2(v[j].z, v[j].w) << 32);
        if (F.lane < 16) SS[(size_t)m * 16 + F.lane] = (F.lane == 0) ? s : 0.f;
    }
    float* cs = (float*)(ws + WS_CS);
    for (int e = (F.vcu * NWAVES + F.wave) * 64 + F.lane; e < 2048 * 32; e += F.G * NWAVES * 64) {
        const int pos = e >> 5, i = e & 31;
        const float inv = 1.0f / powf(10000.0f, (float)i * (1.0f / 32.0f));
        const float ang = (float)pos * inv;
        float sv, cv; sincosf(ang, &sv, &cv);
        cs[(size_t)pos * 64 + i] = cv; cs[(size_t)pos * 64 + 32 + i] = sv;
    }
}
__device__ __forceinline__ void final_norm(Frame& F, const Args& A, int m_lo, int m_hi) {
    const int gw = F.vcu * NWAVES + F.wave, NGW = F.G * NWAVES;
    const float* SS = (const float*)(A.ws + WS_SS); const float* gf = A.in[19]; const bf16* HB = (const bf16*)(A.ws + WS_HB);
    f32x4 g[4];
#pragma unroll
    for (int j = 0; j < 4; ++j) g[j] = *((const f32x4*)gf + 4 * F.lane + j);
    for (int m = m_lo + gw; m < m_hi; m += NGW) {
        float s = (F.lane < 16) ? SS[(size_t)m * 16 + F.lane] : 0.f;
        s = wave_sum(s);
        const float r = 1.0f / sqrtf(s * (1.0f / 1024.0f) + 1e-6f);
        const v4u h0 = *((const GAS v4u*)(HB + (size_t)m * 1024) + 2 * F.lane), h1 = *((const GAS v4u*)(HB + (size_t)m * 1024) + 2 * F.lane + 1);
        GAS f32x4* yr = (GAS f32x4*)(A.out + (size_t)m * 1024) + 4 * F.lane;
        const unsigned w[8] = {h0.x, h0.y, h0.z, h0.w, h1.x, h1.y, h1.z, h1.w};
#pragma unroll
        for (int j = 0; j < 4; ++j) { f32x4 v; v.x = __uint_as_float(w[2 * j] << 16); v.y = __uint_as_float(w[2 * j] & 0xffff0000u); v.z = __uint_as_float(w[2 * j + 1] << 16); v.w = __uint_as_float(w[2 * j + 1] & 0xffff0000u);
            yr[j] = v * g[j] * r; }
    }
}

struct SplitBar { unsigned* bar; unsigned narr; };
__device__ __forceinline__ void sbar_arrive(SplitBar& sb, const XcdBarrier& b) {
    asm volatile("s_waitcnt vmcnt(0)" ::: "memory");
    __syncthreads();
    if (threadIdx.x == 0) {
        unsigned* bar = sb.bar;
        __builtin_amdgcn_s_waitcnt(0);
        const unsigned nloc = b.st[0], nx = b.st[1];
        const unsigned old = xb_add(&bar[XB_XSUB(b.x)], 1u);
        if ((old + 1u) % nloc == 0u) {
            __builtin_amdgcn_fence(__ATOMIC_RELEASE, "agent");
            asm volatile("s_waitcnt vmcnt(0)" ::: "memory");
            const unsigned og = xb_add(&bar[XB_TOP], 1u);
            if ((og + 1u) % nx == 0u) xb_add(&bar[XB_TOPGEN], 1u);
        }
    }
    ++sb.narr;
}
__device__ __forceinline__ void sbar_wait(const SplitBar& sb, const XcdBarrier& b) {
    if (threadIdx.x == 0) {
        unsigned* bar = sb.bar; unsigned* tb = b.bar;
        XB_SPIN(xb_ld(&bar[XB_TOPGEN]) < sb.narr, tb);
        __builtin_amdgcn_fence(__ATOMIC_ACQUIRE, "agent");
        asm volatile("s_waitcnt vmcnt(0)" ::: "memory");
    }
    __syncthreads();
}

template <int PH, int STREAM>
__device__ __forceinline__ void run_part(Frame& F, const Args& args) {
    unsigned char* const ws = args.ws;
    pg8::bf16_t* const HB = (pg8::bf16_t*)(ws + WS_HB); pg8::bf16_t* const QB = (pg8::bf16_t*)(ws + WS_Q); pg8::bf16_t* const KB = (pg8::bf16_t*)(ws + WS_K);
    pg8::bf16_t* const VB = (pg8::bf16_t*)(ws + WS_V); pg8::bf16_t* const OB = (pg8::bf16_t*)(ws + WS_O); pg8::bf16_t* const UB = (pg8::bf16_t*)(ws + WS_U);
    float* const SS = (float*)(ws + WS_SS);
    LAS float* const rst = (LAS float*)(F.lds + RS_OFF);
#define FILL_RS(N_) pg8::RsTab RSA{nullptr, 0, 0}, RSB{nullptr, 0, 0}; \
        if (STREAM == 1) { pg8::Unit u0; if (S.next(0, u0)) { pg8::rs_fill(SS, rst, u0.pm * 256, 256); RSA = pg8::RsTab{rst, u0.pm * 256, 256}; } } \
        else if (F.vcu < 8 * ((N_) / 128)) { pg8::rs_fill(SS, rst + 256, MP + (F.vcu % 8) * 128, 128); RSB = pg8::RsTab{rst + 256, MP + (F.vcu % 8) * 128, 128}; } \
        __syncthreads();
#define RUN_GEMM(EPI, GEO, NTM, TN_) do { if (STREAM == 1) pg8::gemm_phase<pg8::EPI, pg8::StaticOrder, true, true>(F.lds + RING_OFF, g, S, E); \
        else pg8::gemm_small<pg8::GEO, pg8::EPI>(F.lds + RING_OFF, g.A, g.Bt, g.K, MP, NTM, g.N / (TN_), F.vcu, F.G, E); } while (0)
    if constexpr (PH == 1) {
        pg8::Gemm g{HB, (const pg8::bf16_t*)(ws + WS_WQKV), M, 3072, 1024}; pg8::StaticOrder S; S.init(MP, 3072, F.G, (int)blockIdx.x);
        FILL_RS(3072)
        pg8::EpiQKV E{SS, (const float*)(ws + WS_CS), QB, KB, VB, args.out, RSA, RSB};
        RUN_GEMM(EpiQKV, GeoS128, 8, 128);
    }
    if constexpr (PH == 2) {
        at::Ctx C{QB, KB, VB, OB, args.in[2], args.in[3], args.in[8], args.in[9], nullptr, nullptr, at::diff_lambda(args.in[8])};
        for (int vv = F.vcu; vv < 256; vv += F.G) {
            if (STREAM == 0) at::attn_sample_unit<false>(F.lds, vv >> 3, vv & 7, C);
            else { const int x = vv >> 5, c = vv & 31, u = c & 15;
                at::bf16x8 qr[4]; bool pre = false;
#pragma unroll 1
                for (int r = 0; r < 4; ++r) { const int bh = r * 16 + x * 2 + (c >> 4), ub = (r & 1) ? 15 - u : u; const bool hn = r < 3; const int r2 = r + 1, bh2 = r2 * 16 + x * 2 + (c >> 4), ub2 = (r2 & 1) ? 15 - u : u;
                    at::attn_prompt_unit<false>(F.lds, bh >> 3, bh & 7, ub, C, qr, pre, hn, bh2 >> 3, bh2 & 7, ub2); pre = hn; } }
        }
    }
    if constexpr (PH == 3 || PH == 8) {
        pg8::Gemm g{OB, (const pg8::bf16_t*)(ws + (PH == 3 ? WS_WAO : WS_WBO)), M, 1024, 1024}; pg8::StaticOrder S; S.init(MP, 1024, F.G, (int)blockIdx.x);
        pg8::EpiRes E{HB, SS, 1.f};
        RUN_GEMM(EpiRes, GeoS64, 16, 64);
    }
    if constexpr (PH == 4 || PH == 9) {
        pg8::Gemm g{HB, (const pg8::bf16_t*)(ws + WS_W1 + (PH == 9 ? 8 * MiB : 0)), M, FF, 1024}; pg8::StaticOrder S; S.init(MP, FF, F.G, (int)blockIdx.x);
        FILL_RS(FF)
        pg8::EpiFF1 E{SS, UB, FF, RSA, RSB};
        RUN_GEMM(EpiFF1, GeoS128, 8, 128);
    }
    if constexpr (PH == 5 || PH == 10) {
        pg8::Gemm g{UB, (const pg8::bf16_t*)(ws + WS_W2 + (PH == 10 ? 8 * MiB : 0)), M, 1024, FF}; pg8::StaticOrder S; S.init(MP, 1024, F.G, (int)blockIdx.x);
        pg8::EpiRes E{HB, SS, 1.f};
        RUN_GEMM(EpiRes, GeoS64, 16, 64);
    }
    if constexpr (PH == 6) {
        pg8::Gemm g{HB, (const pg8::bf16_t*)(ws + WS_WKVQ), M, 3072, 1024}; pg8::StaticOrder S; S.init(MP, 3072, F.G, (int)blockIdx.x);
        FILL_RS(3072)
        pg8::EpiKVQ E{SS, QB, KB, args.out, RSA, RSB};
        RUN_GEMM(EpiKVQ, GeoS128, 8, 128);
    }
    if constexpr (PH == 7) {
        at::Ctx C{QB, KB, VB, OB, args.in[4], args.in[5], nullptr, nullptr, args.in[14], nullptr, 0.f};
        for (int vv = F.vcu; vv < 256; vv += F.G) {
            if (STREAM == 0) at::attn_sample_unit<true>(F.lds, vv >> 3, vv & 7, C);
            else {
                at::bf16x8 qr[4]; bool pre = false;
#pragma unroll 1
                for (int i = 0; i < 4; ++i) { const int bhh = vv >> 1, par = vv & 1, qb = 4 * (i >> 1) + ((i & 1) ? 3 - par : par); const bool hn = i < 3; const int i2 = i + 1, qb2 = 4 * (i2 >> 1) + ((i2 & 1) ? 3 - par : par);
                    at::attn_prompt_unit<true>(F.lds, bhh >> 4, bhh & 15, qb, C, qr, pre, hn, bhh >> 4, bhh & 15, qb2); pre = hn; } }
        }
    }
    if constexpr (PH == 11) final_norm(F, args, STREAM == 0 ? MP : 0, STREAM == 0 ? M : MP);
#undef FILL_RS
#undef RUN_GEMM
}
__global__ void __launch_bounds__(NWAVES * 64, 2) skel_fwd(Args args) {
    extern __shared__ __attribute__((aligned(16))) unsigned char lds[];
    Frame F;
    F.lds = (LAS unsigned char*)lds;
    F.MISC = (volatile LAS unsigned*)(F.lds + MISC_OFF);
    F.tid = threadIdx.x; F.lane = F.tid & 63; F.wave = __builtin_amdgcn_readfirstlane(F.tid >> 6);
    F.G = gridDim.x; { const int bx = blockIdx.x; F.vcu = (F.G % 8 == 0) ? (bx % 8) * (F.G / 8) + bx / 8 : bx; }
    F.ctl = (gu32*)(args.ws + WS_CTL);
    for (int u = F.tid; u < (LDS_BYTES - LDSCTL_OFF) / 4; u += NWAVES * 64) ((LAS unsigned*)(F.lds + LDSCTL_OFF))[u] = 0u;
    __syncthreads();
    XcdBarrier bar = xcd_barrier_post((unsigned*)(F.ctl + CW_BAR), F.MISC + 8);
    SplitBar sbS{(unsigned*)(F.ctl + CW_BAR) + 4096, 0u}, sbP{(unsigned*)(F.ctl + CW_BAR) + 8192, 0u};
    p0_prologue(F, args);
    xcd_barrier(bar);
#define DO_PHASE(k, FIRST) do { if (!(FIRST)) sbar_wait(sbS, bar); run_part<k, 0>(F, args); sbar_arrive(sbS, bar); \
                                 if (!(FIRST)) sbar_wait(sbP, bar); run_part<k, 1>(F, args); sbar_arrive(sbP, bar); } while (0)
    DO_PHASE(1, true); DO_PHASE(2, false); DO_PHASE(3, false); DO_PHASE(4, false); DO_PHASE(5, false); DO_PHASE(6, false); DO_PHASE(7, false); DO_PHASE(8, false); DO_PHASE(9, false); DO_PHASE(10, false);
#undef DO_PHASE
    sbar_wait(sbS, bar); run_part<11, 0>(F, args);
    sbar_wait(sbP, bar); run_part<11, 1>(F, args);
}

extern "C" void kernel_launch(void* const* d_in, const int* in_sizes, int n_in, void* d_out, int out_size, void* d_ws, size_t ws_size, hipStream_t stream) {
    static int grid = 0;
    if (grid == 0) {
        if (n_in != 20 || out_size != (int)O_END || ws_size < WS_END) { fprintf(stderr, "kernel_launch: unexpected problem (n_in %d out %d ws %zu)\n", n_in, out_size, ws_size); grid = -1; return; }
        int dev = 0, cus = 0, per_cu = 0;
        if (hipGetDevice(&dev) != hipSuccess || hipDeviceGetAttribute(&cus, hipDeviceAttributeMultiprocessorCount, dev) != hipSuccess) { grid = -1; return; }
        if (hipFuncSetAttribute((const void*)skel_fwd, hipFuncAttributeMaxDynamicSharedMemorySize, LDS_BYTES) != hipSuccess) { fprintf(stderr, "kernel_launch: hipFuncSetAttribute failed\n"); grid = -1; return; }
        if (hipOccupancyMaxActiveBlocksPerMultiprocessor(&per_cu, (const void*)skel_fwd, NWAVES * 64, LDS_BYTES) != hipSuccess || per_cu < 1) { fprintf(stderr, "kernel_launch: occupancy query reports %d\n", per_cu); per_cu = 1; }
        (void)hipGetLastError();
        grid = cus;
        if (grid > 256) grid = 256;
    }
    if (grid < 0) return;
    (void)hipMemsetAsync((char*)d_ws + WS_CTL, 0, CTL_ZERO_BYTES, stream);
    Args a{};
    for (int i = 0; i < 20; ++i) a.in[i] = (const float*)d_in[i];
    a.out = (float*)d_out; a.ws = (unsigned char*)d_ws;
    hipLaunchKernelGGL(skel_fwd, dim3(grid), dim3(NWAVES * 64), LDS_BYTES, stream, a);
}
```

```cpp
#include <hip/hip_runtime.h>
#include <cstdio>
#include <cstdint>
#include <cmath>
namespace pg8 {
__device__ __forceinline__ int opaque_tid() { int t = threadIdx.x; asm volatile("" : "+v"(t)); return t; }
#define PG8_LAS __attribute__((address_space(3)))
typedef unsigned short bf16_t;
typedef short bf16x8 __attribute__((ext_vector_type(8)));
typedef float f32x4 __attribute__((ext_vector_type(4)));
typedef unsigned u32x4 __attribute__((ext_vector_type(4)));
constexpr int BM = 256, BK = 64, HALF = 128, HTB = HALF * BK * 2  , STAGE_BYTES = 8 * HTB, NXCD = 8, WGM = 8;

__host__ __device__ __forceinline__ int lds_byte(int r, int c) { const int st = (r >> 4) * 2 + (c >> 5), rr = r & 15, cc = c & 31, ob = rr * 64 + cc * 2; return st * 1024 + (ob ^ (((ob >> 9) & 1) << 5)); }
__host__ __device__ __forceinline__ void stage_rc(int b, int& R, int& C) { const int st = b / 1024, sb = b % 1024, swz = sb ^ (((sb >> 9) & 1) << 5); R = (st >> 1) * 16 + swz / 64; C = (st & 1) * 32 + (swz % 64) / 2; }
__host__ __device__ __forceinline__ int perm32(int rho) { const int n = rho >> 4, i = rho & 15; return 8 * (i >> 2) + 4 * n + (i & 3); }

struct Unit { int pm, pn; };
struct Gemm { const bf16_t* A; const bf16_t* Bt; int M, N, K; };

struct StaticOrder {
    int nM, nN, nwg, G, c;
    __host__ __device__ void init(int M, int N, int G_, int c_) { nM = M / BM; nN = N / BM; nwg = nM * nN; G = G_; c = c_; }
    __host__ __device__ bool next(int i, Unit& u) const {
        const long L = (long)i * G + c; if (L >= nwg) return false;
        int wgid = (int)L; { const int q = nwg / NXCD, r = nwg % NXCD, xcd = wgid % NXCD, off = wgid / NXCD; wgid = (xcd < r ? xcd * (q + 1) : r * (q + 1) + (xcd - r) * q) + off; }
        const int nig = WGM * nN, gid = wgid / nig, fm = gid * WGM, gsz = (nM - fm) < WGM ? (nM - fm) : WGM;
        u.pm = fm + ((wgid % nig) % gsz); u.pn = (wgid % nig) / gsz; return true;
    }
    __device__ __forceinline__ void a_ready(const Unit&) const {}
    __device__ __forceinline__ void done(const Unit&) const {}
};
__device__ __forceinline__ unsigned cvt_pk_bf16(float lo, float hi) { unsigned r; asm volatile("v_cvt_pk_bf16_f32 %0, %1, %2" : "=v"(r) : "v"(lo), "v"(hi)); return r; }
typedef float f32x2 __attribute__((ext_vector_type(2)));

constexpr size_t PO_AKP = 17825792, PO_AVP = 34603008, PO_BKP = 51380224, PO_BVP = 55574528, PO_AKS = 59768832, PO_AVS = 60817408, PO_BKS = 61865984, PO_BVS = 62914560;
constexpr size_t PW_KV = (size_t)36 * 1048576 / 2;
constexpr int P_MP = 16384;
constexpr float P_EPS = 1e-6f;
constexpr float P_C2 = 0.125f * 1.4426950408889634f;
typedef unsigned u32x2 __attribute__((ext_vector_type(2)));
struct GeoBig  { static constexpr int NAI = 2, NBJ = 2, NM = 4, NN = 2, RS_WR = 64, CS_WC = 32, WCN = 4; };
struct GeoS128 { static constexpr int NAI = 1, NBJ = 1, NM = 4, NN = 2, RS_WR = 64, CS_WC = 32, WCN = 4; };
struct GeoS64  { static constexpr int NAI = 1, NBJ = 1, NM = 1, NN = 2, RS_WR = 16, CS_WC = 32, WCN = 2; };
struct Tile { int row0, col0; };

template <class G>
__device__ __forceinline__ void row_rstd(const float* SS, int row0, int fq, float (&rs)[2][4]) {
#pragma unroll
    for (int ai = 0; ai < G::NAI; ++ai)
#pragma unroll
        for (int m = 0; m < G::NM; ++m) {
            const f32x4 v = *(const f32x4*)(SS + (size_t)(row0 + ai * HALF + m * 16) * 16 + 4 * fq);
            float s = (v[0] + v[1]) + (v[2] + v[3]);
            s += __shfl_xor(s, 16); s += __shfl_xor(s, 32);
            rs[ai][m] = 1.0f / sqrtf(s * (1.0f / 1024.0f) + P_EPS);
        }
}
struct RsTab { PG8_LAS const float* t; int row0, nrows; };
__device__ __forceinline__ void rs_fill(const float* SS, PG8_LAS float* t, int row0, int nrows) {
    const int r = threadIdx.x;
    if (r < nrows) {
        const f32x4* p = (const f32x4*)(SS + (size_t)(row0 + r) * 16);
        const f32x4 a = p[0], b = p[1], c = p[2], d = p[3];
        const float s = (((a[0] + a[1]) + (a[2] + a[3])) + ((b[0] + b[1]) + (b[2] + b[3]))) + (((c[0] + c[1]) + (c[2] + c[3])) + ((d[0] + d[1]) + (d[2] + d[3])));
        t[r] = 1.0f / sqrtf(s * (1.0f / 1024.0f) + P_EPS);
    }
}
template <class G>
__device__ __forceinline__ void row_rstd_tab(const RsTab& R, const float* SS, int tile_row0, int row0, int fq, float (&rs)[2][4]) {
    if (tile_row0 >= R.row0 && tile_row0 + (G::NAI == 2 ? 256 : 128) <= R.row0 + R.nrows) {
#pragma unroll
        for (int ai = 0; ai < G::NAI; ++ai)
#pragma unroll
            for (int m = 0; m < G::NM; ++m) rs[ai][m] = R.t[row0 - R.row0 + ai * HALF + m * 16];
    } else row_rstd<G>(SS, row0, fq, rs);
}

struct EpiQKV {
    static constexpr bool PERM = false, AFTER_DRAIN = false;
    const float* SS; const float* cs;
    bf16_t *Qb, *Kb, *Vb; float* out;
    RsTab rsA, rsB;
    __device__ __forceinline__ void operator()(const f32x4 (&acc)[2][2][4][2], const Unit& u, int wr, int wc, int fr, int fq) const { run<GeoBig>(acc, Tile{u.pm * BM, u.pn * BM}, wr, wc, fr, fq, nullptr); }
    template <class G> __device__ __forceinline__ void run(const f32x4 (&acc)[2][2][4][2], const Tile T, int wr, int wc, int fr, int fq, PG8_LAS float* scr) const {
        const int row0 = T.row0 + wr * G::RS_WR + fr;
        float rs[2][4]; row_rstd_tab<G>(G::NAI == 2 ? rsA : rsB, SS, T.row0, row0, fq, rs);
        const int sec = T.col0 >> 10, ct = T.col0 & 1023;
        const bool smp = T.row0 >= P_MP;
#pragma unroll
        for (int ai = 0; ai < G::NAI; ++ai)
#pragma unroll
            for (int m = 0; m < G::NM; ++m) {
                const int row = row0 + ai * HALF + m * 16; const float r = rs[ai][m];
                const int pos = smp ? (1024 + ((row - P_MP) & 31)) : (row & 2047);
                const size_t orow = smp ? (size_t)(row - P_MP) * 1024 : (size_t)row * 1024;
                if (sec < 2) {
                    const int dl = 16 * (wc & 1) + 4 * fq;
                    const f32x4 c4 = *(const f32x4*)(cs + (size_t)pos * 64 + dl), s4 = *(const f32x4*)(cs + (size_t)pos * 64 + 32 + dl);
#pragma unroll
                    for (int bj = 0; bj < G::NBJ; ++bj) {
                        const int col = ct + 128 * bj + 64 * (wc >> 1) + dl;
                        const f32x4 x1 = acc[ai][bj][m][0] * r, x2 = acc[ai][bj][m][1] * r;
                        f32x4 y1 = x1 * c4 - x2 * s4, y2 = x2 * c4 + x1 * s4;
                        if (sec == 0) {
                            y1 = y1 * P_C2; y2 = y2 * P_C2;
                            u32x2 w1, w2; w1.x = cvt_pk_bf16(y1[0], y1[1]); w1.y = cvt_pk_bf16(y1[2], y1[3]); w2.x = cvt_pk_bf16(y2[0], y2[1]); w2.y = cvt_pk_bf16(y2[2], y2[3]);
                            *(u32x2*)(Qb + (size_t)row * 1024 + col) = w1; *(u32x2*)(Qb + (size_t)row * 1024 + col + 32) = w2;
                        } else {
                            float* ok = out + (smp ? PO_AKS : PO_AKP) + orow + col;
                            __builtin_nontemporal_store(y1, (f32x4*)ok); __builtin_nontemporal_store(y2, (f32x4*)(ok + 32));
                            u32x2 w1, w2; w1.x = cvt_pk_bf16(y1[0], y1[1]); w1.y = cvt_pk_bf16(y1[2], y1[3]); w2.x = cvt_pk_bf16(y2[0], y2[1]); w2.y = cvt_pk_bf16(y2[2], y2[3]);
                            *(u32x2*)(Kb + (size_t)row * 1024 + col) = w1; *(u32x2*)(Kb + (size_t)row * 1024 + col + 32) = w2;
                        }
                    }
                } else {
#pragma unroll
                    for (int bj = 0; bj < G::NBJ; ++bj)
#pragma unroll
                        for (int n = 0; n < G::NN; ++n) {
                            const int col = ct + 128 * bj + G::CS_WC * wc + 16 * n + 4 * fq;
                            const f32x4 v = acc[ai][bj][m][n] * r;
                            __builtin_nontemporal_store(v, (f32x4*)(out + (smp ? PO_AVS : PO_AVP) + orow + col));
                            u32x2 w; w.x = cvt_pk_bf16(v[0], v[1]); w.y = cvt_pk_bf16(v[2], v[3]);
                            *(u32x2*)(Vb + (size_t)row * 1024 + col) = w;
                        }
                }
            }
    }
};

struct EpiKVQ {
    static constexpr bool PERM = true, AFTER_DRAIN = false;
    const float* SS; bf16_t *Qb, *Kb; float* out;
    RsTab rsA, rsB;
    __device__ __forceinline__ void operator()(const f32x4 (&acc)[2][2][4][2], const Unit& u, int wr, int wc, int fr, int fq) const { run<GeoBig>(acc, Tile{u.pm * BM, u.pn * BM}, wr, wc, fr, fq, nullptr); }
    template <class G> __device__ __forceinline__ void run(const f32x4 (&acc)[2][2][4][2], const Tile T, int wr, int wc, int fr, int fq, PG8_LAS float* scr) const {
        const int row0 = T.row0 + wr * G::RS_WR + fr;
        float rs[2][4]; row_rstd_tab<G>(G::NAI == 2 ? rsA : rsB, SS, T.row0, row0, fq, rs);
        const int sec = T.col0 >> 10, ct = T.col0 & 1023;
        const bool smp = T.row0 >= P_MP;
        const bool keep = smp || (((T.row0 >> 8) & 7) >= 6);
        const int col0 = ct + wc * 32 + 8 * fq;
#pragma unroll
        for (int ai = 0; ai < G::NAI; ++ai)
#pragma unroll
            for (int m = 0; m < G::NM; ++m) {
                const int row = row0 + ai * HALF + m * 16; const float r = rs[ai][m];
                const size_t orow = smp ? (size_t)(row - P_MP) * 1024 : ((size_t)(row >> 11) * 512 + (size_t)((row & 2047) - 1536)) * 1024;
#pragma unroll
                for (int bj = 0; bj < G::NBJ; ++bj) {
                    const int col = col0 + bj * HALF;
                    f32x4 v0 = acc[ai][bj][m][0] * r, v1 = acc[ai][bj][m][1] * r;
                    if (sec == 2) {
                        v0 = v0 * P_C2; v1 = v1 * P_C2;
                        u32x4 w; w.x = cvt_pk_bf16(v0[0], v0[1]); w.y = cvt_pk_bf16(v0[2], v0[3]); w.z = cvt_pk_bf16(v1[0], v1[1]); w.w = cvt_pk_bf16(v1[2], v1[3]);
                        *(u32x4*)(Qb + (size_t)row * 1024 + col) = w;
                    } else {
                        if (keep) { float* op = out + (sec == 0 ? (smp ? PO_BKS : PO_BKP) : (smp ? PO_BVS : PO_BVP)) + orow + col; __builtin_nontemporal_store(v0, (f32x4*)op); __builtin_nontemporal_store(v1, (f32x4*)(op + 4)); }
                        u32x4 w; w.x = cvt_pk_bf16(v0[0], v0[1]); w.y = cvt_pk_bf16(v0[2], v0[3]); w.z = cvt_pk_bf16(v1[0], v1[1]); w.w = cvt_pk_bf16(v1[2], v1[3]);
                        *(u32x4*)(Kb + (sec == 0 ? (size_t)0 : PW_KV) + (size_t)row * 1024 + col) = w;
                    }
                }
            }
    }
};

struct EpiRes {
    static constexpr bool PERM = true, AFTER_DRAIN = false;
    bf16_t* Hb; float* SS; float sc;
    __device__ __forceinline__ void operator()(const f32x4 (&acc)[2][2][4][2], const Unit& u, int wr, int wc, int fr, int fq) const { run<GeoBig>(acc, Tile{u.pm * BM, u.pn * BM}, wr, wc, fr, fq, nullptr); }
    template <class G> __device__ __forceinline__ void run(const f32x4 (&acc)[2][2][4][2], const Tile T, int wr, int wc, int fr, int fq, PG8_LAS float* scr) const {
        const int row0 = T.row0 + wr * G::RS_WR + fr, col0 = T.col0 + wc * 32 + 8 * fq;
#pragma unroll
        for (int ai = 0; ai < G::NAI; ++ai)
#pragma unroll
            for (int m = 0; m < G::NM; ++m) {
                const int row = row0 + ai * HALF + m * 16;
                float ssq = 0.f;
#pragma unroll
                for (int bj = 0; bj < G::NBJ; ++bj) {
                    bf16_t* p = Hb + (size_t)row * 1024 + col0 + bj * HALF;
                    const u32x4 o = *(const u32x4*)p;
                    f32x4 h0 = acc[ai][bj][m][0] * sc, h1 = acc[ai][bj][m][1] * sc;
                    h0[0] += __uint_as_float(o.x << 16); h0[1] += __uint_as_float(o.x & 0xffff0000u); h0[2] += __uint_as_float(o.y << 16); h0[3] += __uint_as_float(o.y & 0xffff0000u);
                    h1[0] += __uint_as_float(o.z << 16); h1[1] += __uint_as_float(o.z & 0xffff0000u); h1[2] += __uint_as_float(o.w << 16); h1[3] += __uint_as_float(o.w & 0xffff0000u);
                    u32x4 w; w.x = cvt_pk_bf16(h0[0], h0[1]); w.y = cvt_pk_bf16(h0[2], h0[3]); w.z = cvt_pk_bf16(h1[0], h1[1]); w.w = cvt_pk_bf16(h1[2], h1[3]);
                    *(u32x4*)p = w;
                    ssq += ((h0[0] * h0[0] + h0[1] * h0[1]) + (h0[2] * h0[2] + h0[3] * h0[3])) + ((h1[0] * h1[0] + h1[1] * h1[1]) + (h1[2] * h1[2] + h1[3] * h1[3]));
                }
                ssq += __shfl_xor(ssq, 16); ssq += __shfl_xor(ssq, 32);
                if (G::WCN == 4) { if (fq == 0) SS[(size_t)row * 16 + (T.col0 >> 8) * 4 + wc] = ssq; }
                else { if (fq == 0) scr[(wr * G::RS_WR + m * 16 + fr) * 2 + wc] = ssq; }
            }
        if (G::WCN != 4) {
            __syncthreads();
            const int t_ = threadIdx.x;
            if (t_ < 64) SS[(size_t)(T.row0 + t_) * 16 + (T.col0 >> 6)] = scr[t_ * 2] + scr[t_ * 2 + 1];
            __syncthreads();
        }
    }
};

struct EpiResFinal {
    static constexpr bool PERM = true, AFTER_DRAIN = true;
    const bf16_t* Hb; float* SS; float* out; const float* gf; unsigned* cnt; unsigned* tmo;
    __device__ __forceinline__ void fused(f32x4 (&acc)[2][2][4][2], const Unit& u, int wr, int wc, int fr, int fq, PG8_LAS unsigned char* lds, int wid, int lane) const { run<GeoBig>(acc, Tile{u.pm * BM, u.pn * BM}, wr, wc, fr, fq, (PG8_LAS float*)lds); }
    template <class G> __device__ __forceinline__ void run(f32x4 (&acc)[2][2][4][2], const Tile T, int wr, int wc, int fr, int fq, PG8_LAS float* scr) const {
        const int row0 = T.row0 + wr * G::RS_WR + fr, col0 = T.col0 + wc * 32 + 8 * fq;
        const int tid = threadIdx.x, lane = tid & 63, wid = __builtin_amdgcn_readfirstlane(tid >> 6);
#pragma unroll
        for (int ai = 0; ai < G::NAI; ++ai)
#pragma unroll
            for (int m = 0; m < G::NM; ++m) {
                const int row = row0 + ai * HALF + m * 16;
                float ssq = 0.f;
#pragma unroll
                for (int bj = 0; bj < G::NBJ; ++bj) {
                    const u32x4 o = *(const u32x4*)(Hb + (size_t)row * 1024 + col0 + bj * HALF);
                    f32x4 h0 = acc[ai][bj][m][0], h1 = acc[ai][bj][m][1];
                    h0[0] += __uint_as_float(o.x << 16); h0[1] += __uint_as_float(o.x & 0xffff0000u); h0[2] += __uint_as_float(o.y << 16); h0[3] += __uint_as_float(o.y & 0xffff0000u);
                    h1[0] += __uint_as_float(o.z << 16); h1[1] += __uint_as_float(o.z & 0xffff0000u); h1[2] += __uint_as_float(o.w << 16); h1[3] += __uint_as_float(o.w & 0xffff0000u);
                    acc[ai][bj][m][0] = h0; acc[ai][bj][m][1] = h1;
                    ssq += ((h0[0] * h0[0] + h0[1] * h0[1]) + (h0[2] * h0[2] + h0[3] * h0[3])) + ((h1[0] * h1[0] + h1[1] * h1[1]) + (h1[2] * h1[2] + h1[3] * h1[3]));
                }
                ssq += __shfl_xor(ssq, 16); ssq += __shfl_xor(ssq, 32);
                if (G::WCN == 4) { if (fq == 0) __hip_atomic_store(SS + (size_t)row * 16 + (T.col0 >> 8) * 4 + wc, ssq, __ATOMIC_RELAXED, __HIP_MEMORY_SCOPE_AGENT); }
                else { if (fq == 0) scr[(wr * G::RS_WR + m * 16 + fr) * 2 + wc] = ssq; }
            }
        unsigned* c; unsigned want;
        if (G::WCN == 4) {
            c = cnt + 64 * (T.row0 >> 8); want = 32u;
            asm volatile("s_waitcnt vmcnt(0)" ::: "memory");
            if (lane == 0) __hip_atomic_fetch_add(c, 1u, __ATOMIC_RELAXED, __HIP_MEMORY_SCOPE_AGENT);
        } else {
            c = cnt + 64 * (64 + ((T.row0 - P_MP) >> 6)); want = 16u;
            __syncthreads();
            if (tid < 64) __hip_atomic_store(SS + (size_t)(T.row0 + tid) * 16 + (T.col0 >> 6), scr[tid * 2] + scr[tid * 2 + 1], __ATOMIC_RELAXED, __HIP_MEMORY_SCOPE_AGENT);
            asm volatile("s_waitcnt vmcnt(0)" ::: "memory");
            if (tid == 0) __hip_atomic_fetch_add(c, 1u, __ATOMIC_RELAXED, __HIP_MEMORY_SCOPE_AGENT);
        }
        if (wid == 0) {
            const unsigned long long t0 = __builtin_amdgcn_s_memrealtime();
            for (;;) {
                if ((unsigned)__builtin_amdgcn_readfirstlane((int)__hip_atomic_load(c, __ATOMIC_RELAXED, __HIP_MEMORY_SCOPE_AGENT)) >= want) break;
                if (__builtin_amdgcn_s_memrealtime() - t0 > 2000000ull) { if (lane == 0) __hip_atomic_store(tmo, 1u, __ATOMIC_RELAXED, __HIP_MEMORY_SCOPE_AGENT); break; }
                __builtin_amdgcn_s_sleep(2);
            }
            __builtin_amdgcn_fence(__ATOMIC_ACQUIRE, "agent");
            asm volatile("s_waitcnt vmcnt(0)" ::: "memory");
        }
        __syncthreads();
        f32x4 gv[2][2];
#pragma unroll
        for (int bj = 0; bj < G::NBJ; ++bj) { gv[bj][0] = *(const f32x4*)(gf + col0 + bj * HALF); gv[bj][1] = *(const f32x4*)(gf + col0 + bj * HALF + 4); }
#pragma unroll
        for (int ai = 0; ai < G::NAI; ++ai)
#pragma unroll
            for (int m = 0; m < G::NM; ++m) {
                const int row = row0 + ai * HALF + m * 16;
                const f32x4 v = *(const f32x4*)(SS + (size_t)row * 16 + 4 * fq);
                float s = (v[0] + v[1]) + (v[2] + v[3]);
                s += __shfl_xor(s, 16); s += __shfl_xor(s, 32);
                const float r = 1.0f / sqrtf(s * (1.0f / 1024.0f) + P_EPS);
#pragma unroll
                for (int bj = 0; bj < G::NBJ; ++bj) { float* op = out + (size_t)row * 1024 + col0 + bj * HALF;
                    *(f32x4*)op = acc[ai][bj][m][0] * gv[bj][0] * r; *(f32x4*)(op + 4) = acc[ai][bj][m][1] * gv[bj][1] * r; }
            }
        if (G::WCN != 4) __syncthreads();
    }
};

struct EpiFF1 {
    static constexpr bool PERM = true, AFTER_DRAIN = false;
    const float* SS; bf16_t* U; int ldc;
    RsTab rsA, rsB;
    __device__ __forceinline__ void operator()(const f32x4 (&acc)[2][2][4][2], const Unit& u, int wr, int wc, int fr, int fq) const { run<GeoBig>(acc, Tile{u.pm * BM, u.pn * BM}, wr, wc, fr, fq, nullptr); }
    template <class G> __device__ __forceinline__ void run(const f32x4 (&acc)[2][2][4][2], const Tile T, int wr, int wc, int fr, int fq, PG8_LAS float* scr) const {
        const int row0 = T.row0 + wr * G::RS_WR + fr;
        float rs[2][4]; row_rstd_tab<G>(G::NAI == 2 ? rsA : rsB, SS, T.row0, row0, fq, rs);
        const int col0 = T.col0 + wc * 32 + 8 * fq;
#pragma unroll
        for (int ai = 0; ai < G::NAI; ++ai)
#pragma unroll
            for (int m = 0; m < G::NM; ++m) {
                const float r = rs[ai][m]; bf16_t* rowp = U + (size_t)(row0 + ai * HALF + m * 16) * ldc + col0;
#pragma unroll
                for (int bj = 0; bj < G::NBJ; ++bj) {
                    f32x4 v0 = acc[ai][bj][m][0] * r, v1 = acc[ai][bj][m][1] * r;
#pragma unroll
                    for (int i = 0; i < 4; ++i) { const float a = fmaxf(v0[i], 0.f), b = fmaxf(v1[i], 0.f); v0[i] = a * a; v1[i] = b * b; }
                    u32x4 w; w.x = cvt_pk_bf16(v0[0], v0[1]); w.y = cvt_pk_bf16(v0[2], v0[3]); w.z = cvt_pk_bf16(v1[0], v1[1]); w.w = cvt_pk_bf16(v1[2], v1[3]);
                    *(u32x4*)(rowp + bj * HALF) = w;
                }
            }
    }
};
template <class Epi, class Sched, bool ALIGN_EPI = false, bool SP2 = false>
__device__ __forceinline__ void gemm_phase(PG8_LAS unsigned char* lds, const Gemm g, const Sched& S, const Epi& E) {
    const int tid = opaque_tid(), wid = __builtin_amdgcn_readfirstlane(tid >> 6), lane = tid & 63, wr = wid >> 2, wc = wid & 3, fr = lane & 15, fq = lane >> 4;
    const int K = g.K, nt = K / BK;
    unsigned voffA[2], voffB[2];
#pragma unroll
    for (int i = 0; i < 2; ++i) { int R, C; stage_rc(tid * 16 + i * 8192, R, C); const int Rb = Epi::PERM ? ((R & ~31) + perm32(R & 31)) : R;
        voffA[i] = (unsigned)(R * K + C) * 2u; voffB[i] = (unsigned)(Rb * K + C) * 2u; }
    const size_t kstep = (size_t)(BK * 2);
    const size_t hstep = (size_t)HALF * K * 2;
    const size_t tstep = 2 * hstep;
    const unsigned ldsw = (unsigned)wid * 1024u;
    const int aoff = lds_byte(wr * 64 + fr, fq * 8), boff = lds_byte(wc * 32 + fr, fq * 8);
#define PG8_SA(b, h) (((b) * 2 + (h)) * HTB)
#define PG8_SB(b, h) ((4 + (b) * 2 + (h)) * HTB)
#define PG8_STAGE(bufoff, gbase, voff) do { _Pragma("unroll") for (int _i = 0; _i < 2; ++_i) \
        __builtin_amdgcn_global_load_lds((const unsigned*)((const char*)(gbase) + (voff)[_i]), (PG8_LAS unsigned*)(lds + (bufoff) + ldsw + _i * 8192), 16, 0, 0); } while (0)
#define PG8_LDA(dst, b, h) do { _Pragma("unroll") for (int m = 0; m < 4; ++m) _Pragma("unroll") for (int k = 0; k < 2; ++k) dst[m][k] = *(const PG8_LAS bf16x8*)(lds + PG8_SA(b, h) + aoff + m * 2048 + k * 1024); } while (0)
#define PG8_LDB(dst, b, h) do { _Pragma("unroll") for (int n = 0; n < 2; ++n) _Pragma("unroll") for (int k = 0; k < 2; ++k) dst[n][k] = *(const PG8_LAS bf16x8*)(lds + PG8_SB(b, h) + boff + n * 2048 + k * 1024); } while (0)
#define PG8_MMA(ai, bj, At, Bt) do { __builtin_amdgcn_s_setprio(1); _Pragma("unroll") for (int m = 0; m < 4; ++m) _Pragma("unroll") for (int n = 0; n < 2; ++n) _Pragma("unroll") for (int k = 0; k < 2; ++k) \
        acc[ai][bj][m][n] = __builtin_amdgcn_mfma_f32_16x16x32_bf16(Bt[n][k], At[m][k], acc[ai][bj][m][n], 0, 0, 0); __builtin_amdgcn_s_setprio(0); } while (0)
#define PG8_WAIT_V(n) asm volatile("s_waitcnt vmcnt(" #n ")" ::: "memory")
#define PG8_WAIT_L(n) asm volatile("s_waitcnt lgkmcnt(" #n ")" ::: "memory")
#define PG8_BAR __builtin_amdgcn_s_barrier()
#define PG8_SCHED __builtin_amdgcn_sched_barrier(0)
    Unit cur, nxt; int ui = 0;
    if (!S.next(0, cur)) return;
    f32x4 acc[2][2][4][2];
#pragma unroll
    for (int a = 0; a < 2; ++a)
#pragma unroll
        for (int b = 0; b < 2; ++b)
#pragma unroll
            for (int m = 0; m < 4; ++m)
#pragma unroll
                for (int n = 0; n < 2; ++n) acc[a][b][m][n] = (f32x4){0.f, 0.f, 0.f, 0.f};
    bf16x8 At[4][2], B0[2][2], B1[2][2];
    const char* cA = (const char*)g.A + (size_t)cur.pm * tstep; const char* cB = (const char*)g.Bt + (size_t)cur.pn * tstep;
    S.a_ready(cur);
    if constexpr (SP2) {
        PG8_STAGE(PG8_SB(0, 0), cB, voffB); PG8_STAGE(PG8_SB(0, 1), cB + hstep, voffB); PG8_STAGE(PG8_SA(0, 0), cA, voffA); PG8_STAGE(PG8_SA(0, 1), cA + hstep, voffA);
        if (wr == 1) PG8_BAR;
        PG8_WAIT_V(2); PG8_BAR;
        PG8_STAGE(PG8_SB(1, 0), cB + kstep, voffB); PG8_STAGE(PG8_SA(1, 0), cA + kstep, voffA); PG8_STAGE(PG8_SB(1, 1), cB + hstep + kstep, voffB);
        PG8_WAIT_V(6); PG8_BAR;
    } else {
        PG8_STAGE(PG8_SB(0, 0), cB, voffB); PG8_STAGE(PG8_SA(0, 0), cA, voffA); PG8_STAGE(PG8_SB(0, 1), cB + hstep, voffB); PG8_STAGE(PG8_SA(0, 1), cA + hstep, voffA);
        if (wr == 1) PG8_BAR;
        PG8_WAIT_V(4); PG8_BAR;
        PG8_STAGE(PG8_SB(1, 0), cB + kstep, voffB); PG8_STAGE(PG8_SA(1, 0), cA + kstep, voffA); PG8_STAGE(PG8_SB(1, 1), cB + hstep + kstep, voffB);
        PG8_WAIT_V(6); PG8_BAR;
    }
    for (;;) {
        const bool has_next = S.next(ui + 1, nxt);
        const char* nA = has_next ? (const char*)g.A + (size_t)nxt.pm * tstep : cA; const char* nB = has_next ? (const char*)g.Bt + (size_t)nxt.pn * tstep : cB;
        for (int t = 0; t < nt; t += 2) {
            const bool last = (t == nt - 2);
            const char* a1 = cA + (size_t)(t + 1) * kstep;
            const char* a2 = last ? nA : cA + (size_t)(t + 2) * kstep; const char* b2 = last ? nB : cB + (size_t)(t + 2) * kstep;
            const char* a3 = a2 + kstep; const char* b3 = b2 + kstep;
            if (last && has_next) S.a_ready(nxt);
            if constexpr (SP2) {
            PG8_LDB(B0, 0, 0); PG8_LDB(B1, 0, 1); PG8_SCHED; PG8_LDA(At, 0, 0); PG8_STAGE(PG8_SA(1, 1), a1 + hstep, voffA);
            PG8_WAIT_V(8); PG8_WAIT_L(0); PG8_BAR; PG8_MMA(0, 0, At, B0); PG8_MMA(0, 1, At, B1); PG8_BAR; PG8_SCHED;
            PG8_LDA(At, 0, 1); PG8_STAGE(PG8_SB(0, 0), b2, voffB); PG8_STAGE(PG8_SB(0, 1), b2 + hstep, voffB); PG8_STAGE(PG8_SA(0, 0), a2, voffA);
            PG8_WAIT_V(8); PG8_WAIT_L(0); PG8_BAR; PG8_MMA(1, 0, At, B0); PG8_MMA(1, 1, At, B1); PG8_BAR; PG8_SCHED;
            PG8_LDB(B0, 1, 0); PG8_LDB(B1, 1, 1); PG8_SCHED; PG8_LDA(At, 1, 0); PG8_STAGE(PG8_SA(0, 1), a2 + hstep, voffA);
            PG8_WAIT_V(8); PG8_WAIT_L(0); PG8_BAR; PG8_MMA(0, 0, At, B0); PG8_MMA(0, 1, At, B1); PG8_BAR; PG8_SCHED;
            PG8_LDA(At, 1, 1); PG8_STAGE(PG8_SB(1, 0), b3, voffB); PG8_STAGE(PG8_SB(1, 1), b3 + hstep, voffB); PG8_STAGE(PG8_SA(1, 0), a3, voffA);
            PG8_WAIT_V(8); PG8_WAIT_L(0); PG8_BAR; PG8_MMA(1, 0, At, B0); PG8_MMA(1, 1, At, B1); PG8_BAR; PG8_SCHED;
            } else {
            PG8_LDB(B0, 0, 0); PG8_SCHED; PG8_LDA(At, 0, 0); PG8_STAGE(PG8_SA(1, 1), a1 + hstep, voffA);
            PG8_WAIT_L(8); PG8_BAR; PG8_WAIT_L(0); PG8_MMA(0, 0, At, B0); PG8_BAR; PG8_SCHED;
            PG8_LDB(B1, 0, 1); PG8_STAGE(PG8_SB(0, 0), b2, voffB);
            PG8_BAR; PG8_WAIT_L(0); PG8_MMA(0, 1, At, B1); PG8_BAR;
            PG8_LDA(At, 0, 1); PG8_STAGE(PG8_SA(0, 0), a2, voffA);
            PG8_BAR; PG8_WAIT_L(0); PG8_MMA(1, 0, At, B0); PG8_BAR; PG8_SCHED;
            PG8_STAGE(PG8_SB(0, 1), b2 + hstep, voffB);
            PG8_WAIT_V(6); PG8_BAR; PG8_MMA(1, 1, At, B1); PG8_BAR;
            PG8_LDB(B0, 1, 0); PG8_SCHED; PG8_LDA(At, 1, 0); PG8_STAGE(PG8_SA(0, 1), a2 + hstep, voffA);
            PG8_WAIT_L(8); PG8_BAR; PG8_WAIT_L(0); PG8_MMA(0, 0, At, B0); PG8_BAR; PG8_SCHED;
            PG8_LDB(B1, 1, 1); PG8_STAGE(PG8_SB(1, 0), b3, voffB);
            PG8_BAR; PG8_WAIT_L(0); PG8_MMA(0, 1, At, B1); PG8_BAR;
            PG8_LDA(At, 1, 1); PG8_STAGE(PG8_SA(1, 0), a3, voffA);
            PG8_BAR; PG8_WAIT_L(0); PG8_MMA(1, 0, At, B0); PG8_BAR; PG8_SCHED;
            PG8_STAGE(PG8_SB(1, 1), b3 + hstep, voffB);
            PG8_WAIT_V(6); PG8_BAR; PG8_MMA(1, 1, At, B1); PG8_BAR;
            }
        }
        if constexpr (ALIGN_EPI) { if (wr == 0) PG8_BAR; }
        if constexpr (!Epi::AFTER_DRAIN) { E(acc, cur, wr, wc, fr, fq); S.done(cur); }
        if (!has_next) break;
#pragma unroll
        for (int a = 0; a < 2; ++a)
#pragma unroll
            for (int b = 0; b < 2; ++b)
#pragma unroll
                for (int m = 0; m < 4; ++m)
#pragma unroll
                    for (int n = 0; n < 2; ++n) acc[a][b][m][n] = (f32x4){0.f, 0.f, 0.f, 0.f};
        cur = nxt; cA = nA; cB = nB; ++ui;
        if constexpr (ALIGN_EPI) { if (wr == 1) PG8_BAR; }
    }
    PG8_WAIT_V(0);
    if constexpr (!ALIGN_EPI) { if (wr == 0) PG8_BAR; }
    PG8_BAR;
    if constexpr (Epi::AFTER_DRAIN) { E.fused(acc, cur, wr, wc, fr, fq, lds, wid, lane); S.done(cur); }
#undef PG8_SA
#undef PG8_SB
#undef PG8_STAGE
#undef PG8_LDA
#undef PG8_LDB
#undef PG8_MMA
#undef PG8_WAIT_V
#undef PG8_WAIT_L
#undef PG8_BAR
#undef PG8_SCHED
}

template <class G, class Epi>
__device__ __forceinline__ void gemm_small(PG8_LAS unsigned char* lds, const bf16_t* A, const bf16_t* Bt, int K, int row_base, int ntm, int ntn, int vcu, int nwg, const Epi& E) {
    constexpr int TM = (8 / G::WCN) * G::RS_WR * (G::NM * 16 / G::RS_WR), TN = G::WCN * G::CS_WC, SBK = 64, STG = (TM + TN) * 128, NPA = TM / 64, NPB = TN / 64, NP = NPA + NPB;
    static_assert(NP == 4 || NP == 2, "gemm_small: 128 x 128 or 64 x 64 tiles");
    const int tid = opaque_tid(), wid = __builtin_amdgcn_readfirstlane(tid >> 6), lane = tid & 63, wr = wid / G::WCN, wc = wid % G::WCN, fr = lane & 15, fq = lane >> 4;
    const int nk = K / SBK;
    for (int tile = vcu; tile < ntm * ntn; tile += nwg) {
        const int tm = tile % ntm, tn = tile / ntm;
        const bf16_t* Ab = A + (size_t)(row_base + tm * TM) * K; const bf16_t* Bb = Bt + (size_t)(tn * TN) * K;
        f32x4 acc[2][2][4][2];
#pragma unroll
        for (int m = 0; m < G::NM; ++m)
#pragma unroll
            for (int n = 0; n < G::NN; ++n) acc[0][0][m][n] = (f32x4){0.f, 0.f, 0.f, 0.f};
        unsigned goff[NP];
#pragma unroll
        for (int i = 0; i < NP; ++i) { const bool isB = i >= NPA; const int p = wid + 8 * (isB ? i - NPA : i), R = 8 * p + (lane >> 3), c = (lane & 7) ^ ((R >> 1) & 7);
            const int Rs = (isB && Epi::PERM) ? ((R & ~31) + perm32(R & 31)) : R; goff[i] = (unsigned)Rs * K + c * 8; }
#define SM_DMA(stage, kt_) do { _Pragma("unroll") for (int i = 0; i < NP; ++i) { const bool isB = i >= NPA; const int p = wid + 8 * (isB ? i - NPA : i); \
            __builtin_amdgcn_global_load_lds((const unsigned*)((isB ? Bb : Ab) + goff[i] + (size_t)(kt_) * SBK), (PG8_LAS unsigned*)(lds + (stage) * STG + (isB ? TM * 128 : 0) + p * 1024), 16, 0, 0); } } while (0)
#define SM_WAIT(n) asm volatile("s_waitcnt vmcnt(" #n ")" ::: "memory")
#define SM_MMA(stage) do { PG8_LAS unsigned char* sb = lds + (stage) * STG; \
            _Pragma("unroll") for (int kh = 0; kh < 2; ++kh) { bf16x8 af[G::NM], bfr[G::NN]; \
                _Pragma("unroll") for (int m = 0; m < G::NM; ++m) { const int R = wr * G::RS_WR + m * 16 + fr; af[m] = *(const PG8_LAS bf16x8*)(sb + R * 128 + (((kh * 4 + fq) ^ ((R >> 1) & 7)) * 16)); } \
                _Pragma("unroll") for (int n = 0; n < G::NN; ++n) { const int R = wc * G::CS_WC + n * 16 + fr; bfr[n] = *(const PG8_LAS bf16x8*)(sb + TM * 128 + R * 128 + (((kh * 4 + fq) ^ ((R >> 1) & 7)) * 16)); } \
                _Pragma("unroll") for (int m = 0; m < G::NM; ++m) _Pragma("unroll") for (int n = 0; n < G::NN; ++n) acc[0][0][m][n] = __builtin_amdgcn_mfma_f32_16x16x32_bf16(bfr[n], af[m], acc[0][0][m][n], 0, 0, 0); } } while (0)
#define SM_STEP(s, kt_) do { if ((kt_) + 2 < nk) { if (NP == 4) SM_WAIT(8); else SM_WAIT(4); } else if ((kt_) + 1 < nk) { if (NP == 4) SM_WAIT(4); else SM_WAIT(2); } else SM_WAIT(0); \
            asm volatile("s_waitcnt lgkmcnt(0)" ::: "memory"); __builtin_amdgcn_s_barrier(); asm volatile("" ::: "memory"); \
            if ((kt_) + 3 < nk) SM_DMA(((s) + 3) & 3, (kt_) + 3); \
            SM_MMA(s); } while (0)
        SM_DMA(0, 0); SM_DMA(1, 1); SM_DMA(2, 2);
        for (int kt = 0; kt < nk; kt += 4) { SM_STEP(0, kt); SM_STEP(1, kt + 1); SM_STEP(2, kt + 2); SM_STEP(3, kt + 3); }
#undef SM_DMA
#undef SM_WAIT
#undef SM_MMA
#undef SM_STEP
        asm volatile("s_waitcnt lgkmcnt(0)" ::: "memory"); __builtin_amdgcn_s_barrier(); asm volatile("" ::: "memory");
        E.template run<G>(acc, Tile{row_base + tm * TM, tn * TN}, wr, wc, fr, fq, (PG8_LAS float*)(lds + 4 * STG));
    }
}
}
#define GAS __attribute__((address_space(1)))
#define LAS __attribute__((address_space(3)))
typedef unsigned short bf16;
typedef unsigned v4u __attribute__((ext_vector_type(4)));
typedef float f32x4 __attribute__((ext_vector_type(4)));
typedef short bf16x8 __attribute__((ext_vector_type(8)));
typedef GAS unsigned gu32;
typedef GAS unsigned long long gu64;
#define RLX_AGENT __ATOMIC_RELAXED, __HIP_MEMORY_SCOPE_AGENT
#define LDS_WAIT() asm volatile("s_waitcnt lgkmcnt(0)" ::: "memory")
#define VM_WAIT() asm volatile("s_waitcnt vmcnt(0)" ::: "memory")
__device__ __forceinline__ unsigned long long rt() { return __builtin_amdgcn_s_memrealtime(); }
__device__ __forceinline__ unsigned f2bf(float f) { unsigned u = __builtin_bit_cast(unsigned, f); return (u + 0x7fffu + ((u >> 16) & 1u)) >> 16; }
__device__ __forceinline__ unsigned pk2(float lo, float hi) { return f2bf(lo) | (f2bf(hi) << 16); }

#define XB_TMO      128
#define XB_XCNT(j)  (256  + 64 * (j))
#define XB_XSUB(j)  (1280 + 64 * (j))
#define XB_XGEN(j)  (2304 + 64 * (j))
#define XB_TOP      3328
#define XB_TOPGEN   3392
#define XCD_BAR_WORDS 3456
#define XB_SPIN_CAP (1u << 18)

__device__ __forceinline__ unsigned xb_ld(unsigned* p)              { return __hip_atomic_load(p, __ATOMIC_RELAXED, __HIP_MEMORY_SCOPE_AGENT); }
__device__ __forceinline__ unsigned xb_add(unsigned* p, unsigned v) { return __hip_atomic_fetch_add(p, v, __ATOMIC_RELAXED, __HIP_MEMORY_SCOPE_AGENT); }
__device__ __forceinline__ unsigned xb_xcc_id() { return (unsigned)__builtin_amdgcn_s_getreg((3 << 11) | 20) & 0xFu; }
#define XB_SPIN(cond, bar) do { unsigned _sp = 0; while (cond) { __builtin_amdgcn_s_sleep(1); \
    if ((++_sp & 255u) == 0u) { if (xb_ld(&(bar)[XB_TMO])) break; if (_sp > XB_SPIN_CAP) { atomicAdd(&(bar)[XB_TMO], 1u); break; } } } } while (0)

struct XcdBarrier {
    unsigned* bar; unsigned x;
    volatile LAS unsigned* st;
};

__device__ __forceinline__ XcdBarrier xcd_barrier_post(unsigned* bar, volatile LAS unsigned* st) {
    XcdBarrier b; b.bar = bar; b.x = xb_xcc_id(); b.st = st;
    if (threadIdx.x == 0) (void)xb_add(&bar[XB_XCNT(b.x)], 1u);
    return b;
}
__device__ __forceinline__ void xcd_barrier_complete(unsigned* bar, unsigned x, unsigned& nloc, unsigned& nx) {
    const unsigned G = gridDim.x * gridDim.y * gridDim.z;
    unsigned sum, cnt, mine, sp = 0u;
    for (;;) {
        sum = 0u; cnt = 0u; mine = 0u;
#pragma unroll
        for (unsigned j = 0; j < 16; ++j) { const unsigned c = xb_ld(&bar[XB_XCNT(j)]); sum += c; cnt += (c > 0u) ? 1u : 0u; mine = (j == x) ? c : mine; }
        if (sum == G) break;
        __builtin_amdgcn_s_sleep(1);
        if ((++sp & 255u) == 0u) { if (xb_ld(&bar[XB_TMO])) break; if (sp > XB_SPIN_CAP) { atomicAdd(&bar[XB_TMO], 1u); break; } }
    }
    nloc = mine > 0u ? mine : 1u; nx = cnt > 0u ? cnt : 1u;
}

__device__ __forceinline__ void xcd_barrier(const XcdBarrier& b) {
    asm volatile("s_waitcnt vmcnt(0)" ::: "memory");
    __syncthreads();
    if (threadIdx.x == 0) {
        unsigned* bar = b.bar;
        __builtin_amdgcn_s_waitcnt(0);
        unsigned nloc = b.st[0], nx = b.st[1];
        if (nloc == 0u) { xcd_barrier_complete(bar, b.x, nloc, nx); b.st[0] = nloc; b.st[1] = nx; }
        const unsigned old = xb_add(&bar[XB_XSUB(b.x)], 1u);
        const unsigned gen = old / nloc;
        if (old + 1u == (gen + 1u) * nloc) {
#ifndef PROBE_NOWBL2
            __builtin_amdgcn_fence(__ATOMIC_RELEASE, "agent");
#endif
            asm volatile("s_waitcnt vmcnt(0)" ::: "memory");
            const unsigned og = xb_add(&bar[XB_TOP], 1u);
            const unsigned tg = og / nx;
            if (og + 1u == (tg + 1u) * nx) xb_add(&bar[XB_TOPGEN], 1u);
            else XB_SPIN(xb_ld(&bar[XB_TOPGEN]) == tg, bar);
            __builtin_amdgcn_fence(__ATOMIC_ACQUIRE, "agent");
            xb_add(&bar[XB_XGEN(b.x)], 1u);
            asm volatile("s_waitcnt vmcnt(0)" ::: "memory");
        } else {
            XB_SPIN(xb_ld(&bar[XB_XGEN(b.x)]) == gen, bar);
            __builtin_amdgcn_fence(__ATOMIC_ACQUIRE, "agent");
            asm volatile("s_waitcnt vmcnt(0)" ::: "memory");
        }
    }
    __syncthreads();
}

#ifndef THR_VALUE
#define THR_VALUE 8.0f
#endif
namespace at {
#define AT_LAS __attribute__((address_space(3)))
typedef short bf16x8 __attribute__((ext_vector_type(8)));
typedef short s16x4 __attribute__((ext_vector_type(4)));
typedef float f32x16 __attribute__((ext_vector_type(16)));
typedef float f32x4 __attribute__((ext_vector_type(4)));
typedef unsigned u32x4 __attribute__((ext_vector_type(4)));
typedef unsigned u32x2 __attribute__((ext_vector_type(2)));
typedef unsigned short bf16_t;
constexpr int MP = 16384, PITCH = 1024, SEQ = 2048;
constexpr int KCS = 1040;
constexpr int KT_BYTES = 8 * KCS;
constexpr float THR = THR_VALUE;
constexpr int WSF_OFF = 132096;
constexpr int QIMG_OFF = 99328;
__device__ __forceinline__ int crow(int r, int hi) { return (r & 3) + 8 * (r >> 2) + 4 * hi; }
__device__ __forceinline__ unsigned cvtpk(float lo, float hi) { typedef float f2 __attribute__((ext_vector_type(2))); typedef __bf16 b2 __attribute__((ext_vector_type(2))); f2 v = {lo, hi}; b2 b = __builtin_convertvector(v, b2); return __builtin_bit_cast(unsigned, b); }
__device__ __forceinline__ s16x4 vtr(const AT_LAS unsigned char* p) { typedef short v4i16_t __attribute__((ext_vector_type(4))); return __builtin_bit_cast(s16x4, __builtin_amdgcn_ds_read_tr16_b64_v4i16((AT_LAS v4i16_t*)p)); }
#define AT_SYNC() __syncthreads()

template <bool QLDS>
__device__ __forceinline__ void qk_tile(f32x16& p0, f32x16& p1, const AT_LAS unsigned char* kt, const bf16x8 (&qr_)[4], const AT_LAS unsigned char* qimg, int r32, int hi) {
    p0 = f32x16{}; p1 = f32x16{};
#pragma unroll
    for (int d0 = 0; d0 < 4; ++d0) {
        bf16x8 qr[4]; if (QLDS) qr[d0] = *(const AT_LAS bf16x8*)(qimg + (2 * d0 + hi) * 512 + r32 * 16); else qr[d0] = qr_[d0];
        const bf16x8 a0 = *(const AT_LAS bf16x8*)(kt + (2 * d0 + hi) * KCS + r32 * 16);
        const bf16x8 a1 = *(const AT_LAS bf16x8*)(kt + (2 * d0 + hi) * KCS + r32 * 16 + 512);
        p0 = __builtin_amdgcn_mfma_f32_32x32x16_bf16(a0, qr[d0], p0, 0, 0, 0);
        p1 = __builtin_amdgcn_mfma_f32_32x32x16_bf16(a1, qr[d0], p1, 0, 0, 0);
    }
}
template <int ND0>
__device__ __forceinline__ void softmax_tile(f32x16& p0, f32x16& p1, float& m, float& l, f32x16 (&o)[ND0], AT_LAS float* wsf, int r32, int hi) {
    float rm = fmaxf(p0[0], p1[0]);
#pragma unroll
    for (int r = 1; r < 16; ++r) rm = fmaxf(rm, fmaxf(p0[r], p1[r]));
    rm = fmaxf(rm, __shfl_xor(rm, 32));
    if (__any(rm > m + THR)) {
        const float mn = fmaxf(m, rm), f = __builtin_amdgcn_exp2f(m - mn);
        l *= f; m = mn;
        if (hi == 0) wsf[r32] = f;
        asm volatile("s_waitcnt lgkmcnt(0)" ::: "memory");
#pragma unroll
        for (int r = 0; r < 16; ++r) { const float fr_ = wsf[crow(r, hi)];
#pragma unroll
            for (int d0 = 0; d0 < ND0; ++d0) o[d0][r] *= fr_; }
        asm volatile("s_waitcnt lgkmcnt(0)" ::: "memory");
    }
    float s = 0.f;
#pragma unroll
    for (int r = 0; r < 16; ++r) { p0[r] = __builtin_amdgcn_exp2f(p0[r] - m); p1[r] = __builtin_amdgcn_exp2f(p1[r] - m); s += p0[r] + p1[r]; }
    l += s;
}
__device__ __forceinline__ void pack_p(bf16x8 (&pa)[4], const f32x16& p0, const f32x16& p1) {
#pragma unroll
    for (int ks = 0; ks < 4; ++ks) {
        u32x4 w;
        if (ks < 2) { const int b = 8 * ks; w.x = cvtpk(p0[b], p0[b + 1]); w.y = cvtpk(p0[b + 2], p0[b + 3]); w.z = cvtpk(p0[b + 4], p0[b + 5]); w.w = cvtpk(p0[b + 6], p0[b + 7]); }
        else { const int b = 8 * (ks - 2); w.x = cvtpk(p1[b], p1[b + 1]); w.y = cvtpk(p1[b + 2], p1[b + 3]); w.z = cvtpk(p1[b + 4], p1[b + 5]); w.w = cvtpk(p1[b + 6], p1[b + 7]); }
        pa[ks] = __builtin_bit_cast(bf16x8, w);
    }
}
template <int ND0>
__device__ __forceinline__ void pv_packed(f32x16 (&o)[ND0], const AT_LAS unsigned char* vt, const bf16x8 (&pa)[4], int lane, int hi) {
    const AT_LAS unsigned char* vb = vt + ((lane >> 4) & 1) * 32 + (lane & 3) * 8 + (4 * hi + ((lane & 15) >> 2)) * 64;
#pragma unroll
    for (int d0 = 0; d0 < ND0; ++d0)
#pragma unroll
        for (int ks = 0; ks < 4; ++ks) {
            const s16x4 lo = vtr(vb + d0 * 4096 + ks * 1024), hh = vtr(vb + d0 * 4096 + ks * 1024 + 512);
            const bf16x8 bfr = {lo[0], lo[1], lo[2], lo[3], hh[0], hh[1], hh[2], hh[3]};
            o[d0] = __builtin_amdgcn_mfma_f32_32x32x16_bf16(pa[ks], bfr, o[d0], 0, 0, 0);
        }
}
template <int ND0>
__device__ __forceinline__ void pv_tile(f32x16 (&o)[ND0], const AT_LAS unsigned char* vt, const f32x16& p0, const f32x16& p1, int lane, int hi) {
    bf16x8 pa[4]; pack_p(pa, p0, p1); pv_packed<ND0>(o, vt, pa, lane, hi);
}
__device__ __forceinline__ u32x4 ld16(const void* p) { return *(const u32x4*)p; }
__device__ __forceinline__ u32x4 ld16nt(const void* p) { return __builtin_nontemporal_load((const u32x4*)p); }
__device__ __forceinline__ u32x2 f4_to_bf4(u32x4 v) { u32x2 w; w.x = cvtpk(__uint_as_float(v.x), __uint_as_float(v.y)); w.y = cvtpk(__uint_as_float(v.z), __uint_as_float(v.w)); return w; }

struct Ctx {
    const bf16_t *Q, *K, *V; bf16_t* O;
    const float *cache_k, *cache_v;
    const float *lam_p, *subln;
    const float* rel;
    void* stamp;
    float lam;
};
__device__ __forceinline__ float diff_lambda(const float* lp) {
    const int lane = threadIdx.x & 63;
    float sa = lp[lane] * lp[64 + lane], sc = lp[128 + lane] * lp[192 + lane];
#pragma unroll
    for (int o_ = 1; o_ < 64; o_ <<= 1) { sa += __shfl_xor(sa, o_); sc += __shfl_xor(sc, o_); }
    return __expf(sa) - __expf(sc) + 0.2f;
}
#ifndef PROBE_CLK
#define PROBE_CLK() __builtin_amdgcn_s_memtime()
#endif
#ifndef PROBE_STAMP_B
#define PROBE_STAMP_B 1
#endif
#ifndef PROBE_BLK
#define PROBE_BLK 0
#endif
#ifndef PROBE_TID
#define PROBE_TID 0
#endif

template <int NK, int DV>
__device__ __forceinline__ void ld_bf(u32x4 (&st)[NK + DV / 64], const bf16_t* kbase, const bf16_t* vbase, int nrows, int tid) {
    const int row = tid >> 3, ch = tid & 7; const unsigned koff = (unsigned)row * PITCH + ch * 8;
#pragma unroll
    for (int c = 0; c < NK; ++c) st[c] = (row < nrows) ? ld16(kbase + koff + c * 64) : (u32x4){0u, 0u, 0u, 0u};
    if (DV == 64) { st[NK] = (row < nrows) ? ld16(vbase + koff) : (u32x4){0u, 0u, 0u, 0u}; }
    else {
        const int vrow = tid >> 4; const unsigned voff = (unsigned)vrow * PITCH + (tid & 15) * 8;
#pragma unroll
        for (int i = 0; i < 2; ++i) st[NK + i] = (vrow + 32 * i < nrows) ? ld16(vbase + voff + (size_t)i * 32 * PITCH) : (u32x4){0u, 0u, 0u, 0u};
    }
}
template <int NK, int DV>
__device__ __forceinline__ void wr_bf(const u32x4 (&st)[NK + DV / 64], AT_LAS unsigned char* sb, int tid) {
    const int row = tid >> 3, ch = tid & 7;
#pragma unroll
    for (int c = 0; c < NK; ++c) *(AT_LAS u32x4*)(sb + c * KT_BYTES + ch * KCS + row * 16) = st[c];
    AT_LAS unsigned char* vb = sb + NK * KT_BYTES;
    if (DV == 64) { const int col = ch * 8; *(AT_LAS u32x4*)(vb + ((col >> 5) * 4 + (row >> 4)) * 1024 + (row & 15) * 64 + (col & 31) * 2) = st[NK]; }
    else {
        const int vrow = tid >> 4, col = (tid & 15) * 8;
#pragma unroll
        for (int i = 0; i < 2; ++i) *(AT_LAS u32x4*)(vb + ((col >> 5) * 4 + ((vrow + 32 * i) >> 4)) * 1024 + (vrow & 15) * 64 + (col & 31) * 2) = st[NK + i];
    }
}
__device__ __forceinline__ void glds16(const void* gsrc, unsigned lds_dst) { unsigned keep;
    asm volatile("s_mov_b32 %0, m0\n\ts_mov_b32 m0, %2\n\ts_nop 0\n\tglobal_load_lds_dwordx4 %1, off\n\ts_mov_b32 m0, %0" : "=&s"(keep) : "v"(gsrc), "s"(lds_dst) : "memory"); }
template <int NK, int DV>
__device__ __forceinline__ void dma_bf(const bf16_t* kbase, const bf16_t* vbase, AT_LAS unsigned char* sb, int w, int lane) {
    const unsigned s0 = (unsigned)__builtin_amdgcn_readfirstlane((int)(unsigned)(uintptr_t)sb);
#pragma unroll
    for (int c = 0; c < NK; ++c) glds16(kbase + (size_t)lane * PITCH + c * 64 + w * 8, (unsigned)__builtin_amdgcn_readfirstlane((int)(s0 + c * KT_BYTES + w * KCS)));
#pragma unroll
    for (int i = 0; i < DV / 64; ++i) { const int d0 = 2 * i + (w >> 2), rg = w & 3;
        glds16(vbase + (size_t)(16 * rg + (lane >> 2)) * PITCH + d0 * 32 + (lane & 3) * 8, (unsigned)__builtin_amdgcn_readfirstlane((int)(s0 + NK * KT_BYTES + (d0 * 4 + rg) * 1024))); }
}
__device__ __forceinline__ void dma_prompt(const bf16_t* kbase, const bf16_t* vbase, AT_LAS unsigned char* sb, int w, int lane) {
    const unsigned s0 = (unsigned)__builtin_amdgcn_readfirstlane((int)(unsigned)(uintptr_t)sb);
#pragma unroll
    for (int i = 0; i < 2; ++i) { const int j = 2 * w + i, R = 4 * j + (lane >> 4), c = (lane & 15) ^ (R & 15);
        glds16(kbase + (size_t)R * PITCH + c * 8, (unsigned)__builtin_amdgcn_readfirstlane((int)(s0 + j * 1024))); }
#pragma unroll
    for (int i = 0; i < 2; ++i) { const int d0 = 2 * i + (w >> 2), rg = w & 3;
        glds16(vbase + (size_t)(16 * rg + (lane >> 2)) * PITCH + d0 * 32 + (lane & 3) * 8, (unsigned)__builtin_amdgcn_readfirstlane((int)(s0 + 16384 + (d0 * 4 + rg) * 1024))); }
}
__device__ __forceinline__ void dma_promptB(const bf16_t* kbase, const bf16_t* vbase, AT_LAS unsigned char* sb, int w, int lane) {
    const unsigned s0 = (unsigned)__builtin_amdgcn_readfirstlane((int)(unsigned)(uintptr_t)sb);
    { const int R = 8 * w + (lane >> 3), c = (lane & 7) ^ ((R >> 1) & 7);
      glds16(kbase + (size_t)R * PITCH + c * 8, (unsigned)__builtin_amdgcn_readfirstlane((int)(s0 + w * 1024))); }
    { const int d0 = w >> 2, rg = w & 3;
      glds16(vbase + (size_t)(16 * rg + (lane >> 2)) * PITCH + d0 * 32 + (lane & 3) * 8, (unsigned)__builtin_amdgcn_readfirstlane((int)(s0 + 8192 + (d0 * 4 + rg) * 1024))); }
}
template <int NK, int DV>
__device__ __forceinline__ void ld_f32(u32x4 (&st)[2 * NK + DV / 32], const float* kbase, const float* vbase, int tid) {
    { const unsigned off = (unsigned)(tid >> 4) * 1024 + (tid & 15) * 4;
#pragma unroll
      for (int c = 0; c < NK; ++c)
#pragma unroll
          for (int i = 0; i < 2; ++i) st[c * 2 + i] = ld16nt(kbase + off + c * 64 + (size_t)i * 32 * 1024); }
    if (DV == 64) { const unsigned off = (unsigned)(tid >> 4) * 1024 + (tid & 15) * 4;
#pragma unroll
        for (int i = 0; i < 2; ++i) st[2 * NK + i] = ld16nt(vbase + off + (size_t)i * 32 * 1024); }
    else { const unsigned off = (unsigned)(tid >> 5) * 1024 + (tid & 31) * 4;
#pragma unroll
        for (int i = 0; i < 4; ++i) st[2 * NK + i] = ld16nt(vbase + off + (size_t)i * 16 * 1024); }
}
template <int NK, int DV>
__device__ __forceinline__ void wr_f32(const u32x4 (&st)[2 * NK + DV / 32], AT_LAS unsigned char* sb, int tid) {
    { const int row = tid >> 4, c4 = tid & 15;
#pragma unroll
      for (int c = 0; c < NK; ++c)
#pragma unroll
          for (int i = 0; i < 2; ++i) *(AT_LAS u32x2*)(sb + c * KT_BYTES + (c4 >> 1) * KCS + (row + 32 * i) * 16 + (c4 & 1) * 8) = f4_to_bf4(st[c * 2 + i]); }
    AT_LAS unsigned char* vb = sb + NK * KT_BYTES;
    if (DV == 64) { const int row = tid >> 4, col = (tid & 15) * 4;
#pragma unroll
        for (int i = 0; i < 2; ++i) *(AT_LAS u32x2*)(vb + ((col >> 5) * 4 + ((row + 32 * i) >> 4)) * 1024 + (row & 15) * 64 + (col & 31) * 2) = f4_to_bf4(st[2 * NK + i]); }
    else { const int row = tid >> 5, col = (tid & 31) * 4;
#pragma unroll
        for (int i = 0; i < 4; ++i) *(AT_LAS u32x2*)(vb + ((col >> 5) * 4 + ((row + 16 * i) >> 4)) * 1024 + (row & 15) * 64 + (col & 31) * 2) = f4_to_bf4(st[2 * NK + i]); }
}

constexpr int A_STAGE = 2 * KT_BYTES + 16384;
constexpr int A_TP = 132;
constexpr int S_TAB = WSF_OFF + 2048;
template <bool ISB>
__device__ __forceinline__ void attn_sample_unit(AT_LAS unsigned char* lds, int b, int cg, const Ctx& C) {
    constexpr int ND0 = ISB ? 2 : 4, NT = ISB ? 8 : 16, PAST = ISB ? 512 : 1024;
    const int tid = pg8::opaque_tid(), lane = tid & 63, r32 = lane & 31, hi = lane >> 5;
    const int w = __builtin_amdgcn_readfirstlane(tid >> 6), g = w >> 2;
    AT_LAS float* wsf = (AT_LAS float*)(lds + WSF_OFF) + w * 64;
    AT_LAS float* tab = (AT_LAS float*)(lds + S_TAB) + g * 264;
    const bool active = (w & 3) == 0;
    const int qrow0 = MP + b * 32, qpos = 1024 + r32;
    if (ISB) { for (int i = tid; i < 2 * 257; i += 512) { const int hh = i >= 257 ? 1 : 0, j = i - hh * 257; ((AT_LAS float*)(lds + S_TAB))[hh * 264 + j] = C.rel[(2 * cg + hh) * 257 + j] * 1.4426950408889634f; } }
    const float lam = C.lam;
    bf16x8 qr[4];
    AT_LAS unsigned char* qimg = lds + QIMG_OFF + w * 4096;
#pragma unroll
    for (int d0 = 0; d0 < 4; ++d0) { qr[d0] = *(const bf16x8*)(C.Q + (size_t)(qrow0 + r32) * PITCH + cg * 128 + g * 64 + d0 * 16 + hi * 8);
        *(AT_LAS bf16x8*)(qimg + (2 * d0 + hi) * 512 + r32 * 16) = qr[d0]; }
    f32x16 o[ND0];
#pragma unroll
    for (int d0 = 0; d0 < ND0; ++d0) o[d0] = f32x16{};
    float m = -1e30f, l = 0.f;
    const bf16_t* kb0 = C.K + (size_t)qrow0 * PITCH + cg * 128;
    const bf16_t* vb0 = C.V + (size_t)qrow0 * PITCH + cg * 128;
    const float* kc0 = C.cache_k + (size_t)b * PAST * 1024 + cg * 128;
    const float* vc0 = C.cache_v + (size_t)b * PAST * 1024 + cg * 128;
    u32x4 st[8];
    ld_f32<2, 128>(st, kc0, vc0, tid);
    { u32x4 sn[4]; ld_bf<2, 128>(sn, kb0, vb0, 32, tid); wr_bf<2, 128>(sn, lds + 2 * A_STAGE, tid); }
    for (int t = 0; t < NT; ++t) {
        AT_LAS unsigned char* sb = lds + (t & 1) * A_STAGE;
        wr_f32<2, 128>(st, sb, tid);
        AT_SYNC();
        if (t + 1 < NT) ld_f32<2, 128>(st, kc0 + (size_t)(t + 1) * 64 * 1024, vc0 + (size_t)(t + 1) * 64 * 1024, tid);
        if (active) {
            const int nsub = (t == 0) ? 2 : 1;
#pragma unroll 1
            for (int sub = 0; sub < nsub; ++sub) {
                const AT_LAS unsigned char* sc = sub ? (lds + 2 * A_STAGE) : sb;
                f32x16 p0, p1;
                qk_tile<true>(p0, p1, sc + g * KT_BYTES, qr, qimg, r32, hi);
                if (ISB) {
                    const int kpos0 = sub ? 1024 : 512 + t * 64;
                    if (1024 - (kpos0 + 63) >= 128) { const float cb = tab[256];
#pragma unroll
                        for (int r = 0; r < 16; ++r) { p0[r] += cb; p1[r] += cb; } }
                    else {
#pragma unroll
                        for (int r = 0; r < 16; ++r) { const int rel = qpos - (kpos0 + crow(r, hi));
                            const int i0 = rel < -128 ? -128 : (rel > 128 ? 128 : rel), i1 = (rel - 32) < -128 ? -128 : ((rel - 32) > 128 ? 128 : (rel - 32));
                            p0[r] += tab[i0 + 128]; p1[r] += tab[i1 + 128]; } }
                }
                if (sub) {
#pragma unroll
                    for (int r = 0; r < 16; ++r) p1[r] = -INFINITY;
                }
                softmax_tile<ND0>(p0, p1, m, l, o, wsf, r32, hi);
                pv_tile<ND0>(o, sc + 2 * KT_BYTES + (ISB ? g * 8192 : 0), p0, p1, lane, hi);
            }
        }
    }
    AT_SYNC();
    const float lt = l + __shfl_xor(l, 32);
    if (!ISB) {
        { float inv = 1.0f / lt; if (g == 1) inv *= lam; if (hi == 0) wsf[r32] = inv; asm volatile("s_waitcnt lgkmcnt(0)" ::: "memory"); }
        AT_LAS float* T2 = (AT_LAS float*)lds;
        if (active && g == 1) {
#pragma unroll
            for (int r = 0; r < 16; ++r) { const int q = crow(r, hi); const float f = wsf[q];
#pragma unroll
                for (int d0 = 0; d0 < ND0; ++d0) T2[q * A_TP + d0 * 32 + r32] = o[d0][r] * f; }
        }
        AT_SYNC();
        if (active && g == 0) {
#pragma unroll
            for (int r = 0; r < 16; ++r) { const int q = crow(r, hi); const float f = wsf[q];
#pragma unroll
                for (int d0 = 0; d0 < ND0; ++d0) { const int ix = q * A_TP + d0 * 32 + r32; T2[ix] = o[d0][r] * f - T2[ix]; } }
            asm volatile("s_waitcnt lgkmcnt(0)" ::: "memory");
            const int row = lane & 31, half = lane >> 5;
            f32x4 x[16]; float ss = 0.f;
#pragma unroll
            for (int i = 0; i < 16; ++i) { x[i] = *(const AT_LAS f32x4*)(T2 + row * A_TP + half * 64 + 4 * i); ss += (x[i][0] * x[i][0] + x[i][1] * x[i][1]) + (x[i][2] * x[i][2] + x[i][3] * x[i][3]); }
            ss += __shfl_xor(ss, 32);
            const float rinv = 0.8f / sqrtf(ss * (1.0f / 128.0f) + 1e-6f);
            bf16_t* op = C.O + (size_t)(qrow0 + row) * PITCH + cg * 128 + half * 64;
#pragma unroll
            for (int i = 0; i < 16; i += 2) {
                const f32x4 g0 = *(const f32x4*)(C.subln + half * 64 + 4 * i), g1 = *(const f32x4*)(C.subln + half * 64 + 4 * i + 4);
                const f32x4 y0 = x[i] * g0 * rinv, y1 = x[i + 1] * g1 * rinv;
                u32x4 wv; wv.x = cvtpk(y0[0], y0[1]); wv.y = cvtpk(y0[2], y0[3]); wv.z = cvtpk(y1[0], y1[1]); wv.w = cvtpk(y1[2], y1[3]);
                *(u32x4*)(op + 4 * i) = wv;
            }
        }
    } else if (active) {
        { const float inv = 1.0f / lt; if (hi == 0) wsf[r32] = inv; asm volatile("s_waitcnt lgkmcnt(0)" ::: "memory"); }
        AT_LAS bf16_t* stg = (AT_LAS bf16_t*)lds + g * 2048;
#pragma unroll
        for (int r = 0; r < 16; ++r) { const int q = crow(r, hi); const float f = wsf[q];
#pragma unroll
            for (int d0 = 0; d0 < ND0; ++d0) { const unsigned pk = cvtpk(o[d0][r] * f, 0.f); stg[q * 64 + d0 * 32 + r32] = (bf16_t)(pk & 0xffffu); } }
        asm volatile("s_waitcnt lgkmcnt(0)" ::: "memory");
        bf16_t* op = C.O + (size_t)qrow0 * PITCH + cg * 128 + g * 64;
#pragma unroll
        for (int i = 0; i < 4; ++i) { const int row = i * 8 + (lane >> 3), ch = lane & 7; const u32x4 v = *(const AT_LAS u32x4*)(stg + row * 64 + ch * 8); *(u32x4*)(op + (size_t)row * PITCH + ch * 8) = v; }
    }
    AT_SYNC();
}

constexpr int P_STAGE = 16384 + 16384;
constexpr int P_EPI = 65536;
constexpr int P_WSF = 135168;
constexpr int P_TAB = P_WSF + 2048;
template <bool ISB>
__device__ __forceinline__ void attn_prompt_unit(AT_LAS unsigned char* lds, int b, int cg, int ub, const Ctx& C, bf16x8 (&qr)[4], bool pre, bool has_next, int nb, int ncg, int nub) {
#ifdef PROBE_STAMP
    const unsigned long long tsA_ = PROBE_CLK();
#endif
    constexpr int ND0 = ISB ? 2 : 4, NS = ISB ? 8 : 4, STG = ISB ? 16384 : P_STAGE, DIST = ISB ? 4 : 2, VOFF = ISB ? 8192 : 16384, KR2 = ISB ? 4096 : 8192;
    const int tid = pg8::opaque_tid(), lane = tid & 63, r32 = lane & 31, hi = lane >> 5;
#ifdef PROBE_PARITY
    const int w = __builtin_amdgcn_readfirstlane(tid >> 6), g = ISB ? 0 : (w >> 2), qi = w & 3;
#else
    const int w = __builtin_amdgcn_readfirstlane(tid >> 6), g = w >> 2, qi = w & 3;
#endif
    AT_LAS float* wsf = (AT_LAS float*)(lds + P_WSF) + w * 64;
    AT_LAS float* tab = (AT_LAS float*)(lds + P_TAB);
    const int cw = ISB ? 4 * ub + (w >> 1) : 2 * ub + (qi >> 1);
    const int kt0 = ISB ? ((4 * ub - 8) > 0 ? (4 * ub - 8) : 0) : 0, NT = (ISB ? 4 * ub + 4 : 2 * ub + 2) - kt0;
    const int fv = ISB ? ((cw - 8) > 0 ? (cw - 8) : 0) : 0;
    const int qoff = ISB ? ub * 256 + w * 32 : ub * 128 + qi * 32, qrow0 = b * SEQ + qoff, qpos = qoff + r32;
    const int ccol = ISB ? cg * 64 : cg * 128;
    if (!pre) { if (ISB) { if (tid < 257) tab[tid] = C.rel[cg * 257 + tid] * 1.4426950408889634f; } }
    AT_LAS float* subl = (AT_LAS float*)(lds + P_TAB);
    if (!ISB && !pre) { if (tid < 128) subl[tid] = C.subln[tid]; }
    const float lam = C.lam;
    if (!pre) {
#pragma unroll
        for (int d0 = 0; d0 < 4; ++d0) qr[d0] = *(const bf16x8*)(C.Q + (size_t)(qrow0 + r32) * PITCH + ccol + (ISB ? 0 : g * 64) + d0 * 16 + hi * 8);
    }
    f32x16 o[ND0];
#pragma unroll
    for (int d0 = 0; d0 < ND0; ++d0) o[d0] = f32x16{};
    f32x16 negm = f32x16{};
    float m = 0.f, l = 0.f;
    bf16x8 pa[4];
#pragma unroll
    for (int ks = 0; ks < 4; ++ks) pa[ks] = bf16x8{};
    const bf16_t* kb0 = C.K + (size_t)(b * SEQ + kt0 * 64) * PITCH + ccol;
    const bf16_t* vb0 = C.V + (size_t)(b * SEQ + kt0 * 64) * PITCH + ccol;
#define P_DMA(tt) do { if (ISB) dma_promptB(kb0 + (size_t)(tt) * 64 * PITCH, vb0 + (size_t)(tt) * 64 * PITCH, lds + ((tt) & (NS - 1)) * STG, w, lane); \
                       else dma_prompt(kb0 + (size_t)(tt) * 64 * PITCH, vb0 + (size_t)(tt) * 64 * PITCH, lds + ((tt) & (NS - 1)) * STG, w, lane); } while (0)
    if (!pre) {
#pragma unroll
        for (int tt = 0; tt < DIST; ++tt) if (tt < NT) P_DMA(tt);
    }
    const int vlane = ((lane >> 4) & 1) * 32 + (lane & 3) * 8 + (4 * hi + ((lane & 15) >> 2)) * 64 + VOFF;
    const int klane = ISB ? (r32 * 128 + ((hi ^ ((r32 >> 1) & 7)) << 4)) : (r32 * 256 + (((g * 8 + hi) ^ (r32 & 15)) << 4));
#define P_VRD(buf, blk) do { _Pragma("unroll") for (int ks = 0; ks < 4; ++ks) { buf[2 * ks] = vtr(vp + (blk) * 4096 + ks * 1024); buf[2 * ks + 1] = vtr(vp + (blk) * 4096 + ks * 1024 + 512); } } while (0)
#define P_VMM(buf, blk) do { _Pragma("unroll") for (int ks = 0; ks < 4; ++ks) { const bf16x8 bfr = {buf[2 * ks][0], buf[2 * ks][1], buf[2 * ks][2], buf[2 * ks][3], buf[2 * ks + 1][0], buf[2 * ks + 1][1], buf[2 * ks + 1][2], buf[2 * ks + 1][3]}; \
        o[blk] = __builtin_amdgcn_mfma_f32_32x32x16_bf16(pa[ks], bfr, o[blk], 0, 0, 0); } } while (0)
#define P_SB() __builtin_amdgcn_sched_barrier(0)
#define P_KRD(scur) do { \
        _Pragma("unroll") for (int d0 = 0; d0 < 4; ++d0) { ka[2 * d0] = *(const AT_LAS bf16x8*)(lds + (scur) + (klane ^ (d0 << 5))); ka[2 * d0 + 1] = *(const AT_LAS bf16x8*)(lds + (scur) + (klane ^ (d0 << 5)) + KR2); } } while (0)
#define P_PV(sprev, KRD_STMT) do { const AT_LAS unsigned char* vp = lds + (sprev) + vlane; \
        P_VMM(va, 0); \
        if (ND0 == 4) { P_VRD(va, 2); P_SB(); P_VMM(vb, 1); P_VRD(vb, 3); P_SB(); P_VMM(va, 2); KRD_STMT; P_SB(); P_VMM(vb, 3); } else { KRD_STMT; P_SB(); P_VMM(vb, 1); } P_SB(); } while (0)
#define P_PRE(sprev) do { const AT_LAS unsigned char* vp = lds + (sprev) + vlane; P_VRD(va, 0); P_VRD(vb, 1); } while (0)
#define P_BAR() do { __builtin_amdgcn_sched_barrier(0); asm volatile("s_barrier" ::: "memory"); __builtin_amdgcn_sched_barrier(0); } while (0)
#define P_BAR_V0() do { __builtin_amdgcn_sched_barrier(0); asm volatile("s_waitcnt vmcnt(0)\n\ts_barrier" ::: "memory"); __builtin_amdgcn_sched_barrier(0); } while (0)
#define P_BAR_V2() do { __builtin_amdgcn_sched_barrier(0); asm volatile("s_waitcnt vmcnt(2)\n\ts_barrier" ::: "memory"); __builtin_amdgcn_sched_barrier(0); } while (0)
#define P_BAR_V4() do { __builtin_amdgcn_sched_barrier(0); asm volatile("s_waitcnt vmcnt(4)\n\ts_barrier" ::: "memory"); __builtin_amdgcn_sched_barrier(0); } while (0)
    if (pre) {
        if (ISB) asm volatile("s_waitcnt vmcnt(4) lgkmcnt(0)\n\ts_barrier" ::: "memory");
        else if (g == 0) asm volatile("s_waitcnt vmcnt(8) lgkmcnt(0)\n\ts_barrier" ::: "memory");
        else asm volatile("s_waitcnt vmcnt(0) lgkmcnt(0)\n\ts_barrier" ::: "memory");
    }
    else asm volatile("s_waitcnt vmcnt(0) lgkmcnt(0)\n\ts_barrier" ::: "memory");
    if (g == 1) P_BAR();
    f32x16 p0, p1;
    s16x4 va[8], vb[8]; bf16x8 ka[8];
#ifdef PROBE_STAMP
    unsigned long long stamp_acc = 0;
#endif
    P_PRE(0);
#ifdef PROBE_STAMP
    const unsigned long long tsB_ = PROBE_CLK();
#endif
    for (int t = 0; t < NT; ++t) {
#ifdef PROBE_PARITY
        if (t > 0 && !ISB) P_BAR();
#else
        if (t > 0) P_BAR();
#endif
#ifdef PROBE_STAMP
        const unsigned long long ts0_ = PROBE_CLK();
#endif
        P_PV((t > 0 ? ((t - 1) & (NS - 1)) : 0) * STG, P_KRD((t & (NS - 1)) * STG));
        p0 = __builtin_amdgcn_mfma_f32_32x32x16_bf16(ka[0], qr[0], negm, 0, 0, 0); p1 = __builtin_amdgcn_mfma_f32_32x32x16_bf16(ka[1], qr[0], negm, 0, 0, 0);
#pragma unroll
        for (int d0 = 1; d0 < 4; ++d0) { p0 = __builtin_amdgcn_mfma_f32_32x32x16_bf16(ka[2 * d0], qr[d0], p0, 0, 0, 0); p1 = __builtin_amdgcn_mfma_f32_32x32x16_bf16(ka[2 * d0 + 1], qr[d0], p1, 0, 0, 0); }
        if (ISB) { const int nn = NT - 2 - t; if (nn >= 2) P_BAR_V4(); else if (nn == 1) P_BAR_V2(); else P_BAR_V0(); }
        else P_BAR_V0();
#ifdef PROBE_STAMP
        const unsigned long long ts1_ = PROBE_CLK();
#endif
        if (t + DIST < NT) P_DMA(t + DIST);
        const int kt = kt0 + t;
        const bool vis = ISB ? (kt <= cw && kt >= cw - 8) : (kt <= cw);
        if (vis) {
            if (ISB) {
                const int relmin = cw * 64 + (w & 1) * 32 - (kt * 64 + 63);
                if (relmin >= 128) { const float cb = tab[256];
#pragma unroll
                    for (int r = 0; r < 16; ++r) { p0[r] += cb; p1[r] += cb; } }
                else {
#pragma unroll
                    for (int r = 0; r < 16; ++r) { const int rel = qpos - (kt * 64 + crow(r, hi));
                        const int i0 = rel < -128 ? -128 : (rel > 128 ? 128 : rel), i1 = (rel - 32) < -128 ? -128 : ((rel - 32) > 128 ? 128 : (rel - 32));
                        p0[r] += tab[i0 + 128]; p1[r] += tab[i1 + 128]; } }
            }
            float ra = __builtin_fmaxf(__builtin_fmaxf(p0[0], p0[1]), p1[0]), rb = __builtin_fmaxf(__builtin_fmaxf(p0[2], p0[3]), p1[1]);
            ra = __builtin_fmaxf(__builtin_fmaxf(ra, p1[2]), p1[3]);
#pragma unroll
            for (int r = 4; r < 16; r += 4) { ra = __builtin_fmaxf(__builtin_fmaxf(ra, p0[r]), p0[r + 1]); rb = __builtin_fmaxf(__builtin_fmaxf(rb, p0[r + 2]), p0[r + 3]);
                                              ra = __builtin_fmaxf(__builtin_fmaxf(ra, p1[r]), p1[r + 1]); rb = __builtin_fmaxf(__builtin_fmaxf(rb, p1[r + 2]), p1[r + 3]); }
            float rm = __builtin_fmaxf(ra, rb);
            { auto rr = __builtin_amdgcn_permlane32_swap(__float_as_uint(rm), __float_as_uint(rm), false, false); rm = __builtin_fmaxf(__uint_as_float(rr[0]), __uint_as_float(rr[1])); }
            const bool first = (kt == fv);
            if (first || __any(rm > THR)) {
                const float dl = first ? rm : __builtin_fmaxf(rm, 0.f);
                m += dl;
#pragma unroll
                for (int r = 0; r < 16; ++r) { p0[r] -= dl; p1[r] -= dl; }
#pragma unroll
                for (int r = 0; r < 16; ++r) negm[r] = -m;
                if (!first) {
                    const float f = __builtin_amdgcn_exp2f(-dl); l *= f;
                    if (hi == 0) wsf[r32] = f;
                    asm volatile("s_waitcnt lgkmcnt(0)" ::: "memory");
#pragma unroll
                    for (int r = 0; r < 16; ++r) { const float fr_ = wsf[crow(r, hi)];
#pragma unroll
                        for (int d0 = 0; d0 < ND0; ++d0) o[d0][r] *= fr_; }
                    asm volatile("s_waitcnt lgkmcnt(0)" ::: "memory");
                }
            }
            float s = 0.f;
#pragma unroll
            for (int r = 0; r < 16; ++r) { p0[r] = __builtin_amdgcn_exp2f(p0[r]); p1[r] = __builtin_amdgcn_exp2f(p1[r]); s += p0[r] + p1[r]; }
            l += s;
#ifdef PROBE_S2X
            { float xs = 0.f;
              for (int rep = 0; rep < PROBE_S2X; ++rep) {
#pragma unroll
              for (int r = 0; r < 16; ++r) { xs += __builtin_amdgcn_exp2f(p0[r] - 20.f - xs) + __builtin_amdgcn_exp2f(p1[r] - 21.f - xs); } }
              asm volatile("" :: "v"(xs)); }
#endif
            pack_p(pa, p0, p1);
        } else {
#pragma unroll
            for (int ks = 0; ks < 4; ++ks) pa[ks] = bf16x8{};
        }
        P_PRE((t & (NS - 1)) * STG);
#ifdef PROBE_STAMP
        { const unsigned long long ts2_ = PROBE_CLK(); if (ISB == (PROBE_STAMP_B != 0)) { if (PROBE_STAMP == 1) stamp_acc += ts1_ - ts0_; else if (PROBE_STAMP == 2) stamp_acc += ts2_ - ts1_; else stamp_acc += ts2_ - ts0_; } }
#endif
    }
#ifdef PROBE_STAMP
    const unsigned long long tsC_ = PROBE_CLK();
#endif
#ifdef PROBE_PARITY
    if (!ISB) P_BAR();
#else
    P_BAR();
#endif
    P_PV(((NT - 1) & (NS - 1)) * STG, (void)0);
    asm volatile("s_waitcnt lgkmcnt(0)" ::: "memory");
    if (g == 0) P_BAR();
    P_BAR();
    if (has_next) {
        const int nkt0 = ISB ? ((4 * nub - 8) > 0 ? (4 * nub - 8) : 0) : 0, nNT = (ISB ? 4 * nub + 4 : 2 * nub + 2) - nkt0, nccol = ISB ? ncg * 64 : ncg * 128;
        const bf16_t* nk0 = C.K + (size_t)(nb * SEQ + nkt0 * 64) * PITCH + nccol; const bf16_t* nv0 = C.V + (size_t)(nb * SEQ + nkt0 * 64) * PITCH + nccol;
#pragma unroll
        for (int tt = 0; tt < DIST; ++tt) if (tt < nNT) { if (ISB) dma_promptB(nk0 + (size_t)tt * 64 * PITCH, nv0 + (size_t)tt * 64 * PITCH, lds + tt * STG, w, lane); else dma_prompt(nk0 + (size_t)tt * 64 * PITCH, nv0 + (size_t)tt * 64 * PITCH, lds + tt * STG, w, lane); }
        const int nqrow0 = nb * SEQ + (ISB ? nub * 256 + w * 32 : nub * 128 + qi * 32);
#pragma unroll
        for (int d0 = 0; d0 < 4; ++d0) qr[d0] = *(const bf16x8*)(C.Q + (size_t)(nqrow0 + r32) * PITCH + nccol + (ISB ? 0 : g * 64) + d0 * 16 + hi * 8);
    }
#undef P_KRD
#undef P_PRE
#undef P_BAR
#undef P_BAR_V0
#undef P_BAR_V2
#undef P_BAR_V4
#undef P_DMA
#undef P_VRD
#undef P_VMM
#undef P_SB
#undef P_PV
    const float lt = l + __shfl_xor(l, 32);
    if (!ISB) {
        { float inv = 1.0f / lt; if (g == 1) inv *= lam; if (hi == 0) wsf[r32] = inv; asm volatile("s_waitcnt lgkmcnt(0)" ::: "memory"); }
        AT_LAS float* T2 = (AT_LAS float*)(lds + P_EPI) + qi * (32 * A_TP);
        if (g == 1) {
#pragma unroll
            for (int r = 0; r < 16; ++r) { const int q = crow(r, hi); const float f = wsf[q];
#pragma unroll
                for (int d0 = 0; d0 < ND0; ++d0) T2[q * A_TP + d0 * 32 + r32] = o[d0][r] * f; }
        }
        asm volatile("s_waitcnt lgkmcnt(0)\n\ts_barrier" ::: "memory");
        if (g == 0) {
#pragma unroll
            for (int r = 0; r < 16; ++r) { const int q = crow(r, hi); const float f = wsf[q];
#pragma unroll
                for (int d0 = 0; d0 < ND0; ++d0) { const int ix = q * A_TP + d0 * 32 + r32; T2[ix] = o[d0][r] * f - T2[ix]; } }
            asm volatile("s_waitcnt lgkmcnt(0)" ::: "memory");
            const int row = lane & 31, half = lane >> 5;
            f32x4 x[16]; float ss = 0.f;
#pragma unroll
            for (int i = 0; i < 16; ++i) { x[i] = *(const AT_LAS f32x4*)(T2 + row * A_TP + half * 64 + 4 * i); ss += (x[i][0] * x[i][0] + x[i][1] * x[i][1]) + (x[i][2] * x[i][2] + x[i][3] * x[i][3]); }
            ss += __shfl_xor(ss, 32);
            const float rinv = 0.8f / sqrtf(ss * (1.0f / 128.0f) + 1e-6f);
            bf16_t* op = C.O + (size_t)(qrow0 + row) * PITCH + cg * 128 + half * 64;
#pragma unroll
            for (int i = 0; i < 16; i += 4) {
                const f32x4 g0 = *(const AT_LAS f32x4*)(subl + half * 64 + 4 * i), g1 = *(const AT_LAS f32x4*)(subl + half * 64 + 4 * i + 4), g2 = *(const AT_LAS f32x4*)(subl + half * 64 + 4 * i + 8), g3 = *(const AT_LAS f32x4*)(subl + half * 64 + 4 * i + 12);
                const f32x4 y0 = x[i] * g0 * rinv, y1 = x[i + 1] * g1 * rinv, y2 = x[i + 2] * g2 * rinv, y3 = x[i + 3] * g3 * rinv;
                u32x4 wv; wv.x = cvtpk(y0[0], y0[1]); wv.y = cvtpk(y0[2], y0[3]); wv.z = cvtpk(y1[0], y1[1]); wv.w = cvtpk(y1[2], y1[3]);
                u32x4 wz; wz.x = cvtpk(y2[0], y2[1]); wz.y = cvtpk(y2[2], y2[3]); wz.z = cvtpk(y3[0], y3[1]); wz.w = cvtpk(y3[2], y3[3]);
                *(u32x4*)(op + 4 * i) = wv; *(u32x4*)(op + 4 * i + 8) = wz;
            }
        }
    } else {
        { const float inv = 1.0f / lt; if (hi == 0) wsf[r32] = inv; asm volatile("s_waitcnt lgkmcnt(0)" ::: "memory"); }
        AT_LAS bf16_t* stg = (AT_LAS bf16_t*)(lds + P_EPI) + w * 2048;
#pragma unroll
        for (int r = 0; r < 16; ++r) { const int q = crow(r, hi); const float f = wsf[q];
#pragma unroll
            for (int d0 = 0; d0 < ND0; ++d0) { const unsigned pk = cvtpk(o[d0][r] * f, 0.f); stg[q * 64 + d0 * 32 + r32] = (bf16_t)(pk & 0xffffu); } }
        asm volatile("s_waitcnt lgkmcnt(0)" ::: "memory");
        bf16_t* op = C.O + (size_t)qrow0 * PITCH + ccol;
#pragma unroll
        for (int i = 0; i < 4; ++i) { const int row = i * 8 + (lane >> 3), ch = lane & 7; const u32x4 v = *(const AT_LAS u32x4*)(stg + row * 64 + ch * 8); *(u32x4*)(op + (size_t)row * PITCH + ch * 8) = v; }
    }
    asm volatile("s_waitcnt lgkmcnt(0)\n\ts_barrier" ::: "memory");
#ifdef PROBE_STAMP
    { const unsigned long long tsD_ = PROBE_CLK(); if (ISB == (PROBE_STAMP_B != 0)) { if (PROBE_STAMP == 4) stamp_acc = tsB_ - tsA_; else if (PROBE_STAMP == 5) stamp_acc = tsD_ - tsC_; else if (PROBE_STAMP == 6) stamp_acc = tsD_ - tsA_; }
      if (blockIdx.x == PROBE_BLK && tid == PROBE_TID) atomicAdd((unsigned long long*)C.stamp, stamp_acc); }
#endif
}
}

constexpr int NWAVES = 8;
#ifndef MK_N_LAUNCHES
#define MK_N_LAUNCHES 1
#endif
constexpr int N_PHASES = 12;
constexpr int DMODEL = 1024, SEQ = 2048, NBATCH = 8, MP = NBATCH * SEQ, MS = 1024, M = MP + MS, FF = 4096;
constexpr size_t O_Y = 0, O_AKP = 17825792, O_AVP = 34603008, O_BKP = 51380224, O_BVP = 55574528, O_AKS = 59768832, O_AVS = 60817408, O_BKS = 61865984, O_BVS = 62914560, O_END = 63963136;
constexpr size_t MiB = 1u << 20;
constexpr size_t WS_CTL = 0, CTL_ZERO_BYTES = 1 * MiB;
constexpr size_t WS_WQKV = 2 * MiB, WS_WAO = 8 * MiB, WS_WKVQ = 10 * MiB, WS_WBO = 16 * MiB, WS_W1 = 18 * MiB  , WS_W2 = 34 * MiB  ;
constexpr size_t WS_CS = 50 * MiB;
constexpr size_t WS_SS = 51 * MiB;
constexpr size_t WS_HB = 54 * MiB, WS_Q = 90 * MiB, WS_K = 126 * MiB, WS_V = 162 * MiB, WS_O = 198 * MiB;
constexpr size_t WS_U = 234 * MiB;
constexpr size_t WS_END = 372 * MiB;
constexpr int CW_TMO = 0, CW_CODE = 1, CW_BAR = 4096, CW_FIN = 8192;
constexpr int RS_OFF = 139264;
constexpr int RING_OFF = 0, RING_BYTES = 131072, LDS_BYTES = 163840, LDSCTL_OFF = LDS_BYTES - 1024, MISC_OFF = LDSCTL_OFF + 320;

struct Args { const float* in[20]; float* out; unsigned char* ws; int ph_lo, ph_hi, li, pad; };

struct Frame {
    LAS unsigned char* lds; volatile LAS unsigned* MISC; gu32* ctl;
    int tid, lane, wave, vcu, G;
};

__device__ __forceinline__ float wave_sum(float v) {
#pragma unroll
    for (int o = 1; o < 64; o <<= 1) v += __shfl_xor(v, o);
    return v;
}
__device__ __forceinline__ int pi64(int d) { return d < 32 ? 32 * (d >> 4) + (d & 15) : 32 * ((d - 32) >> 4) + 16 + ((d - 32) & 15); }
template <bool PERMQK>
__device__ __forceinline__ void p0_transpose_item(const float* W, const float* g, int K, int N, bf16* WT, int row_off, LAS float* scr, int item, int lane) {
    const int nblk = N / 32, kb = item / nblk, nb = item % nblk, k0 = 64 * kb, n0 = 32 * nb;
    float wv[32];
#pragma unroll
    for (int i = 0; i < 32; ++i) { const int kk = 2 * i + (lane >> 5); wv[i] = __builtin_nontemporal_load(W + (size_t)(k0 + kk) * N + n0 + (lane & 31)); }
#pragma unroll
    for (int i = 0; i < 32; ++i) { const int kk = 2 * i + (lane >> 5); const float gv = g ? g[k0 + kk] : 1.0f; scr[kk * 33 + (lane & 31)] = wv[i] * gv; }
    LDS_WAIT(); asm volatile("" ::: "memory");
    const int c = lane & 7;
#pragma unroll
    for (int j = 0; j < 4; ++j) { const int n = (lane >> 3) + 8 * j; const LAS float* s = scr + (8 * c) * 33 + n;
        v4u o; o.x = pk2(s[0 * 33], s[1 * 33]); o.y = pk2(s[2 * 33], s[3 * 33]); o.z = pk2(s[4 * 33], s[5 * 33]); o.w = pk2(s[6 * 33], s[7 * 33]);
        int nn = n0 + n; if (PERMQK && nn < 2048) nn = (nn & ~63) + pi64(nn & 63);
        *(GAS v4u*)(WT + (size_t)(row_off + nn) * K + k0 + 8 * c) = o; }
    LDS_WAIT(); asm volatile("" ::: "memory");
}
__device__ __forceinline__ void p0_prologue(Frame& F, const Args& A) {
    unsigned char* ws = A.ws;
    LAS float* scr = (LAS float*)(F.lds + RING_OFF + F.wave * 16384);
    const int gw = F.vcu * NWAVES + F.wave, NGW = F.G * NWAVES;
    constexpr int I_QKV = 16 * 96, I_SQ = 16 * 32, I_KV = 16 * 64, I_F1 = 16 * 128, I_F2 = 64 * 32;
    constexpr int NITEMS = I_QKV + I_SQ + I_KV + I_SQ + I_SQ + 2 * I_F1 + 2 * I_F2;
    const float* g_attn = A.in[6]; const float* g_mlp = A.in[16];
    for (int it = gw; it < NITEMS; it += NGW) {
        int r = it;
        if (r < I_QKV) { p0_transpose_item<true>(A.in[7], g_attn, 1024, 3072, (bf16*)(ws + WS_WQKV), 0, scr, r, F.lane); continue; } r -= I_QKV;
        if (r < I_SQ) { p0_transpose_item<false>(A.in[10], nullptr, 1024, 1024, (bf16*)(ws + WS_WAO), 0, scr, r, F.lane); continue; } r -= I_SQ;
        if (r < I_KV) { p0_transpose_item<false>(A.in[12], A.in[11], 1024, 2048, (bf16*)(ws + WS_WKVQ), 0, scr, r, F.lane); continue; } r -= I_KV;
        if (r < I_SQ) { p0_transpose_item<false>(A.in[13], g_attn + 1024, 1024, 1024, (bf16*)(ws + WS_WKVQ), 2048, scr, r, F.lane); continue; } r -= I_SQ;
        if (r < I_SQ) { p0_transpose_item<false>(A.in[15], nullptr, 1024, 1024, (bf16*)(ws + WS_WBO), 0, scr, r, F.lane); continue; } r -= I_SQ;
        if (r < I_F1) { p0_transpose_item<false>(A.in[17], g_mlp, 1024, 4096, (bf16*)(ws + WS_W1), 0, scr, r, F.lane); continue; } r -= I_F1;
        if (r < I_F1) { p0_transpose_item<false>(A.in[17] + (size_t)1024 * 4096, g_mlp + 1024, 1024, 4096, (bf16*)(ws + WS_W1 + 8 * MiB), 0, scr, r, F.lane); continue; } r -= I_F1;
        if (r < I_F2) { p0_transpose_item<false>(A.in[18], nullptr, 4096, 1024, (bf16*)(ws + WS_W2), 0, scr, r, F.lane); continue; } r -= I_F2;
        p0_transpose_item<false>(A.in[18] + (size_t)4096 * 1024, nullptr, 4096, 1024, (bf16*)(ws + WS_W2 + 8 * MiB), 0, scr, r, F.lane);
    }
    bf16* HB = (bf16*)(ws + WS_HB); float* SS = (float*)(ws + WS_SS);
    for (int m = gw; m < M; m += NGW) {
        const float* xrow = (m < MP) ? A.in[0] + (size_t)m * 1024 : A.in[1] + (size_t)(m - MP) * 1024;
        const GAS f32x4* xr = (const GAS f32x4*)xrow + F.lane;
        f32x4 v[4]; float s = 0.f;
#pragma unroll
        for (int j = 0; j < 4; ++j) { v[j] = __builtin_nontemporal_load(xr + 64 * j); s += (v[j].x * v[j].x + v[j].y * v[j].y) + (v[j].z * v[j].z + v[j].w * v[j].w); }
        s = wave_sum(s);
        GAS unsigned long long* o8 = (GAS unsigned long long*)(HB + (size_t)m * 1024) + F.lane;
#pragma unroll
        for (int j = 0; j < 4; ++j) o8[64 * j] = (unsigned long long)pk2(v[j].x, v[j].y) | ((unsigned long long)pk2(v[j].z, v[j].w) << 32);
        if (F.lane < 16) SS[(size_t)m * 16 + F.lane] = (F.lane == 0) ? s : 0.f;
    }
    float* cs = (float*)(ws + WS_CS);
    for (int e = (F.vcu * NWAVES + F.wave) * 64 + F.lane; e < 2048 * 32; e += F.G * NWAVES * 64) {
        const int pos = e >> 5, i = e & 31;
        const float inv = 1.0f / powf(10000.0f, (float)i * (1.0f / 32.0f));
        const float ang = (float)pos * inv;
        float sv, cv; sincosf(ang, &sv, &cv);
        cs[(size_t)pos * 64 + i] = cv; cs[(size_t)pos * 64 + 32 + i] = sv;
    }
}
__device__ __forceinline__ void final_norm(Frame& F, const Args& A, int m_lo, int m_hi) {
    const int gw = F.vcu * NWAVES + F.wave, NGW = F.G * NWAVES;
    const float* SS = (const float*)(A.ws + WS_SS); const float* gf = A.in[19]; const bf16* HB = (const bf16*)(A.ws + WS_HB);
    f32x4 g[4];
#pragma unroll
    for (int j = 0; j < 4; ++j) g[j] = *((const f32x4*)gf + 4 * F.lane + j);
    for (int m = m_lo + gw; m < m_hi; m += NGW) {
        float s = (F.lane < 16) ? SS[(size_t)m * 16 + F.lane] : 0.f;
        s = wave_sum(s);
        const float r = 1.0f / sqrtf(s * (1.0f / 1024.0f) + 1e-6f);
        const v4u h0 = __builtin_nontemporal_load((const GAS v4u*)(HB + (size_t)m * 1024) + 2 * F.lane), h1 = __builtin_nontemporal_load((const GAS v4u*)(HB + (size_t)m * 1024) + 2 * F.lane + 1);
        GAS f32x4* yr = (GAS f32x4*)(A.out + (size_t)m * 1024) + 4 * F.lane;
        const unsigned w[8] = {h0.x, h0.y, h0.z, h0.w, h1.x, h1.y, h1.z, h1.w};
#pragma unroll
        for (int j = 0; j < 4; ++j) { f32x4 v; v.x = __uint_as_float(w[2 * j] << 16); v.y = __uint_as_float(w[2 * j] & 0xffff0000u); v.z = __uint_as_float(w[2 * j + 1] << 16); v.w = __uint_as_float(w[2 * j + 1] & 0xffff0000u);
            __builtin_nontemporal_store(v * g[j] * r, yr + j); }
    }
}

struct SplitBar { unsigned* bar; unsigned narr; };
__device__ __forceinline__ void sbar_arrive(SplitBar& sb, const XcdBarrier& b) {
    asm volatile("s_waitcnt vmcnt(0)" ::: "memory");
    __syncthreads();
    if (threadIdx.x == 0) {
        unsigned* bar = sb.bar;
        __builtin_amdgcn_s_waitcnt(0);
        const unsigned nloc = b.st[0], nx = b.st[1];
        const unsigned old = xb_add(&bar[XB_XSUB(b.x)], 1u);
        if ((old + 1u) % nloc == 0u) {
            __builtin_amdgcn_fence(__ATOMIC_RELEASE, "agent");
            asm volatile("s_waitcnt vmcnt(0)" ::: "memory");
            const unsigned og = xb_add(&bar[XB_TOP], 1u);
            if ((og + 1u) % nx == 0u) xb_add(&bar[XB_TOPGEN], 1u);
        }
    }
    ++sb.narr;
}
__device__ __forceinline__ void sbar_wait(const SplitBar& sb, const XcdBarrier& b) {
    if (threadIdx.x == 0) {
        unsigned* bar = sb.bar; unsigned* tb = b.bar;
        XB_SPIN(xb_ld(&bar[XB_TOPGEN]) < sb.narr, tb);
        __builtin_amdgcn_fence(__ATOMIC_ACQUIRE, "agent");
        asm volatile("s_waitcnt vmcnt(0)" ::: "memory");
    }
    __syncthreads();
}

template <int PH, int STREAM>
__device__ __forceinline__ void run_part(Frame& F, const Args& args) {
    unsigned char* const ws = args.ws;
    pg8::bf16_t* const HB = (pg8::bf16_t*)(ws + WS_HB); pg8::bf16_t* const QB = (pg8::bf16_t*)(ws + WS_Q); pg8::bf16_t* const KB = (pg8::bf16_t*)(ws + WS_K);
    pg8::bf16_t* const VB = (pg8::bf16_t*)(ws + WS_V); pg8::bf16_t* const OB = (pg8::bf16_t*)(ws + WS_O); pg8::bf16_t* const UB = (pg8::bf16_t*)(ws + WS_U);
    float* const SS = (float*)(ws + WS_SS);
    LAS float* const rst = (LAS float*)(F.lds + RS_OFF);
#define FILL_RS(N_) pg8::RsTab RSA{nullptr, 0, 0}, RSB{nullptr, 0, 0}; \
        if (STREAM == 1) { pg8::Unit u0; if (S.next(0, u0)) { pg8::rs_fill(SS, rst, u0.pm * 256, 256); RSA = pg8::RsTab{rst, u0.pm * 256, 256}; } } \
        else if (F.vcu < 8 * ((N_) / 128)) { pg8::rs_fill(SS, rst + 256, MP + (F.vcu % 8) * 128, 128); RSB = pg8::RsTab{rst + 256, MP + (F.vcu % 8) * 128, 128}; } \
        __syncthreads();
#define RUN_GEMM(EPI, GEO, NTM, TN_) do { if (STREAM == 1) pg8::gemm_phase<pg8::EPI, pg8::StaticOrder, true, true>(F.lds + RING_OFF, g, S, E); \
        else pg8::gemm_small<pg8::GEO, pg8::EPI>(F.lds + RING_OFF, g.A, g.Bt, g.K, MP, NTM, g.N / (TN_), F.vcu, F.G, E); } while (0)
    if constexpr (PH == 1) {
        pg8::Gemm g{HB, (const pg8::bf16_t*)(ws + WS_WQKV), M, 3072, 1024}; pg8::StaticOrder S; S.init(MP, 3072, F.G, (int)blockIdx.x);
        FILL_RS(3072)
        pg8::EpiQKV E{SS, (const float*)(ws + WS_CS), QB, KB, VB, args.out, RSA, RSB};
        RUN_GEMM(EpiQKV, GeoS128, 8, 128);
    }
    if constexpr (PH == 2) {
        at::Ctx C{QB, KB, VB, OB, args.in[2], args.in[3], args.in[8], args.in[9], nullptr, nullptr, at::diff_lambda(args.in[8])};
        for (int vv = F.vcu; vv < 256; vv += F.G) {
            if (STREAM == 0) at::attn_sample_unit<false>(F.lds, vv >> 3, vv & 7, C);
            else { const int x = vv >> 5, c = vv & 31, u = c & 15;
                at::bf16x8 qr[4]; bool pre = false;
#pragma unroll 1
                for (int r = 0; r < 4; ++r) { const int bh = r * 16 + x * 2 + (c >> 4), ub = (r & 1) ? 15 - u : u; const bool hn = r < 3; const int r2 = r + 1, bh2 = r2 * 16 + x * 2 + (c >> 4), ub2 = (r2 & 1) ? 15 - u : u;
                    at::attn_prompt_unit<false>(F.lds, bh >> 3, bh & 7, ub, C, qr, pre, hn, bh2 >> 3, bh2 & 7, ub2); pre = hn; } }
        }
    }
    if constexpr (PH == 3 || PH == 8) {
        pg8::Gemm g{OB, (const pg8::bf16_t*)(ws + (PH == 3 ? WS_WAO : WS_WBO)), M, 1024, 1024}; pg8::StaticOrder S; S.init(MP, 1024, F.G, (int)blockIdx.x);
        pg8::EpiRes E{HB, SS, 1.f};
        RUN_GEMM(EpiRes, GeoS64, 16, 64);
    }
    if constexpr (PH == 4 || PH == 9) {
        pg8::Gemm g{HB, (const pg8::bf16_t*)(ws + WS_W1 + (PH == 9 ? 8 * MiB : 0)), M, FF, 1024}; pg8::StaticOrder S; S.init(MP, FF, F.G, (int)blockIdx.x);
        FILL_RS(FF)
        pg8::EpiFF1 E{SS, UB, FF, RSA, RSB};
        RUN_GEMM(EpiFF1, GeoS128, 8, 128);
    }
    if constexpr (PH == 5 || PH == 10) {
        pg8::Gemm g{UB, (const pg8::bf16_t*)(ws + WS_W2 + (PH == 10 ? 8 * MiB : 0)), M, 1024, FF}; pg8::StaticOrder S; S.init(MP, 1024, F.G, (int)blockIdx.x);
        pg8::EpiRes E{HB, SS, 1.f};
        RUN_GEMM(EpiRes, GeoS64, 16, 64);
    }
    if constexpr (PH == 6) {
        pg8::Gemm g{HB, (const pg8::bf16_t*)(ws + WS_WKVQ), M, 3072, 1024}; pg8::StaticOrder S; S.init(MP, 3072, F.G, (int)blockIdx.x);
        FILL_RS(3072)
        pg8::EpiKVQ E{SS, QB, KB, args.out, RSA, RSB};
        RUN_GEMM(EpiKVQ, GeoS128, 8, 128);
    }
    if constexpr (PH == 7) {
        at::Ctx C{QB, KB, VB, OB, args.in[4], args.in[5], nullptr, nullptr, args.in[14], nullptr, 0.f};
        for (int vv = F.vcu; vv < 256; vv += F.G) {
            if (STREAM == 0) at::attn_sample_unit<true>(F.lds, vv >> 3, vv & 7, C);
            else {
                at::bf16x8 qr[4]; bool pre = false;
#pragma unroll 1
                for (int i = 0; i < 4; ++i) { const int bhh = vv >> 1, par = vv & 1, qb = 4 * (i >> 1) + ((i & 1) ? 3 - par : par); const bool hn = i < 3; const int i2 = i + 1, qb2 = 4 * (i2 >> 1) + ((i2 & 1) ? 3 - par : par);
                    at::attn_prompt_unit<true>(F.lds, bhh >> 4, bhh & 15, qb, C, qr, pre, hn, bhh >> 4, bhh & 15, qb2); pre = hn; } }
        }
    }
    if constexpr (PH == 11) final_norm(F, args, STREAM == 0 ? MP : 0, STREAM == 0 ? M : MP);
#undef FILL_RS
#undef RUN_GEMM
}
__global__ void __launch_bounds__(NWAVES * 64, 2) skel_fwd(Args args) {
    extern __shared__ __attribute__((aligned(16))) unsigned char lds[];
    Frame F;
    F.lds = (LAS unsigned char*)lds;
    F.MISC = (volatile LAS unsigned*)(F.lds + MISC_OFF);
    F.tid = threadIdx.x; F.lane = F.tid & 63; F.wave = __builtin_amdgcn_readfirstlane(F.tid >> 6);
    F.G = gridDim.x; { const int bx = blockIdx.x; F.vcu = (F.G % 8 == 0) ? (bx % 8) * (F.G / 8) + bx / 8 : bx; }
    F.ctl = (gu32*)(args.ws + WS_CTL);
    for (int u = F.tid; u < (LDS_BYTES - LDSCTL_OFF) / 4; u += NWAVES * 64) ((LAS unsigned*)(F.lds + LDSCTL_OFF))[u] = 0u;
    __syncthreads();
    XcdBarrier bar = xcd_barrier_post((unsigned*)(F.ctl + CW_BAR), F.MISC + 8);
    SplitBar sbS{(unsigned*)(F.ctl + CW_BAR) + 4096, 0u}, sbP{(unsigned*)(F.ctl + CW_BAR) + 8192, 0u};
    p0_prologue(F, args);
    xcd_barrier(bar);
#ifdef PROBE_PART
#define RT_ST(v) asm volatile("s_memrealtime %0\n\ts_waitcnt lgkmcnt(0)" : "=s"(v) :: "memory")
    unsigned long long part_acc = 0;
#define TIMED_PART(k, s) do { unsigned long long a_, b_; RT_ST(a_); run_part<k, s>(F, args); RT_ST(b_); if ((k) * 2 + (s) == PROBE_PART) part_acc += b_ - a_; } while (0)
#else
#define TIMED_PART(k, s) run_part<k, s>(F, args)
#endif
#define DO_PHASE(k, FIRST) do { if (!(FIRST)) sbar_wait(sbS, bar); TIMED_PART(k, 0); sbar_arrive(sbS, bar); \
                                 if (!(FIRST)) sbar_wait(sbP, bar); TIMED_PART(k, 1); sbar_arrive(sbP, bar); } while (0)
    DO_PHASE(1, true); DO_PHASE(2, false); DO_PHASE(3, false); DO_PHASE(4, false); DO_PHASE(5, false); DO_PHASE(6, false); DO_PHASE(7, false); DO_PHASE(8, false); DO_PHASE(9, false); DO_PHASE(10, false);
#undef DO_PHASE
    sbar_wait(sbS, bar); run_part<11, 0>(F, args);
    sbar_wait(sbP, bar); run_part<11, 1>(F, args);
#ifdef PROBE_PART
    if (blockIdx.x == PROBE_BLK && F.tid == 0) { unsigned long long t0; RT_ST(t0); for (;;) { unsigned long long t1; RT_ST(t1); if (t1 - t0 >= part_acc) break; __builtin_amdgcn_s_sleep(8); } }
#endif
}

extern "C" void kernel_launch(void* const* d_in, const int* in_sizes, int n_in, void* d_out, int out_size, void* d_ws, size_t ws_size, hipStream_t stream) {
    static int grid = 0;
    if (grid == 0) {
        if (n_in != 20 || out_size != (int)O_END || ws_size < WS_END) { fprintf(stderr, "kernel_launch: unexpected problem (n_in %d out %d ws %zu)\n", n_in, out_size, ws_size); grid = -1; return; }
        int dev = 0, cus = 0, per_cu = 0;
        if (hipGetDevice(&dev) != hipSuccess || hipDeviceGetAttribute(&cus, hipDeviceAttributeMultiprocessorCount, dev) != hipSuccess) { grid = -1; return; }
        if (hipFuncSetAttribute((const void*)skel_fwd, hipFuncAttributeMaxDynamicSharedMemorySize, LDS_BYTES) != hipSuccess) { fprintf(stderr, "kernel_launch: hipFuncSetAttribute failed\n"); grid = -1; return; }
        if (hipOccupancyMaxActiveBlocksPerMultiprocessor(&per_cu, (const void*)skel_fwd, NWAVES * 64, LDS_BYTES) != hipSuccess || per_cu < 1) { fprintf(stderr, "kernel_launch: occupancy query reports %d\n", per_cu); per_cu = 1; }
        (void)hipGetLastError();
        grid = cus;
        if (grid > 256) grid = 256;
    }
    if (grid < 0) return;
    (void)hipMemsetAsync((char*)d_ws + WS_CTL, 0, CTL_ZERO_BYTES, stream);
    Args a{};
    for (int i = 0; i < 20; ++i) a.in[i] = (const float*)d_in[i];
    a.out = (float*)d_out; a.ws = (unsigned char*)d_ws;
    hipLaunchKernelGGL(skel_fwd, dim3(grid), dim3(NWAVES * 64), LDS_BYTES, stream, a);
}
```

```cpp
#include <hip/hip_runtime.h>
#include <cstdio>
#include <cstdint>
#include <cmath>
namespace pg8 {
__device__ __forceinline__ int opaque_tid() { int t = threadIdx.x; asm volatile("" : "+v"(t)); return t; }
#define PG8_LAS __attribute__((address_space(3)))
typedef unsigned short bf16_t;
typedef short bf16x8 __attribute__((ext_vector_type(8)));
typedef float f32x4 __attribute__((ext_vector_type(4)));
typedef unsigned u32x4 __attribute__((ext_vector_type(4)));
constexpr int BM = 256, BK = 64, HALF = 128, HTB = HALF * BK * 2  , STAGE_BYTES = 8 * HTB, NXCD = 8, WGM = 8;

__host__ __device__ __forceinline__ int lds_byte(int r, int c) { const int st = (r >> 4) * 2 + (c >> 5), rr = r & 15, cc = c & 31, ob = rr * 64 + cc * 2; return st * 1024 + (ob ^ (((ob >> 9) & 1) << 5)); }
__host__ __device__ __forceinline__ void stage_rc(int b, int& R, int& C) { const int st = b / 1024, sb = b % 1024, swz = sb ^ (((sb >> 9) & 1) << 5); R = (st >> 1) * 16 + swz / 64; C = (st & 1) * 32 + (swz % 64) / 2; }
__host__ __device__ __forceinline__ int perm32(int rho) { const int n = rho >> 4, i = rho & 15; return 8 * (i >> 2) + 4 * n + (i & 3); }

struct Unit { int pm, pn; };
struct Gemm { const bf16_t* A; const bf16_t* Bt; int M, N, K; };

struct StaticOrder {
    int nM, nN, nwg, G, c;
    __host__ __device__ void init(int M, int N, int G_, int c_) { nM = M / BM; nN = N / BM; nwg = nM * nN; G = G_; c = c_; }
    __host__ __device__ bool next(int i, Unit& u) const {
        const long L = (long)i * G + c; if (L >= nwg) return false;
        int wgid = (int)L; { const int q = nwg / NXCD, r = nwg % NXCD, xcd = wgid % NXCD, off = wgid / NXCD; wgid = (xcd < r ? xcd * (q + 1) : r * (q + 1) + (xcd - r) * q) + off; }
        const int nig = WGM * nN, gid = wgid / nig, fm = gid * WGM, gsz = (nM - fm) < WGM ? (nM - fm) : WGM;
        u.pm = fm + ((wgid % nig) % gsz); u.pn = (wgid % nig) / gsz; return true;
    }
    __device__ __forceinline__ void a_ready(const Unit&) const {}
    __device__ __forceinline__ void done(const Unit&) const {}
};
__device__ __forceinline__ unsigned cvt_pk_bf16(float lo, float hi) { unsigned r; asm volatile("v_cvt_pk_bf16_f32 %0, %1, %2" : "=v"(r) : "v"(lo), "v"(hi)); return r; }
typedef float f32x2 __attribute__((ext_vector_type(2)));

constexpr size_t PO_AKP = 17825792, PO_AVP = 34603008, PO_BKP = 51380224, PO_BVP = 55574528, PO_AKS = 59768832, PO_AVS = 60817408, PO_BKS = 61865984, PO_BVS = 62914560;
constexpr size_t PW_KV = (size_t)36 * 1048576 / 2;
constexpr int P_MP = 16384;
constexpr float P_EPS = 1e-6f;
constexpr float P_C2 = 0.125f * 1.4426950408889634f;
typedef unsigned u32x2 __attribute__((ext_vector_type(2)));
struct GeoBig  { static constexpr int NAI = 2, NBJ = 2, NM = 4, NN = 2, RS_WR = 64, CS_WC = 32, WCN = 4; };
struct GeoS128 { static constexpr int NAI = 1, NBJ = 1, NM = 4, NN = 2, RS_WR = 64, CS_WC = 32, WCN = 4; };
struct GeoS12864 { static constexpr int NAI = 1, NBJ = 1, NM = 2, NN = 2, RS_WR = 32, CS_WC = 32, WCN = 2; };
struct GeoS64  { static constexpr int NAI = 1, NBJ = 1, NM = 1, NN = 2, RS_WR = 16, CS_WC = 32, WCN = 2; };
struct Tile { int row0, col0; };

template <class G>
__device__ __forceinline__ void row_rstd(const float* SS, int row0, int fq, float (&rs)[2][4]) {
#pragma unroll
    for (int ai = 0; ai < G::NAI; ++ai)
#pragma unroll
        for (int m = 0; m < G::NM; ++m) {
            const f32x4 v = *(const f32x4*)(SS + (size_t)(row0 + ai * HALF + m * 16) * 16 + 4 * fq);
            float s = (v[0] + v[1]) + (v[2] + v[3]);
            s += __shfl_xor(s, 16); s += __shfl_xor(s, 32);
            rs[ai][m] = 1.0f / sqrtf(s * (1.0f / 1024.0f) + P_EPS);
        }
}
struct RsTab { PG8_LAS const float* t; int row0, nrows; };
__device__ __forceinline__ void rs_fill(const float* SS, PG8_LAS float* t, int row0, int nrows) {
    const int r = threadIdx.x;
    if (r < nrows) {
        const f32x4* p = (const f32x4*)(SS + (size_t)(row0 + r) * 16);
        const f32x4 a = p[0], b = p[1], c = p[2], d = p[3];
        const float s = (((a[0] + a[1]) + (a[2] + a[3])) + ((b[0] + b[1]) + (b[2] + b[3]))) + (((c[0] + c[1]) + (c[2] + c[3])) + ((d[0] + d[1]) + (d[2] + d[3])));
        t[r] = 1.0f / sqrtf(s * (1.0f / 1024.0f) + P_EPS);
    }
}
template <class G>
__device__ __forceinline__ void row_rstd_tab(const RsTab& R, const float* SS, int tile_row0, int row0, int fq, float (&rs)[2][4]) {
    if (tile_row0 >= R.row0 && tile_row0 + (G::NAI == 2 ? 256 : 128) <= R.row0 + R.nrows) {
#pragma unroll
        for (int ai = 0; ai < G::NAI; ++ai)
#pragma unroll
            for (int m = 0; m < G::NM; ++m) rs[ai][m] = R.t[row0 - R.row0 + ai * HALF + m * 16];
    } else row_rstd<G>(SS, row0, fq, rs);
}

struct EpiQKV {
    static constexpr bool PERM = false, AFTER_DRAIN = false;
    const float* SS; const float* cs;
    bf16_t *Qb, *Kb, *Vb; float* out;
    RsTab rsA, rsB;
    __device__ __forceinline__ void operator()(const f32x4 (&acc)[2][2][4][2], const Unit& u, int wr, int wc, int fr, int fq) const { run<GeoBig>(acc, Tile{u.pm * BM, u.pn * BM}, wr, wc, fr, fq, nullptr); }
    template <class G> __device__ __forceinline__ void run(const f32x4 (&acc)[2][2][4][2], const Tile T, int wr, int wc, int fr, int fq, PG8_LAS float* scr) const {
        const int row0 = T.row0 + wr * G::RS_WR + fr;
        float rs[2][4]; row_rstd_tab<G>(G::NAI == 2 ? rsA : rsB, SS, T.row0, row0, fq, rs);
        const int sec = T.col0 >> 10, ct = T.col0 & 1023;
        const bool smp = T.row0 >= P_MP;
#pragma unroll
        for (int ai = 0; ai < G::NAI; ++ai)
#pragma unroll
            for (int m = 0; m < G::NM; ++m) {
                const int row = row0 + ai * HALF + m * 16; const float r = rs[ai][m];
                const int pos = smp ? (1024 + ((row - P_MP) & 31)) : (row & 2047);
                const size_t orow = smp ? (size_t)(row - P_MP) * 1024 : (size_t)row * 1024;
                if (sec < 2) {
                    const int dl = 16 * (wc & 1) + 4 * fq;
                    const f32x4 c4 = *(const f32x4*)(cs + (size_t)pos * 64 + dl), s4 = *(const f32x4*)(cs + (size_t)pos * 64 + 32 + dl);
#pragma unroll
                    for (int bj = 0; bj < G::NBJ; ++bj) {
                        const int col = ct + 128 * bj + 64 * (wc >> 1) + dl;
                        const f32x4 x1 = acc[ai][bj][m][0] * r, x2 = acc[ai][bj][m][1] * r;
                        f32x4 y1 = x1 * c4 - x2 * s4, y2 = x2 * c4 + x1 * s4;
                        if (sec == 0) {
                            y1 = y1 * P_C2; y2 = y2 * P_C2;
                            u32x2 w1, w2; w1.x = cvt_pk_bf16(y1[0], y1[1]); w1.y = cvt_pk_bf16(y1[2], y1[3]); w2.x = cvt_pk_bf16(y2[0], y2[1]); w2.y = cvt_pk_bf16(y2[2], y2[3]);
                            *(u32x2*)(Qb + (size_t)row * 1024 + col) = w1; *(u32x2*)(Qb + (size_t)row * 1024 + col + 32) = w2;
                        } else {
                            if (smp) { float* ok = out + PO_AKS + orow + col;
                                __builtin_nontemporal_store(y1, (f32x4*)ok); __builtin_nontemporal_store(y2, (f32x4*)(ok + 32)); }
                            u32x2 w1, w2; w1.x = cvt_pk_bf16(y1[0], y1[1]); w1.y = cvt_pk_bf16(y1[2], y1[3]); w2.x = cvt_pk_bf16(y2[0], y2[1]); w2.y = cvt_pk_bf16(y2[2], y2[3]);
                            *(u32x2*)(Kb + (size_t)row * 1024 + col) = w1; *(u32x2*)(Kb + (size_t)row * 1024 + col + 32) = w2;
                        }
                    }
                } else {
#pragma unroll
                    for (int bj = 0; bj < G::NBJ; ++bj)
#pragma unroll
                        for (int n = 0; n < G::NN; ++n) {
                            const int col = ct + 128 * bj + G::CS_WC * wc + 16 * n + 4 * fq;
                            const f32x4 v = acc[ai][bj][m][n] * r;
                            if (smp) __builtin_nontemporal_store(v, (f32x4*)(out + PO_AVS + orow + col));
                            u32x2 w; w.x = cvt_pk_bf16(v[0], v[1]); w.y = cvt_pk_bf16(v[2], v[3]);
                            *(u32x2*)(Vb + (size_t)row * 1024 + col) = w;
                        }
                }
            }
    }
};

struct EpiKVQ {
    static constexpr bool PERM = true, AFTER_DRAIN = false;
    const float* SS; bf16_t *Qb, *Kb; float* out;
    RsTab rsA, rsB;
    __device__ __forceinline__ void operator()(const f32x4 (&acc)[2][2][4][2], const Unit& u, int wr, int wc, int fr, int fq) const { run<GeoBig>(acc, Tile{u.pm * BM, u.pn * BM}, wr, wc, fr, fq, nullptr); }
    template <class G> __device__ __forceinline__ void run(const f32x4 (&acc)[2][2][4][2], const Tile T, int wr, int wc, int fr, int fq, PG8_LAS float* scr) const {
        const int row0 = T.row0 + wr * G::RS_WR + fr;
        float rs[2][4]; row_rstd_tab<G>(G::NAI == 2 ? rsA : rsB, SS, T.row0, row0, fq, rs);
        const int sec = T.col0 >> 10, ct = T.col0 & 1023;
        const bool smp = T.row0 >= P_MP;
        const int col0 = ct + wc * 32 + 8 * fq;
#pragma unroll
        for (int ai = 0; ai < G::NAI; ++ai)
#pragma unroll
            for (int m = 0; m < G::NM; ++m) {
                const int row = row0 + ai * HALF + m * 16; const float r = rs[ai][m];
                const size_t orow = (size_t)(row - P_MP) * 1024;
#pragma unroll
                for (int bj = 0; bj < G::NBJ; ++bj) {
                    const int col = col0 + bj * HALF;
                    f32x4 v0 = acc[ai][bj][m][0] * r, v1 = acc[ai][bj][m][1] * r;
                    if (sec == 2) {
                        v0 = v0 * P_C2; v1 = v1 * P_C2;
                        u32x4 w; w.x = cvt_pk_bf16(v0[0], v0[1]); w.y = cvt_pk_bf16(v0[2], v0[3]); w.z = cvt_pk_bf16(v1[0], v1[1]); w.w = cvt_pk_bf16(v1[2], v1[3]);
                        *(u32x4*)(Qb + (size_t)row * 1024 + col) = w;
                    } else {
                        if (smp) { float* op = out + (sec == 0 ? PO_BKS : PO_BVS) + orow + col; __builtin_nontemporal_store(v0, (f32x4*)op); __builtin_nontemporal_store(v1, (f32x4*)(op + 4)); }
                        u32x4 w; w.x = cvt_pk_bf16(v0[0], v0[1]); w.y = cvt_pk_bf16(v0[2], v0[3]); w.z = cvt_pk_bf16(v1[0], v1[1]); w.w = cvt_pk_bf16(v1[2], v1[3]);
                        *(u32x4*)(Kb + (sec == 0 ? (size_t)0 : PW_KV) + (size_t)row * 1024 + col) = w;
                    }
                }
            }
    }
};

struct EpiRes {
    static constexpr bool PERM = true, AFTER_DRAIN = false;
    bf16_t* Hb; float* SS; float sc;
    __device__ __forceinline__ void operator()(const f32x4 (&acc)[2][2][4][2], const Unit& u, int wr, int wc, int fr, int fq) const { run<GeoBig>(acc, Tile{u.pm * BM, u.pn * BM}, wr, wc, fr, fq, nullptr); }
    template <class G> __device__ __forceinline__ void run(const f32x4 (&acc)[2][2][4][2], const Tile T, int wr, int wc, int fr, int fq, PG8_LAS float* scr) const {
        const int row0 = T.row0 + wr * G::RS_WR + fr, col0 = T.col0 + wc * 32 + 8 * fq;
#pragma unroll
        for (int ai = 0; ai < G::NAI; ++ai)
#pragma unroll
            for (int m = 0; m < G::NM; ++m) {
                const int row = row0 + ai * HALF + m * 16;
                float ssq = 0.f;
#pragma unroll
                for (int bj = 0; bj < G::NBJ; ++bj) {
                    bf16_t* p = Hb + (size_t)row * 1024 + col0 + bj * HALF;
                    const u32x4 o = *(const u32x4*)p;
                    f32x4 h0 = acc[ai][bj][m][0] * sc, h1 = acc[ai][bj][m][1] * sc;
                    h0[0] += __uint_as_float(o.x << 16); h0[1] += __uint_as_float(o.x & 0xffff0000u); h0[2] += __uint_as_float(o.y << 16); h0[3] += __uint_as_float(o.y & 0xffff0000u);
                    h1[0] += __uint_as_float(o.z << 16); h1[1] += __uint_as_float(o.z & 0xffff0000u); h1[2] += __uint_as_float(o.w << 16); h1[3] += __uint_as_float(o.w & 0xffff0000u);
                    u32x4 w; w.x = cvt_pk_bf16(h0[0], h0[1]); w.y = cvt_pk_bf16(h0[2], h0[3]); w.z = cvt_pk_bf16(h1[0], h1[1]); w.w = cvt_pk_bf16(h1[2], h1[3]);
                    *(u32x4*)p = w;
                    ssq += ((h0[0] * h0[0] + h0[1] * h0[1]) + (h0[2] * h0[2] + h0[3] * h0[3])) + ((h1[0] * h1[0] + h1[1] * h1[1]) + (h1[2] * h1[2] + h1[3] * h1[3]));
                }
                ssq += __shfl_xor(ssq, 16); ssq += __shfl_xor(ssq, 32);
                if (G::WCN == 4) { if (fq == 0) SS[(size_t)row * 16 + (T.col0 >> 8) * 4 + wc] = ssq; }
                else { if (fq == 0) scr[(wr * G::RS_WR + m * 16 + fr) * 2 + wc] = ssq; }
            }
        if (G::WCN != 4) {
            __syncthreads();
            const int t_ = threadIdx.x;
            if (t_ < (8 / G::WCN) * G::RS_WR) SS[(size_t)(T.row0 + t_) * 16 + (T.col0 >> 6)] = scr[t_ * 2] + scr[t_ * 2 + 1];
            __syncthreads();
        }
    }
};

struct EpiResFinal {
    static constexpr bool PERM = true, AFTER_DRAIN = true;
    const bf16_t* Hb; float* SS; float* out; const float* gf; unsigned* cnt; unsigned* tmo;
    __device__ __forceinline__ void fused(f32x4 (&acc)[2][2][4][2], const Unit& u, int wr, int wc, int fr, int fq, PG8_LAS unsigned char* lds, int wid, int lane) const { run<GeoBig>(acc, Tile{u.pm * BM, u.pn * BM}, wr, wc, fr, fq, (PG8_LAS float*)lds); }
    template <class G> __device__ __forceinline__ void run(f32x4 (&acc)[2][2][4][2], const Tile T, int wr, int wc, int fr, int fq, PG8_LAS float* scr) const {
        const int row0 = T.row0 + wr * G::RS_WR + fr, col0 = T.col0 + wc * 32 + 8 * fq;
        const int tid = threadIdx.x, lane = tid & 63, wid = __builtin_amdgcn_readfirstlane(tid >> 6);
#pragma unroll
        for (int ai = 0; ai < G::NAI; ++ai)
#pragma unroll
            for (int m = 0; m < G::NM; ++m) {
                const int row = row0 + ai * HALF + m * 16;
                float ssq = 0.f;
#pragma unroll
                for (int bj = 0; bj < G::NBJ; ++bj) {
                    const u32x4 o = *(const u32x4*)(Hb + (size_t)row * 1024 + col0 + bj * HALF);
                    f32x4 h0 = acc[ai][bj][m][0], h1 = acc[ai][bj][m][1];
                    h0[0] += __uint_as_float(o.x << 16); h0[1] += __uint_as_float(o.x & 0xffff0000u); h0[2] += __uint_as_float(o.y << 16); h0[3] += __uint_as_float(o.y & 0xffff0000u);
                    h1[0] += __uint_as_float(o.z << 16); h1[1] += __uint_as_float(o.z & 0xffff0000u); h1[2] += __uint_as_float(o.w << 16); h1[3] += __uint_as_float(o.w & 0xffff0000u);
                    acc[ai][bj][m][0] = h0; acc[ai][bj][m][1] = h1;
                    ssq += ((h0[0] * h0[0] + h0[1] * h0[1]) + (h0[2] * h0[2] + h0[3] * h0[3])) + ((h1[0] * h1[0] + h1[1] * h1[1]) + (h1[2] * h1[2] + h1[3] * h1[3]));
                }
                ssq += __shfl_xor(ssq, 16); ssq += __shfl_xor(ssq, 32);
                if (G::WCN == 4) { if (fq == 0) __hip_atomic_store(SS + (size_t)row * 16 + (T.col0 >> 8) * 4 + wc, ssq, __ATOMIC_RELAXED, __HIP_MEMORY_SCOPE_AGENT); }
                else { if (fq == 0) scr[(wr * G::RS_WR + m * 16 + fr) * 2 + wc] = ssq; }
            }
        unsigned* c; unsigned want;
        if (G::WCN == 4) {
            c = cnt + 64 * (T.row0 >> 8); want = 32u;
            asm volatile("s_waitcnt vmcnt(0)" ::: "memory");
            if (lane == 0) __hip_atomic_fetch_add(c, 1u, __ATOMIC_RELAXED, __HIP_MEMORY_SCOPE_AGENT);
        } else {
            c = cnt + 64 * (64 + ((T.row0 - P_MP) >> 6)); want = 16u;
            __syncthreads();
            if (tid < 64) __hip_atomic_store(SS + (size_t)(T.row0 + tid) * 16 + (T.col0 >> 6), scr[tid * 2] + scr[tid * 2 + 1], __ATOMIC_RELAXED, __HIP_MEMORY_SCOPE_AGENT);
            asm volatile("s_waitcnt vmcnt(0)" ::: "memory");
            if (tid == 0) __hip_atomic_fetch_add(c, 1u, __ATOMIC_RELAXED, __HIP_MEMORY_SCOPE_AGENT);
        }
        if (wid == 0) {
            const unsigned long long t0 = __builtin_amdgcn_s_memrealtime();
            for (;;) {
                if ((unsigned)__builtin_amdgcn_readfirstlane((int)__hip_atomic_load(c, __ATOMIC_RELAXED, __HIP_MEMORY_SCOPE_AGENT)) >= want) break;
                if (__builtin_amdgcn_s_memrealtime() - t0 > 2000000ull) { if (lane == 0) __hip_atomic_store(tmo, 1u, __ATOMIC_RELAXED, __HIP_MEMORY_SCOPE_AGENT); break; }
                __builtin_amdgcn_s_sleep(2);
            }
            __builtin_amdgcn_fence(__ATOMIC_ACQUIRE, "agent");
            asm volatile("s_waitcnt vmcnt(0)" ::: "memory");
        }
        __syncthreads();
        f32x4 gv[2][2];
#pragma unroll
        for (int bj = 0; bj < G::NBJ; ++bj) { gv[bj][0] = *(const f32x4*)(gf + col0 + bj * HALF); gv[bj][1] = *(const f32x4*)(gf + col0 + bj * HALF + 4); }
#pragma unroll
        for (int ai = 0; ai < G::NAI; ++ai)
#pragma unroll
            for (int m = 0; m < G::NM; ++m) {
                const int row = row0 + ai * HALF + m * 16;
                const f32x4 v = *(const f32x4*)(SS + (size_t)row * 16 + 4 * fq);
                float s = (v[0] + v[1]) + (v[2] + v[3]);
                s += __shfl_xor(s, 16); s += __shfl_xor(s, 32);
                const float r = 1.0f / sqrtf(s * (1.0f / 1024.0f) + P_EPS);
#pragma unroll
                for (int bj = 0; bj < G::NBJ; ++bj) { float* op = out + (size_t)row * 1024 + col0 + bj * HALF;
                    *(f32x4*)op = acc[ai][bj][m][0] * gv[bj][0] * r; *(f32x4*)(op + 4) = acc[ai][bj][m][1] * gv[bj][1] * r; }
            }
        if (G::WCN != 4) __syncthreads();
    }
};

struct EpiFF1 {
    static constexpr bool PERM = true, AFTER_DRAIN = false;
    const float* SS; bf16_t* U; int ldc;
    RsTab rsA, rsB;
    __device__ __forceinline__ void operator()(const f32x4 (&acc)[2][2][4][2], const Unit& u, int wr, int wc, int fr, int fq) const { run<GeoBig>(acc, Tile{u.pm * BM, u.pn * BM}, wr, wc, fr, fq, nullptr); }
    template <class G> __device__ __forceinline__ void run(const f32x4 (&acc)[2][2][4][2], const Tile T, int wr, int wc, int fr, int fq, PG8_LAS float* scr) const {
        const int row0 = T.row0 + wr * G::RS_WR + fr;
        float rs[2][4]; row_rstd_tab<G>(G::NAI == 2 ? rsA : rsB, SS, T.row0, row0, fq, rs);
        const int col0 = T.col0 + wc * 32 + 8 * fq;
#pragma unroll
        for (int ai = 0; ai < G::NAI; ++ai)
#pragma unroll
            for (int m = 0; m < G::NM; ++m) {
                const float r = rs[ai][m]; bf16_t* rowp = U + (size_t)(row0 + ai * HALF + m * 16) * ldc + col0;
#pragma unroll
                for (int bj = 0; bj < G::NBJ; ++bj) {
                    f32x4 v0 = acc[ai][bj][m][0] * r, v1 = acc[ai][bj][m][1] * r;
#pragma unroll
                    for (int i = 0; i < 4; ++i) { const float a = fmaxf(v0[i], 0.f), b = fmaxf(v1[i], 0.f); v0[i] = a * a; v1[i] = b * b; }
                    u32x4 w; w.x = cvt_pk_bf16(v0[0], v0[1]); w.y = cvt_pk_bf16(v0[2], v0[3]); w.z = cvt_pk_bf16(v1[0], v1[1]); w.w = cvt_pk_bf16(v1[2], v1[3]);
                    *(u32x4*)(rowp + bj * HALF) = w;
                }
            }
    }
};
template <class Epi, class Sched, bool ALIGN_EPI = false, bool SP2 = false>
__device__ __forceinline__ void gemm_phase(PG8_LAS unsigned char* lds, const Gemm g, const Sched& S, const Epi& E) {
    const int tid = opaque_tid(), wid = __builtin_amdgcn_readfirstlane(tid >> 6), lane = tid & 63, wr = wid >> 2, wc = wid & 3, fr = lane & 15, fq = lane >> 4;
    const int K = g.K, nt = K / BK;
    unsigned voffA[2], voffB[2];
#pragma unroll
    for (int i = 0; i < 2; ++i) { int R, C; stage_rc(tid * 16 + i * 8192, R, C); const int Rb = Epi::PERM ? ((R & ~31) + perm32(R & 31)) : R;
        voffA[i] = (unsigned)(R * K + C) * 2u; voffB[i] = (unsigned)(Rb * K + C) * 2u; }
    const size_t kstep = (size_t)(BK * 2);
    const size_t hstep = (size_t)HALF * K * 2;
    const size_t tstep = 2 * hstep;
    const unsigned ldsw = (unsigned)wid * 1024u;
    const int aoff = lds_byte(wr * 64 + fr, fq * 8), boff = lds_byte(wc * 32 + fr, fq * 8);
#define PG8_SA(b, h) (((b) * 2 + (h)) * HTB)
#define PG8_SB(b, h) ((4 + (b) * 2 + (h)) * HTB)
#define PG8_STAGE(bufoff, gbase, voff) do { _Pragma("unroll") for (int _i = 0; _i < 2; ++_i) \
        __builtin_amdgcn_global_load_lds((const unsigned*)((const char*)(gbase) + (voff)[_i]), (PG8_LAS unsigned*)(lds + (bufoff) + ldsw + _i * 8192), 16, 0, 0); } while (0)
#define PG8_LDA(dst, b, h) do { _Pragma("unroll") for (int m = 0; m < 4; ++m) _Pragma("unroll") for (int k = 0; k < 2; ++k) dst[m][k] = *(const PG8_LAS bf16x8*)(lds + PG8_SA(b, h) + aoff + m * 2048 + k * 1024); } while (0)
#define PG8_LDB(dst, b, h) do { _Pragma("unroll") for (int n = 0; n < 2; ++n) _Pragma("unroll") for (int k = 0; k < 2; ++k) dst[n][k] = *(const PG8_LAS bf16x8*)(lds + PG8_SB(b, h) + boff + n * 2048 + k * 1024); } while (0)
#define PG8_MMA(ai, bj, At, Bt) do { __builtin_amdgcn_s_setprio(1); _Pragma("unroll") for (int m = 0; m < 4; ++m) _Pragma("unroll") for (int n = 0; n < 2; ++n) _Pragma("unroll") for (int k = 0; k < 2; ++k) \
        acc[ai][bj][m][n] = __builtin_amdgcn_mfma_f32_16x16x32_bf16(Bt[n][k], At[m][k], acc[ai][bj][m][n], 0, 0, 0); __builtin_amdgcn_s_setprio(0); } while (0)
#define PG8_WAIT_V(n) asm volatile("s_waitcnt vmcnt(" #n ")" ::: "memory")
#define PG8_WAIT_L(n) asm volatile("s_waitcnt lgkmcnt(" #n ")" ::: "memory")
#define PG8_BAR __builtin_amdgcn_s_barrier()
#define PG8_SCHED __builtin_amdgcn_sched_barrier(0)
    Unit cur, nxt; int ui = 0;
    if (!S.next(0, cur)) return;
    f32x4 acc[2][2][4][2];
#pragma unroll
    for (int a = 0; a < 2; ++a)
#pragma unroll
        for (int b = 0; b < 2; ++b)
#pragma unroll
            for (int m = 0; m < 4; ++m)
#pragma unroll
                for (int n = 0; n < 2; ++n) acc[a][b][m][n] = (f32x4){0.f, 0.f, 0.f, 0.f};
    bf16x8 At[4][2], B0[2][2], B1[2][2];
    const char* cA = (const char*)g.A + (size_t)cur.pm * tstep; const char* cB = (const char*)g.Bt + (size_t)cur.pn * tstep;
    S.a_ready(cur);
    if constexpr (SP2) {
        PG8_STAGE(PG8_SB(0, 0), cB, voffB); PG8_STAGE(PG8_SB(0, 1), cB + hstep, voffB); PG8_STAGE(PG8_SA(0, 0), cA, voffA); PG8_STAGE(PG8_SA(0, 1), cA + hstep, voffA);
        if (wr == 1) PG8_BAR;
        PG8_WAIT_V(2); PG8_BAR;
        PG8_STAGE(PG8_SB(1, 0), cB + kstep, voffB); PG8_STAGE(PG8_SA(1, 0), cA + kstep, voffA); PG8_STAGE(PG8_SB(1, 1), cB + hstep + kstep, voffB);
        PG8_WAIT_V(6); PG8_BAR;
    } else {
        PG8_STAGE(PG8_SB(0, 0), cB, voffB); PG8_STAGE(PG8_SA(0, 0), cA, voffA); PG8_STAGE(PG8_SB(0, 1), cB + hstep, voffB); PG8_STAGE(PG8_SA(0, 1), cA + hstep, voffA);
        if (wr == 1) PG8_BAR;
        PG8_WAIT_V(4); PG8_BAR;
        PG8_STAGE(PG8_SB(1, 0), cB + kstep, voffB); PG8_STAGE(PG8_SA(1, 0), cA + kstep, voffA); PG8_STAGE(PG8_SB(1, 1), cB + hstep + kstep, voffB);
        PG8_WAIT_V(6); PG8_BAR;
    }
    for (;;) {
        const bool has_next = S.next(ui + 1, nxt);
        const char* nA = has_next ? (const char*)g.A + (size_t)nxt.pm * tstep : cA; const char* nB = has_next ? (const char*)g.Bt + (size_t)nxt.pn * tstep : cB;
        for (int t = 0; t < nt; t += 2) {
            const bool last = (t == nt - 2);
            const char* a1 = cA + (size_t)(t + 1) * kstep;
            const char* a2 = last ? nA : cA + (size_t)(t + 2) * kstep; const char* b2 = last ? nB : cB + (size_t)(t + 2) * kstep;
            const char* a3 = a2 + kstep; const char* b3 = b2 + kstep;
            if (last && has_next) S.a_ready(nxt);
            if constexpr (SP2) {
            PG8_LDB(B0, 0, 0); PG8_LDB(B1, 0, 1); PG8_SCHED; PG8_LDA(At, 0, 0); PG8_STAGE(PG8_SA(1, 1), a1 + hstep, voffA);
            PG8_WAIT_V(8); PG8_WAIT_L(0); PG8_BAR; PG8_MMA(0, 0, At, B0); PG8_MMA(0, 1, At, B1); PG8_BAR; PG8_SCHED;
            PG8_LDA(At, 0, 1); PG8_STAGE(PG8_SB(0, 0), b2, voffB); PG8_STAGE(PG8_SB(0, 1), b2 + hstep, voffB); PG8_STAGE(PG8_SA(0, 0), a2, voffA);
            PG8_WAIT_V(8); PG8_WAIT_L(0); PG8_BAR; PG8_MMA(1, 0, At, B0); PG8_MMA(1, 1, At, B1); PG8_BAR; PG8_SCHED;
            PG8_LDB(B0, 1, 0); PG8_LDB(B1, 1, 1); PG8_SCHED; PG8_LDA(At, 1, 0); PG8_STAGE(PG8_SA(0, 1), a2 + hstep, voffA);
            PG8_WAIT_V(8); PG8_WAIT_L(0); PG8_BAR; PG8_MMA(0, 0, At, B0); PG8_MMA(0, 1, At, B1); PG8_BAR; PG8_SCHED;
            PG8_LDA(At, 1, 1); PG8_STAGE(PG8_SB(1, 0), b3, voffB); PG8_STAGE(PG8_SB(1, 1), b3 + hstep, voffB); PG8_STAGE(PG8_SA(1, 0), a3, voffA);
            PG8_WAIT_V(8); PG8_WAIT_L(0); PG8_BAR; PG8_MMA(1, 0, At, B0); PG8_MMA(1, 1, At, B1); PG8_BAR; PG8_SCHED;
            } else {
            PG8_LDB(B0, 0, 0); PG8_SCHED; PG8_LDA(At, 0, 0); PG8_STAGE(PG8_SA(1, 1), a1 + hstep, voffA);
            PG8_WAIT_L(8); PG8_BAR; PG8_WAIT_L(0); PG8_MMA(0, 0, At, B0); PG8_BAR; PG8_SCHED;
            PG8_LDB(B1, 0, 1); PG8_STAGE(PG8_SB(0, 0), b2, voffB);
            PG8_BAR; PG8_WAIT_L(0); PG8_MMA(0, 1, At, B1); PG8_BAR;
            PG8_LDA(At, 0, 1); PG8_STAGE(PG8_SA(0, 0), a2, voffA);
            PG8_BAR; PG8_WAIT_L(0); PG8_MMA(1, 0, At, B0); PG8_BAR; PG8_SCHED;
            PG8_STAGE(PG8_SB(0, 1), b2 + hstep, voffB);
            PG8_WAIT_V(6); PG8_BAR; PG8_MMA(1, 1, At, B1); PG8_BAR;
            PG8_LDB(B0, 1, 0); PG8_SCHED; PG8_LDA(At, 1, 0); PG8_STAGE(PG8_SA(0, 1), a2 + hstep, voffA);
            PG8_WAIT_L(8); PG8_BAR; PG8_WAIT_L(0); PG8_MMA(0, 0, At, B0); PG8_BAR; PG8_SCHED;
            PG8_LDB(B1, 1, 1); PG8_STAGE(PG8_SB(1, 0), b3, voffB);
            PG8_BAR; PG8_WAIT_L(0); PG8_MMA(0, 1, At, B1); PG8_BAR;
            PG8_LDA(At, 1, 1); PG8_STAGE(PG8_SA(1, 0), a3, voffA);
            PG8_BAR; PG8_WAIT_L(0); PG8_MMA(1, 0, At, B0); PG8_BAR; PG8_SCHED;
            PG8_STAGE(PG8_SB(1, 1), b3 + hstep, voffB);
            PG8_WAIT_V(6); PG8_BAR; PG8_MMA(1, 1, At, B1); PG8_BAR;
            }
        }
        if constexpr (ALIGN_EPI) { if (wr == 0) PG8_BAR; }
        if constexpr (!Epi::AFTER_DRAIN) { E(acc, cur, wr, wc, fr, fq); S.done(cur); }
        if (!has_next) break;
#pragma unroll
        for (int a = 0; a < 2; ++a)
#pragma unroll
            for (int b = 0; b < 2; ++b)
#pragma unroll
                for (int m = 0; m < 4; ++m)
#pragma unroll
                    for (int n = 0; n < 2; ++n) acc[a][b][m][n] = (f32x4){0.f, 0.f, 0.f, 0.f};
        cur = nxt; cA = nA; cB = nB; ++ui;
        if constexpr (ALIGN_EPI) { if (wr == 1) PG8_BAR; }
    }
    PG8_WAIT_V(0);
    if constexpr (!ALIGN_EPI) { if (wr == 0) PG8_BAR; }
    PG8_BAR;
    if constexpr (Epi::AFTER_DRAIN) { E.fused(acc, cur, wr, wc, fr, fq, lds, wid, lane); S.done(cur); }
#undef PG8_SA
#undef PG8_SB
#undef PG8_STAGE
#undef PG8_LDA
#undef PG8_LDB
#undef PG8_MMA
#undef PG8_WAIT_V
#undef PG8_WAIT_L
#undef PG8_BAR
#undef PG8_SCHED
}

__device__ __forceinline__ int small_first_tile(int vcu, int nt, int nwg) {
    if (nwg == 256 && nt < 256 && (nt & 63) == 0) { const int per = nt >> 3, j = vcu & 31; return j < per ? (vcu >> 5) * per + j : nt; }
    return vcu;
}
template <class G, class Epi>
__device__ __forceinline__ void gemm_small(PG8_LAS unsigned char* lds, const bf16_t* A, const bf16_t* Bt, int K, int row_base, int ntm, int ntn, int vcu, int nwg, const Epi& E) {
    constexpr int TM = (8 / G::WCN) * G::RS_WR * (G::NM * 16 / G::RS_WR), TN = G::WCN * G::CS_WC, SBK = 64, STG = (TM + TN) * 128, NPA = TM / 64, NPB = TN / 64, NP = NPA + NPB;
    static_assert(NP == 4 || NP == 3 || NP == 2, "gemm_small: 128 x 128, 128 x 64 or 64 x 64 tiles");
    const int tid = opaque_tid(), wid = __builtin_amdgcn_readfirstlane(tid >> 6), lane = tid & 63, wr = wid / G::WCN, wc = wid % G::WCN, fr = lane & 15, fq = lane >> 4;
    const int nk = K / SBK;
    for (int tile = small_first_tile(vcu, ntm * ntn, nwg); tile < ntm * ntn; tile += nwg) {
        const int tm = tile % ntm, tn = tile / ntm;
        const bf16_t* Ab = A + (size_t)(row_base + tm * TM) * K; const bf16_t* Bb = Bt + (size_t)(tn * TN) * K;
        f32x4 acc[2][2][4][2];
#pragma unroll
        for (int m = 0; m < G::NM; ++m)
#pragma unroll
            for (int n = 0; n < G::NN; ++n) acc[0][0][m][n] = (f32x4){0.f, 0.f, 0.f, 0.f};
        unsigned goff[NP];
#pragma unroll
        for (int i = 0; i < NP; ++i) { const bool isB = i >= NPA; const int p = wid + 8 * (isB ? i - NPA : i), R = 8 * p + (lane >> 3), c = (lane & 7) ^ ((R >> 1) & 7);
            const int Rs = (isB && Epi::PERM) ? ((R & ~31) + perm32(R & 31)) : R; goff[i] = (unsigned)Rs * K + c * 8; }
#define SM_DMA(stage, kt_) do { _Pragma("unroll") for (int i = 0; i < NP; ++i) { const bool isB = i >= NPA; const int p = wid + 8 * (isB ? i - NPA : i); \
            __builtin_amdgcn_global_load_lds((const unsigned*)((isB ? Bb : Ab) + goff[i] + (size_t)(kt_) * SBK), (PG8_LAS unsigned*)(lds + (stage) * STG + (isB ? TM * 128 : 0) + p * 1024), 16, 0, 0); } } while (0)
#define SM_WAIT(n) asm volatile("s_waitcnt vmcnt(" #n ")" ::: "memory")
#define SM_MMA(stage) do { PG8_LAS unsigned char* sb = lds + (stage) * STG; \
            _Pragma("unroll") for (int kh = 0; kh < 2; ++kh) { bf16x8 af[G::NM], bfr[G::NN]; \
                _Pragma("unroll") for (int m = 0; m < G::NM; ++m) { const int R = wr * G::RS_WR + m * 16 + fr; af[m] = *(const PG8_LAS bf16x8*)(sb + R * 128 + (((kh * 4 + fq) ^ ((R >> 1) & 7)) * 16)); } \
                _Pragma("unroll") for (int n = 0; n < G::NN; ++n) { const int R = wc * G::CS_WC + n * 16 + fr; bfr[n] = *(const PG8_LAS bf16x8*)(sb + TM * 128 + R * 128 + (((kh * 4 + fq) ^ ((R >> 1) & 7)) * 16)); } \
                _Pragma("unroll") for (int m = 0; m < G::NM; ++m) _Pragma("unroll") for (int n = 0; n < G::NN; ++n) acc[0][0][m][n] = __builtin_amdgcn_mfma_f32_16x16x32_bf16(bfr[n], af[m], acc[0][0][m][n], 0, 0, 0); } } while (0)
#define SM_STEP(s, kt_) do { if ((kt_) + 2 < nk) { if (NP == 4) SM_WAIT(8); else if (NP == 3) SM_WAIT(6); else SM_WAIT(4); } else if ((kt_) + 1 < nk) { if (NP == 4) SM_WAIT(4); else if (NP == 3) SM_WAIT(3); else SM_WAIT(2); } else SM_WAIT(0); \
            asm volatile("s_waitcnt lgkmcnt(0)" ::: "memory"); __builtin_amdgcn_s_barrier(); asm volatile("" ::: "memory"); \
            if ((kt_) + 3 < nk) SM_DMA(((s) + 3) & 3, (kt_) + 3); \
            __builtin_amdgcn_s_setprio(1); SM_MMA(s); __builtin_amdgcn_s_setprio(0); } while (0)
        SM_DMA(0, 0); SM_DMA(1, 1); SM_DMA(2, 2);
        for (int kt = 0; kt < nk; kt += 4) { SM_STEP(0, kt); SM_STEP(1, kt + 1); SM_STEP(2, kt + 2); SM_STEP(3, kt + 3); }
#undef SM_DMA
#undef SM_WAIT
#undef SM_MMA
#undef SM_STEP
        asm volatile("s_waitcnt lgkmcnt(0)" ::: "memory"); __builtin_amdgcn_s_barrier(); asm volatile("" ::: "memory");
        E.template run<G>(acc, Tile{row_base + tm * TM, tn * TN}, wr, wc, fr, fq, (PG8_LAS float*)(lds + 4 * STG));
    }
}
}
#define GAS __attribute__((address_space(1)))
#define LAS __attribute__((address_space(3)))
typedef unsigned short bf16;
typedef unsigned v4u __attribute__((ext_vector_type(4)));
typedef float f32x4 __attribute__((ext_vector_type(4)));
typedef short bf16x8 __attribute__((ext_vector_type(8)));
typedef GAS unsigned gu32;
typedef GAS unsigned long long gu64;
#define RLX_AGENT __ATOMIC_RELAXED, __HIP_MEMORY_SCOPE_AGENT
#define LDS_WAIT() asm volatile("s_waitcnt lgkmcnt(0)" ::: "memory")
#define VM_WAIT() asm volatile("s_waitcnt vmcnt(0)" ::: "memory")
__device__ __forceinline__ unsigned long long rt() { return __builtin_amdgcn_s_memrealtime(); }
__device__ __forceinline__ unsigned f2bf(float f) { unsigned u = __builtin_bit_cast(unsigned, f); return (u + 0x7fffu + ((u >> 16) & 1u)) >> 16; }
__device__ __forceinline__ unsigned pk2(float lo, float hi) { return f2bf(lo) | (f2bf(hi) << 16); }

#define XB_TMO      128
#define XB_XCNT(j)  (256  + 64 * (j))
#define XB_XSUB(j)  (1280 + 64 * (j))
#define XB_XGEN(j)  (2304 + 64 * (j))
#define XB_TOP      3328
#define XB_TOPGEN   3392
#define XCD_BAR_WORDS 3456
#define XB_SPIN_CAP (1u << 18)

__device__ __forceinline__ unsigned xb_ld(unsigned* p)              { return __hip_atomic_load(p, __ATOMIC_RELAXED, __HIP_MEMORY_SCOPE_AGENT); }
__device__ __forceinline__ unsigned xb_add(unsigned* p, unsigned v) { return __hip_atomic_fetch_add(p, v, __ATOMIC_RELAXED, __HIP_MEMORY_SCOPE_AGENT); }
__device__ __forceinline__ unsigned xb_xcc_id() { return (unsigned)__builtin_amdgcn_s_getreg((3 << 11) | 20) & 0xFu; }
#define XB_SPIN(cond, bar) do { unsigned _sp = 0; while (cond) { __builtin_amdgcn_s_sleep(1); \
    if ((++_sp & 255u) == 0u) { if (xb_ld(&(bar)[XB_TMO])) break; if (_sp > XB_SPIN_CAP) { atomicAdd(&(bar)[XB_TMO], 1u); break; } } } } while (0)

struct XcdBarrier {
    unsigned* bar; unsigned x;
    volatile LAS unsigned* st;
};

__device__ __forceinline__ XcdBarrier xcd_barrier_post(unsigned* bar, volatile LAS unsigned* st) {
    XcdBarrier b; b.bar = bar; b.x = xb_xcc_id(); b.st = st;
    if (threadIdx.x == 0) (void)xb_add(&bar[XB_XCNT(b.x)], 1u);
    return b;
}
__device__ __forceinline__ void xcd_barrier_complete(unsigned* bar, unsigned x, unsigned& nloc, unsigned& nx) {
    const unsigned G = gridDim.x * gridDim.y * gridDim.z;
    unsigned sum, cnt, mine, sp = 0u;
    for (;;) {
        sum = 0u; cnt = 0u; mine = 0u;
#pragma unroll
        for (unsigned j = 0; j < 16; ++j) { const unsigned c = xb_ld(&bar[XB_XCNT(j)]); sum += c; cnt += (c > 0u) ? 1u : 0u; mine = (j == x) ? c : mine; }
        if (sum == G) break;
        __builtin_amdgcn_s_sleep(1);
        if ((++sp & 255u) == 0u) { if (xb_ld(&bar[XB_TMO])) break; if (sp > XB_SPIN_CAP) { atomicAdd(&bar[XB_TMO], 1u); break; } }
    }
    nloc = mine > 0u ? mine : 1u; nx = cnt > 0u ? cnt : 1u;
}

__device__ __forceinline__ void xcd_barrier(const XcdBarrier& b) {
    asm volatile("s_waitcnt vmcnt(0)" ::: "memory");
    __syncthreads();
    if (threadIdx.x == 0) {
        unsigned* bar = b.bar;
        __builtin_amdgcn_s_waitcnt(0);
        unsigned nloc = b.st[0], nx = b.st[1];
        if (nloc == 0u) { xcd_barrier_complete(bar, b.x, nloc, nx); b.st[0] = nloc; b.st[1] = nx; }
        const unsigned old = xb_add(&bar[XB_XSUB(b.x)], 1u);
        const unsigned gen = old / nloc;
        if (old + 1u == (gen + 1u) * nloc) {
#ifndef PROBE_NOWBL2
            __builtin_amdgcn_fence(__ATOMIC_RELEASE, "agent");
#endif
            asm volatile("s_waitcnt vmcnt(0)" ::: "memory");
            const unsigned og = xb_add(&bar[XB_TOP], 1u);
            const unsigned tg = og / nx;
            if (og + 1u == (tg + 1u) * nx) xb_add(&bar[XB_TOPGEN], 1u);
            else XB_SPIN(xb_ld(&bar[XB_TOPGEN]) == tg, bar);
            __builtin_amdgcn_fence(__ATOMIC_ACQUIRE, "agent");
            xb_add(&bar[XB_XGEN(b.x)], 1u);
            asm volatile("s_waitcnt vmcnt(0)" ::: "memory");
        } else {
            XB_SPIN(xb_ld(&bar[XB_XGEN(b.x)]) == gen, bar);
            __builtin_amdgcn_fence(__ATOMIC_ACQUIRE, "agent");
            asm volatile("s_waitcnt vmcnt(0)" ::: "memory");
        }
    }
    __syncthreads();
}

#ifndef B_LOCKSTEP
#define B_LOCKSTEP 1
#endif
#ifndef THR_VALUE
#define THR_VALUE 8.0f
#endif
namespace at {
#define AT_LAS __attribute__((address_space(3)))
typedef short bf16x8 __attribute__((ext_vector_type(8)));
typedef short s16x4 __attribute__((ext_vector_type(4)));
typedef float f32x16 __attribute__((ext_vector_type(16)));
typedef float f32x4 __attribute__((ext_vector_type(4)));
typedef unsigned u32x4 __attribute__((ext_vector_type(4)));
typedef unsigned u32x2 __attribute__((ext_vector_type(2)));
typedef unsigned short bf16_t;
constexpr int MP = 16384, PITCH = 1024, SEQ = 2048;
constexpr int KCS = 1040;
constexpr int KT_BYTES = 8 * KCS;
constexpr float THR = THR_VALUE;
constexpr int WSF_OFF = 132096;
constexpr int QIMG_OFF = 99328;
__device__ __forceinline__ int crow(int r, int hi) { return (r & 3) + 8 * (r >> 2) + 4 * hi; }
__device__ __forceinline__ unsigned cvtpk(float lo, float hi) { typedef float f2 __attribute__((ext_vector_type(2))); typedef __bf16 b2 __attribute__((ext_vector_type(2))); f2 v = {lo, hi}; b2 b = __builtin_convertvector(v, b2); return __builtin_bit_cast(unsigned, b); }
__device__ __forceinline__ s16x4 vtr(const AT_LAS unsigned char* p) { typedef short v4i16_t __attribute__((ext_vector_type(4))); return __builtin_bit_cast(s16x4, __builtin_amdgcn_ds_read_tr16_b64_v4i16((AT_LAS v4i16_t*)p)); }
#define AT_SYNC() __syncthreads()

template <bool QLDS>
__device__ __forceinline__ void qk_tile(f32x16& p0, f32x16& p1, const AT_LAS unsigned char* kt, const bf16x8 (&qr_)[4], const AT_LAS unsigned char* qimg, int r32, int hi) {
    p0 = f32x16{}; p1 = f32x16{};
#pragma unroll
    for (int d0 = 0; d0 < 4; ++d0) {
        bf16x8 qr[4]; if (QLDS) qr[d0] = *(const AT_LAS bf16x8*)(qimg + (2 * d0 + hi) * 512 + r32 * 16); else qr[d0] = qr_[d0];
        const bf16x8 a0 = *(const AT_LAS bf16x8*)(kt + (2 * d0 + hi) * KCS + r32 * 16);
        const bf16x8 a1 = *(const AT_LAS bf16x8*)(kt + (2 * d0 + hi) * KCS + r32 * 16 + 512);
        p0 = __builtin_amdgcn_mfma_f32_32x32x16_bf16(a0, qr[d0], p0, 0, 0, 0);
        p1 = __builtin_amdgcn_mfma_f32_32x32x16_bf16(a1, qr[d0], p1, 0, 0, 0);
    }
}
template <int ND0>
__device__ __forceinline__ void softmax_tile(f32x16& p0, f32x16& p1, float& m, float& l, f32x16 (&o)[ND0], AT_LAS float* wsf, int r32, int hi) {
    float rm = fmaxf(p0[0], p1[0]);
#pragma unroll
    for (int r = 1; r < 16; ++r) rm = fmaxf(rm, fmaxf(p0[r], p1[r]));
    rm = fmaxf(rm, __shfl_xor(rm, 32));
    if (__any(rm > m + THR)) {
        const float mn = fmaxf(m, rm), f = __builtin_amdgcn_exp2f(m - mn);
        l *= f; m = mn;
        if (hi == 0) wsf[r32] = f;
        asm volatile("s_waitcnt lgkmcnt(0)" ::: "memory");
#pragma unroll
        for (int r = 0; r < 16; ++r) { const float fr_ = wsf[crow(r, hi)];
#pragma unroll
            for (int d0 = 0; d0 < ND0; ++d0) o[d0][r] *= fr_; }
        asm volatile("s_waitcnt lgkmcnt(0)" ::: "memory");
    }
    float s = 0.f;
#pragma unroll
    for (int r = 0; r < 16; ++r) { p0[r] = __builtin_amdgcn_exp2f(p0[r] - m); p1[r] = __builtin_amdgcn_exp2f(p1[r] - m); s += p0[r] + p1[r]; }
    l += s;
}
__device__ __forceinline__ void pack_p(bf16x8 (&pa)[4], const f32x16& p0, const f32x16& p1) {
#pragma unroll
    for (int ks = 0; ks < 4; ++ks) {
        u32x4 w;
        if (ks < 2) { const int b = 8 * ks; w.x = cvtpk(p0[b], p0[b + 1]); w.y = cvtpk(p0[b + 2], p0[b + 3]); w.z = cvtpk(p0[b + 4], p0[b + 5]); w.w = cvtpk(p0[b + 6], p0[b + 7]); }
        else { const int b = 8 * (ks - 2); w.x = cvtpk(p1[b], p1[b + 1]); w.y = cvtpk(p1[b + 2], p1[b + 3]); w.z = cvtpk(p1[b + 4], p1[b + 5]); w.w = cvtpk(p1[b + 6], p1[b + 7]); }
        pa[ks] = __builtin_bit_cast(bf16x8, w);
    }
}
template <int ND0>
__device__ __forceinline__ void pv_packed(f32x16 (&o)[ND0], const AT_LAS unsigned char* vt, const bf16x8 (&pa)[4], int lane, int hi) {
    const AT_LAS unsigned char* vb = vt + ((lane >> 4) & 1) * 32 + (lane & 3) * 8 + (4 * hi + ((lane & 15) >> 2)) * 64;
#pragma unroll
    for (int d0 = 0; d0 < ND0; ++d0)
#pragma unroll
        for (int ks = 0; ks < 4; ++ks) {
            const s16x4 lo = vtr(vb + d0 * 4096 + ks * 1024), hh = vtr(vb + d0 * 4096 + ks * 1024 + 512);
            const bf16x8 bfr = {lo[0], lo[1], lo[2], lo[3], hh[0], hh[1], hh[2], hh[3]};
            o[d0] = __builtin_amdgcn_mfma_f32_32x32x16_bf16(pa[ks], bfr, o[d0], 0, 0, 0);
        }
}
template <int ND0>
__device__ __forceinline__ void pv_tile(f32x16 (&o)[ND0], const AT_LAS unsigned char* vt, const f32x16& p0, const f32x16& p1, int lane, int hi) {
    bf16x8 pa[4]; pack_p(pa, p0, p1); pv_packed<ND0>(o, vt, pa, lane, hi);
}
__device__ __forceinline__ u32x4 ld16(const void* p) { return *(const u32x4*)p; }
__device__ __forceinline__ u32x4 ld16nt(const void* p) { return __builtin_nontemporal_load((const u32x4*)p); }
__device__ __forceinline__ u32x2 f4_to_bf4(u32x4 v) { u32x2 w; w.x = cvtpk(__uint_as_float(v.x), __uint_as_float(v.y)); w.y = cvtpk(__uint_as_float(v.z), __uint_as_float(v.w)); return w; }

struct Ctx {
    const bf16_t *Q, *K, *V; bf16_t* O;
    const float *cache_k, *cache_v;
    const float *lam_p, *subln;
    const float* rel;
    void* stamp;
    float lam;
    float* kvout;
};
__device__ __forceinline__ float diff_lambda(const float* lp) {
    const int lane = threadIdx.x & 63;
    float sa = lp[lane] * lp[64 + lane], sc = lp[128 + lane] * lp[192 + lane];
#pragma unroll
    for (int o_ = 1; o_ < 64; o_ <<= 1) { sa += __shfl_xor(sa, o_); sc += __shfl_xor(sc, o_); }
    return __expf(sa) - __expf(sc) + 0.2f;
}
#ifndef PROBE_CLK
#define PROBE_CLK() __builtin_amdgcn_s_memtime()
#endif
#ifndef PROBE_STAMP_B
#define PROBE_STAMP_B 1
#endif
#ifndef PROBE_BLK
#define PROBE_BLK 0
#endif
#ifndef PROBE_TID
#define PROBE_TID 0
#endif

template <int NK, int DV>
__device__ __forceinline__ void ld_bf(u32x4 (&st)[NK + DV / 64], const bf16_t* kbase, const bf16_t* vbase, int nrows, int tid) {
    const int row = tid >> 3, ch = tid & 7; const unsigned koff = (unsigned)row * PITCH + ch * 8;
#pragma unroll
    for (int c = 0; c < NK; ++c) st[c] = (row < nrows) ? ld16(kbase + koff + c * 64) : (u32x4){0u, 0u, 0u, 0u};
    if (DV == 64) { st[NK] = (row < nrows) ? ld16(vbase + koff) : (u32x4){0u, 0u, 0u, 0u}; }
    else {
        const int vrow = tid >> 4; const unsigned voff = (unsigned)vrow * PITCH + (tid & 15) * 8;
#pragma unroll
        for (int i = 0; i < 2; ++i) st[NK + i] = (vrow + 32 * i < nrows) ? ld16(vbase + voff + (size_t)i * 32 * PITCH) : (u32x4){0u, 0u, 0u, 0u};
    }
}
template <int NK, int DV>
__device__ __forceinline__ void wr_bf(const u32x4 (&st)[NK + DV / 64], AT_LAS unsigned char* sb, int tid) {
    const int row = tid >> 3, ch = tid & 7;
#pragma unroll
    for (int c = 0; c < NK; ++c) *(AT_LAS u32x4*)(sb + c * KT_BYTES + ch * KCS + row * 16) = st[c];
    AT_LAS unsigned char* vb = sb + NK * KT_BYTES;
    if (DV == 64) { const int col = ch * 8; *(AT_LAS u32x4*)(vb + ((col >> 5) * 4 + (row >> 4)) * 1024 + (row & 15) * 64 + (col & 31) * 2) = st[NK]; }
    else {
        const int vrow = tid >> 4, col = (tid & 15) * 8;
#pragma unroll
        for (int i = 0; i < 2; ++i) *(AT_LAS u32x4*)(vb + ((col >> 5) * 4 + ((vrow + 32 * i) >> 4)) * 1024 + (vrow & 15) * 64 + (col & 31) * 2) = st[NK + i];
    }
}
__device__ __forceinline__ void glds16(const void* gsrc, unsigned lds_dst) { unsigned keep;
    asm volatile("s_mov_b32 %0, m0\n\ts_mov_b32 m0, %2\n\ts_nop 0\n\tglobal_load_lds_dwordx4 %1, off\n\ts_mov_b32 m0, %0" : "=&s"(keep) : "v"(gsrc), "s"(lds_dst) : "memory"); }
template <int NK, int DV>
__device__ __forceinline__ void dma_bf(const bf16_t* kbase, const bf16_t* vbase, AT_LAS unsigned char* sb, int w, int lane) {
    const unsigned s0 = (unsigned)__builtin_amdgcn_readfirstlane((int)(unsigned)(uintptr_t)sb);
#pragma unroll
    for (int c = 0; c < NK; ++c) glds16(kbase + (size_t)lane * PITCH + c * 64 + w * 8, (unsigned)__builtin_amdgcn_readfirstlane((int)(s0 + c * KT_BYTES + w * KCS)));
#pragma unroll
    for (int i = 0; i < DV / 64; ++i) { const int d0 = 2 * i + (w >> 2), rg = w & 3;
        glds16(vbase + (size_t)(16 * rg + (lane >> 2)) * PITCH + d0 * 32 + (lane & 3) * 8, (unsigned)__builtin_amdgcn_readfirstlane((int)(s0 + NK * KT_BYTES + (d0 * 4 + rg) * 1024))); }
}
__device__ __forceinline__ void dma_prompt(const bf16_t* kbase, const bf16_t* vbase, AT_LAS unsigned char* sb, int w, int lane) {
    const unsigned s0 = (unsigned)__builtin_amdgcn_readfirstlane((int)(unsigned)(uintptr_t)sb);
#pragma unroll
    for (int i = 0; i < 2; ++i) { const int j = 2 * w + i, R = 4 * j + (lane >> 4), c = (lane & 15) ^ (R & 15);
        glds16(kbase + (size_t)R * PITCH + c * 8, (unsigned)__builtin_amdgcn_readfirstlane((int)(s0 + j * 1024))); }
#pragma unroll
    for (int i = 0; i < 2; ++i) { const int d0 = 2 * i + (w >> 2), rg = w & 3;
        glds16(vbase + (size_t)(16 * rg + (lane >> 2)) * PITCH + d0 * 32 + (lane & 3) * 8, (unsigned)__builtin_amdgcn_readfirstlane((int)(s0 + 16384 + (d0 * 4 + rg) * 1024))); }
}
__device__ __forceinline__ void dma_promptB(const bf16_t* kbase, const bf16_t* vbase, AT_LAS unsigned char* sb, int w, int lane) {
    const unsigned s0 = (unsigned)__builtin_amdgcn_readfirstlane((int)(unsigned)(uintptr_t)sb);
    { const int R = 8 * w + (lane >> 3), c = (lane & 7) ^ ((R >> 1) & 7);
      glds16(kbase + (size_t)R * PITCH + c * 8, (unsigned)__builtin_amdgcn_readfirstlane((int)(s0 + w * 1024))); }
    { const int d0 = w >> 2, rg = w & 3;
      glds16(vbase + (size_t)(16 * rg + (lane >> 2)) * PITCH + d0 * 32 + (lane & 3) * 8, (unsigned)__builtin_amdgcn_readfirstlane((int)(s0 + 8192 + (d0 * 4 + rg) * 1024))); }
}
template <int NK, int DV>
__device__ __forceinline__ void ld_f32(u32x4 (&st)[2 * NK + DV / 32], const float* kbase, const float* vbase, int tid) {
    { const unsigned off = (unsigned)(tid >> 4) * 1024 + (tid & 15) * 4;
#pragma unroll
      for (int c = 0; c < NK; ++c)
#pragma unroll
          for (int i = 0; i < 2; ++i) st[c * 2 + i] = ld16nt(kbase + off + c * 64 + (size_t)i * 32 * 1024); }
    if (DV == 64) { const unsigned off = (unsigned)(tid >> 4) * 1024 + (tid & 15) * 4;
#pragma unroll
        for (int i = 0; i < 2; ++i) st[2 * NK + i] = ld16nt(vbase + off + (size_t)i * 32 * 1024); }
    else { const unsigned off = (unsigned)(tid >> 5) * 1024 + (tid & 31) * 4;
#pragma unroll
        for (int i = 0; i < 4; ++i) st[2 * NK + i] = ld16nt(vbase + off + (size_t)i * 16 * 1024); }
}
template <int NK, int DV>
__device__ __forceinline__ void wr_f32(const u32x4 (&st)[2 * NK + DV / 32], AT_LAS unsigned char* sb, int tid) {
    { const int row = tid >> 4, c4 = tid & 15;
#pragma unroll
      for (int c = 0; c < NK; ++c)
#pragma unroll
          for (int i = 0; i < 2; ++i) *(AT_LAS u32x2*)(sb + c * KT_BYTES + (c4 >> 1) * KCS + (row + 32 * i) * 16 + (c4 & 1) * 8) = f4_to_bf4(st[c * 2 + i]); }
    AT_LAS unsigned char* vb = sb + NK * KT_BYTES;
    if (DV == 64) { const int row = tid >> 4, col = (tid & 15) * 4;
#pragma unroll
        for (int i = 0; i < 2; ++i) *(AT_LAS u32x2*)(vb + ((col >> 5) * 4 + ((row + 32 * i) >> 4)) * 1024 + (row & 15) * 64 + (col & 31) * 2) = f4_to_bf4(st[2 * NK + i]); }
    else { const int row = tid >> 5, col = (tid & 31) * 4;
#pragma unroll
        for (int i = 0; i < 4; ++i) *(AT_LAS u32x2*)(vb + ((col >> 5) * 4 + ((row + 16 * i) >> 4)) * 1024 + (row & 15) * 64 + (col & 31) * 2) = f4_to_bf4(st[2 * NK + i]); }
}

constexpr int A_STAGE = 2 * KT_BYTES + 16384;
constexpr int A_TP = 132;
constexpr int S_TAB = WSF_OFF + 2048;
template <bool ISB>
__device__ __forceinline__ void attn_sample_unit(AT_LAS unsigned char* lds, int b, int cg, const Ctx& C) {
    constexpr int ND0 = ISB ? 2 : 4, NT = ISB ? 8 : 16, PAST = ISB ? 512 : 1024;
    const int tid = pg8::opaque_tid(), lane = tid & 63, r32 = lane & 31, hi = lane >> 5;
    const int w = __builtin_amdgcn_readfirstlane(tid >> 6), g = w >> 2;
    AT_LAS float* wsf = (AT_LAS float*)(lds + WSF_OFF) + w * 64;
    AT_LAS float* tab = (AT_LAS float*)(lds + S_TAB) + g * 264;
    const bool active = (w & 3) == 0;
    const int qrow0 = MP + b * 32, qpos = 1024 + r32;
    if (ISB) { for (int i = tid; i < 2 * 257; i += 512) { const int hh = i >= 257 ? 1 : 0, j = i - hh * 257; ((AT_LAS float*)(lds + S_TAB))[hh * 264 + j] = C.rel[(2 * cg + hh) * 257 + j] * 1.4426950408889634f; } }
    const float lam = C.lam;
    bf16x8 qr[4];
    AT_LAS unsigned char* qimg = lds + QIMG_OFF + w * 4096;
#pragma unroll
    for (int d0 = 0; d0 < 4; ++d0) { qr[d0] = *(const bf16x8*)(C.Q + (size_t)(qrow0 + r32) * PITCH + cg * 128 + g * 64 + d0 * 16 + hi * 8);
        *(AT_LAS bf16x8*)(qimg + (2 * d0 + hi) * 512 + r32 * 16) = qr[d0]; }
    f32x16 o[ND0];
#pragma unroll
    for (int d0 = 0; d0 < ND0; ++d0) o[d0] = f32x16{};
    float m = -1e30f, l = 0.f;
    const bf16_t* kb0 = C.K + (size_t)qrow0 * PITCH + cg * 128;
    const bf16_t* vb0 = C.V + (size_t)qrow0 * PITCH + cg * 128;
    const float* kc0 = C.cache_k + (size_t)b * PAST * 1024 + cg * 128;
    const float* vc0 = C.cache_v + (size_t)b * PAST * 1024 + cg * 128;
    u32x4 st[8];
    ld_f32<2, 128>(st, kc0, vc0, tid);
    { u32x4 sn[4]; ld_bf<2, 128>(sn, kb0, vb0, 32, tid); wr_bf<2, 128>(sn, lds + 2 * A_STAGE, tid); }
    for (int t = 0; t < NT; ++t) {
        AT_LAS unsigned char* sb = lds + (t & 1) * A_STAGE;
        wr_f32<2, 128>(st, sb, tid);
        AT_SYNC();
        if (t + 1 < NT) ld_f32<2, 128>(st, kc0 + (size_t)(t + 1) * 64 * 1024, vc0 + (size_t)(t + 1) * 64 * 1024, tid);
        if (active) {
            const int nsub = (t == 0) ? 2 : 1;
#pragma unroll 1
            for (int sub = 0; sub < nsub; ++sub) {
                const AT_LAS unsigned char* sc = sub ? (lds + 2 * A_STAGE) : sb;
                f32x16 p0, p1;
                qk_tile<true>(p0, p1, sc + g * KT_BYTES, qr, qimg, r32, hi);
                if (ISB) {
                    const int kpos0 = sub ? 1024 : 512 + t * 64;
                    if (1024 - (kpos0 + 63) >= 128) { const float cb = tab[256];
#pragma unroll
                        for (int r = 0; r < 16; ++r) { p0[r] += cb; p1[r] += cb; } }
                    else {
#pragma unroll
                        for (int r = 0; r < 16; ++r) { const int rel = qpos - (kpos0 + crow(r, hi));
                            const int i0 = rel < -128 ? -128 : (rel > 128 ? 128 : rel), i1 = (rel - 32) < -128 ? -128 : ((rel - 32) > 128 ? 128 : (rel - 32));
                            p0[r] += tab[i0 + 128]; p1[r] += tab[i1 + 128]; } }
                }
                if (sub) {
#pragma unroll
                    for (int r = 0; r < 16; ++r) p1[r] = -INFINITY;
                }
                softmax_tile<ND0>(p0, p1, m, l, o, wsf, r32, hi);
                pv_tile<ND0>(o, sc + 2 * KT_BYTES + (ISB ? g * 8192 : 0), p0, p1, lane, hi);
            }
        }
    }
    AT_SYNC();
    const float lt = l + __shfl_xor(l, 32);
    if (!ISB) {
        { float inv = 1.0f / lt; if (g == 1) inv *= lam; if (hi == 0) wsf[r32] = inv; asm volatile("s_waitcnt lgkmcnt(0)" ::: "memory"); }
        AT_LAS float* T2 = (AT_LAS float*)lds;
        if (active && g == 1) {
#pragma unroll
            for (int r = 0; r < 16; ++r) { const int q = crow(r, hi); const float f = wsf[q];
#pragma unroll
                for (int d0 = 0; d0 < ND0; ++d0) T2[q * A_TP + d0 * 32 + r32] = o[d0][r] * f; }
        }
        AT_SYNC();
        if (active && g == 0) {
#pragma unroll
            for (int r = 0; r < 16; ++r) { const int q = crow(r, hi); const float f = wsf[q];
#pragma unroll
                for (int d0 = 0; d0 < ND0; ++d0) { const int ix = q * A_TP + d0 * 32 + r32; T2[ix] = o[d0][r] * f - T2[ix]; } }
            asm volatile("s_waitcnt lgkmcnt(0)" ::: "memory");
            const int row = lane & 31, half = lane >> 5;
            f32x4 x[16]; float ss = 0.f;
#pragma unroll
            for (int i = 0; i < 16; ++i) { x[i] = *(const AT_LAS f32x4*)(T2 + row * A_TP + half * 64 + 4 * i); ss += (x[i][0] * x[i][0] + x[i][1] * x[i][1]) + (x[i][2] * x[i][2] + x[i][3] * x[i][3]); }
            ss += __shfl_xor(ss, 32);
            const float rinv = 0.8f / sqrtf(ss * (1.0f / 128.0f) + 1e-6f);
            bf16_t* op = C.O + (size_t)(qrow0 + row) * PITCH + cg * 128 + half * 64;
#pragma unroll
            for (int i = 0; i < 16; i += 2) {
                const f32x4 g0 = *(const f32x4*)(C.subln + half * 64 + 4 * i), g1 = *(const f32x4*)(C.subln + half * 64 + 4 * i + 4);
                const f32x4 y0 = x[i] * g0 * rinv, y1 = x[i + 1] * g1 * rinv;
                u32x4 wv; wv.x = cvtpk(y0[0], y0[1]); wv.y = cvtpk(y0[2], y0[3]); wv.z = cvtpk(y1[0], y1[1]); wv.w = cvtpk(y1[2], y1[3]);
                *(u32x4*)(op + 4 * i) = wv;
            }
        }
    } else if (active) {
        { const float inv = 1.0f / lt; if (hi == 0) wsf[r32] = inv; asm volatile("s_waitcnt lgkmcnt(0)" ::: "memory"); }
        AT_LAS bf16_t* stg = (AT_LAS bf16_t*)lds + g * 2048;
#pragma unroll
        for (int r = 0; r < 16; ++r) { const int q = crow(r, hi); const float f = wsf[q];
#pragma unroll
            for (int d0 = 0; d0 < ND0; ++d0) { const unsigned pk = cvtpk(o[d0][r] * f, 0.f); stg[q * 64 + d0 * 32 + r32] = (bf16_t)(pk & 0xffffu); } }
        asm volatile("s_waitcnt lgkmcnt(0)" ::: "memory");
        bf16_t* op = C.O + (size_t)qrow0 * PITCH + cg * 128 + g * 64;
#pragma unroll
        for (int i = 0; i < 4; ++i) { const int row = i * 8 + (lane >> 3), ch = lane & 7; const u32x4 v = *(const AT_LAS u32x4*)(stg + row * 64 + ch * 8); *(u32x4*)(op + (size_t)row * PITCH + ch * 8) = v; }
    }
    AT_SYNC();
}

constexpr int P_STAGE = 16384 + 16384;
constexpr int P_EPI = 65536;
constexpr int P_WSF = 135168;
constexpr int P_TAB = P_WSF + 2048;
template <bool ISB>
__device__ __forceinline__ void attn_prompt_unit(AT_LAS unsigned char* lds, int b, int cg, int ub, const Ctx& C, bf16x8 (&qr)[4], bool pre, bool has_next, int nb, int ncg, int nub) {
#ifdef PROBE_STAMP
    const unsigned long long tsA_ = PROBE_CLK();
#endif
    constexpr int ND0 = ISB ? 2 : 4, NS = ISB ? 8 : 4, STG = ISB ? 16384 : P_STAGE, DIST = ISB ? 4 : 2, VOFF = ISB ? 8192 : 16384, KR2 = ISB ? 4096 : 8192;
    const int tid = pg8::opaque_tid(), lane = tid & 63, r32 = lane & 31, hi = lane >> 5;
    constexpr bool LOCK = ISB && (B_LOCKSTEP != 0);
    const int w = __builtin_amdgcn_readfirstlane(tid >> 6), g = LOCK ? 0 : (w >> 2), qi = w & 3;
    AT_LAS float* wsf = (AT_LAS float*)(lds + P_WSF) + w * 64;
    AT_LAS float* tab = (AT_LAS float*)(lds + P_TAB);
    const int cw = ISB ? 4 * ub + (w >> 1) : 2 * ub + (qi >> 1);
    const int cc = ISB ? (w >> 1) : 0, jlo = ISB ? (ub == 0 ? 5 : (ub == 1 ? 1 : 0)) : 0;
    const int kt0 = ISB ? 4 * ub - 8 + jlo : 0, NT = ISB ? 9 - jlo : 2 * ub + 2, NTD = ISB ? NT + 3 : NT;
    const int fv = ISB ? ((cw - 8) > 0 ? (cw - 8) : 0) : 0;
    const int qoff = ISB ? ub * 256 + w * 32 : ub * 128 + qi * 32, qrow0 = b * SEQ + qoff, qpos = qoff + r32;
    const int ccol = ISB ? cg * 64 : cg * 128;
    if (!pre) { if (ISB) { if (tid < 320) tab[tid] = C.rel[cg * 257 + (tid < 256 ? tid : 256)] * 1.4426950408889634f; } }
    AT_LAS float* subl = (AT_LAS float*)(lds + P_TAB);
    if (!ISB && !pre) { if (tid < 128) subl[tid] = C.subln[tid]; }
    const float lam = C.lam;
    if (!pre) {
#pragma unroll
        for (int d0 = 0; d0 < 4; ++d0) qr[d0] = *(const bf16x8*)(C.Q + (size_t)(qrow0 + r32) * PITCH + ccol + (ISB ? 0 : g * 64) + d0 * 16 + hi * 8);
    }
    f32x16 o[ND0];
#pragma unroll
    for (int d0 = 0; d0 < ND0; ++d0) o[d0] = f32x16{};
    f32x16 negm = f32x16{};
    float m = 0.f, l = 0.f;
    f32x16 lacc = f32x16{};
    const bf16x8 ones = {(short)0x3f80, (short)0x3f80, (short)0x3f80, (short)0x3f80, (short)0x3f80, (short)0x3f80, (short)0x3f80, (short)0x3f80};
    bf16x8 pa[4];
#pragma unroll
    for (int ks = 0; ks < 4; ++ks) pa[ks] = bf16x8{};
    const bf16_t* kb0 = C.K + (size_t)(b * SEQ) * PITCH + ccol;
    const bf16_t* vb0 = C.V + (size_t)(b * SEQ) * PITCH + ccol;
#define P_DMA(tt) do { if (ISB) { const int gt_ = (kt0 + (tt)) > 0 ? (kt0 + (tt)) : 0; dma_promptB(kb0 + (size_t)gt_ * 64 * PITCH, vb0 + (size_t)gt_ * 64 * PITCH, lds + ((tt) & (NS - 1)) * STG, w, lane); } \
                       else dma_prompt(kb0 + (size_t)(tt) * 64 * PITCH, vb0 + (size_t)(tt) * 64 * PITCH, lds + ((tt) & (NS - 1)) * STG, w, lane); } while (0)
    if (!pre) {
#pragma unroll
        for (int tt = 0; tt < (ISB ? 7 : DIST); ++tt) if (tt < NTD) P_DMA(tt);
    }
    const int vlane = ((lane >> 4) & 1) * 32 + (lane & 3) * 8 + (4 * hi + ((lane & 15) >> 2)) * 64 + VOFF;
    const int klane = ISB ? (r32 * 128 + ((hi ^ ((r32 >> 1) & 7)) << 4)) : (r32 * 256 + (((g * 8 + hi) ^ (r32 & 15)) << 4));
#define P_VRD(buf, blk) do { _Pragma("unroll") for (int ks = 0; ks < 4; ++ks) { buf[2 * ks] = vtr(vp + (blk) * 4096 + ks * 1024); buf[2 * ks + 1] = vtr(vp + (blk) * 4096 + ks * 1024 + 512); } } while (0)
#define P_VMM(buf, blk) do { _Pragma("unroll") for (int ks = 0; ks < 4; ++ks) { const bf16x8 bfr = {buf[2 * ks][0], buf[2 * ks][1], buf[2 * ks][2], buf[2 * ks][3], buf[2 * ks + 1][0], buf[2 * ks + 1][1], buf[2 * ks + 1][2], buf[2 * ks + 1][3]}; \
        o[blk] = __builtin_amdgcn_mfma_f32_32x32x16_bf16(pa[ks], bfr, o[blk], 0, 0, 0); } } while (0)
#define P_SB() __builtin_amdgcn_sched_barrier(0)
#define P_KRD(scur) do { \
        _Pragma("unroll") for (int d0 = 0; d0 < 4; ++d0) { ka[2 * d0] = *(const AT_LAS bf16x8*)(lds + (scur) + (klane ^ (d0 << 5))); ka[2 * d0 + 1] = *(const AT_LAS bf16x8*)(lds + (scur) + (klane ^ (d0 << 5)) + KR2); } } while (0)
#define P_PV(sprev, KRD_STMT) do { const AT_LAS unsigned char* vp = lds + (sprev) + vlane; \
        P_VMM(va, 0); \
        if (ND0 == 4) { P_VRD(va, 2); P_SB(); P_VMM(vb, 1); P_VRD(vb, 3); P_SB(); P_VMM(va, 2); KRD_STMT; P_SB(); P_VMM(vb, 3); } else { KRD_STMT; P_SB(); P_VMM(vb, 1); _Pragma("unroll") for (int ks = 0; ks < 4; ++ks) lacc = __builtin_amdgcn_mfma_f32_32x32x16_bf16(pa[ks], ones, lacc, 0, 0, 0); } P_SB(); } while (0)
#define P_PRE(sprev) do { const AT_LAS unsigned char* vp = lds + (sprev) + vlane; P_VRD(va, 0); P_VRD(vb, 1); } while (0)
#define P_BAR() do { __builtin_amdgcn_sched_barrier(0); asm volatile("s_barrier" ::: "memory"); __builtin_amdgcn_sched_barrier(0); } while (0)
#define P_BAR_V0() do { __builtin_amdgcn_sched_barrier(0); asm volatile("s_waitcnt vmcnt(0)\n\ts_barrier" ::: "memory"); __builtin_amdgcn_sched_barrier(0); } while (0)
#define P_BAR_V2() do { __builtin_amdgcn_sched_barrier(0); asm volatile("s_waitcnt vmcnt(2)\n\ts_barrier" ::: "memory"); __builtin_amdgcn_sched_barrier(0); } while (0)
#define P_BAR_V6() do { __builtin_amdgcn_sched_barrier(0); asm volatile("s_waitcnt vmcnt(6)\n\ts_barrier" ::: "memory"); __builtin_amdgcn_sched_barrier(0); } while (0)
#define P_BAR_V8() do { __builtin_amdgcn_sched_barrier(0); asm volatile("s_waitcnt vmcnt(8)\n\ts_barrier" ::: "memory"); __builtin_amdgcn_sched_barrier(0); } while (0)
#define P_BAR_V4() do { __builtin_amdgcn_sched_barrier(0); asm volatile("s_waitcnt vmcnt(4)\n\ts_barrier" ::: "memory"); __builtin_amdgcn_sched_barrier(0); } while (0)
    if (pre) {
        if (ISB) asm volatile("s_waitcnt vmcnt(4) lgkmcnt(0)\n\ts_barrier" ::: "memory");
        else if (g == 0) asm volatile("s_waitcnt vmcnt(8) lgkmcnt(0)\n\ts_barrier" ::: "memory");
        else asm volatile("s_waitcnt vmcnt(0) lgkmcnt(0)\n\ts_barrier" ::: "memory");
    }
    else asm volatile("s_waitcnt vmcnt(0) lgkmcnt(0)\n\ts_barrier" ::: "memory");
    const float cbv = ISB ? tab[256] : 0.f;
    if (ISB && pre) P_DMA(6);
    if (g == 1) P_BAR();
    f32x16 p0, p1;
    s16x4 va[8], vb[8]; bf16x8 ka[8];
#ifdef PROBE_STAMP
    unsigned long long stamp_acc = 0;
#endif
    P_PRE(cc * STG);
    if (LOCK) P_KRD(cc * STG);
#ifdef PROBE_STAMP
    const unsigned long long tsB_ = PROBE_CLK();
#endif
    for (int t = 0; t < NT; ++t) {
        if (t > 0 && !LOCK) P_BAR();
        __builtin_amdgcn_s_setprio(1);
#ifdef PROBE_STAMP
        const unsigned long long ts0_ = PROBE_CLK();
#endif
        if (LOCK) P_PV((t > 0 ? ((t - 1 + cc) & (NS - 1)) : 0) * STG, (void)0);
        else P_PV((t > 0 ? ((t - 1 + cc) & (NS - 1)) : 0) * STG, P_KRD(((t + cc) & (NS - 1)) * STG));
        p0 = __builtin_amdgcn_mfma_f32_32x32x16_bf16(ka[0], qr[0], negm, 0, 0, 0); p1 = __builtin_amdgcn_mfma_f32_32x32x16_bf16(ka[1], qr[0], negm, 0, 0, 0);
#pragma unroll
        for (int d0 = 1; d0 < 4; ++d0) { p0 = __builtin_amdgcn_mfma_f32_32x32x16_bf16(ka[2 * d0], qr[d0], p0, 0, 0, 0); p1 = __builtin_amdgcn_mfma_f32_32x32x16_bf16(ka[2 * d0 + 1], qr[d0], p1, 0, 0, 0); }
        __builtin_amdgcn_s_setprio(0);
        if (ISB) { const int nn = NT - 2 - t;
            if (nn >= 2) P_BAR_V4(); else if (nn == 1) { if (ub >= 6) P_BAR_V6(); else P_BAR_V2(); } else if (nn == 0) { if (ub >= 6) P_BAR_V8(); else P_BAR_V0(); } else { if (ub >= 6) P_BAR(); else P_BAR_V0(); } }
        else { if (t == NT - 1) P_BAR(); else P_BAR_V0(); }
#ifdef PROBE_STAMP
        const unsigned long long ts1_ = PROBE_CLK();
#endif
        if (ISB) { if (t + 7 < NTD) P_DMA(t + 7); } else if (t + DIST < NT) P_DMA(t + DIST);
        if (LOCK) P_PRE(((t + cc) & (NS - 1)) * STG);
        const int kt = kt0 + t + cc;
        const bool vis = ISB ? (kt >= 0) : (kt <= cw);
        if (vis) {
            if (ISB) {
                const int relmin = cw * 64 + (w & 1) * 32 - (kt * 64 + 63);
                if (relmin >= 128) { }
                else {
                    const AT_LAS float* tb = tab + (128 + (cw - kt) * 64 + (w & 1) * 32 + r32 - 4 * hi);
#pragma unroll
                    for (int r = 0; r < 16; ++r) { p0[r] += tb[-((r & 3) + 8 * (r >> 2))]; p1[r] += tb[-((r & 3) + 8 * (r >> 2)) - 32]; } }
            }
            float ra = __builtin_fmaxf(__builtin_fmaxf(p0[0], p0[1]), p1[0]), rb = __builtin_fmaxf(__builtin_fmaxf(p0[2], p0[3]), p1[1]);
            ra = __builtin_fmaxf(__builtin_fmaxf(ra, p1[2]), p1[3]);
#pragma unroll
            for (int r = 4; r < 16; r += 4) { ra = __builtin_fmaxf(__builtin_fmaxf(ra, p0[r]), p0[r + 1]); rb = __builtin_fmaxf(__builtin_fmaxf(rb, p0[r + 2]), p0[r + 3]);
                                              ra = __builtin_fmaxf(__builtin_fmaxf(ra, p1[r]), p1[r + 1]); rb = __builtin_fmaxf(__builtin_fmaxf(rb, p1[r + 2]), p1[r + 3]); }
            float rm = __builtin_fmaxf(ra, rb);
            { auto rr = __builtin_amdgcn_permlane32_swap(__float_as_uint(rm), __float_as_uint(rm), false, false); rm = __builtin_fmaxf(__uint_as_float(rr[0]), __uint_as_float(rr[1])); }
            const bool first = (kt == fv);
            if (first || __any(rm > THR)) {
                const float dl = first ? rm : __builtin_fmaxf(rm, 0.f);
                m += dl;
#pragma unroll
                for (int r = 0; r < 16; ++r) { p0[r] -= dl; p1[r] -= dl; }
#pragma unroll
                for (int r = 0; r < 16; ++r) negm[r] = -m;
                if (!first) {
                    const float f = __builtin_amdgcn_exp2f(-dl); l *= f;
                    if (hi == 0) wsf[r32] = f;
                    asm volatile("s_waitcnt lgkmcnt(0)" ::: "memory");
#pragma unroll
                    for (int r = 0; r < 16; ++r) { const float fr_ = wsf[crow(r, hi)]; if (ISB) lacc[r] *= fr_;
#pragma unroll
                        for (int d0 = 0; d0 < ND0; ++d0) o[d0][r] *= fr_; }
                    asm volatile("s_waitcnt lgkmcnt(0)" ::: "memory");
                }
            }
            float s = 0.f;
#pragma unroll
            for (int r = 0; r < 16; ++r) { p0[r] = __builtin_amdgcn_exp2f(p0[r]); p1[r] = __builtin_amdgcn_exp2f(p1[r]); if (!ISB) s += p0[r] + p1[r]; }
            l += s;
#ifdef PROBE_S2X
            { float xs = 0.f;
              for (int rep = 0; rep < PROBE_S2X; ++rep) {
#pragma unroll
              for (int r = 0; r < 16; ++r) { xs += __builtin_amdgcn_exp2f(p0[r] - 20.f - xs) + __builtin_amdgcn_exp2f(p1[r] - 21.f - xs); } }
              asm volatile("" :: "v"(xs)); }
#endif
            pack_p(pa, p0, p1);
        } else {
#pragma unroll
            for (int ks = 0; ks < 4; ++ks) pa[ks] = bf16x8{};
        }
        if (!ISB && t >= NT - 2) {
            const AT_LAS unsigned char* sbt = lds + (t & (NS - 1)) * STG;
            float* const ob = C.kvout + (size_t)(b * SEQ + t * 64) * PITCH + ccol;
#pragma unroll
            for (int i = 0; i < 2; ++i) { const int j = 2 * w + i;
#pragma unroll
                for (int h = 0; h < 2; ++h) { const int rr = (lane >> 5) + 2 * h, R = 4 * j + rr, q = lane & 31, c = q >> 1;
                    const u32x2 x = *(const AT_LAS u32x2*)(sbt + j * 1024 + rr * 256 + ((c ^ (R & 15)) << 4) + (q & 1) * 8);
                    const f32x4 y = {__uint_as_float(x.x << 16), __uint_as_float(x.x & 0xffff0000u), __uint_as_float(x.y << 16), __uint_as_float(x.y & 0xffff0000u)};
                    __builtin_nontemporal_store(y, (f32x4*)(ob + pg8::PO_AKP + (size_t)R * PITCH + q * 4)); } }
#pragma unroll
            for (int i = 0; i < 2; ++i) { const int d0 = 2 * i + (w >> 2), rg = w & 3;
#pragma unroll
                for (int h = 0; h < 2; ++h) { const int row = (lane >> 3) + 8 * h, u8 = lane & 7;
                    const u32x2 x = *(const AT_LAS u32x2*)(sbt + 16384 + (d0 * 4 + rg) * 1024 + row * 64 + u8 * 8);
                    const f32x4 y = {__uint_as_float(x.x << 16), __uint_as_float(x.x & 0xffff0000u), __uint_as_float(x.y << 16), __uint_as_float(x.y & 0xffff0000u)};
                    __builtin_nontemporal_store(y, (f32x4*)(ob + pg8::PO_AVP + (size_t)(16 * rg + row) * PITCH + d0 * 32 + u8 * 4)); } }
        }
        if (ISB && t == NT - 4) {
            m += cbv;
#pragma unroll
            for (int r = 0; r < 16; ++r) negm[r] = -m;
        }
        if (ISB && ub >= 6 && t >= NT - 4) {
            const int nt_ = t + 3, kto = kt0 + nt_;
            const AT_LAS unsigned char* sbt = lds + (nt_ & (NS - 1)) * STG;
            float* const ob = C.kvout + ((size_t)b * 512 + (size_t)(kto * 64 - 1536)) * PITCH + ccol;
#pragma unroll
            for (int h = 0; h < 2; ++h) { const int rr = (lane >> 4) + 4 * h, R = 8 * w + rr, q = lane & 15, c = q >> 1;
                const u32x2 x = *(const AT_LAS u32x2*)(sbt + w * 1024 + rr * 128 + ((c ^ ((R >> 1) & 7)) << 4) + (q & 1) * 8);
                const f32x4 y = {__uint_as_float(x.x << 16), __uint_as_float(x.x & 0xffff0000u), __uint_as_float(x.y << 16), __uint_as_float(x.y & 0xffff0000u)};
                __builtin_nontemporal_store(y, (f32x4*)(ob + pg8::PO_BKP + (size_t)R * PITCH + q * 4)); }
            { const int d0 = w >> 2, rg = w & 3;
#pragma unroll
              for (int h = 0; h < 2; ++h) { const int row = (lane >> 3) + 8 * h, u8 = lane & 7;
                const u32x2 x = *(const AT_LAS u32x2*)(sbt + 8192 + (d0 * 4 + rg) * 1024 + row * 64 + u8 * 8);
                const f32x4 y = {__uint_as_float(x.x << 16), __uint_as_float(x.x & 0xffff0000u), __uint_as_float(x.y << 16), __uint_as_float(x.y & 0xffff0000u)};
                __builtin_nontemporal_store(y, (f32x4*)(ob + pg8::PO_BVP + (size_t)(16 * rg + row) * PITCH + d0 * 32 + u8 * 4)); } }
        }
        if (!LOCK) P_PRE(((t + cc) & (NS - 1)) * STG);
        else if (t + 1 < NT) P_KRD(((t + 1 + cc) & (NS - 1)) * STG);
#ifdef PROBE_STAMP
        { const unsigned long long ts2_ = PROBE_CLK(); if (ISB == (PROBE_STAMP_B != 0)) { if (PROBE_STAMP == 1) stamp_acc += ts1_ - ts0_; else if (PROBE_STAMP == 2) stamp_acc += ts2_ - ts1_; else stamp_acc += ts2_ - ts0_; } }
#endif
    }
#ifdef PROBE_STAMP
    const unsigned long long tsC_ = PROBE_CLK();
#endif
    if (!LOCK) P_BAR();
    P_PV(((NT - 1 + cc) & (NS - 1)) * STG, (void)0);
    asm volatile("s_waitcnt lgkmcnt(0)" ::: "memory");
    if (g == 0) P_BAR();
    P_BAR();
    if (has_next) {
        const int nkt0 = ISB ? 4 * nub - 8 + (nub == 0 ? 5 : (nub == 1 ? 1 : 0)) : 0, nNT = 2 * nub + 2, nccol = ISB ? ncg * 64 : ncg * 128;
        const bf16_t* nk0 = C.K + (size_t)(nb * SEQ) * PITCH + nccol; const bf16_t* nv0 = C.V + (size_t)(nb * SEQ) * PITCH + nccol;
#pragma unroll
        for (int tt = 0; tt < (ISB ? 6 : DIST); ++tt) {
            if (ISB) { const int gt_ = (nkt0 + tt) > 0 ? (nkt0 + tt) : 0; dma_promptB(nk0 + (size_t)gt_ * 64 * PITCH, nv0 + (size_t)gt_ * 64 * PITCH, lds + tt * STG, w, lane); }
            else if (tt < nNT) dma_prompt(nk0 + (size_t)tt * 64 * PITCH, nv0 + (size_t)tt * 64 * PITCH, lds + tt * STG, w, lane); }
        const int nqrow0 = nb * SEQ + (ISB ? nub * 256 + w * 32 : nub * 128 + qi * 32);
#pragma unroll
        for (int d0 = 0; d0 < 4; ++d0) qr[d0] = *(const bf16x8*)(C.Q + (size_t)(nqrow0 + r32) * PITCH + nccol + (ISB ? 0 : g * 64) + d0 * 16 + hi * 8);
    }
#undef P_KRD
#undef P_PRE
#undef P_BAR
#undef P_BAR_V0
#undef P_BAR_V2
#undef P_BAR_V4
#undef P_BAR_V6
#undef P_BAR_V8
#undef P_DMA
#undef P_VRD
#undef P_VMM
#undef P_SB
#undef P_PV
    const float lt = l + __shfl_xor(l, 32);
    if (!ISB) {
        { float inv = 1.0f / lt; if (g == 1) inv *= lam; if (hi == 0) wsf[r32] = inv; asm volatile("s_waitcnt lgkmcnt(0)" ::: "memory"); }
        AT_LAS float* T2 = (AT_LAS float*)(lds + P_EPI) + qi * (32 * A_TP);
        if (g == 1) {
#pragma unroll
            for (int r = 0; r < 16; ++r) { const int q = crow(r, hi); const float f = wsf[q];
#pragma unroll
                for (int d0 = 0; d0 < ND0; ++d0) T2[q * A_TP + d0 * 32 + r32] = o[d0][r] * f; }
        }
        asm volatile("s_waitcnt lgkmcnt(0)\n\ts_barrier" ::: "memory");
        if (g == 0) {
#pragma unroll
            for (int r = 0; r < 16; ++r) { const int q = crow(r, hi); const float f = wsf[q];
#pragma unroll
                for (int d0 = 0; d0 < ND0; ++d0) { const int ix = q * A_TP + d0 * 32 + r32; T2[ix] = o[d0][r] * f - T2[ix]; } }
            asm volatile("s_waitcnt lgkmcnt(0)" ::: "memory");
            const int row = lane & 31, half = lane >> 5;
            f32x4 x[16]; float ss = 0.f;
#pragma unroll
            for (int i = 0; i < 16; ++i) { x[i] = *(const AT_LAS f32x4*)(T2 + row * A_TP + half * 64 + 4 * i); ss += (x[i][0] * x[i][0] + x[i][1] * x[i][1]) + (x[i][2] * x[i][2] + x[i][3] * x[i][3]); }
            ss += __shfl_xor(ss, 32);
            const float rinv = 0.8f / sqrtf(ss * (1.0f / 128.0f) + 1e-6f);
            bf16_t* op = C.O + (size_t)(qrow0 + row) * PITCH + cg * 128 + half * 64;
#pragma unroll
            for (int i = 0; i < 16; i += 4) {
                const f32x4 g0 = *(const AT_LAS f32x4*)(subl + half * 64 + 4 * i), g1 = *(const AT_LAS f32x4*)(subl + half * 64 + 4 * i + 4), g2 = *(const AT_LAS f32x4*)(subl + half * 64 + 4 * i + 8), g3 = *(const AT_LAS f32x4*)(subl + half * 64 + 4 * i + 12);
                const f32x4 y0 = x[i] * g0 * rinv, y1 = x[i + 1] * g1 * rinv, y2 = x[i + 2] * g2 * rinv, y3 = x[i + 3] * g3 * rinv;
                u32x4 wv; wv.x = cvtpk(y0[0], y0[1]); wv.y = cvtpk(y0[2], y0[3]); wv.z = cvtpk(y1[0], y1[1]); wv.w = cvtpk(y1[2], y1[3]);
                u32x4 wz; wz.x = cvtpk(y2[0], y2[1]); wz.y = cvtpk(y2[2], y2[3]); wz.z = cvtpk(y3[0], y3[1]); wz.w = cvtpk(y3[2], y3[3]);
                *(u32x4*)(op + 4 * i) = wv; *(u32x4*)(op + 4 * i + 8) = wz;
            }
        }
    } else {
        AT_LAS bf16_t* stg = (AT_LAS bf16_t*)(lds + 6 * 16384) + w * 2048;
#pragma unroll
        for (int r = 0; r < 16; ++r) { const int q = crow(r, hi); const float f = __builtin_amdgcn_rcpf(lacc[r]);
#pragma unroll
            for (int d0 = 0; d0 < ND0; ++d0) { const unsigned pk = cvtpk(o[d0][r] * f, 0.f); stg[q * 64 + d0 * 32 + r32] = (bf16_t)(pk & 0xffffu); } }
        asm volatile("s_waitcnt lgkmcnt(0)" ::: "memory");
        bf16_t* op = C.O + (size_t)qrow0 * PITCH + ccol;
#pragma unroll
        for (int i = 0; i < 4; ++i) { const int row = i * 8 + (lane >> 3), ch = lane & 7; const u32x4 v = *(const AT_LAS u32x4*)(stg + row * 64 + ch * 8); *(u32x4*)(op + (size_t)row * PITCH + ch * 8) = v; }
    }
    asm volatile("s_waitcnt lgkmcnt(0)\n\ts_barrier" ::: "memory");
#ifdef PROBE_STAMP
    { const unsigned long long tsD_ = PROBE_CLK(); if (ISB == (PROBE_STAMP_B != 0)) { if (PROBE_STAMP == 4) stamp_acc = tsB_ - tsA_; else if (PROBE_STAMP == 5) stamp_acc = tsD_ - tsC_; else if (PROBE_STAMP == 6) stamp_acc = tsD_ - tsA_; }
      if (blockIdx.x == PROBE_BLK && tid == PROBE_TID) atomicAdd((unsigned long long*)C.stamp, stamp_acc); }
#endif
}
}

constexpr int NWAVES = 8;
#ifndef MK_N_LAUNCHES
#define MK_N_LAUNCHES 1
#endif
constexpr int N_PHASES = 12;
constexpr int DMODEL = 1024, SEQ = 2048, NBATCH = 8, MP = NBATCH * SEQ, MS = 1024, M = MP + MS, FF = 4096;
constexpr size_t O_Y = 0, O_AKP = 17825792, O_AVP = 34603008, O_BKP = 51380224, O_BVP = 55574528, O_AKS = 59768832, O_AVS = 60817408, O_BKS = 61865984, O_BVS = 62914560, O_END = 63963136;
constexpr size_t MiB = 1u << 20;
constexpr size_t WS_CTL = 0, CTL_ZERO_BYTES = 64 * 1024;
constexpr size_t WS_WQKV = 2 * MiB, WS_WAO = 8 * MiB, WS_WKVQ = 10 * MiB, WS_WBO = 16 * MiB, WS_W1 = 18 * MiB  , WS_W2 = 34 * MiB  ;
constexpr size_t WS_CS = 50 * MiB;
constexpr size_t WS_SS = 51 * MiB;
constexpr size_t WS_HB = 54 * MiB, WS_Q = 90 * MiB, WS_K = 126 * MiB, WS_V = 162 * MiB, WS_O = 198 * MiB;
constexpr size_t WS_U = 234 * MiB;
constexpr size_t WS_END = 372 * MiB;
constexpr int CW_TMO = 0, CW_CODE = 1, CW_BAR = 4096, CW_FIN = 8192;
constexpr int RS_OFF = 139264;
constexpr int RING_OFF = 0, RING_BYTES = 131072, LDS_BYTES = 163840, LDSCTL_OFF = LDS_BYTES - 1024, MISC_OFF = LDSCTL_OFF + 320;

struct Args { const float* in[20]; float* out; unsigned char* ws; int ph_lo, ph_hi, li, pad; };

struct Frame {
    LAS unsigned char* lds; volatile LAS unsigned* MISC; gu32* ctl;
    int tid, lane, wave, vcu, G;
};

__device__ __forceinline__ float wave_sum(float v) {
#pragma unroll
    for (int o = 1; o < 64; o <<= 1) v += __shfl_xor(v, o);
    return v;
}
__device__ __forceinline__ int pi64(int d) { return d < 32 ? 32 * (d >> 4) + (d & 15) : 32 * ((d - 32) >> 4) + 16 + ((d - 32) & 15); }
template <bool PERMQK>
__device__ __forceinline__ void p0_transpose_item(const float* W, const float* g, int K, int N, bf16* WT, int row_off, LAS float* scr, int item, int lane) {
    const int nblk = N / 32, kb = item / nblk, nb = item % nblk, k0 = 64 * kb, n0 = 32 * nb;
    float wv[32];
#pragma unroll
    for (int i = 0; i < 32; ++i) { const int kk = 2 * i + (lane >> 5); wv[i] = __builtin_nontemporal_load(W + (size_t)(k0 + kk) * N + n0 + (lane & 31)); }
#pragma unroll
    for (int i = 0; i < 32; ++i) { const int kk = 2 * i + (lane >> 5); const float gv = g ? g[k0 + kk] : 1.0f; scr[kk * 33 + (lane & 31)] = wv[i] * gv; }
    LDS_WAIT(); asm volatile("" ::: "memory");
    const int c = lane & 7;
#pragma unroll
    for (int j = 0; j < 4; ++j) { const int n = (lane >> 3) + 8 * j; const LAS float* s = scr + (8 * c) * 33 + n;
        v4u o; o.x = pk2(s[0 * 33], s[1 * 33]); o.y = pk2(s[2 * 33], s[3 * 33]); o.z = pk2(s[4 * 33], s[5 * 33]); o.w = pk2(s[6 * 33], s[7 * 33]);
        int nn = n0 + n; if (PERMQK && nn < 2048) nn = (nn & ~63) + pi64(nn & 63);
        *(GAS v4u*)(WT + (size_t)(row_off + nn) * K + k0 + 8 * c) = o; }
    LDS_WAIT(); asm volatile("" ::: "memory");
}
__device__ __forceinline__ void p0_prologue(Frame& F, const Args& A) {
    unsigned char* ws = A.ws;
    LAS float* scr = (LAS float*)(F.lds + RING_OFF + F.wave * 16384);
    const int gw = F.vcu * NWAVES + F.wave, NGW = F.G * NWAVES;
    constexpr int I_QKV = 16 * 96, I_SQ = 16 * 32, I_KV = 16 * 64, I_F1 = 16 * 128, I_F2 = 64 * 32;
    constexpr int NITEMS = I_QKV + I_SQ + I_KV + I_SQ + I_SQ + 2 * I_F1 + 2 * I_F2;
    const float* g_attn = A.in[6]; const float* g_mlp = A.in[16];
    for (int it = gw; it < NITEMS; it += NGW) {
        int r = it;
        if (r < I_QKV) { p0_transpose_item<true>(A.in[7], g_attn, 1024, 3072, (bf16*)(ws + WS_WQKV), 0, scr, r, F.lane); continue; } r -= I_QKV;
        if (r < I_SQ) { p0_transpose_item<false>(A.in[10], nullptr, 1024, 1024, (bf16*)(ws + WS_WAO), 0, scr, r, F.lane); continue; } r -= I_SQ;
        if (r < I_KV) { p0_transpose_item<false>(A.in[12], A.in[11], 1024, 2048, (bf16*)(ws + WS_WKVQ), 0, scr, r, F.lane); continue; } r -= I_KV;
        if (r < I_SQ) { p0_transpose_item<false>(A.in[13], g_attn + 1024, 1024, 1024, (bf16*)(ws + WS_WKVQ), 2048, scr, r, F.lane); continue; } r -= I_SQ;
        if (r < I_SQ) { p0_transpose_item<false>(A.in[15], nullptr, 1024, 1024, (bf16*)(ws + WS_WBO), 0, scr, r, F.lane); continue; } r -= I_SQ;
        if (r < I_F1) { p0_transpose_item<false>(A.in[17], g_mlp, 1024, 4096, (bf16*)(ws + WS_W1), 0, scr, r, F.lane); continue; } r -= I_F1;
        if (r < I_F1) { p0_transpose_item<false>(A.in[17] + (size_t)1024 * 4096, g_mlp + 1024, 1024, 4096, (bf16*)(ws + WS_W1 + 8 * MiB), 0, scr, r, F.lane); continue; } r -= I_F1;
        if (r < I_F2) { p0_transpose_item<false>(A.in[18], nullptr, 4096, 1024, (bf16*)(ws + WS_W2), 0, scr, r, F.lane); continue; } r -= I_F2;
        p0_transpose_item<false>(A.in[18] + (size_t)4096 * 1024, nullptr, 4096, 1024, (bf16*)(ws + WS_W2 + 8 * MiB), 0, scr, r, F.lane);
    }
    bf16* HB = (bf16*)(ws + WS_HB); float* SS = (float*)(ws + WS_SS);
    for (int m = gw; m < M; m += NGW) {
        const float* xrow = (m < MP) ? A.in[0] + (size_t)m * 1024 : A.in[1] + (size_t)(m - MP) * 1024;
        const GAS f32x4* xr = (const GAS f32x4*)xrow + F.lane;
        f32x4 v[4]; float s = 0.f;
#pragma unroll
        for (int j = 0; j < 4; ++j) { v[j] = __builtin_nontemporal_load(xr + 64 * j); s += (v[j].x * v[j].x + v[j].y * v[j].y) + (v[j].z * v[j].z + v[j].w * v[j].w); }
        s = wave_sum(s);
        GAS unsigned long long* o8 = (GAS unsigned long long*)(HB + (size_t)m * 1024) + F.lane;
#pragma unroll
        for (int j = 0; j < 4; ++j) o8[64 * j] = (unsigned long long)pk2(v[j].x, v[j].y) | ((unsigned long long)pk2(v[j].z, v[j].w) << 32);
        if (F.lane < 16) SS[(size_t)m * 16 + F.lane] = (F.lane == 0) ? s : 0.f;
    }
    float* cs = (float*)(ws + WS_CS);
    for (int e = (F.vcu * NWAVES + F.wave) * 64 + F.lane; e < 2048 * 32; e += F.G * NWAVES * 64) {
        const int pos = e >> 5, i = e & 31;
        const float inv = 1.0f / powf(10000.0f, (float)i * (1.0f / 32.0f));
        const float ang = (float)pos * inv;
        float sv, cv; sincosf(ang, &sv, &cv);
        cs[(size_t)pos * 64 + i] = cv; cs[(size_t)pos * 64 + 32 + i] = sv;
    }
}
__device__ __forceinline__ void final_norm(Frame& F, const Args& A, int m_lo, int m_hi) {
    const int gw = F.vcu * NWAVES + F.wave, NGW = F.G * NWAVES;
    const float* SS = (const float*)(A.ws + WS_SS); const float* gf = A.in[19]; const bf16* HB = (const bf16*)(A.ws + WS_HB);
    f32x4 g[4];
#pragma unroll
    for (int j = 0; j < 4; ++j) g[j] = *((const f32x4*)gf + 4 * F.lane + j);
    for (int m = m_lo + gw; m < m_hi; m += NGW) {
        float s = (F.lane < 16) ? SS[(size_t)m * 16 + F.lane] : 0.f;
        s = wave_sum(s);
        const float r = 1.0f / sqrtf(s * (1.0f / 1024.0f) + 1e-6f);
        const v4u h0 = __builtin_nontemporal_load((const GAS v4u*)(HB + (size_t)m * 1024) + 2 * F.lane), h1 = __builtin_nontemporal_load((const GAS v4u*)(HB + (size_t)m * 1024) + 2 * F.lane + 1);
        GAS f32x4* yr = (GAS f32x4*)(A.out + (size_t)m * 1024) + 4 * F.lane;
        const unsigned w[8] = {h0.x, h0.y, h0.z, h0.w, h1.x, h1.y, h1.z, h1.w};
#pragma unroll
        for (int j = 0; j < 4; ++j) { f32x4 v; v.x = __uint_as_float(w[2 * j] << 16); v.y = __uint_as_float(w[2 * j] & 0xffff0000u); v.z = __uint_as_float(w[2 * j + 1] << 16); v.w = __uint_as_float(w[2 * j + 1] & 0xffff0000u);
            __builtin_nontemporal_store(v * g[j] * r, yr + j); }
    }
}

struct SplitBar { unsigned* bar; unsigned narr; };
__device__ __forceinline__ void sbar_arrive(SplitBar& sb, const XcdBarrier& b) {
    asm volatile("s_waitcnt vmcnt(0)" ::: "memory");
    __syncthreads();
    if (threadIdx.x == 0) {
        unsigned* bar = sb.bar;
        __builtin_amdgcn_s_waitcnt(0);
        const unsigned nloc = b.st[0], nx = b.st[1];
        const unsigned old = xb_add(&bar[XB_XSUB(b.x)], 1u);
        if ((old + 1u) % nloc == 0u) {
            __builtin_amdgcn_fence(__ATOMIC_RELEASE, "agent");
            asm volatile("s_waitcnt vmcnt(0)" ::: "memory");
            const unsigned og = xb_add(&bar[XB_TOP], 1u);
            if ((og + 1u) % nx == 0u) xb_add(&bar[XB_TOPGEN], 1u);
        }
    }
    ++sb.narr;
}
__device__ __forceinline__ void sbar_wait(const SplitBar& sb, const XcdBarrier& b) {
    if (threadIdx.x == 0) {
        unsigned* bar = sb.bar; unsigned* tb = b.bar;
        XB_SPIN(xb_ld(&bar[XB_TOPGEN]) < sb.narr, tb);
        __builtin_amdgcn_fence(__ATOMIC_ACQUIRE, "agent");
        asm volatile("s_waitcnt vmcnt(0)" ::: "memory");
    }
    __syncthreads();
}

__device__ __forceinline__ void sbar_arrive_wait(SplitBar& X, const SplitBar& Y, const XcdBarrier& b) {
    asm volatile("s_waitcnt vmcnt(0)" ::: "memory");
    __syncthreads();
    if (threadIdx.x == 0) {
        unsigned* xw = X.bar; unsigned* yw = Y.bar; unsigned* tb = b.bar;
        __builtin_amdgcn_s_waitcnt(0);
        const unsigned nloc = b.st[0], nx = b.st[1];
        asm volatile("buffer_inv sc1" ::: "memory");
        const unsigned gy = xb_ld(&yw[XB_TOPGEN]);
        const unsigned old = xb_add(&xw[XB_XSUB(b.x)], 1u);
        if ((old + 1u) % nloc == 0u) {
            __builtin_amdgcn_fence(__ATOMIC_RELEASE, "agent");
            asm volatile("s_waitcnt vmcnt(0)" ::: "memory");
            const unsigned og = xb_add(&xw[XB_TOP], 1u);
            if ((og + 1u) % nx == 0u) xb_add(&xw[XB_TOPGEN], 1u);
        }
        if (gy < Y.narr) XB_SPIN(xb_ld(&yw[XB_TOPGEN]) < Y.narr, tb);
        asm volatile("s_waitcnt vmcnt(0)" ::: "memory");
    }
    ++X.narr;
    __syncthreads();
}

template <int PH, int STREAM>
__device__ __forceinline__ void run_part(Frame& F, const Args& args) {
    unsigned char* const ws = args.ws;
    pg8::bf16_t* const HB = (pg8::bf16_t*)(ws + WS_HB); pg8::bf16_t* const QB = (pg8::bf16_t*)(ws + WS_Q); pg8::bf16_t* const KB = (pg8::bf16_t*)(ws + WS_K);
    pg8::bf16_t* const VB = (pg8::bf16_t*)(ws + WS_V); pg8::bf16_t* const OB = (pg8::bf16_t*)(ws + WS_O); pg8::bf16_t* const UB = (pg8::bf16_t*)(ws + WS_U);
    float* const SS = (float*)(ws + WS_SS);
    LAS float* const rst = (LAS float*)(F.lds + RS_OFF);
#define FILL_RS(N_) pg8::RsTab RSA{nullptr, 0, 0}, RSB{nullptr, 0, 0}; \
        if (STREAM == 1) { pg8::Unit u0; if (S.next(0, u0)) { pg8::rs_fill(SS, rst, u0.pm * 256, 256); RSA = pg8::RsTab{rst, u0.pm * 256, 256}; } } \
        else if (pg8::small_first_tile(F.vcu, 8 * ((N_) / 128), F.G) < 8 * ((N_) / 128)) { pg8::rs_fill(SS, rst + 256, MP + (F.vcu % 8) * 128, 128); RSB = pg8::RsTab{rst + 256, MP + (F.vcu % 8) * 128, 128}; } \
        __syncthreads();
#define RUN_GEMM(EPI, GEO, NTM, TN_) do { if (STREAM == 1) pg8::gemm_phase<pg8::EPI, pg8::StaticOrder, true, true>(F.lds + RING_OFF, g, S, E); \
        else pg8::gemm_small<pg8::GEO, pg8::EPI>(F.lds + RING_OFF, g.A, g.Bt, g.K, MP, NTM, g.N / (TN_), F.vcu, F.G, E); } while (0)
    if constexpr (PH == 1) {
        pg8::Gemm g{HB, (const pg8::bf16_t*)(ws + WS_WQKV), M, 3072, 1024}; pg8::StaticOrder S; S.init(MP, 3072, F.G, (int)blockIdx.x);
        FILL_RS(3072)
        pg8::EpiQKV E{SS, (const float*)(ws + WS_CS), QB, KB, VB, args.out, RSA, RSB};
        RUN_GEMM(EpiQKV, GeoS128, 8, 128);
    }
    if constexpr (PH == 2) {
        at::Ctx C{QB, KB, VB, OB, args.in[2], args.in[3], args.in[8], args.in[9], nullptr, nullptr, at::diff_lambda(args.in[8]), args.out};
        for (int vv = F.vcu; vv < 256; vv += F.G) {
            if (STREAM == 0) at::attn_sample_unit<false>(F.lds, vv >> 3, vv & 7, C);
            else { const int x = vv >> 5, c = vv & 31, u = c & 15;
                at::bf16x8 qr[4]; bool pre = false;
#pragma unroll 1
                for (int r = 0; r < 4; ++r) { const int bh = r * 16 + x * 2 + (c >> 4), ub = (r & 1) ? 15 - u : u; const bool hn = r < 3; const int r2 = r + 1, bh2 = r2 * 16 + x * 2 + (c >> 4), ub2 = (r2 & 1) ? 15 - u : u;
                    at::attn_prompt_unit<false>(F.lds, bh >> 3, bh & 7, ub, C, qr, pre, hn, bh2 >> 3, bh2 & 7, ub2); pre = hn; } }
        }
    }
    if constexpr (PH == 3 || PH == 8) {
        pg8::Gemm g{OB, (const pg8::bf16_t*)(ws + (PH == 3 ? WS_WAO : WS_WBO)), M, 1024, 1024}; pg8::StaticOrder S; S.init(MP, 1024, F.G, (int)blockIdx.x);
        pg8::EpiRes E{HB, SS, 1.f};
        RUN_GEMM(EpiRes, GeoS64, 16, 64);
    }
    if constexpr (PH == 4 || PH == 9) {
        pg8::Gemm g{HB, (const pg8::bf16_t*)(ws + WS_W1 + (PH == 9 ? 8 * MiB : 0)), M, FF, 1024}; pg8::StaticOrder S; S.init(MP, FF, F.G, (int)blockIdx.x);
        FILL_RS(FF)
        pg8::EpiFF1 E{SS, UB, FF, RSA, RSB};
        RUN_GEMM(EpiFF1, GeoS128, 8, 128);
    }
    if constexpr (PH == 5 || PH == 10) {
        pg8::Gemm g{UB, (const pg8::bf16_t*)(ws + WS_W2 + (PH == 10 ? 8 * MiB : 0)), M, 1024, FF}; pg8::StaticOrder S; S.init(MP, 1024, F.G, (int)blockIdx.x);
        pg8::EpiRes E{HB, SS, 1.f};
        if (STREAM == 1) pg8::gemm_phase<pg8::EpiRes, pg8::StaticOrder, true, true>(F.lds + RING_OFF, g, S, E);
        else pg8::gemm_small<pg8::GeoS12864, pg8::EpiRes>(F.lds + RING_OFF, g.A, g.Bt, g.K, MP, 8, 16, F.vcu, F.G, E);
    }
    if constexpr (PH == 6) {
        pg8::Gemm g{HB, (const pg8::bf16_t*)(ws + WS_WKVQ), M, 3072, 1024}; pg8::StaticOrder S; S.init(MP, 3072, F.G, (int)blockIdx.x);
        FILL_RS(3072)
        pg8::EpiKVQ E{SS, QB, KB, args.out, RSA, RSB};
        RUN_GEMM(EpiKVQ, GeoS128, 8, 128);
    }
    if constexpr (PH == 7) {
        at::Ctx C{QB, KB, VB, OB, args.in[4], args.in[5], nullptr, nullptr, args.in[14], nullptr, 0.f, args.out};
        for (int vv = F.vcu; vv < 256; vv += F.G) {
            if (STREAM == 0) at::attn_sample_unit<true>(F.lds, vv >> 3, vv & 7, C);
            else {
                at::bf16x8 qr[4]; bool pre = false;
#pragma unroll 1
                for (int i = 0; i < 4; ++i) { const int bhh = vv >> 1, par = vv & 1, qb = 4 * (i >> 1) + ((i & 1) ? 3 - par : par); const bool hn = i < 3; const int i2 = i + 1, qb2 = 4 * (i2 >> 1) + ((i2 & 1) ? 3 - par : par);
                    at::attn_prompt_unit<true>(F.lds, bhh >> 4, bhh & 15, qb, C, qr, pre, hn, bhh >> 4, bhh & 15, qb2); pre = hn; } }
        }
    }
    if constexpr (PH == 11) final_norm(F, args, STREAM == 0 ? MP : 0, STREAM == 0 ? M : MP);
#undef FILL_RS
#undef RUN_GEMM
}
__global__ void __launch_bounds__(NWAVES * 64, 2) skel_fwd(Args args) {
    extern __shared__ __attribute__((aligned(16))) unsigned char lds[];
    Frame F;
    F.lds = (LAS unsigned char*)lds;
    F.MISC = (volatile LAS unsigned*)(F.lds + MISC_OFF);
    F.tid = threadIdx.x; F.lane = F.tid & 63; F.wave = __builtin_amdgcn_readfirstlane(F.tid >> 6);
    F.G = gridDim.x; { const int bx = blockIdx.x; F.vcu = (F.G % 8 == 0) ? (bx % 8) * (F.G / 8) + bx / 8 : bx; }
    F.ctl = (gu32*)(args.ws + WS_CTL);
    for (int u = F.tid; u < (LDS_BYTES - LDSCTL_OFF) / 4; u += NWAVES * 64) ((LAS unsigned*)(F.lds + LDSCTL_OFF))[u] = 0u;
    __syncthreads();
    XcdBarrier bar = xcd_barrier_post((unsigned*)(F.ctl + CW_BAR), F.MISC + 8);
    SplitBar sbS{(unsigned*)(F.ctl + CW_BAR) + 4096, 0u}, sbP{(unsigned*)(F.ctl + CW_BAR) + 8192, 0u};
    p0_prologue(F, args);
    xcd_barrier(bar);
#ifdef PROBE_PART
#define RT_ST(v) asm volatile("s_memrealtime %0\n\ts_waitcnt lgkmcnt(0)" : "=s"(v) :: "memory")
    unsigned long long part_acc = 0;
#define TIMED_PART(k, s) do { unsigned long long a_, b_; RT_ST(a_); run_part<k, s>(F, args); RT_ST(b_); if ((k) * 2 + (s) == PROBE_PART) part_acc += b_ - a_; } while (0)
#elif defined(DUP_PART)
#define TIMED_PART(k, s) do { run_part<k, s>(F, args); if ((k) * 2 + (s) == DUP_PART) { __syncthreads(); run_part<k, s>(F, args); } } while (0)
#elif defined(DUP_PART)
#define TIMED_PART(k, s) do { run_part<k, s>(F, args); if ((k) * 2 + (s) == DUP_PART) { __syncthreads(); run_part<k, s>(F, args); } } while (0)
#else
#define TIMED_PART(k, s) run_part<k, s>(F, args)
#endif
#define DO_PHASE(k, FIRST) do { TIMED_PART(k, 0); if (FIRST) sbar_arrive(sbS, bar); else sbar_arrive_wait(sbS, sbP, bar); \
                                 TIMED_PART(k, 1); sbar_arrive_wait(sbP, sbS, bar); } while (0)
    DO_PHASE(1, true); DO_PHASE(2, false); DO_PHASE(3, false); DO_PHASE(4, false); DO_PHASE(5, false); DO_PHASE(6, false); DO_PHASE(7, false); DO_PHASE(8, false); DO_PHASE(9, false); DO_PHASE(10, false);
#undef DO_PHASE
    run_part<11, 0>(F, args);
    sbar_wait(sbP, bar); run_part<11, 1>(F, args);
#ifdef PROBE_PART
    if (blockIdx.x == PROBE_BLK && F.tid == 0) { unsigned long long t0; RT_ST(t0); for (;;) { unsigned long long t1; RT_ST(t1); if (t1 - t0 >= part_acc) break; __builtin_amdgcn_s_sleep(8); } }
#endif
}

extern "C" void kernel_launch(void* const* d_in, const int* in_sizes, int n_in, void* d_out, int out_size, void* d_ws, size_t ws_size, hipStream_t stream) {
    static int grid = 0;
    if (grid == 0) {
        if (n_in != 20 || out_size != (int)O_END || ws_size < WS_END) { fprintf(stderr, "kernel_launch: unexpected problem (n_in %d out %d ws %zu)\n", n_in, out_size, ws_size); grid = -1; return; }
        int dev = 0, cus = 0, per_cu = 0;
        if (hipGetDevice(&dev) != hipSuccess || hipDeviceGetAttribute(&cus, hipDeviceAttributeMultiprocessorCount, dev) != hipSuccess) { grid = -1; return; }
        if (hipFuncSetAttribute((const void*)skel_fwd, hipFuncAttributeMaxDynamicSharedMemorySize, LDS_BYTES) != hipSuccess) { fprintf(stderr, "kernel_launch: hipFuncSetAttribute failed\n"); grid = -1; return; }
        if (hipOccupancyMaxActiveBlocksPerMultiprocessor(&per_cu, (const void*)skel_fwd, NWAVES * 64, LDS_BYTES) != hipSuccess || per_cu < 1) { fprintf(stderr, "kernel_launch: occupancy query reports %d\n", per_cu); per_cu = 1; }
        (void)hipGetLastError();
        grid = cus;
        if (grid > 256) grid = 256;
    }
    if (grid < 0) return;
    (void)hipMemsetAsync((char*)d_ws + WS_CTL, 0, CTL_ZERO_BYTES, stream);
    Args a{};
    for (int i = 0; i < 20; ++i) a.in[i] = (const float*)d_in[i];
    a.out = (float*)d_out; a.ws = (unsigned char*)d_ws;
    hipLaunchKernelGGL(skel_fwd, dim3(grid), dim3(NWAVES * 64), LDS_BYTES, stream, a);
}
```
